# Optimizing an MI355X kernel written in HIP

```python
import math
import jax, jax.numpy as jnp
from jax import lax
import numpy as np

D_MODEL = 2048
BATCH = 4
SEQ = 8192
DEPTH = 1

D_RNN = 2048
RNN_HEADS = 16
RNN_BLOCK = D_RNN // RNN_HEADS
CONV_WIDTH = 4
LRU_C = 8.0
MLA_HEADS = 16
Q_LORA = 512
KV_LORA = 512
QK_NOPE = 128
QK_ROPE = 64
V_HEAD = 128
ROPE_THETA = 10000.0
Q_BLOCK = 128
PEER_HEADS = 8
N_KEYS = 128
N_EXPERTS = N_KEYS * N_KEYS
D_KEY = 256
PEER_TOPK = 16
PEER_CHUNK = 128
DN_ALPHA = (2.0 * DEPTH) ** 0.25
DN_BETA = (8.0 * DEPTH) ** -0.25
LN_EPS = 1e-5
RMS_EPS = 1e-6
IN_WIDTHS = (D_RNN, D_RNN, Q_LORA, KV_LORA, QK_ROPE, D_MODEL, D_MODEL)
IN_COLS = sum(IN_WIDTHS)
IN_SPLITS = tuple(int(v) for v in np.cumsum(IN_WIDTHS)[:-1])

kernel_name = "hybrid_rglru_mla_peer_deepnorm_adaln"


def layer_norm(x, g, b):
    xf = x.astype(jnp.float32)
    mu = jnp.mean(xf, -1, keepdims=True)
    var = jnp.mean(jnp.square(xf - mu), -1, keepdims=True)
    return ((xf - mu) * lax.rsqrt(var + LN_EPS)).astype(x.dtype) * g + b


def rms_norm(x, g):
    xf = x.astype(jnp.float32)
    return (xf * lax.rsqrt(jnp.mean(xf * xf, -1, keepdims=True) + RMS_EPS)).astype(x.dtype) * g


def apply_rope(x, cos, sin):
    x1, x2 = jnp.split(x, 2, axis=-1)
    return jnp.concatenate([x1 * cos - x2 * sin, x2 * cos + x1 * sin], axis=-1)


def rg_lru_branch(xr, gr, conv_w, conv_b, w_a, b_a, w_x, b_x, lam):
    B, S, _ = xr.shape
    xc = lax.conv_general_dilated(
        xr, conv_w[:, None, :], window_strides=(1,), padding=[(CONV_WIDTH - 1, 0)],
        dimension_numbers=('NWC', 'WIO', 'NWC'), feature_group_count=D_RNN) + conv_b
    xh = xc.reshape(B, S, RNN_HEADS, RNN_BLOCK)
    r = jax.nn.sigmoid(jnp.einsum('bshi,hij->bshj', xh, w_a).reshape(B, S, D_RNN) + b_a)
    i = jax.nn.sigmoid(jnp.einsum('bshi,hij->bshj', xh, w_x).reshape(B, S, D_RNN) + b_x)
    log_a = (-LRU_C * r.astype(jnp.float32)) * jax.nn.softplus(-lam.astype(jnp.float32))
    a = jnp.exp(log_a)
    mult = jnp.sqrt(-jnp.expm1(2.0 * log_a))
    bx = mult * (i * xc).astype(jnp.float32)

    def combine(left, right):
        a1, b1 = left
        a2, b2 = right
        return a1 * a2, a2 * b1 + b2

    _, h = lax.associative_scan(combine, (a, bx), axis=1)
    return h.astype(xr.dtype) * jax.nn.gelu(gr)


def mla_branch(q_c, kv_c, k_r, cos, sin, q_norm_g, w_uq, kv_norm_g, w_ukv):
    B, S, _ = q_c.shape
    q = (rms_norm(q_c, q_norm_g) @ w_uq).reshape(B, S, MLA_HEADS, QK_NOPE + QK_ROPE)
    q_nope = q[..., :QK_NOPE]
    q_rope = apply_rope(q[..., QK_NOPE:], cos[:, :, None, :], sin[:, :, None, :])
    kv = (rms_norm(kv_c, kv_norm_g) @ w_ukv).reshape(B, S, MLA_HEADS, QK_NOPE + V_HEAD)
    k_nope = kv[..., :QK_NOPE]
    v = kv[..., QK_NOPE:]
    k_rope = apply_rope(k_r, cos, sin)
    scale = (QK_NOPE + QK_ROPE) ** -0.5
    nb = S // Q_BLOCK
    qn_blocks = q_nope.reshape(B, nb, Q_BLOCK, MLA_HEADS, QK_NOPE).transpose(1, 0, 2, 3, 4)
    qr_blocks = q_rope.reshape(B, nb, Q_BLOCK, MLA_HEADS, QK_ROPE).transpose(1, 0, 2, 3, 4)
    key_pos = jnp.arange(S)

    def attend(args):
        qn, qr, blk = args
        s = (jnp.einsum('bqhd,bkhd->bhqk', qn, k_nope)
             + jnp.einsum('bqhr,bkr->bhqk', qr, k_rope)).astype(jnp.float32) * scale
        q_pos = blk * Q_BLOCK + jnp.arange(Q_BLOCK)
        causal = key_pos[None, :] <= q_pos[:, None]
        s = jnp.where(causal, s, -jnp.inf)
        p = jax.nn.softmax(s, axis=-1).astype(v.dtype)
        return jnp.einsum('bhqk,bkhd->bqhd', p, v)

    o = lax.map(attend, (qn_blocks, qr_blocks, jnp.arange(nb)))
    return o.transpose(1, 0, 2, 3, 4).reshape(B, S, MLA_HEADS * V_HEAD)


def peer_ffn(u, w_q, sub_keys, expert_u, expert_v):
    B, S, D = u.shape
    T = B * S
    ut = u.reshape(T, D)
    q = (ut @ w_q).reshape(T, PEER_HEADS, 2, D_KEY // 2)
    s = jnp.einsum('thpd,pnd->thpn', q, sub_keys).astype(jnp.float32)
    top_s, top_i = lax.top_k(s, PEER_TOPK)
    cand_s = top_s[:, :, 0, :, None] + top_s[:, :, 1, None, :]
    cand_i = top_i[:, :, 0, :, None] * N_KEYS + top_i[:, :, 1, None, :]
    best_s, best_j = lax.top_k(cand_s.reshape(T, PEER_HEADS, PEER_TOPK * PEER_TOPK), PEER_TOPK)
    idx = jnp.take_along_axis(cand_i.reshape(T, PEER_HEADS, PEER_TOPK * PEER_TOPK), best_j, axis=-1)
    g = jax.nn.softmax(best_s, axis=-1).astype(u.dtype)
    nc = T // PEER_CHUNK

    def experts(args):
        xc, ic, gc = args
        act = jax.nn.gelu(jnp.einsum('cd,chkd->chk', xc, jnp.take(expert_u, ic, axis=0))) * gc
        return jnp.einsum('chk,chkd->cd', act, jnp.take(expert_v, ic, axis=0))

    y = lax.map(experts, (ut.reshape(nc, PEER_CHUNK, D),
                          idx.reshape(nc, PEER_CHUNK, PEER_HEADS, PEER_TOPK),
                          g.reshape(nc, PEER_CHUNK, PEER_HEADS, PEER_TOPK)))
    return y.reshape(B, S, D)


def setup_inputs(seed: int = 0) -> dict:
    key = jax.random.key(seed)
    ks = jax.random.split(key, 32)
    L, D = DEPTH, D_MODEL
    f32 = jnp.float32

    def nrm(k, shape, scale):
        return jax.random.normal(k, shape, f32) * scale

    x = jax.random.normal(ks[0], (BATCH, SEQ, D), f32)
    c = jax.random.normal(ks[1], (BATCH, D), f32)
    offs = jax.random.randint(ks[2], (BATCH, 1), 0, 1024, dtype=jnp.int32)
    positions = (offs + jnp.arange(SEQ, dtype=jnp.int32)[None, :]).astype(jnp.int32)
    a0 = jax.random.uniform(ks[3], (L, D_RNN), f32, 0.9, 0.999)
    p0 = a0 ** (1.0 / LRU_C)
    rg_lambda = jnp.log(p0) - jnp.log1p(-p0)
    return {
        "x": x,
        "c": c,
        "positions": positions,
        "w_ada": nrm(ks[4], (L, D, 6 * D), 0.1 * D ** -0.5),
        "b_ada": nrm(ks[5], (L, 6 * D), 0.01),
        "w_in": nrm(ks[6], (L, D, IN_COLS), D ** -0.5),
        "conv_w": nrm(ks[7], (L, CONV_WIDTH, D_RNN), CONV_WIDTH ** -0.5),
        "conv_b": nrm(ks[8], (L, D_RNN), 0.01),
        "w_rg_a": nrm(ks[9], (L, RNN_HEADS, RNN_BLOCK, RNN_BLOCK), RNN_BLOCK ** -0.5),
        "b_rg_a": nrm(ks[10], (L, D_RNN), 0.01),
        "w_rg_x": nrm(ks[11], (L, RNN_HEADS, RNN_BLOCK, RNN_BLOCK), RNN_BLOCK ** -0.5),
        "b_rg_x": nrm(ks[12], (L, D_RNN), 0.01),
        "rg_lambda": rg_lambda,
        "w_rnn_out": nrm(ks[13], (L, D_RNN, D), DN_BETA * D_RNN ** -0.5),
        "q_norm_g": 1.0 + nrm(ks[14], (L, Q_LORA), 0.01),
        "w_uq": nrm(ks[15], (L, Q_LORA, MLA_HEADS * (QK_NOPE + QK_ROPE)), Q_LORA ** -0.5),
        "kv_norm_g": 1.0 + nrm(ks[16], (L, KV_LORA), 0.01),
        "w_ukv": nrm(ks[17], (L, KV_LORA, MLA_HEADS * (QK_NOPE + V_HEAD)), KV_LORA ** -0.5),
        "w_mla_out": nrm(ks[18], (L, MLA_HEADS * V_HEAD, D), DN_BETA * (MLA_HEADS * V_HEAD) ** -0.5),
        "w_o": nrm(ks[19], (L, D, D), DN_BETA * D ** -0.5),
        "ln1_g": 1.0 + nrm(ks[20], (L, D), 0.01),
        "ln1_b": nrm(ks[21], (L, D), 0.01),
        "peer_wq": nrm(ks[22], (L, D, PEER_HEADS * D_KEY), D ** -0.5),
        "peer_keys": nrm(ks[23], (L, 2, N_KEYS, D_KEY // 2), (D_KEY // 2) ** -0.5),
        "peer_u": nrm(ks[24], (L, N_EXPERTS, D), D ** -0.5),
        "peer_v": nrm(ks[25], (L, N_EXPERTS, D), DN_BETA),
        "ln2_g": 1.0 + nrm(ks[26], (L, D), 0.01),
        "ln2_b": nrm(ks[27], (L, D), 0.01),
    }


def reference(x, c, positions, w_ada, b_ada, w_in, conv_w, conv_b, w_rg_a, b_rg_a, w_rg_x, b_rg_x,
              rg_lambda, w_rnn_out, q_norm_g, w_uq, kv_norm_g, w_ukv, w_mla_out, w_o, ln1_g, ln1_b,
              peer_wq, peer_keys, peer_u, peer_v, ln2_g, ln2_b):
    inv_freq = ROPE_THETA ** (-jnp.arange(0, QK_ROPE, 2, dtype=jnp.float32) / QK_ROPE)
    ang = positions.astype(jnp.float32)[..., None] * inv_freq
    cos = jnp.cos(ang).astype(x.dtype)
    sin = jnp.sin(ang).astype(x.dtype)
    c_act = jax.nn.silu(c)
    for l in range(DEPTH):
        mod = c_act @ w_ada[l] + b_ada[l]
        sh1, sc1, gt1, sh2, sc2, gt2 = [m[:, None, :] for m in jnp.split(mod, 6, axis=-1)]

        h = x * (1.0 + sc1) + sh1
        proj = h @ w_in[l]
        xr, gr, q_c, kv_c, k_r, g_rnn, g_mla = jnp.split(proj, IN_SPLITS, axis=-1)
        y_rnn = rg_lru_branch(xr, gr, conv_w[l], conv_b[l], w_rg_a[l], b_rg_a[l],
                              w_rg_x[l], b_rg_x[l], rg_lambda[l]) @ w_rnn_out[l]
        y_mla = mla_branch(q_c, kv_c, k_r, cos, sin, q_norm_g[l], w_uq[l],
                           kv_norm_g[l], w_ukv[l]) @ w_mla_out[l]
        mixed = (jax.nn.sigmoid(g_rnn) * y_rnn + jax.nn.sigmoid(g_mla) * y_mla) @ w_o[l]
        x = layer_norm(DN_ALPHA * x + (1.0 + gt1) * mixed, ln1_g[l], ln1_b[l])

        h = x * (1.0 + sc2) + sh2
        y_ffn = peer_ffn(h, peer_wq[l], peer_keys[l], peer_u[l], peer_v[l])
        x = layer_norm(DN_ALPHA * x + (1.0 + gt2) * y_ffn, ln2_g[l], ln2_b[l])
    return x
```

```cpp
#include <hip/hip_runtime.h>
#include <cstdio>
#include <cstdint>

#ifndef MK_N_LAUNCHES
#define MK_N_LAUNCHES 1
#endif

#define LAS __attribute__((address_space(3)))
#define GAS __attribute__((address_space(1)))
typedef unsigned short bf16;
typedef short bf16x8 __attribute__((ext_vector_type(8)));
typedef float f32x2 __attribute__((ext_vector_type(2)));
typedef _Float16 f16x2 __attribute__((ext_vector_type(2)));
typedef float f32x4 __attribute__((ext_vector_type(4)));
typedef float f32x16 __attribute__((ext_vector_type(16)));
typedef unsigned u32x2 __attribute__((ext_vector_type(2)));
typedef unsigned u32x4 __attribute__((ext_vector_type(4)));
typedef int i32x4 __attribute__((ext_vector_type(4)));
typedef int i32x8 __attribute__((ext_vector_type(8)));

constexpr int NB = 4, SEQ = 8192, DM = 2048, NT = NB * SEQ;
constexpr int NH = 16, QLORA = 512, KVLORA = 512, DNOPE = 128, DROPE = 64, DV = 128, DQK = 192;
constexpr int IN_COLS = 9280, NPROJ = 9472;
constexpr int PEER_H = 8, NKEYS = 128, TOPK = 16;
constexpr float DN_ALPHA = 1.189207115002721f;
constexpr float LN_EPS = 1e-5f, RMS_EPS = 1e-6f;
constexpr float QSCALE = 0.07216878364870322f * 1.4426950408889634f;
constexpr int NWAVES = 8, NTHREADS = 512;
constexpr float PU_SCALE = 1024.0f, PV_SCALE = 64.0f;
constexpr float SC_H = 16.0f, SC_WIN = 1024.0f, SC_RA = 4.0f, SC_AO = 32.0f, SC_TMP = 32.0f, SC_WSQ = 2048.0f;
constexpr float SC_Q = 64.0f, SC_K = 16.0f, SC_V = 16.0f, SC_P = 64.0f;

constexpr size_t MiB = 1u << 20;
constexpr size_t WS_CTL = 0, CTL_ZERO_BYTES = 1 * MiB;
constexpr size_t WS_MOD = 1 * MiB;
constexpr size_t WS_RS = 1 * MiB + 512 * 1024;
constexpr size_t WS_SSP = 100 * MiB;
constexpr size_t WS_ROPE = 2 * MiB;
constexpr size_t WS_WIN = 10 * MiB;
constexpr size_t WS_WRNN = 47 * MiB, WS_WMLA = 55 * MiB, WS_WO = 63 * MiB, WS_WPQ = 71 * MiB;
constexpr size_t WS_WUQ = 79 * MiB;
constexpr size_t WS_WUK = 82 * MiB, WS_WUV = 84 * MiB;
constexpr size_t WS_WGA = 86 * MiB;
constexpr size_t WS_WGX = 86 * MiB + 512 * 1024;
constexpr size_t WS_PKEYS = 87 * MiB;
constexpr size_t WS_SUMM = 88 * MiB;
constexpr size_t WS_KR = 90 * MiB;
constexpr size_t WS_S0 = 128 * MiB;
constexpr size_t WS_XR = 256 * MiB, WS_GG = 384 * MiB, WS_SGR = 512 * MiB, WS_SGM = 640 * MiB;
constexpr size_t WS_QKVC = 768 * MiB;
constexpr size_t WS_KVC8 = 800 * MiB;
constexpr size_t WS_TMP = 832 * MiB;
constexpr size_t WS_IDX = 960 * MiB, WS_GATE = 976 * MiB;
constexpr size_t WS_TMP8 = 768 * MiB;
constexpr size_t WS_K = 256 * MiB;
constexpr size_t WS_VT = 448 * MiB;
constexpr size_t WS_R1 = 256 * MiB;
constexpr size_t WS_PQ = 512 * MiB;
constexpr size_t WS_PU = 640 * MiB, WS_PV = 704 * MiB;
constexpr size_t WS_END = 1024 * MiB;
constexpr size_t WS_WQS = WS_WPQ + 4 * MiB;
constexpr size_t CTL_WQAMAX = 32768 * 4;
constexpr size_t WS_H2I = 768 * MiB;
constexpr size_t WS_HSC = 100 * MiB, WS_USC = 101 * MiB, WS_VSC = 102 * MiB;
constexpr size_t WS_AO8 = WS_S0 + 64 * MiB;
constexpr size_t OUT_Q = 0, OUT_K = 96 * MiB, OUT_VT = 192 * MiB;

constexpr int LDS_BYTES = 147456, LDSCTL_OFF = 146944;

typedef __bf16 bf16v2 __attribute__((ext_vector_type(2)));
__device__ __forceinline__ unsigned pk2(float lo, float hi) { const bf16v2 v = __builtin_convertvector((f32x2){lo, hi}, bf16v2); return __builtin_bit_cast(unsigned, v); }
__device__ __forceinline__ float bflo(unsigned w) { return __uint_as_float(w << 16); }
__device__ __forceinline__ float bfhi(unsigned w) { return __uint_as_float(w & 0xffff0000u); }
__device__ __forceinline__ float bf1(bf16 b) { return __uint_as_float(((unsigned)b) << 16); }
__device__ __forceinline__ float sigmoidf_(float y) { return __builtin_amdgcn_rcpf(1.0f + __builtin_amdgcn_exp2f(-1.4426950408889634f * y)); }
__device__ __forceinline__ float gelu_tanh(float x) { const float z = 0.7978845608028654f * (x + 0.044715f * x * x * x); return x * sigmoidf_(2.0f * z); }
__device__ __forceinline__ float wave_sum(float v) {
#pragma unroll
    for (int o = 1; o < 64; o <<= 1) v += __shfl_xor(v, o);
    return v;
}
__device__ __forceinline__ float clamp448(float v) { return __builtin_amdgcn_fmed3f(v, -448.0f, 448.0f); }
__device__ __forceinline__ unsigned pk4_f8(float a, float b, float c, float d) { int w = __builtin_amdgcn_cvt_pk_fp8_f32(clamp448(a), clamp448(b), 0, false); w = __builtin_amdgcn_cvt_pk_fp8_f32(clamp448(c), clamp448(d), w, true); return (unsigned)w; }
__device__ __forceinline__ int fresh_lane() { int l; asm volatile("v_mbcnt_lo_u32_b32 %0, -1, 0\n\tv_mbcnt_hi_u32_b32 %0, -1, %0" : "=v"(l)); return l; }
__device__ __forceinline__ float wave_max(float v) {
#pragma unroll
    for (int o = 1; o < 64; o <<= 1) v = fmaxf(v, __shfl_xor(v, o));
    return v;
}
__device__ __forceinline__ unsigned pk4_i8(float a, float b, float c, float d) {
    const int ia = (int)__builtin_rintf(__builtin_amdgcn_fmed3f(a, -127.f, 127.f)), ib = (int)__builtin_rintf(__builtin_amdgcn_fmed3f(b, -127.f, 127.f)), ic = (int)__builtin_rintf(__builtin_amdgcn_fmed3f(c, -127.f, 127.f)), id = (int)__builtin_rintf(__builtin_amdgcn_fmed3f(d, -127.f, 127.f));
    return (unsigned)(ia & 0xff) | ((unsigned)(ib & 0xff) << 8) | ((unsigned)(ic & 0xff) << 16) | ((unsigned)id << 24); }
#define LDS_WAIT() asm volatile("s_waitcnt lgkmcnt(0)" ::: "memory")
#define VM_WAIT() asm volatile("s_waitcnt vmcnt(0)" ::: "memory")

#define XB_TMO      128
#define XB_XCNT(j)  (256  + 64 * (j))
#define XB_XSUB(j)  (1280 + 64 * (j))
#define XB_XGEN(j)  (2304 + 64 * (j))
#define XB_TOP      3328
#define XB_TOPGEN   3392
#define XCD_BAR_WORDS 3456
#define XB_SPIN_CAP (1u << 20)
__device__ __forceinline__ unsigned xb_ld(unsigned* p)              { return __hip_atomic_load(p, __ATOMIC_RELAXED, __HIP_MEMORY_SCOPE_AGENT); }
__device__ __forceinline__ unsigned xb_add(unsigned* p, unsigned v) { return __hip_atomic_fetch_add(p, v, __ATOMIC_RELAXED, __HIP_MEMORY_SCOPE_AGENT); }
__device__ __forceinline__ unsigned xb_xcc_id() { return (unsigned)__builtin_amdgcn_s_getreg((3 << 11) | 20) & 0xFu; }
#define XB_SPIN(cond, bar) do { unsigned _sp = 0; while (cond) { __builtin_amdgcn_s_sleep(1); \
    if ((++_sp & 255u) == 0u) { if (xb_ld(&(bar)[XB_TMO])) break; if (_sp > XB_SPIN_CAP) { atomicAdd(&(bar)[XB_TMO], 1u); break; } } } } while (0)
struct XcdBarrier { unsigned* bar; unsigned x; volatile LAS unsigned* st; };
__device__ __forceinline__ XcdBarrier xcd_barrier_post(unsigned* bar, volatile LAS unsigned* st) {
    XcdBarrier b; b.bar = bar; b.x = xb_xcc_id(); b.st = st;
    if (threadIdx.x == 0) (void)xb_add(&bar[XB_XCNT(b.x)], 1u);
    return b;
}
__device__ __forceinline__ void xcd_barrier_complete(unsigned* bar, unsigned x, unsigned& nloc, unsigned& nx) {
    const unsigned G = gridDim.x * gridDim.y * gridDim.z;
    unsigned sum, cnt, mine, sp = 0u;
    for (;;) {
        sum = 0u; cnt = 0u; mine = 0u;
#pragma unroll
        for (unsigned j = 0; j < 16; ++j) { const unsigned c = xb_ld(&bar[XB_XCNT(j)]); sum += c; cnt += (c > 0u) ? 1u : 0u; mine = (j == x) ? c : mine; }
        if (sum == G) break;
        __builtin_amdgcn_s_sleep(1);
        if ((++sp & 255u) == 0u) { if (xb_ld(&bar[XB_TMO])) break; if (sp > XB_SPIN_CAP) { atomicAdd(&bar[XB_TMO], 1u); break; } }
    }
    nloc = mine > 0u ? mine : 1u; nx = cnt > 0u ? cnt : 1u;
}
__device__ __forceinline__ void xcd_barrier(const XcdBarrier& b) {
    asm volatile("s_waitcnt vmcnt(0)" ::: "memory");
    __syncthreads();
    if (threadIdx.x == 0) {
        unsigned* bar = b.bar;
        __builtin_amdgcn_s_waitcnt(0);
        unsigned nloc = b.st[0], nx = b.st[1];
        if (nloc == 0u) { xcd_barrier_complete(bar, b.x, nloc, nx); b.st[0] = nloc; b.st[1] = nx; }
        const unsigned old = xb_add(&bar[XB_XSUB(b.x)], 1u);
        const unsigned gen = old / nloc;
        if (old + 1u == (gen + 1u) * nloc) {
            __builtin_amdgcn_fence(__ATOMIC_RELEASE, "agent");
            asm volatile("s_waitcnt vmcnt(0)" ::: "memory");
            const unsigned og = xb_add(&bar[XB_TOP], 1u);
            const unsigned tg = og / nx;
            if (og + 1u == (tg + 1u) * nx) xb_add(&bar[XB_TOPGEN], 1u);
            else XB_SPIN(xb_ld(&bar[XB_TOPGEN]) == tg, bar);
            __builtin_amdgcn_fence(__ATOMIC_ACQUIRE, "agent");
            asm volatile("s_waitcnt vmcnt(0)" ::: "memory");
        } else {
            XB_SPIN(xb_ld(&bar[XB_TOPGEN]) == gen, bar);
            __builtin_amdgcn_fence(__ATOMIC_ACQUIRE, "agent");
            asm volatile("s_waitcnt vmcnt(0)" ::: "memory");
        }
    }
    __syncthreads();
}

__device__ __forceinline__ void glds16(const char* sbase, unsigned voff, unsigned lds_dst) {
    unsigned keep;
    asm volatile("s_mov_b32 %0, m0\n\ts_mov_b32 m0, %3\n\ts_nop 0\n\tglobal_load_lds_dwordx4 %1, %2\n\ts_mov_b32 m0, %0" : "=&s"(keep) : "v"(voff), "s"(sbase), "s"(lds_dst) : "memory");
}
namespace pg8 {
constexpr int BM = 256, BK = 64, HALF = 128, HTB = HALF * BK * 2, STAGE_BYTES = 8 * HTB, NXCD = 8, WGM = 4;
__host__ __device__ __forceinline__ int lds_byte(int r, int c) { const int st = (r >> 4) * 2 + (c >> 5), rr = r & 15, cc = c & 31, ob = rr * 64 + cc * 2; return st * 1024 + (ob ^ (((ob >> 9) & 1) << 5)); }
__host__ __device__ __forceinline__ void stage_rc(int b, int& R, int& C) { const int st = b / 1024, sb = b % 1024, swz = sb ^ (((sb >> 9) & 1) << 5); R = (st >> 1) * 16 + swz / 64; C = (st & 1) * 32 + (swz % 64) / 2; }
__host__ __device__ __forceinline__ int perm32(int rho) { const int n = rho >> 4, i = rho & 15; return 8 * (i >> 2) + 4 * n + (i & 3); }
struct Unit { int pm, pn; };
struct Gemm { const void* A; const void* Bt; int M, N, nt, lda_b, ldb_b; const void* A2 = nullptr; const void* Bt2 = nullptr; int nt1 = 0; };
__host__ __device__ __forceinline__ Gemm gemm_bf16(const bf16* A, const bf16* Bt, int M, int N, int K, int lda, int ldb) { return Gemm{A, Bt, M, N, K / 64, lda * 2, ldb * 2}; }
__host__ __device__ __forceinline__ Gemm gemm_f8(const unsigned char* A, const unsigned char* Bt, int M, int N, int K, int lda, int ldb) { return Gemm{A, Bt, M, N, K / 128, lda, ldb}; }
struct StaticOrder {
    int nM, nN, nwg, G, c;
    __host__ __device__ void init(int M, int N, int G_, int c_) { nM = M / BM; nN = N / BM; nwg = nM * nN; G = G_; c = c_; }
    __host__ __device__ bool next(int i, Unit& u) const {
        const long L = (long)i * G + c; if (L >= nwg) return false;
        int wgid = (int)L; { const int q = nwg / NXCD, r = nwg % NXCD, xcd = wgid % NXCD, off = wgid / NXCD; wgid = (xcd < r ? xcd * (q + 1) : r * (q + 1) + (xcd - r) * q) + off; }
        const int nig = WGM * nN, gid = wgid / nig, fm = gid * WGM, gsz = (nM - fm) < WGM ? (nM - fm) : WGM;
        u.pm = fm + ((wgid % nig) % gsz); u.pn = (wgid % nig) / gsz; return true;
    }
    __device__ __forceinline__ void a_ready(const Unit&) const {}
    __device__ __forceinline__ void done(const Unit&) const {}
};
template <class Epi, class Sched, int F8 = 0, bool ALIGN_EPI = true>
__device__ __forceinline__ void gemm_phase(LAS unsigned char* lds, const Gemm g, const Sched& S, const Epi& E, int wid) {
    const int lane = fresh_lane(), tid = wid * 64 + lane, wr = wid >> 2, wc = wid & 3, fr = lane & 15, fq = lane >> 4;
    const int nt = g.nt;
    unsigned voffA, voffB;
    { int R, C; stage_rc(tid * 16, R, C); const int Rb = Epi::PERM ? ((R & ~31) + perm32(R & 31)) : R; voffA = (unsigned)(R * g.lda_b + C * 2); voffB = (unsigned)(Rb * g.ldb_b + C * 2); }
    const size_t qstepA = (size_t)64 * g.lda_b, qstepB = (size_t)64 * g.ldb_b;
    const unsigned ldsbase = (unsigned)(size_t)lds;
    const size_t kstep = (size_t)(BK * 2);
    const size_t hstepA = (size_t)HALF * g.lda_b, hstepB = (size_t)HALF * g.ldb_b;
    const size_t tstepA = 2 * hstepA, tstepB = 2 * hstepB;
    const unsigned ldsw = (unsigned)wid * 1024u;
    const int aoff = lds_byte(wr * 64 + fr, fq * 8), boff = lds_byte(wc * 32 + fr, fq * 8);
#define PG8_SA(b, h) (((b) * 2 + (h)) * HTB)
#define PG8_SB(b, h) ((4 + (b) * 2 + (h)) * HTB)
#define PG8_STAGE_A(bufoff, gbase) do { glds16((const char*)(gbase), voffA, ldsbase + (bufoff) + ldsw); glds16((const char*)(gbase) + qstepA, voffA, ldsbase + (bufoff) + ldsw + 8192); } while (0)
#define PG8_STAGE_B(bufoff, gbase) do { glds16((const char*)(gbase), voffB, ldsbase + (bufoff) + ldsw); glds16((const char*)(gbase) + qstepB, voffB, ldsbase + (bufoff) + ldsw + 8192); } while (0)
#define PG8_LD8(p) __builtin_shufflevector(*(const LAS i32x4*)(p), *(const LAS i32x4*)((p) + 1024), 0, 1, 2, 3, 4, 5, 6, 7)
#define PG8_LDA(dst, b, h) do { _Pragma("unroll") for (int m = 0; m < 4; ++m) dst[m] = PG8_LD8(lds + PG8_SA(b, h) + aoff + m * 2048); } while (0)
#define PG8_LDB(dst, b, h) do { _Pragma("unroll") for (int n = 0; n < 2; ++n) dst[n] = PG8_LD8(lds + PG8_SB(b, h) + boff + n * 2048); } while (0)
#define PG8_LO(v) __builtin_bit_cast(bf16x8, __builtin_shufflevector(v, v, 0, 1, 2, 3))
#define PG8_HI(v) __builtin_bit_cast(bf16x8, __builtin_shufflevector(v, v, 4, 5, 6, 7))
#define PG8_MMA(ai, bj, At, Bt) do { __builtin_amdgcn_s_setprio(1); _Pragma("unroll") for (int m = 0; m < 4; ++m) _Pragma("unroll") for (int n = 0; n < 2; ++n) { \
        if constexpr (F8 == 1) acc[ai][bj][m][n] = __builtin_amdgcn_mfma_scale_f32_16x16x128_f8f6f4(Bt[n], At[m], acc[ai][bj][m][n], 0, 0, 0, 0x7F7F7F7F, 0, 0x7F7F7F7F); \
        else if constexpr (F8 == 2) { i32x4 ci = __builtin_bit_cast(i32x4, acc[ai][bj][m][n]); \
               ci = __builtin_amdgcn_mfma_i32_16x16x64_i8(__builtin_shufflevector(Bt[n], Bt[n], 0, 1, 2, 3), __builtin_shufflevector(At[m], At[m], 0, 1, 2, 3), ci, 0, 0, 0); \
               ci = __builtin_amdgcn_mfma_i32_16x16x64_i8(__builtin_shufflevector(Bt[n], Bt[n], 4, 5, 6, 7), __builtin_shufflevector(At[m], At[m], 4, 5, 6, 7), ci, 0, 0, 0); \
               acc[ai][bj][m][n] = __builtin_bit_cast(f32x4, ci); } \
        else { acc[ai][bj][m][n] = __builtin_amdgcn_mfma_f32_16x16x32_bf16(PG8_LO(Bt[n]), PG8_LO(At[m]), acc[ai][bj][m][n], 0, 0, 0); \
               acc[ai][bj][m][n] = __builtin_amdgcn_mfma_f32_16x16x32_bf16(PG8_HI(Bt[n]), PG8_HI(At[m]), acc[ai][bj][m][n], 0, 0, 0); } } \
        __builtin_amdgcn_s_setprio(0); } while (0)
#define PG8_WAIT_V(n) asm volatile("s_waitcnt vmcnt(" #n ")" ::: "memory")
#define PG8_WAIT_L(n) asm volatile("s_waitcnt lgkmcnt(" #n ")" ::: "memory")
#define PG8_BAR __builtin_amdgcn_s_barrier()
#define PG8_SCHED __builtin_amdgcn_sched_barrier(0)
    Unit cur, nxt; int ui = 0;
    if (!S.next(0, cur)) return;
    f32x4 acc[2][2][4][2];
#pragma unroll
    for (int a = 0; a < 2; ++a)
#pragma unroll
        for (int b = 0; b < 2; ++b)
#pragma unroll
            for (int m = 0; m < 4; ++m)
#pragma unroll
                for (int n = 0; n < 2; ++n) acc[a][b][m][n] = (f32x4){0.f, 0.f, 0.f, 0.f};
    i32x8 At[4], B0[2], B1[2];
    const char* cA = (const char*)g.A + (size_t)cur.pm * tstepA; const char* cB = (const char*)g.Bt + (size_t)cur.pn * tstepB;
    const bool two = g.A2 != nullptr; const int nt1 = two ? g.nt1 : nt;
    const char* cA2 = two ? (const char*)g.A2 + (size_t)cur.pm * tstepA : cA; const char* cB2 = two ? (const char*)g.Bt2 + (size_t)cur.pn * tstepB : cB;
    S.a_ready(cur);
    PG8_STAGE_B(PG8_SB(0, 0), cB); PG8_STAGE_B(PG8_SB(0, 1), cB + hstepB); PG8_STAGE_A(PG8_SA(0, 0), cA); PG8_STAGE_A(PG8_SA(0, 1), cA + hstepA);
    if (wr == 1) PG8_BAR;
    PG8_WAIT_V(2); PG8_BAR;
    PG8_STAGE_B(PG8_SB(1, 0), cB + kstep); PG8_STAGE_A(PG8_SA(1, 0), cA + kstep); PG8_STAGE_B(PG8_SB(1, 1), cB + hstepB + kstep);
    PG8_WAIT_V(6); PG8_BAR;
    for (;;) {
        const bool has_next = S.next(ui + 1, nxt);
        const char* nA = has_next ? (const char*)g.A + (size_t)nxt.pm * tstepA : cA; const char* nB = has_next ? (const char*)g.Bt + (size_t)nxt.pn * tstepB : cB;
#pragma unroll 1
        for (int t = 0; t < nt; t += 2) {
            const bool last = (t == nt - 2);
            const char* a1 = (t < nt1 ? cA + (size_t)t * kstep : cA2 + (size_t)(t - nt1) * kstep) + kstep;
            const char* a2 = last ? nA : (t + 2 < nt1 ? cA + (size_t)(t + 2) * kstep : cA2 + (size_t)(t + 2 - nt1) * kstep);
            const char* b2 = last ? nB : (t + 2 < nt1 ? cB + (size_t)(t + 2) * kstep : cB2 + (size_t)(t + 2 - nt1) * kstep);
            const char* a3 = a2 + kstep; const char* b3 = b2 + kstep;
            if (last && has_next) S.a_ready(nxt);
            PG8_LDB(B0, 0, 0); PG8_LDB(B1, 0, 1); PG8_SCHED; PG8_LDA(At, 0, 0); PG8_STAGE_A(PG8_SA(1, 1), a1 + hstepA);
            PG8_WAIT_V(8); PG8_WAIT_L(0); PG8_BAR; PG8_MMA(0, 0, At, B0); PG8_MMA(0, 1, At, B1); PG8_BAR; PG8_SCHED;
            PG8_LDA(At, 0, 1); PG8_STAGE_B(PG8_SB(0, 0), b2); PG8_STAGE_B(PG8_SB(0, 1), b2 + hstepB); PG8_STAGE_A(PG8_SA(0, 0), a2);
            PG8_WAIT_V(8); PG8_WAIT_L(0); PG8_BAR; PG8_MMA(1, 0, At, B0); PG8_MMA(1, 1, At, B1); PG8_BAR; PG8_SCHED;
            PG8_LDB(B0, 1, 0); PG8_LDB(B1, 1, 1); PG8_SCHED; PG8_LDA(At, 1, 0); PG8_STAGE_A(PG8_SA(0, 1), a2 + hstepA);
            PG8_WAIT_V(8); PG8_WAIT_L(0); PG8_BAR; PG8_MMA(0, 0, At, B0); PG8_MMA(0, 1, At, B1); PG8_BAR; PG8_SCHED;
            PG8_LDA(At, 1, 1); PG8_STAGE_B(PG8_SB(1, 0), b3); PG8_STAGE_B(PG8_SB(1, 1), b3 + hstepB); PG8_STAGE_A(PG8_SA(1, 0), a3);
            PG8_WAIT_V(8); PG8_WAIT_L(0); PG8_BAR; PG8_MMA(1, 0, At, B0); PG8_MMA(1, 1, At, B1); PG8_BAR; PG8_SCHED;
            if constexpr (Epi::HAS_MID) { if (t + 2 == nt1) { int fr2 = fr, fq2 = fq; asm volatile("" : "+v"(fr2), "+v"(fq2)); E.mid(acc, cur, wr, wc, fr2, fq2); } }
        }
        if constexpr (ALIGN_EPI) { if (wr == 0) PG8_BAR; }
        { int fr2 = fr, fq2 = fq; asm volatile("" : "+v"(fr2), "+v"(fq2));
          E(acc, cur, wr, wc, fr2, fq2); }
        if (!has_next) break;
#pragma unroll
        for (int a = 0; a < 2; ++a)
#pragma unroll
            for (int b = 0; b < 2; ++b)
#pragma unroll
                for (int m = 0; m < 4; ++m)
#pragma unroll
                    for (int n = 0; n < 2; ++n) acc[a][b][m][n] = (f32x4){0.f, 0.f, 0.f, 0.f};
        cur = nxt; cA = nA; cB = nB; ++ui;
        if (two) { cA2 = (const char*)g.A2 + (size_t)cur.pm * tstepA; cB2 = (const char*)g.Bt2 + (size_t)cur.pn * tstepB; } else { cA2 = cA; cB2 = cB; }
        if constexpr (ALIGN_EPI) { if (wr == 1) PG8_BAR; }
    }
    PG8_WAIT_V(0);
    if constexpr (!ALIGN_EPI) { if (wr == 0) PG8_BAR; }
    PG8_BAR;
#undef PG8_SA
#undef PG8_SB
#undef PG8_STAGE_A
#undef PG8_STAGE_B
#undef PG8_LDA
#undef PG8_LDB
#undef PG8_LD8
#undef PG8_LO
#undef PG8_HI
#undef PG8_MMA
#undef PG8_WAIT_V
#undef PG8_WAIT_L
#undef PG8_BAR
#undef PG8_SCHED
}
}
typedef f32x4 AccT[2][2][4][2];

#ifdef PROBE_RELAUNCH
struct Args { const float* in[28]; float* out; unsigned char* ws; int ph_lo, ph_hi, bslot; };
#else
struct Args { const float* in[28]; float* out; unsigned char* ws; int ph_lo, ph_hi; };
#endif
struct Frame {
    LAS unsigned char* lds; int tid, lane, wave, G, blk;
    const float *x, *c, *w_ada, *b_ada, *w_in, *conv_w, *conv_b, *w_rg_a, *b_rg_a, *w_rg_x, *b_rg_x, *rg_lambda, *w_rnn_out, *q_norm_g, *w_uq, *kv_norm_g, *w_ukv,
                *w_mla_out, *w_o, *ln1_g, *ln1_b, *peer_wq, *peer_keys, *peer_u, *peer_v, *ln2_g, *ln2_b;
    const int* positions;
    float* out; unsigned char* ws;
};
#define WSP(T, off) ((T*)(F.ws + (off)))

template <int MAP> __device__ __forceinline__ int colmap(int n) {
    if (MAP == 0) return n;
    if (MAP == 1) return n < 5120 ? n : (n < 9216 ? n + 64 : (n < 9280 ? n - 4096 : -1));
    if (MAP == 2) { if (n < 2048) return (n >> 7) * 192 + (n & 127); const int m = n - 2048, h = m >> 6, jj = m & 63; return h * 192 + 128 + (jj >> 1) + 32 * (jj & 1); }
    if (MAP == 3) return (n >> 7) * 256 + (n & 127);
    return (n >> 7) * 256 + 128 + (n & 127);
}
template <int MAP, bool F8> __device__ __forceinline__ void tr_item64(const float* W, int ldw, void* WTv, int ldt, float scale, const float* kscale, LAS float* scr, int k0, int n0, int lane) {
    const int col = colmap<MAP>(n0 + lane);
#pragma unroll
    for (int kk = 0; kk < 64; ++kk) { float v = 0.f;
        if (col >= 0) { v = W[(size_t)(k0 + kk) * ldw + col] * scale; if (kscale) v *= kscale[k0 + kk]; }
        scr[kk * 65 + lane] = v; }
    LDS_WAIT();
    const LAS float* sp = scr + lane;
    if (F8) { unsigned char* o = (unsigned char*)WTv + (size_t)(n0 + lane) * ldt + k0;
#pragma unroll
        for (int q = 0; q < 4; ++q) { u32x4 w;
#pragma unroll
            for (int d = 0; d < 4; ++d) { const int k = 16 * q + 4 * d; w[d] = pk4_f8(sp[k * 65], sp[(k + 1) * 65], sp[(k + 2) * 65], sp[(k + 3) * 65]); }
            *(u32x4*)(o + 16 * q) = w; }
    } else { bf16* o = (bf16*)WTv + (size_t)(n0 + lane) * ldt + k0;
#pragma unroll
        for (int q = 0; q < 8; ++q) { u32x4 w;
#pragma unroll
            for (int d = 0; d < 4; ++d) { const int k = 8 * q + 2 * d; w[d] = pk2(sp[k * 65], sp[(k + 1) * 65]); }
            *(u32x4*)(o + 8 * q) = w; } }
    LDS_WAIT();
}
__device__ __forceinline__ void p0_prologue(Frame& F, int qbank = 0) {
    const int tid = F.tid, lane = F.lane;
    if (F.blk < 192) {
        LAS float* ca = (LAS float*)F.lds; LAS float* red = (LAS float*)(F.lds + 32768);
        for (int i = tid; i < NB * DM; i += NTHREADS) { const float v = F.c[i]; ca[i] = v * sigmoidf_(v); }
        __syncthreads();
        const int cq = tid & 15, rg = tid >> 4, c0 = 64 * F.blk + 4 * cq;
        f32x4 a0 = {0, 0, 0, 0}, a1 = a0, a2 = a0, a3 = a0;
#pragma unroll 8
        for (int k = rg; k < DM; k += 32) { const f32x4 w = *(const f32x4*)(F.w_ada + (size_t)k * 12288 + c0);
            a0 += ca[k] * w; a1 += ca[DM + k] * w; a2 += ca[2 * DM + k] * w; a3 += ca[3 * DM + k] * w; }
        *(LAS f32x4*)(red + (rg * 4 + 0) * 64 + 4 * cq) = a0; *(LAS f32x4*)(red + (rg * 4 + 1) * 64 + 4 * cq) = a1;
        *(LAS f32x4*)(red + (rg * 4 + 2) * 64 + 4 * cq) = a2; *(LAS f32x4*)(red + (rg * 4 + 3) * 64 + 4 * cq) = a3;
        __syncthreads();
        if (tid < 256) { const int b = tid >> 6, col = tid & 63; float s = 0.f;
            for (int r = 0; r < 32; ++r) s += red[(r * 4 + b) * 64 + col];
            WSP(float, WS_MOD)[b * 12288 + 64 * F.blk + col] = s + F.b_ada[64 * F.blk + col]; }
        __syncthreads();
    }
    {
        LAS float* scr = (LAS float*)(F.lds + F.wave * 16640);
        unsigned* qhead = (unsigned*)(F.ws + WS_CTL) + 8192 + 2048 * qbank + 64 * (F.blk & 31);
        constexpr int I_IN = (NPROJ / 64) * (DM / 64), I_SQ = (DM / 64) * (DM / 64), I_UQ = (3072 / 64) * (512 / 64), I_UK = (2048 / 64) * (512 / 64), I_RG = 16 * 2 * 2;
        constexpr int NITEMS = I_IN + 4 * I_SQ + I_UQ + 2 * I_UK + 2 * I_RG;
        int nxt = 0; if (lane == 0) nxt = (int)__hip_atomic_fetch_add(qhead, 1u, __ATOMIC_RELAXED, __HIP_MEMORY_SCOPE_AGENT);
        for (;;) {
            const int it = __builtin_amdgcn_readfirstlane(nxt) * 32 + (F.blk & 31); if (it >= NITEMS) break;
            if (lane == 0) nxt = (int)__hip_atomic_fetch_add(qhead, 1u, __ATOMIC_RELAXED, __HIP_MEMORY_SCOPE_AGENT);
            int r = it;
            if (r < I_IN) { tr_item64<1, true>(F.w_in, IN_COLS, WSP(unsigned char, WS_WIN), DM, SC_WIN, nullptr, scr, 64 * (r / (NPROJ / 64)), 64 * (r % (NPROJ / 64)), lane); continue; } r -= I_IN;
            if (r < I_SQ) { tr_item64<0, true>(F.w_rnn_out, DM, WSP(unsigned char, WS_WRNN), DM, SC_WSQ, nullptr, scr, 64 * (r / 32), 64 * (r % 32), lane); continue; } r -= I_SQ;
            if (r < I_SQ) { tr_item64<0, true>(F.w_mla_out, DM, WSP(unsigned char, WS_WMLA), DM, SC_WSQ, nullptr, scr, 64 * (r / 32), 64 * (r % 32), lane); continue; } r -= I_SQ;
            if (r < I_SQ) { tr_item64<0, true>(F.w_o, DM, WSP(unsigned char, WS_WO), DM, SC_WSQ, nullptr, scr, 64 * (r / 32), 64 * (r % 32), lane); continue; } r -= I_SQ;
            if (r < I_SQ) {
                const int k0 = 64 * (r / 32), n0 = 64 * (r % 32); float am = 0.f;
#pragma unroll
                for (int kk = 0; kk < 64; ++kk) am = fmaxf(am, fabsf(F.peer_wq[(size_t)(k0 + kk) * DM + n0 + lane]));
                (void)__hip_atomic_fetch_max((unsigned*)(F.ws + WS_CTL + CTL_WQAMAX) + n0 + lane, __float_as_uint(am), __ATOMIC_RELAXED, __HIP_MEMORY_SCOPE_AGENT);
                continue; } r -= I_SQ;
            if (r < I_UQ) { tr_item64<2, true>(F.w_uq, 3072, WSP(unsigned char, WS_WUQ), 512, SC_WIN, F.q_norm_g, scr, 64 * (r / 48), 64 * (r % 48), lane); continue; } r -= I_UQ;
            if (r < I_UK) { tr_item64<3, true>(F.w_ukv, 4096, WSP(unsigned char, WS_WUK), 512, SC_WIN, F.kv_norm_g, scr, 64 * (r / 32), 64 * (r % 32), lane); continue; } r -= I_UK;
            if (r < I_UK) { tr_item64<4, true>(F.w_ukv, 4096, WSP(unsigned char, WS_WUV), 512, SC_WIN, F.kv_norm_g, scr, 64 * (r / 32), 64 * (r % 32), lane); continue; } r -= I_UK;
            if (r < I_RG) { const int h = r >> 2, q = r & 3; tr_item64<0, false>(F.w_rg_a + h * 16384, 128, WSP(bf16, WS_WGA) + h * 16384, 128, 1.0f, nullptr, scr, 64 * (q >> 1), 64 * (q & 1), lane); continue; } r -= I_RG;
            { const int h = r >> 2, q = r & 3; tr_item64<0, false>(F.w_rg_x + h * 16384, 128, WSP(bf16, WS_WGX) + h * 16384, 128, 1.0f, nullptr, scr, 64 * (q >> 1), 64 * (q & 1), lane); }
        }
    }
    {
        const int gt = F.blk * NTHREADS + tid, NGT = F.G * NTHREADS;
        f32x2* rope = WSP(f32x2, WS_ROPE);
        for (int i = gt; i < NT * 32; i += NGT) { const int t = i >> 5, j = i & 31;
            const float inv_freq = exp2f(-(float)j * (13.287712379549449f / 32.0f));
            const float ang = (float)F.positions[t] * inv_freq;
            double rev = (double)ang * 0.15915494309189535; rev -= rint(rev);
            const float rv = (float)rev;
            rope[i] = (f32x2){__builtin_amdgcn_cosf(rv), __builtin_amdgcn_sinf(rv)}; }
        bf16* pk = WSP(bf16, WS_PKEYS);
        for (int i = gt; i < 2 * 128 * 128 / 2; i += NGT) { const f32x2 v = *(const f32x2*)(F.peer_keys + 2 * i); ((unsigned*)pk)[i] = pk2(v.x, v.y); }
    }
}

__device__ __forceinline__ void p1_modulate(Frame& F) {
    const int gw = F.blk * NWAVES + F.wave, NGW = F.G * NWAVES;
    const float* mod = WSP(float, WS_MOD); unsigned char* hb = WSP(unsigned char, WS_S0);
    for (int m = gw; m < NT; m += NGW) {
        const int b = m >> 13; const float* sh = mod + b * 12288; const float* sc = sh + 2048;
#pragma unroll
        for (int j = 0; j < 2; ++j) { const int col = 1024 * j + 16 * F.lane; u32x4 o;
#pragma unroll
            for (int q = 0; q < 4; ++q) { const f32x4 v = *(const f32x4*)(F.x + (size_t)m * DM + col + 4 * q), s = *(const f32x4*)(sc + col + 4 * q), h = *(const f32x4*)(sh + col + 4 * q);
                o[q] = pk4_f8((v.x * (1.f + s.x) + h.x) * SC_H, (v.y * (1.f + s.y) + h.y) * SC_H, (v.z * (1.f + s.z) + h.z) * SC_H, (v.w * (1.f + s.w) + h.w) * SC_H); }
            *(u32x4*)(hb + (size_t)m * DM + col) = o; }
    }
    if (F.wave < 4) {
        const int lane = F.lane, it = F.blk * 4 + F.wave;
        LAS float* scr = (LAS float*)(F.lds + F.wave * 16640);
        for (int r = it; r < 1024; r += 4 * F.G) {
            const int k0 = 64 * (r / 32), n0 = 64 * (r % 32);
            const float am = fmaxf(__uint_as_float(((const unsigned*)(F.ws + WS_CTL + CTL_WQAMAX))[n0 + lane]), 1e-30f), qs = 127.0f / am;
#pragma unroll
            for (int kk = 0; kk < 64; ++kk) scr[kk * 65 + lane] = F.peer_wq[(size_t)(k0 + kk) * DM + n0 + lane];
            LDS_WAIT();
            if (k0 == 0) WSP(float, WS_WQS)[n0 + lane] = am * (1.0f / 127.0f);
            const LAS float* sp = scr + lane;
            unsigned char* o = WSP(unsigned char, WS_WPQ) + (size_t)(n0 + lane) * DM + k0;
#pragma unroll
            for (int q = 0; q < 4; ++q) { u32x4 w;
#pragma unroll
                for (int d = 0; d < 4; ++d) { const int k = 16 * q + 4 * d; w[d] = pk4_i8(sp[k * 65] * qs, sp[(k + 1) * 65] * qs, sp[(k + 2) * 65] * qs, sp[(k + 3) * 65] * qs); }
                *(u32x4*)(o + 16 * q) = w; }
            LDS_WAIT();
        }
    }
}

#define EPI_ROWS(...) _Pragma("unroll") for (int ai = 0; ai < 2; ++ai) _Pragma("unroll") for (int m = 0; m < 4; ++m) { const int row = u.pm * 256 + ai * 128 + wr * 64 + m * 16 + fr; \
    _Pragma("unroll") for (int bj = 0; bj < 2; ++bj) { const int cl = bj * 128 + wc * 32 + 8 * fq; const f32x4 v0 = acc[ai][bj][m][0] * esc, v1 = acc[ai][bj][m][1] * esc; __VA_ARGS__ } }
__device__ __forceinline__ u32x4 pack8(const f32x4 a, const f32x4 b) { return (u32x4){pk2(a.x, a.y), pk2(a.z, a.w), pk2(b.x, b.y), pk2(b.z, b.w)}; }

struct EpiProj {
    static constexpr bool HAS_MID = false;
    static constexpr bool PERM = true;
    bf16 *XR, *GG; unsigned char *QC8, *KVC8; bf16 *SGR, *SGM; float *KR, *SS; float esc;
    __device__ __forceinline__ void operator()(const AccT& acc, const pg8::Unit& u, int wr, int wc, int fr, int fq) const {
        const int pn = u.pn;
        if (pn < 8) { bf16* O = XR + pn * 256;
            EPI_ROWS( *(u32x4*)(O + (size_t)row * DM + cl) = pack8(v0, v1); )
        } else if (pn < 16) { bf16* O = GG + (pn - 8) * 256;
            EPI_ROWS( f32x4 a, b; for (int e = 0; e < 4; ++e) { a[e] = gelu_tanh(v0[e]); b[e] = gelu_tanh(v1[e]); } *(u32x4*)(O + (size_t)row * DM + cl) = pack8(a, b); )
        } else if (pn < 20) { const int which = (pn >= 18); const int c0 = (pn & 1) * 256;
#pragma unroll
            for (int ai = 0; ai < 2; ++ai)
#pragma unroll
                for (int m = 0; m < 4; ++m) { const int row = u.pm * 256 + ai * 128 + wr * 64 + m * 16 + fr; float s = 0.f;
#pragma unroll
                    for (int bj = 0; bj < 2; ++bj) { const int cl = bj * 128 + wc * 32 + 8 * fq; const f32x4 v0 = acc[ai][bj][m][0] * esc, v1 = acc[ai][bj][m][1] * esc;
                        *(u32x2*)((which ? KVC8 : QC8) + (size_t)row * 512 + c0 + cl) = (u32x2){pk4_f8(v0.x * SC_H, v0.y * SC_H, v0.z * SC_H, v0.w * SC_H), pk4_f8(v1.x * SC_H, v1.y * SC_H, v1.z * SC_H, v1.w * SC_H)};
                        s += (v0.x * v0.x + v0.y * v0.y) + (v0.z * v0.z + v0.w * v0.w) + (v1.x * v1.x + v1.y * v1.y) + (v1.z * v1.z + v1.w * v1.w); }
                    SS[(size_t)row * 64 + which * 32 + (pn & 1) * 16 + wc * 4 + fq] = s; }
        } else if (pn < 36) { bf16* O = (pn < 28 ? SGR + (pn - 20) * 256 : SGM + (pn - 28) * 256);
            EPI_ROWS( f32x4 a, b; for (int e = 0; e < 4; ++e) { a[e] = sigmoidf_(v0[e]); b[e] = sigmoidf_(v1[e]); } *(u32x4*)(O + (size_t)row * DM + cl) = pack8(a, b); )
        } else {
            EPI_ROWS( if (cl < 64) { *(f32x4*)(KR + (size_t)row * 64 + cl) = v0; *(f32x4*)(KR + (size_t)row * 64 + cl + 4) = v1; } )
        }
    }
};
struct EpiGate1 {
    static constexpr bool HAS_MID = false;
    static constexpr bool PERM = true; const bf16* SG; bf16* O; float esc;
    __device__ __forceinline__ void operator()(const AccT& acc, const pg8::Unit& u, int wr, int wc, int fr, int fq) const {
        EPI_ROWS( const size_t off = (size_t)row * DM + u.pn * 256 + cl; const u32x4 g = *(const u32x4*)(SG + off);
            f32x4 a = {v0.x * bflo(g.x), v0.y * bfhi(g.x), v0.z * bflo(g.y), v0.w * bfhi(g.y)}, b = {v1.x * bflo(g.z), v1.y * bfhi(g.z), v1.z * bflo(g.w), v1.w * bfhi(g.w)};
            *(u32x4*)(O + off) = pack8(a, b); )
    }
};
struct EpiGate2 {
    static constexpr bool HAS_MID = false;
    static constexpr bool PERM = true; const bf16* SG; const bf16* T; unsigned char* O8; float esc;
    __device__ __forceinline__ void operator()(const AccT& acc, const pg8::Unit& u, int wr, int wc, int fr, int fq) const {
        EPI_ROWS( const size_t off = (size_t)row * DM + u.pn * 256 + cl; const u32x4 g = *(const u32x4*)(SG + off); const u32x4 p = *(const u32x4*)(T + off);
            *(u32x2*)(O8 + off) = (u32x2){pk4_f8((bflo(p.x) + v0.x * bflo(g.x)) * SC_TMP, (bfhi(p.x) + v0.y * bfhi(g.x)) * SC_TMP, (bflo(p.y) + v0.z * bflo(g.y)) * SC_TMP, (bfhi(p.y) + v0.w * bfhi(g.y)) * SC_TMP),
                                          pk4_f8((bflo(p.z) + v1.x * bflo(g.z)) * SC_TMP, (bfhi(p.z) + v1.y * bfhi(g.z)) * SC_TMP, (bflo(p.w) + v1.z * bflo(g.w)) * SC_TMP, (bfhi(p.w) + v1.w * bfhi(g.w)) * SC_TMP)}; )
    }
};
struct EpiMix {
    static constexpr bool HAS_MID = true;
    static constexpr bool PERM = true; const bf16* SGR; const bf16* SGM; unsigned char* O8; float r12, e2;
    __device__ __forceinline__ void mid(AccT& acc, const pg8::Unit& u, int wr, int wc, int fr, int fq) const {
#pragma unroll
        for (int ai = 0; ai < 2; ++ai) {
            u32x4 gr[8], gm[8];
#pragma unroll
            for (int m = 0; m < 4; ++m)
#pragma unroll
                for (int bj = 0; bj < 2; ++bj) { const size_t off = (size_t)(u.pm * 256 + ai * 128 + wr * 64 + m * 16 + fr) * DM + u.pn * 256 + bj * 128 + wc * 32 + 8 * fq;
                    gr[m * 2 + bj] = *(const u32x4*)(SGR + off); gm[m * 2 + bj] = *(const u32x4*)(SGM + off); }
            __builtin_amdgcn_sched_barrier(0);
#pragma unroll
            for (int m = 0; m < 4; ++m)
#pragma unroll
                for (int bj = 0; bj < 2; ++bj) { const u32x4 r = gr[m * 2 + bj], d = gm[m * 2 + bj];
                    const f32x4 n0 = {bflo(r.x), bfhi(r.x), bflo(r.y), bfhi(r.y)}, n1 = {bflo(r.z), bfhi(r.z), bflo(r.w), bfhi(r.w)};
                    const f32x4 d0 = {bflo(d.x), bfhi(d.x), bflo(d.y), bfhi(d.y)}, d1 = {bflo(d.z), bfhi(d.z), bflo(d.w), bfhi(d.w)};
#pragma unroll
                    for (int e = 0; e < 4; ++e) { acc[ai][bj][m][0][e] *= r12 * n0[e] * __builtin_amdgcn_rcpf(fmaxf(d0[e], 1e-12f)); acc[ai][bj][m][1][e] *= r12 * n1[e] * __builtin_amdgcn_rcpf(fmaxf(d1[e], 1e-12f)); } }
            __builtin_amdgcn_sched_barrier(0);
        }
    }
    __device__ __forceinline__ void operator()(const AccT& acc, const pg8::Unit& u, int wr, int wc, int fr, int fq) const {
        const float esc = e2 * SC_TMP;
#pragma unroll
        for (int ai = 0; ai < 2; ++ai) {
            u32x4 gmv[8];
#pragma unroll
            for (int m = 0; m < 4; ++m)
#pragma unroll
                for (int bj = 0; bj < 2; ++bj) gmv[m * 2 + bj] = *(const u32x4*)(SGM + (size_t)(u.pm * 256 + ai * 128 + wr * 64 + m * 16 + fr) * DM + u.pn * 256 + bj * 128 + wc * 32 + 8 * fq);
            __builtin_amdgcn_sched_barrier(0);
#pragma unroll
            for (int m = 0; m < 4; ++m)
#pragma unroll
                for (int bj = 0; bj < 2; ++bj) { const size_t off = (size_t)(u.pm * 256 + ai * 128 + wr * 64 + m * 16 + fr) * DM + u.pn * 256 + bj * 128 + wc * 32 + 8 * fq; const u32x4 gm = gmv[m * 2 + bj];
                    const f32x4 v0 = acc[ai][bj][m][0] * esc, v1 = acc[ai][bj][m][1] * esc;
                    *(u32x2*)(O8 + off) = (u32x2){pk4_f8(v0.x * fmaxf(bflo(gm.x), 1e-12f), v0.y * fmaxf(bfhi(gm.x), 1e-12f), v0.z * fmaxf(bflo(gm.y), 1e-12f), v0.w * fmaxf(bfhi(gm.y), 1e-12f)),
                                                  pk4_f8(v1.x * fmaxf(bflo(gm.z), 1e-12f), v1.y * fmaxf(bfhi(gm.z), 1e-12f), v1.z * fmaxf(bflo(gm.w), 1e-12f), v1.w * fmaxf(bfhi(gm.w), 1e-12f))}; }
            __builtin_amdgcn_sched_barrier(0);
        }
    }
};
struct EpiRes1 {
    static constexpr bool HAS_MID = false;
    static constexpr bool PERM = true; const float* X; const float* mod; bf16* R; float esc;
    __device__ __forceinline__ void operator()(const AccT& acc, const pg8::Unit& u, int wr, int wc, int fr, int fq) const {
        f32x4 g[2][2];
#pragma unroll
        for (int bj = 0; bj < 2; ++bj) { const float* gt = mod + ((u.pm * 256) >> 13) * 12288 + 4096 + u.pn * 256 + bj * 128 + wc * 32 + 8 * fq; g[bj][0] = 1.f + *(const f32x4*)gt; g[bj][1] = 1.f + *(const f32x4*)(gt + 4); }
#pragma unroll
        for (int ai = 0; ai < 2; ++ai) {
            f32x4 xv[8][2];
#pragma unroll
            for (int m = 0; m < 4; ++m)
#pragma unroll
                for (int bj = 0; bj < 2; ++bj) { const float* xp = X + (size_t)(u.pm * 256 + ai * 128 + wr * 64 + m * 16 + fr) * DM + u.pn * 256 + bj * 128 + wc * 32 + 8 * fq; xv[m * 2 + bj][0] = *(const f32x4*)xp; xv[m * 2 + bj][1] = *(const f32x4*)(xp + 4); }
            __builtin_amdgcn_sched_barrier(0);
#pragma unroll
            for (int m = 0; m < 4; ++m)
#pragma unroll
                for (int bj = 0; bj < 2; ++bj) { const size_t off = (size_t)(u.pm * 256 + ai * 128 + wr * 64 + m * 16 + fr) * DM + u.pn * 256 + bj * 128 + wc * 32 + 8 * fq;
                    *(u32x4*)(R + off) = pack8(DN_ALPHA * xv[m * 2 + bj][0] + g[bj][0] * (acc[ai][bj][m][0] * esc), DN_ALPHA * xv[m * 2 + bj][1] + g[bj][1] * (acc[ai][bj][m][1] * esc)); }
            __builtin_amdgcn_sched_barrier(0);
        }
    }
};
struct EpiQuery {
    static constexpr bool HAS_MID = false;
    static constexpr bool PERM = true; bf16* O; const float* HS; const float* WS;
    __device__ __forceinline__ void operator()(const AccT& acc, const pg8::Unit& u, int wr, int wc, int fr, int fq) const {
#pragma unroll
        for (int ai = 0; ai < 2; ++ai)
#pragma unroll
            for (int m = 0; m < 4; ++m) { const int row = u.pm * 256 + ai * 128 + wr * 64 + m * 16 + fr; const float hs = HS[row];
#pragma unroll
                for (int bj = 0; bj < 2; ++bj) { const int col = u.pn * 256 + bj * 128 + wc * 32 + 8 * fq; const f32x4 w0 = *(const f32x4*)(WS + col) * hs, w1 = *(const f32x4*)(WS + col + 4) * hs;
                    const i32x4 a0 = __builtin_bit_cast(i32x4, acc[ai][bj][m][0]), a1 = __builtin_bit_cast(i32x4, acc[ai][bj][m][1]);
                    const f32x4 v0 = {(float)a0.x * w0.x, (float)a0.y * w0.y, (float)a0.z * w0.z, (float)a0.w * w0.w}, v1 = {(float)a1.x * w1.x, (float)a1.y * w1.y, (float)a1.z * w1.z, (float)a1.w * w1.w};
                    *(u32x4*)(O + (size_t)row * DM + col) = pack8(v0, v1); } }
    }
};
#ifdef PROBE_GEMM
struct EpiNull {
    static constexpr bool HAS_MID = false;
    static constexpr bool PERM = true; float* O;
    __device__ __forceinline__ void operator()(const AccT& acc, const pg8::Unit& u, int wr, int wc, int fr, int fq) const {
        f32x4 s = {0.f, 0.f, 0.f, 0.f};
#pragma unroll
        for (int ai = 0; ai < 2; ++ai)
#pragma unroll
            for (int bj = 0; bj < 2; ++bj)
#pragma unroll
                for (int m = 0; m < 4; ++m) s += acc[ai][bj][m][0] + acc[ai][bj][m][1];
        *(f32x4*)(O + ((size_t)(u.pm * 8 + u.pn) * 512 + (wr * 4 + wc) * 64 + fq * 16 + fr) * 4) = s;
    }
};
#endif
struct EpiPlain {
    static constexpr bool HAS_MID = false;
    static constexpr bool PERM = true; bf16* O; float esc;
    __device__ __forceinline__ void operator()(const AccT& acc, const pg8::Unit& u, int wr, int wc, int fr, int fq) const {
        EPI_ROWS( *(u32x4*)(O + (size_t)row * DM + u.pn * 256 + cl) = pack8(v0, v1); )
    }
};
struct EpiQ {
    static constexpr bool HAS_MID = false;
    static constexpr bool PERM = true; unsigned char* Q; const float* SS; const f32x2* rope; float esc;
    __device__ __forceinline__ void operator()(const AccT& acc, const pg8::Unit& u, int wr, int wc, int fr, int fq) const {
        const bool is_rope = u.pn >= 8;
        EPI_ROWS( const float rs = SS[(size_t)row * 2] * (QSCALE * SC_Q); const int b = row >> 13, s = row & 8191;
            if (!is_rope) { const int cg = u.pn * 256 + cl, h = cg >> 7, d = cg & 127;
                *(u32x2*)(Q + (unsigned)(((b * NH + h) * SEQ + s) * DQK + d)) = (u32x2){pk4_f8(v0.x * rs, v0.y * rs, v0.z * rs, v0.w * rs), pk4_f8(v1.x * rs, v1.y * rs, v1.z * rs, v1.w * rs)};
            } else { const int cg = (u.pn - 8) * 256 + cl, h = cg >> 6, jj = cg & 63; const f32x4* cs = (const f32x4*)(rope + (size_t)row * 32 + (jj >> 1));
                const f32x4 c0 = cs[0], c1 = cs[1];
                *(u32x2*)(Q + (unsigned)(((b * NH + h) * SEQ + s) * DQK + 128 + jj)) = (u32x2){
                    pk4_f8((v0.x * c0.x - v0.y * c0.y) * rs, (v0.y * c0.x + v0.x * c0.y) * rs, (v0.z * c0.z - v0.w * c0.w) * rs, (v0.w * c0.z + v0.z * c0.w) * rs),
                    pk4_f8((v1.x * c1.x - v1.y * c1.y) * rs, (v1.y * c1.x + v1.x * c1.y) * rs, (v1.z * c1.z - v1.w * c1.w) * rs, (v1.w * c1.z + v1.z * c1.w) * rs)}; } )
    }
};
struct EpiK {
    static constexpr bool HAS_MID = false;
    static constexpr bool PERM = true; unsigned char* K; const float* SS; float esc;
    __device__ __forceinline__ void operator()(const AccT& acc, const pg8::Unit& u, int wr, int wc, int fr, int fq) const {
        EPI_ROWS( const float rs = SS[(size_t)row * 2 + 1] * SC_K; const int b = row >> 13, s = row & 8191;
            const int cg = u.pn * 256 + cl, h = cg >> 7, d = cg & 127;
            *(u32x2*)(K + (unsigned)(((b * NH + h) * SEQ + s) * DQK + d)) = (u32x2){pk4_f8(v0.x * rs, v0.y * rs, v0.z * rs, v0.w * rs), pk4_f8(v1.x * rs, v1.y * rs, v1.z * rs, v1.w * rs)}; )
    }
};
struct EpiVT {
    static constexpr bool HAS_MID = false;
    static constexpr bool PERM = true; unsigned char* VT; const float* SS; float esc;
    __device__ __forceinline__ void operator()(const AccT& acc, const pg8::Unit& u, int wr, int wc, int fr, int fq) const {
        EPI_ROWS( const int t0 = u.pn * 256 + cl, b = t0 >> 13, s = t0 & 8191, h = row >> 7, d = row & 127; const f32x4* sp = (const f32x4*)(SS + (size_t)t0 * 2);
            const f32x4 s0 = sp[0] * SC_V, s1 = sp[1] * SC_V, s2 = sp[2] * SC_V, s3 = sp[3] * SC_V;
            *(u32x2*)(VT + (unsigned)(((((b * NH + h) * 128 + (s >> 6)) * 128 + d) * 64 + (s & 63)))) = (u32x2){pk4_f8(v0.x * s0.y, v0.y * s0.w, v0.z * s1.y, v0.w * s1.w), pk4_f8(v1.x * s2.y, v1.y * s2.w, v1.z * s3.y, v1.w * s3.w)}; )
    }
};

constexpr int RG_W = 288;
constexpr int RG_SUB = 64;
constexpr int RG_XC = 0, RG_GGT = 36864, RG_OUT = 69632;
__device__ __forceinline__ unsigned char* rg_ab(unsigned char* ws, int tile) { return tile < 1536 ? ws + WS_TMP + (size_t)tile * 131072 : ws + WS_AO8 + (size_t)(tile - 1536) * 131072; }
__device__ __forceinline__ float rg_h_lo(unsigned w) { return (float)__builtin_bit_cast(_Float16, (unsigned short)(w & 0xffffu)); }
__device__ __forceinline__ float rg_h_hi(unsigned w) { return (float)__builtin_bit_cast(_Float16, (unsigned short)(w >> 16)); }
struct RgMap { float A, H; };
__device__ __forceinline__ RgMap rg_then(const RgMap f, const RgMap g) { return RgMap{f.A * g.A, g.A * f.H + g.H}; }
__device__ __forceinline__ void rglru_passA(Frame& F) {
    const int tid = F.tid, lane = F.lane, wave = F.wave;
    {
        const float* ssp = WSP(float, WS_SSP); float* rs = WSP(float, WS_RS);
        for (int i = F.blk * NTHREADS + tid; i < NT * 2; i += F.G * NTHREADS) { const f32x4* p = (const f32x4*)(ssp + (size_t)i * 32); float s = 0.f;
#pragma unroll
            for (int k = 0; k < 8; ++k) { const f32x4 a = p[k]; s += (a.x + a.y) + (a.z + a.w); }
            rs[i] = __builtin_amdgcn_rsqf(s * (1.f / 512.f) + RMS_EPS); } }
    LAS unsigned char* L = F.lds;
    const bf16* XR = WSP(bf16, WS_XR); float* SUMM = WSP(float, WS_SUMM);
    const int q = lane >> 4;
    for (int tile = F.blk; tile < NB * 32 * NH; tile += F.G) {
        const int hh = tile & 15, c = (tile >> 4) & 31, b = tile >> 9;
        const int ech = 16 * wave + (lane & 15), egch = hh * 128 + ech;
        bf16x8 bA[4], bX[4];
        { const bf16* ga = WSP(bf16, WS_WGA) + hh * 16384 + ech * 128 + 8 * (lane >> 4); const bf16* gx = WSP(bf16, WS_WGX) + hh * 16384 + ech * 128 + 8 * (lane >> 4);
#pragma unroll
            for (int ks = 0; ks < 4; ++ks) { bA[ks] = *(const bf16x8*)(ga + 32 * ks); bX[ks] = *(const bf16x8*)(gx + 32 * ks); } }
        const float e_ba = F.b_rg_a[egch], e_bx = F.b_rg_x[egch];
        const float lam = F.rg_lambda[egch]; const float e_sp8 = -8.0f * 1.4426950408889634f * ((lam > 15.f) ? expf(-lam) : (lam < -15.f ? -lam : log1pf(expf(-lam))));
        const int crow = tid >> 4, c8 = (tid & 15) * 8, cg = hh * 128 + c8;
        float cw[4][8], cb[8];
#pragma unroll
        for (int w = 0; w < 4; ++w) { const f32x4 p = *(const f32x4*)(F.conv_w + w * DM + cg), qq = *(const f32x4*)(F.conv_w + w * DM + cg + 4);
            cw[w][0] = p.x; cw[w][1] = p.y; cw[w][2] = p.z; cw[w][3] = p.w; cw[w][4] = qq.x; cw[w][5] = qq.y; cw[w][6] = qq.z; cw[w][7] = qq.w; }
        { const f32x4 p = *(const f32x4*)(F.conv_b + cg), qq = *(const f32x4*)(F.conv_b + cg + 4); cb[0] = p.x; cb[1] = p.y; cb[2] = p.z; cb[3] = p.w; cb[4] = qq.x; cb[5] = qq.y; cb[6] = qq.z; cb[7] = qq.w; }
        float S = 0.f, atot = 1.f;
        u32x4* abw = (u32x4*)rg_ab(F.ws, tile) + (wave * 64 + lane) * 4;
        const size_t tbase = (size_t)b * SEQ + c * 256;
        u32x4 xn[2][4];
#pragma unroll
        for (int hf = 0; hf < 2; ++hf)
#pragma unroll
            for (int w = 0; w < 4; ++w) { const int rr = crow + 32 * hf - 3 + w; xn[hf][w] = (u32x4){0u, 0u, 0u, 0u}; if (c * 256 + rr >= 0) xn[hf][w] = *(const u32x4*)(XR + (tbase + rr) * DM + cg); }
#pragma unroll 1
        for (int sub = 0; sub < 256 / RG_SUB; ++sub) {
            const size_t t0 = tbase + sub * RG_SUB;
            LAS unsigned char* XC = L + RG_XC + (sub & 1) * 18432;
#pragma unroll
            for (int hf = 0; hf < 2; ++hf) { float a[8];
#pragma unroll
                for (int e = 0; e < 8; ++e) a[e] = cb[e];
#pragma unroll
                for (int w = 0; w < 4; ++w) { const u32x4 xv = xn[hf][w];
                    a[0] += cw[w][0] * bflo(xv.x); a[1] += cw[w][1] * bfhi(xv.x); a[2] += cw[w][2] * bflo(xv.y); a[3] += cw[w][3] * bfhi(xv.y);
                    a[4] += cw[w][4] * bflo(xv.z); a[5] += cw[w][5] * bfhi(xv.z); a[6] += cw[w][6] * bflo(xv.w); a[7] += cw[w][7] * bfhi(xv.w); }
                *(LAS u32x4*)(XC + (crow + 32 * hf) * RG_W + c8 * 2) = (u32x4){pk2(a[0], a[1]), pk2(a[2], a[3]), pk2(a[4], a[5]), pk2(a[6], a[7])}; }
            __syncthreads();
            if (sub + 1 < 256 / RG_SUB) {
#pragma unroll
                for (int hf = 0; hf < 2; ++hf)
#pragma unroll
                    for (int w = 0; w < 4; ++w) xn[hf][w] = *(const u32x4*)(XR + (t0 + RG_SUB + crow + 32 * hf - 3 + w) * DM + cg); }
            f32x4 accA[4], accX[4];
#pragma unroll
            for (int rb = 0; rb < 4; ++rb) { accA[rb] = (f32x4){0, 0, 0, 0}; accX[rb] = (f32x4){0, 0, 0, 0}; }
#pragma unroll
            for (int ks = 0; ks < 4; ++ks) { const int ko = (ks * 32 + 8 * (lane >> 4)) * 2;
#pragma unroll
                for (int rb = 0; rb < 4; ++rb) { const bf16x8 af = *(const LAS bf16x8*)(XC + (rb * 16 + (lane & 15)) * RG_W + ko);
                    accA[rb] = __builtin_amdgcn_mfma_f32_16x16x32_bf16(af, bA[ks], accA[rb], 0, 0, 0);
                    accX[rb] = __builtin_amdgcn_mfma_f32_16x16x32_bf16(af, bX[ks], accX[rb], 0, 0, 0); } }
#pragma unroll
            for (int rb = 0; rb < 4; ++rb) {
                RgMap G{1.f, 0.f}; u32x4 pw = {0u, 0u, 0u, 0u};
#pragma unroll
                for (int r = 0; r < 4; ++r) { const int trow = rb * 16 + 4 * q + r;
                    const float xcv = bf1(*(const LAS bf16*)(XC + trow * RG_W + ech * 2));
                    const float rr = sigmoidf_(accA[rb][r] + e_ba), ii = sigmoidf_(accX[rb][r] + e_bx);
                    const float l2 = rr * e_sp8;
                    const float a_ = __builtin_amdgcn_exp2f(l2);
                    const float x2 = l2 * (2.0f * 0.6931471805599453f);
                    const float ser = -x2 * (1.0f + x2 * (0.5f + x2 * (0.16666667f + x2 * (0.041666668f + x2 * 0.008333334f))));
                    const float om = (x2 > -0.25f) ? ser : (1.0f - a_ * a_);
                    const float b_ = __builtin_amdgcn_sqrtf(om) * ii * xcv;
                    pw[r] = __builtin_bit_cast(unsigned, __builtin_amdgcn_cvt_pkrtz(l2, b_));
                    G.H = a_ * G.H + b_; G.A *= a_; }
                abw[sub * 2048 + rb] = pw;
                const RgMap P{__shfl_xor(G.A, 16), __shfl_xor(G.H, 16)};
                const RgMap pr = (q & 1) ? rg_then(P, G) : rg_then(G, P);
                const RgMap Q{__shfl_xor(pr.A, 32), __shfl_xor(pr.H, 32)};
                const RgMap T = (q & 2) ? rg_then(Q, pr) : rg_then(pr, Q);
                S = T.A * S + T.H; atot *= T.A;
            }
        }
        if (q == 0) *(f32x2*)(SUMM + ((size_t)(b * 32 + c) * DM + egch) * 2) = (f32x2){atot, S};
    }
    __syncthreads();
}
__device__ __forceinline__ void rglru_passB(Frame& F) {
    const int tid = F.tid, lane = F.lane, wave = F.wave;
    LAS unsigned char* L = F.lds;
    const bf16* GG = WSP(bf16, WS_GG); unsigned char* RA = WSP(unsigned char, WS_S0); const float* SUMM = WSP(float, WS_SUMM);
    const int q = lane >> 4;
    for (int tile = F.blk; tile < NB * 32 * NH; tile += F.G) {
        const int hh = tile & 15, c = (tile >> 4) & 31, b = tile >> 9;
        const int ech = 16 * wave + (lane & 15), egch = hh * 128 + ech;
        const int crow = tid >> 4, c8 = (tid & 15) * 8, cg = hh * 128 + c8;
        const size_t tbase = (size_t)b * SEQ + c * 256;
        const u32x4* abr = (const u32x4*)rg_ab(F.ws, tile) + (wave * 64 + lane) * 4;
        u32x4 gn[2], ab[4];
        gn[0] = *(const u32x4*)(GG + (tbase + crow) * DM + cg); gn[1] = *(const u32x4*)(GG + (tbase + crow + 32) * DM + cg);
#pragma unroll
        for (int rb = 0; rb < 4; ++rb) ab[rb] = abr[rb];
        float S;
        { f32x2 sv[8];
#pragma unroll
            for (int k = 0; k < 8; ++k) { const int cc = 8 * q + k; sv[k] = (f32x2){1.f, 0.f}; if (cc < c) sv[k] = *(const f32x2*)(SUMM + ((size_t)(b * 32 + cc) * DM + egch) * 2); }
            RgMap M{1.f, 0.f};
#pragma unroll
            for (int k = 0; k < 8; ++k) M = rg_then(M, RgMap{sv[k].x, sv[k].y});
            const RgMap P{__shfl_xor(M.A, 16), __shfl_xor(M.H, 16)}; const RgMap pr = (q & 1) ? rg_then(P, M) : rg_then(M, P);
            const RgMap Q{__shfl_xor(pr.A, 32), __shfl_xor(pr.H, 32)}; const RgMap T = (q & 2) ? rg_then(Q, pr) : rg_then(pr, Q);
            S = T.H; }
#pragma unroll 1
        for (int sub = 0; sub < 256 / RG_SUB; ++sub) {
            const size_t t0 = tbase + sub * RG_SUB;
            LAS unsigned char* GT = L + RG_GGT + (sub & 1) * 16384; LAS unsigned char* OT = L + RG_OUT + (sub & 1) * 8192;
            *(LAS u32x4*)(GT + crow * 256 + c8 * 2) = gn[0]; *(LAS u32x4*)(GT + (crow + 32) * 256 + c8 * 2) = gn[1];
            u32x4 abc[4];
#pragma unroll
            for (int rb = 0; rb < 4; ++rb) abc[rb] = ab[rb];
            __syncthreads();
            if (sub + 1 < 256 / RG_SUB) {
                gn[0] = *(const u32x4*)(GG + (t0 + RG_SUB + crow) * DM + cg); gn[1] = *(const u32x4*)(GG + (t0 + RG_SUB + crow + 32) * DM + cg);
#pragma unroll
                for (int rb = 0; rb < 4; ++rb) ab[rb] = abr[(sub + 1) * 2048 + rb]; }
#pragma unroll
            for (int rb = 0; rb < 4; ++rb) {
                float av[4], bv[4];
#pragma unroll
                for (int r = 0; r < 4; ++r) { const unsigned pk = abc[rb][r]; av[r] = __builtin_amdgcn_exp2f(rg_h_lo(pk)); bv[r] = rg_h_hi(pk); }
                RgMap G{1.f, 0.f};
#pragma unroll
                for (int r = 0; r < 4; ++r) { G.H = av[r] * G.H + bv[r]; G.A *= av[r]; }
                const RgMap P{__shfl_xor(G.A, 16), __shfl_xor(G.H, 16)};
                const RgMap pr = (q & 1) ? rg_then(P, G) : rg_then(G, P);
                const RgMap Q{__shfl_xor(pr.A, 32), __shfl_xor(pr.H, 32)};
                const RgMap T = (q & 2) ? rg_then(Q, pr) : rg_then(pr, Q);
                RgMap E{1.f, 0.f}; if (q & 2) E = Q; if (q & 1) E = rg_then(E, P);
                float h = E.A * S + E.H; float y[4];
#pragma unroll
                for (int r = 0; r < 4; ++r) { const int trow = rb * 16 + 4 * q + r; h = av[r] * h + bv[r]; y[r] = h * bf1(*(const LAS bf16*)(GT + trow * 256 + ech * 2)) * SC_RA; }
                const unsigned w = pk4_f8(y[0], y[1], y[2], y[3]); const int tr0 = rb * 16 + 4 * q;
                OT[tr0 * 128 + ech] = (unsigned char)w; OT[(tr0 + 1) * 128 + ech] = (unsigned char)(w >> 8); OT[(tr0 + 2) * 128 + ech] = (unsigned char)(w >> 16); OT[(tr0 + 3) * 128 + ech] = (unsigned char)(w >> 24);
                S = T.A * S + T.H;
            }
            __syncthreads();
            { const int r = tid >> 3, cq = (tid & 7) * 16; *(u32x4*)(RA + (t0 + r) * DM + hh * 128 + cq) = *(const LAS u32x4*)(OT + r * 128 + cq); }
        }
    }
    __syncthreads();
}

__device__ __forceinline__ void krope_fill(Frame& F) {
    const int fl = fresh_lane(); const int gw = F.blk * NWAVES + F.wave, NGW = F.G * NWAVES, j4 = (fl & 7) * 4, tsub = fl >> 3;
    const float* KR = WSP(float, WS_KR); const f32x2* rope = WSP(f32x2, WS_ROPE); unsigned char* K = (unsigned char*)F.out + OUT_K;
    for (int tp = gw; tp < NT / 8; tp += NGW) { const int t = 8 * tp + tsub, b = t >> 13, s = t & 8191;
        const f32x4 x1 = *(const f32x4*)(KR + (size_t)t * 64 + j4), x2 = *(const f32x4*)(KR + (size_t)t * 64 + 32 + j4);
        const f32x4 c01 = *(const f32x4*)(rope + (size_t)t * 32 + j4), c23 = *(const f32x4*)(rope + (size_t)t * 32 + j4 + 2);
        const u32x2 w = {pk4_f8((x1.x * c01.x - x2.x * c01.y) * SC_K, (x2.x * c01.x + x1.x * c01.y) * SC_K, (x1.y * c01.z - x2.y * c01.w) * SC_K, (x2.y * c01.z + x1.y * c01.w) * SC_K),
                         pk4_f8((x1.z * c23.x - x2.z * c23.y) * SC_K, (x2.z * c23.x + x1.z * c23.y) * SC_K, (x1.w * c23.z - x2.w * c23.w) * SC_K, (x2.w * c23.z + x1.w * c23.w) * SC_K)};
#pragma unroll
        for (int h = 0; h < NH; ++h) *(u32x2*)(K + ((size_t)(b * NH + h) * SEQ + s) * DQK + 128 + 2 * j4) = w; }
}

constexpr int AT_KB = 12288, AT_VB = 8192, AT_BUF = AT_KB + AT_VB;
#define AT_LD8(p0_, p1_) __builtin_shufflevector(*(const LAS i32x4*)(p0_), *(const LAS i32x4*)(p1_), 0, 1, 2, 3, 4, 5, 6, 7)
constexpr int AT_SLOT = AT_KB + AT_VB, AT_NSLOT = 5;
struct AttnState { f32x16 o[4], p0, p1; f32x4 osum; i32x8 pb; float m_run; };
#define AT_MFMA(A_, B_, C_) __builtin_amdgcn_mfma_scale_f32_32x32x64_f8f6f4(A_, B_, C_, 0, 0, 0, 0x7F7F7F7F, 0, 0x7F7F7F7F)
#define AT_PIN() __builtin_amdgcn_sched_barrier(0)
template <bool FAST>
__device__ __forceinline__ void attn_iter(AttnState& S, const i32x8 (&qf)[3], const LAS unsigned char* Vprev, const LAS unsigned char* Knext, int xo0, int xo1, int r32, int hi,
                                          bool act_prev, bool act_cur, bool act_next, bool need_mask, int dq) {
    constexpr float CS = 1.0f / (SC_Q * SC_K), LSP = 6.0f;
    const f32x16 z16 = {0.f, 0.f, 0.f, 0.f, 0.f, 0.f, 0.f, 0.f, 0.f, 0.f, 0.f, 0.f, 0.f, 0.f, 0.f, 0.f};
    const int sel = (((r32 & 15) >> 2) & 1) == ((hi * 2 + (r32 >> 4)) & 1) ? 0x38383838 : 0;
    const i32x8 ones8 = {sel, sel, sel, sel, sel, sel, sel, sel};
#define AT_ROWSUM(PB_, ACC_) __builtin_amdgcn_mfma_scale_f32_16x16x128_f8f6f4(ones8, PB_, ACC_, 0, 0, 0, 0x7F7F7F7F, 0, 0x7F7F7F7F)
    float pmax = -__builtin_inff();
    if (FAST) {
        const LAS unsigned char* vb = Vprev + r32 * 64;
        const i32x8 v0 = AT_LD8(vb + xo0, vb + xo1), v1 = AT_LD8(vb + 2048 + xo0, vb + 2048 + xo1);
        S.osum = AT_ROWSUM(S.pb, S.osum);
        AT_PIN(); pmax = fmaxf(fmaxf(S.p0[0], S.p0[1]), fmaxf(S.p0[2], S.p0[3])); pmax = fmaxf(pmax, fmaxf(fmaxf(S.p0[4], S.p0[5]), fmaxf(S.p0[6], S.p0[7]))); AT_PIN();
        S.o[0] = AT_MFMA(v0, S.pb, S.o[0]);
        const i32x8 v2 = AT_LD8(vb + 4096 + xo0, vb + 4096 + xo1);
        AT_PIN(); pmax = fmaxf(pmax, fmaxf(fmaxf(S.p0[8], S.p0[9]), fmaxf(S.p0[10], S.p0[11]))); pmax = fmaxf(pmax, fmaxf(fmaxf(S.p0[12], S.p0[13]), fmaxf(S.p0[14], S.p0[15]))); AT_PIN();
        S.o[1] = AT_MFMA(v1, S.pb, S.o[1]);
        const i32x8 v3 = AT_LD8(vb + 6144 + xo0, vb + 6144 + xo1);
        AT_PIN(); pmax = fmaxf(pmax, fmaxf(fmaxf(S.p1[0], S.p1[1]), fmaxf(S.p1[2], S.p1[3]))); pmax = fmaxf(pmax, fmaxf(fmaxf(S.p1[4], S.p1[5]), fmaxf(S.p1[6], S.p1[7]))); AT_PIN();
        S.o[2] = AT_MFMA(v2, S.pb, S.o[2]);
        AT_PIN(); pmax = fmaxf(pmax, fmaxf(fmaxf(S.p1[8], S.p1[9]), fmaxf(S.p1[10], S.p1[11]))); pmax = fmaxf(pmax, fmaxf(fmaxf(S.p1[12], S.p1[13]), fmaxf(S.p1[14], S.p1[15]))); AT_PIN();
        S.o[3] = AT_MFMA(v3, S.pb, S.o[3]);
    } else if (act_prev) {
        const LAS unsigned char* vb = Vprev + r32 * 64;
        S.osum = AT_ROWSUM(S.pb, S.osum);
#pragma unroll
        for (int d = 0; d < 4; ++d) { const i32x8 vf = AT_LD8(vb + d * 2048 + xo0, vb + d * 2048 + xo1); S.o[d] = AT_MFMA(vf, S.pb, S.o[d]); AT_PIN(); }
    }
    if (!FAST) {
        if (act_cur) {
            if (need_mask) { const float NEG = -__builtin_inff();
#pragma unroll
                for (int r = 0; r < 16; ++r) { const int cr = (r & 3) + 8 * (r >> 2); if (cr > dq) S.p0[r] = NEG; if (cr + 32 > dq) S.p1[r] = NEG; } }
#pragma unroll
            for (int r = 0; r < 16; ++r) pmax = fmaxf(pmax, fmaxf(S.p0[r], S.p1[r]));
        }
    }
    float alpha = 1.f; bool resc = false; f32x16 n0 = z16, n1 = z16;
    if (FAST || act_cur) {
        { auto rr = __builtin_amdgcn_permlane32_swap(__float_as_uint(pmax), __float_as_uint(pmax), false, false); pmax = fmaxf(__uint_as_float(rr[0]), __uint_as_float(rr[1])) * CS; }
        resc = !__all(pmax - S.m_run <= 2.0f);
        const float mn = resc ? fmaxf(S.m_run, pmax) : S.m_run; alpha = __builtin_amdgcn_exp2f(S.m_run - mn); S.m_run = mn;
    }
    const float moff = LSP - S.m_run;
    const LAS unsigned char* kb = Knext + r32 * 192;
    if (FAST) {
        i32x8 ka = AT_LD8(kb + xo0, kb + xo1), kc = AT_LD8(kb + 32 * 192 + xo0, kb + 32 * 192 + xo1);
#pragma unroll
        for (int ks = 0; ks < 3; ++ks) {
            n0 = AT_MFMA(ka, qf[ks], ks == 0 ? z16 : n0); n1 = AT_MFMA(kc, qf[ks], ks == 0 ? z16 : n1);
            if (ks < 2) { ka = AT_LD8(kb + (ks + 1) * 64 + xo0, kb + (ks + 1) * 64 + xo1); kc = AT_LD8(kb + 32 * 192 + (ks + 1) * 64 + xo0, kb + 32 * 192 + (ks + 1) * 64 + xo1); }
            AT_PIN();
#pragma unroll
            for (int r = (ks * 16) / 3; r < ((ks + 1) * 16) / 3; ++r) { S.p0[r] = __builtin_amdgcn_exp2f(__builtin_fmaf(S.p0[r], CS, moff)); S.p1[r] = __builtin_amdgcn_exp2f(__builtin_fmaf(S.p1[r], CS, moff)); }
            AT_PIN();
        }
    } else {
        if (act_next) {
#pragma unroll
            for (int ks = 0; ks < 3; ++ks) { const i32x8 ka = AT_LD8(kb + ks * 64 + xo0, kb + ks * 64 + xo1), kc = AT_LD8(kb + 32 * 192 + ks * 64 + xo0, kb + 32 * 192 + ks * 64 + xo1);
                n0 = AT_MFMA(ka, qf[ks], ks == 0 ? z16 : n0); n1 = AT_MFMA(kc, qf[ks], ks == 0 ? z16 : n1); } }
        if (act_cur) {
#pragma unroll
            for (int r = 0; r < 16; ++r) { S.p0[r] = __builtin_amdgcn_exp2f(__builtin_fmaf(S.p0[r], CS, moff)); S.p1[r] = __builtin_amdgcn_exp2f(__builtin_fmaf(S.p1[r], CS, moff)); } }
    }
    if (FAST || act_cur) {
#pragma unroll
        for (int jj = 0; jj < 4; ++jj) { int a = __builtin_amdgcn_cvt_pk_fp8_f32(S.p0[4 * jj], S.p0[4 * jj + 1], 0, false); a = __builtin_amdgcn_cvt_pk_fp8_f32(S.p0[4 * jj + 2], S.p0[4 * jj + 3], a, true);
            int bq = __builtin_amdgcn_cvt_pk_fp8_f32(S.p1[4 * jj], S.p1[4 * jj + 1], 0, false); bq = __builtin_amdgcn_cvt_pk_fp8_f32(S.p1[4 * jj + 2], S.p1[4 * jj + 3], bq, true);
            auto rr = __builtin_amdgcn_permlane32_swap((unsigned)a, (unsigned)bq, false, false); S.pb[2 * jj] = (int)rr[0]; S.pb[2 * jj + 1] = (int)rr[1]; }
        if (resc) {
#pragma unroll
            for (int d = 0; d < 4; ++d)
#pragma unroll
                for (int r = 0; r < 16; ++r) S.o[d][r] *= alpha;
            S.osum = S.osum * alpha;
        }
    }
    S.p0 = n0; S.p1 = n1;
#undef AT_ROWSUM
}
__device__ __forceinline__ void attn_block(Frame& F, int bh, int qb, const unsigned char* Q, const unsigned char* Kg, const unsigned char* VTg, unsigned char* AO) {
    const int lane = F.lane, wave = F.wave, r32 = lane & 31, hi = lane >> 5;
    LAS unsigned char* L = F.lds; const unsigned ldsbase = (unsigned)(size_t)L;
    const int q0 = qb * 256, qrow = q0 + 32 * wave + r32, ntiles = 4 * (qb + 1);
    unsigned kv0, kv1, vv;
    { const int q = wave * 64 + lane, row = q / 12, pos = q % 12, c = (pos & ~3) | ((pos ^ (row >> 2)) & 3); kv0 = (unsigned)((row * 12 + c) * 16); }
    { const int q = (wave + 8) * 64 + lane, row = q / 12, pos = q % 12, c = (pos & ~3) | ((pos ^ (row >> 2)) & 3); kv1 = (unsigned)((row * 12 + c) * 16); }
    { const int q = wave * 64 + lane, row = q >> 2, pos = q & 3, c = pos ^ ((row >> 2) & 3); vv = (unsigned)((row * 4 + c) * 16); }
    const bool k2 = wave < 4;
    const char* kgb = (const char*)Kg + (size_t)bh * SEQ * DQK; const char* vgb = (const char*)VTg + (size_t)bh * SEQ * DV;
#define AT_ISSUE(tile, slot) do { const int _t = (tile) < ntiles ? (tile) : ntiles - 1; const unsigned _s = ldsbase + (slot) * AT_SLOT; \
        glds16(kgb + (size_t)_t * AT_KB, kv0, _s + wave * 1024); if (k2) glds16(kgb + (size_t)_t * AT_KB, kv1, _s + (wave + 8) * 1024); \
        glds16(vgb + (size_t)_t * AT_VB, vv, _s + AT_KB + wave * 1024); } while (0)
    AT_ISSUE(0, 0); AT_ISSUE(1, 1); AT_ISSUE(2, 2);
    i32x8 qf[3];
    { const unsigned char* qp = Q + ((size_t)bh * SEQ + qrow) * DQK + 32 * hi;
#pragma unroll
        for (int ks = 0; ks < 3; ++ks) { const i32x4 lo = *(const i32x4*)(qp + 64 * ks), hh = *(const i32x4*)(qp + 64 * ks + 16); qf[ks] = __builtin_shufflevector(lo, hh, 0, 1, 2, 3, 4, 5, 6, 7); } }
    asm volatile("s_waitcnt vmcnt(0)" ::: "memory");
    const f32x16 z16 = {0.f, 0.f, 0.f, 0.f, 0.f, 0.f, 0.f, 0.f, 0.f, 0.f, 0.f, 0.f, 0.f, 0.f, 0.f, 0.f};
    AttnState S; S.o[0] = z16; S.o[1] = z16; S.o[2] = z16; S.o[3] = z16; S.osum = (f32x4){0.f, 0.f, 0.f, 0.f}; S.p0 = z16; S.p1 = z16; S.m_run = -1e30f;
    S.pb = (i32x8){0, 0, 0, 0, 0, 0, 0, 0};
    const int swz = (r32 >> 2) & 3; const int xo0 = (((2 * hi) ^ swz) << 4), xo1 = (((2 * hi + 1) ^ swz) << 4);
    const int wfirst = q0 + 32 * wave, wlast = wfirst + 31;
    __syncthreads();
    { const LAS unsigned char* kb = L + r32 * 192;
#pragma unroll
        for (int ks = 0; ks < 3; ++ks) { const i32x8 ka = AT_LD8(kb + ks * 64 + xo0, kb + ks * 64 + xo1), kc = AT_LD8(kb + 32 * 192 + ks * 64 + xo0, kb + 32 * 192 + ks * 64 + xo1);
            S.p0 = AT_MFMA(ka, qf[ks], ks == 0 ? z16 : S.p0); S.p1 = AT_MFMA(kc, qf[ks], ks == 0 ? z16 : S.p1); } }
    const int nfast = 4 * qb;
#define AT_HEAD(j) if (k2) asm volatile("s_waitcnt vmcnt(3)" ::: "memory"); else asm volatile("s_waitcnt vmcnt(2)" ::: "memory"); \
        __syncthreads(); AT_ISSUE((j) + 3, ((j) + 3) % 5); \
        const LAS unsigned char* Vprev = L + (((j) + 4) % 5) * AT_SLOT + AT_KB; const LAS unsigned char* Knext = L + (((j) + 1) % 5) * AT_SLOT;
#define AT_SLOW(j) { const bool ap = (j) >= 1 && 64 * ((j) - 1) <= wlast, ac = (j) < ntiles && 64 * (j) <= wlast, an = (j) + 1 < ntiles && 64 * ((j) + 1) <= wlast; \
        attn_iter<false>(S, qf, Vprev, Knext, xo0, xo1, r32, hi, ap, ac, an, 64 * (j) + 63 > wfirst, qrow - 64 * (j) - 4 * hi); }
    int j = 0;
    { AT_HEAD(0); AT_SLOW(0); j = 1; }
#pragma unroll 1
    for (; j + 1 < nfast; ++j) { AT_HEAD(j); attn_iter<true>(S, qf, Vprev, Knext, xo0, xo1, r32, hi, true, true, true, false, 0); }
#pragma unroll 1
    for (; j <= ntiles; ++j) { AT_HEAD(j); AT_SLOW(j); }
#undef AT_HEAD
#undef AT_SLOW
#undef AT_ISSUE
    { int l2; asm volatile("v_mbcnt_lo_u32_b32 %0, -1, 0\n\tv_mbcnt_hi_u32_b32 %0, -1, %0" : "=v"(l2));
      const float inv = SC_AO / (SC_V * S.osum[0]); unsigned char* op = AO + ((size_t)(bh >> 4) * SEQ + qb * 256 + 32 * wave + (l2 & 31)) * DM + (bh & 15) * 128 + 4 * (l2 >> 5);
#pragma unroll
        for (int d = 0; d < 4; ++d)
#pragma unroll
            for (int g = 0; g < 4; ++g) *(unsigned*)(op + 32 * d + 8 * g) = pk4_f8(S.o[d][4 * g] * inv, S.o[d][4 * g + 1] * inv, S.o[d][4 * g + 2] * inv, S.o[d][4 * g + 3] * inv); }
    asm volatile("s_waitcnt vmcnt(0)" ::: "memory");
    __syncthreads();
}
#undef AT_MFMA
#undef AT_PIN
__device__ __forceinline__ void attn_phase(Frame& F) {
    const unsigned char* Q = (const unsigned char*)F.out + OUT_Q; const unsigned char* Kg = (const unsigned char*)F.out + OUT_K; const unsigned char* VTg = (const unsigned char*)F.out + OUT_VT; unsigned char* AO = WSP(unsigned char, WS_AO8);
    for (int it = F.blk; it < 1024; it += F.G) {
        const int r = it / F.G;
        int bh, y;
        if (F.G == 256) { const int x = F.blk & 7, loc = F.blk >> 3; bh = x * 8 + r * 2 + (loc >> 4); y = loc & 15; }
        else { bh = it >> 4; y = it & 15; }
        attn_block(F, bh, 31 - y, Q, Kg, VTg, AO);
        attn_block(F, bh, y, Q, Kg, VTg, AO);
    }
}

__device__ __forceinline__ void ln1_phase(Frame& F) {
    const int gw = F.blk * NWAVES + F.wave, NGW = F.G * NWAVES, lane = fresh_lane();
    bf16* R1 = WSP(bf16, WS_R1); unsigned char* H2I = WSP(unsigned char, WS_H2I); float* HSC = WSP(float, WS_HSC); const float* mod = WSP(float, WS_MOD);
    u32x4 wnx[4];
    { const u32x4* rp = (const u32x4*)(R1 + (size_t)gw * DM) + lane;
#pragma unroll
        for (int j = 0; j < 4; ++j) wnx[j] = rp[64 * j]; }
    for (int m = gw; m < NT; m += NGW) {
        u32x4* rp = (u32x4*)(R1 + (size_t)m * DM) + lane; f32x4 v[8]; float s = 0.f;
        u32x4 wc[4];
#pragma unroll
        for (int j = 0; j < 4; ++j) wc[j] = wnx[j];
        if (m + NGW < NT) { const u32x4* rq = (const u32x4*)(R1 + (size_t)(m + NGW) * DM) + lane;
#pragma unroll
            for (int j = 0; j < 4; ++j) wnx[j] = rq[64 * j]; }
#pragma unroll
        for (int j = 0; j < 4; ++j) { const u32x4 w = wc[j]; v[2 * j] = (f32x4){bflo(w.x), bfhi(w.x), bflo(w.y), bfhi(w.y)}; v[2 * j + 1] = (f32x4){bflo(w.z), bfhi(w.z), bflo(w.w), bfhi(w.w)};
            s += ((v[2 * j].x + v[2 * j].y) + (v[2 * j].z + v[2 * j].w)) + ((v[2 * j + 1].x + v[2 * j + 1].y) + (v[2 * j + 1].z + v[2 * j + 1].w)); }
        const float mean = wave_sum(s) * (1.f / DM); float s2 = 0.f;
#pragma unroll
        for (int j = 0; j < 8; ++j) { v[j] = v[j] - mean; s2 += (v[j].x * v[j].x + v[j].y * v[j].y) + (v[j].z * v[j].z + v[j].w * v[j].w); }
        const float rstd = __builtin_amdgcn_rsqf(wave_sum(s2) * (1.f / DM) + LN_EPS);
        const int b = m >> 13; const float* sh2 = mod + b * 12288 + 6144; const float* sc2 = mod + b * 12288 + 8192;
        float amax = 0.f;
#pragma unroll
        for (int j = 0; j < 4; ++j) { const int col = 512 * j + 8 * lane; f32x4 y[2];
#pragma unroll
            for (int q = 0; q < 2; ++q) { const f32x4 g = *(const f32x4*)(F.ln1_g + col + 4 * q), bb = *(const f32x4*)(F.ln1_b + col + 4 * q);
                y[q] = v[2 * j + q] * rstd * g + bb; v[2 * j + q] = y[q] * (1.f + *(const f32x4*)(sc2 + col + 4 * q)) + *(const f32x4*)(sh2 + col + 4 * q);
                const f32x4 hh = v[2 * j + q]; amax = fmaxf(amax, fmaxf(fmaxf(fabsf(hh.x), fabsf(hh.y)), fmaxf(fabsf(hh.z), fabsf(hh.w)))); }
            rp[64 * j] = pack8(y[0], y[1]); }
        amax = fmaxf(wave_max(amax), 1e-20f); const float qs = 127.0f / amax;
        if (lane == 0) HSC[m] = amax * (1.0f / 127.0f);
#pragma unroll
        for (int j = 0; j < 4; ++j) { const f32x4 a = v[2 * j] * qs, c = v[2 * j + 1] * qs;
            *(u32x2*)(H2I + (size_t)m * DM + 512 * j + 8 * lane) = (u32x2){pk4_i8(a.x, a.y, a.z, a.w), pk4_i8(c.x, c.y, c.z, c.w)}; }
    }
    auto conv_table = [&](const float* src, unsigned char* dst, float* sc) {
        f32x4 rn[8];
#pragma unroll
        for (int j = 0; j < 4; ++j) { rn[2 * j] = *(const f32x4*)(src + (size_t)gw * DM + 512 * j + 8 * lane); rn[2 * j + 1] = *(const f32x4*)(src + (size_t)gw * DM + 512 * j + 8 * lane + 4); }
        for (int e = gw; e < 16384; e += NGW) { f32x4 r[8]; float amax = 0.f;
#pragma unroll
            for (int j = 0; j < 8; ++j) r[j] = rn[j];
            if (e + NGW < 16384) {
#pragma unroll
                for (int j = 0; j < 4; ++j) { rn[2 * j] = *(const f32x4*)(src + (size_t)(e + NGW) * DM + 512 * j + 8 * lane); rn[2 * j + 1] = *(const f32x4*)(src + (size_t)(e + NGW) * DM + 512 * j + 8 * lane + 4); } }
#pragma unroll
            for (int j = 0; j < 8; ++j) amax = fmaxf(amax, fmaxf(fmaxf(fabsf(r[j].x), fabsf(r[j].y)), fmaxf(fabsf(r[j].z), fabsf(r[j].w))));
            amax = fmaxf(wave_max(amax), 1e-30f); const float qs = 127.0f / amax;
            if (lane == 0) sc[e] = amax * (1.0f / 127.0f);
#pragma unroll
            for (int j = 0; j < 4; ++j) { const f32x4 a = r[2 * j] * qs, c = r[2 * j + 1] * qs;
                *(u32x2*)(dst + (size_t)e * DM + 512 * j + 8 * lane) = (u32x2){pk4_i8(a.x, a.y, a.z, a.w), pk4_i8(c.x, c.y, c.z, c.w)}; } } };
    conv_table(F.peer_u, WSP(unsigned char, WS_PU), WSP(float, WS_USC));
    conv_table(F.peer_v, WSP(unsigned char, WS_PV), WSP(float, WS_VSC));
}

constexpr int PK_KW = 288, PK_KEYS = 0, PK_SF = 2 * 128 * PK_KW  , PK_SI = PK_SF + 64 * 2 * 16 * 4, PK_TAB = PK_SI + 64 * 2 * 16 * 4;
__device__ __forceinline__ unsigned ord_key(float s) { unsigned u = __float_as_uint(s); return u ^ ((u >> 31) ? 0xffffffffu : 0x80000000u); }
__device__ __forceinline__ float ord_inv(unsigned k) { return __uint_as_float((k >> 31) ? (k ^ 0x80000000u) : ~k); }
#define PK_CE(a_, b_) do { const unsigned _h = (a_) > (b_) ? (a_) : (b_), _l = (a_) > (b_) ? (b_) : (a_); (a_) = _h; (b_) = _l; } while (0)
__device__ __forceinline__ void sort16_desc(unsigned (&v)[16]) {
#pragma unroll
    for (int k = 2; k <= 16; k <<= 1)
#pragma unroll
        for (int j = k >> 1; j > 0; j >>= 1)
#pragma unroll
            for (int i = 0; i < 16; ++i) { const int l = i ^ j; if (l > i) { if ((i & k) == 0) PK_CE(v[i], v[l]); else PK_CE(v[l], v[i]); } }
}
__device__ __forceinline__ void merge16_desc(unsigned (&v)[16]) {
#pragma unroll
    for (int j = 8; j > 0; j >>= 1)
#pragma unroll
        for (int i = 0; i < 16; ++i) { const int l = i ^ j; if (l > i) PK_CE(v[i], v[l]); }
}
__device__ __forceinline__ void top16_with_partner(unsigned (&v)[16], int mask) {
    unsigned o[16];
#pragma unroll
    for (int i = 0; i < 16; ++i) o[i] = (unsigned)__shfl_xor((int)v[i], mask);
#pragma unroll
    for (int i = 0; i < 16; ++i) v[i] = v[i] > o[15 - i] ? v[i] : o[15 - i];
    merge16_desc(v);
}
__device__ __forceinline__ void peer_score_phase(Frame& F) {
    const int tid = F.tid, lane = F.lane, wave = F.wave;
    LAS unsigned char* L = F.lds;
    const bf16* PQ = WSP(bf16, WS_PQ); int* IDX = WSP(int, WS_IDX); float* GATE = WSP(float, WS_GATE);
    { const u32x4* kg = WSP(u32x4, WS_PKEYS);
#pragma unroll
        for (int i = 0; i < 8; ++i) { const int id = tid + NTHREADS * i, r = id >> 4, ch = id & 15; *(LAS u32x4*)(L + PK_KEYS + r * PK_KW + ch * 16) = kg[id]; } }
    if (tid == 0) { int n = 0; for (int i = 0; i < 16; ++i) for (int j = 0; j < 16; ++j) if ((i + 1) * (j + 1) <= 16) L[PK_TAB + n++] = (unsigned char)(i * 16 + j); for (; n < 64; ++n) L[PK_TAB + n] = 0xff; }
    __syncthreads();
    LAS float* SF = (LAS float*)(L + PK_SF); LAS int* SI = (LAS int*)(L + PK_SI);
    for (int tile = F.blk; tile < NT * PEER_H / 64; tile += F.G) {
        const int R0 = tile * 64;
        { const int p = wave >> 2, rb = (wave & 3) * 16, c = lane & 15, fq = lane >> 4; const bf16* qp = PQ + (size_t)(R0 + rb + c) * 256 + p * 128 + 8 * fq;
            bf16x8 qfr[4];
#pragma unroll
            for (int ks = 0; ks < 4; ++ks) qfr[ks] = *(const bf16x8*)(qp + 32 * ks);
            unsigned lo[16], hi[16];
#pragma unroll
            for (int nb = 0; nb < 8; ++nb) { f32x4 acc = {0, 0, 0, 0};
#pragma unroll
                for (int ks = 0; ks < 4; ++ks) { const bf16x8 kfr = *(const LAS bf16x8*)(L + PK_KEYS + (p * 128 + nb * 16 + c) * PK_KW + (ks * 32 + 8 * fq) * 2);
                    acc = __builtin_amdgcn_mfma_f32_16x16x32_bf16(kfr, qfr[ks], acc, 0, 0, 0); }
#pragma unroll
                for (int r = 0; r < 4; ++r) { const unsigned key = (ord_key(acc[r]) & ~127u) | (unsigned)(127 - (16 * nb + 4 * fq + r));
                    if (nb < 4) lo[nb * 4 + r] = key; else hi[(nb - 4) * 4 + r] = key; } }
            sort16_desc(lo); sort16_desc(hi);
#pragma unroll
            for (int i = 0; i < 16; ++i) lo[i] = lo[i] > hi[15 - i] ? lo[i] : hi[15 - i];
            merge16_desc(lo);
            top16_with_partner(lo, 16); top16_with_partner(lo, 32);
            if (fq == 0) { LAS float* sf = SF + ((rb + c) * 2 + p) * 16; LAS int* si = SI + ((rb + c) * 2 + p) * 16;
#pragma unroll
                for (int i = 0; i < 16; ++i) { sf[i] = ord_inv(lo[i] & ~127u); si[i] = 127 - (int)(lo[i] & 127u); } } }
        __syncthreads();
        if (tid < 256) { const int R = tid >> 2, c = tid & 3; const LAS float* a = SF + (R * 2) * 16; const LAS float* bq = a + 16;
            unsigned v[16];
#pragma unroll
            for (int m = 0; m < 16; ++m) { v[m] = 0u; if (m < 13) { const unsigned pr = L[PK_TAB + c + 4 * m]; if (pr != 0xffu) v[m] = (ord_key(a[pr >> 4] + bq[pr & 15]) & ~255u) | (255u - pr); } }
            sort16_desc(v); top16_with_partner(v, 1); top16_with_partner(v, 2);
            unsigned w0 = c == 0 ? v[0] : (c == 1 ? v[4] : (c == 2 ? v[8] : v[12])), w1 = c == 0 ? v[1] : (c == 1 ? v[5] : (c == 2 ? v[9] : v[13]));
            unsigned w2 = c == 0 ? v[2] : (c == 1 ? v[6] : (c == 2 ? v[10] : v[14])), w3 = c == 0 ? v[3] : (c == 1 ? v[7] : (c == 2 ? v[11] : v[15]));
            const unsigned pm = 255u - (v[0] & 255u); const float smax = a[pm >> 4] + bq[pm & 15];
            const LAS int* ia = SI + (R * 2) * 16; const LAS int* ib = ia + 16;
            const unsigned p0 = 255u - (w0 & 255u), p1 = 255u - (w1 & 255u), p2 = 255u - (w2 & 255u), p3 = 255u - (w3 & 255u);
            f32x4 e = {__expf(a[p0 >> 4] + bq[p0 & 15] - smax), __expf(a[p1 >> 4] + bq[p1 & 15] - smax), __expf(a[p2 >> 4] + bq[p2 & 15] - smax), __expf(a[p3 >> 4] + bq[p3 & 15] - smax)};
            float sum = (e.x + e.y) + (e.z + e.w); sum += __shfl_xor(sum, 1); sum += __shfl_xor(sum, 2);
            const float inv = 1.0f / sum; const size_t ob = (size_t)(R0 + R) * 16 + 4 * c;
            *(f32x4*)(GATE + ob) = e * inv;
            *(int4*)(IDX + ob) = make_int4(ia[p0 >> 4] * NKEYS + ib[p0 & 15], ia[p1 >> 4] * NKEYS + ib[p1 & 15], ia[p2 >> 4] * NKEYS + ib[p2 & 15], ia[p3 >> 4] * NKEYS + ib[p3 & 15]); }
        __syncthreads();
    }
}
#undef PK_CE

__device__ __forceinline__ void ln2_rows(Frame& F, int m0, int nrows) {
    int lane; asm volatile("v_mbcnt_lo_u32_b32 %0, -1, 0\n\tv_mbcnt_hi_u32_b32 %0, -1, %0" : "=v"(lane));
    const bf16* X1 = WSP(bf16, WS_R1); const float* mod = WSP(float, WS_MOD); const bf16* Y = WSP(bf16, WS_TMP);
    f32x4 g1[8];
    { const f32x4* gt2 = (const f32x4*)(mod + (m0 >> 13) * 12288 + 10240) + lane;
#pragma unroll
        for (int j = 0; j < 8; ++j) g1[j] = 1.f + gt2[64 * j]; }
    u32x2 yn[8], xn[8];
    { const u32x2* yb = (const u32x2*)(Y + (size_t)m0 * DM) + lane; const u32x2* xb = (const u32x2*)(X1 + (size_t)m0 * DM) + lane;
#pragma unroll
        for (int j = 0; j < 8; ++j) { yn[j] = yb[64 * j]; xn[j] = xb[64 * j]; } }
#pragma unroll 1
    for (int m = m0; m < m0 + nrows; ++m) {
        f32x4* yp = (f32x4*)(F.out + (size_t)m * DM) + lane;
        f32x4 v[8]; float s = 0.f;
#pragma unroll
        for (int j = 0; j < 8; ++j) { const u32x2 yw = yn[j], xw = xn[j]; const f32x4 y = {bflo(yw.x), bfhi(yw.x), bflo(yw.y), bfhi(yw.y)}, x = {bflo(xw.x), bfhi(xw.x), bflo(xw.y), bfhi(xw.y)};
            v[j] = DN_ALPHA * x + g1[j] * y; s += (v[j].x + v[j].y) + (v[j].z + v[j].w); }
        { const int mn = m + 1 < m0 + nrows ? m + 1 : m; const u32x2* yb = (const u32x2*)(Y + (size_t)mn * DM) + lane; const u32x2* xb = (const u32x2*)(X1 + (size_t)mn * DM) + lane;
#pragma unroll
            for (int j = 0; j < 8; ++j) { yn[j] = yb[64 * j]; xn[j] = xb[64 * j]; } }
        const float mean = wave_sum(s) * (1.f / DM); float s2 = 0.f;
#pragma unroll
        for (int j = 0; j < 8; ++j) { v[j] = v[j] - mean; s2 += (v[j].x * v[j].x + v[j].y * v[j].y) + (v[j].z * v[j].z + v[j].w * v[j].w); }
        const float rstd = __builtin_amdgcn_rsqf(wave_sum(s2) * (1.f / DM) + LN_EPS);
#pragma unroll
        for (int j = 0; j < 8; ++j) yp[64 * j] = v[j] * rstd * *((const f32x4*)F.ln2_g + 64 * j + lane) + *((const f32x4*)F.ln2_b + 64 * j + lane);
    }
}
constexpr int PE_WAVE_LDS = 16384;
template <int N, int M> __device__ __forceinline__ void xreduce_step(float (&v)[M], bool bit, int mask) {
#pragma unroll
    for (int i = 0; i < N / 2; ++i) { const float keep = bit ? v[i + N / 2] : v[i], send = bit ? v[i] : v[i + N / 2]; v[i] = keep + __shfl_xor(send, mask); }
}
template <int N, int M> __device__ __forceinline__ void xreduce_step_i(int (&v)[M], bool bit, int mask) {
#pragma unroll
    for (int i = 0; i < N / 2; ++i) { const int keep = bit ? v[i + N / 2] : v[i], send = bit ? v[i] : v[i + N / 2]; v[i] = keep + __shfl_xor(send, mask); }
}
__device__ __forceinline__ void peer_eval_phase(Frame& F) {
    const int lane = F.lane, g = lane >> 3, c16 = lane & 7;
    const unsigned char* H2I = WSP(unsigned char, WS_H2I); const float* HSC = WSP(float, WS_HSC); const float* USC = WSP(float, WS_USC); const float* VSC = WSP(float, WS_VSC); const int* IDX = WSP(int, WS_IDX); const float* GATE = WSP(float, WS_GATE);
    const unsigned char* PU = WSP(unsigned char, WS_PU); const unsigned char* PV = WSP(unsigned char, WS_PV); bf16* Y = WSP(bf16, WS_TMP);
    LAS int* idxL = (LAS int*)(F.lds + F.wave * PE_WAVE_LDS); LAS float* DL = (LAS float*)(F.lds + F.wave * PE_WAVE_LDS + 8192);
    for (int tb = F.blk; tb < NT / 128; tb += F.G) {
        const int tok0 = tb * 128 + F.wave * 16;
#pragma unroll 4
        for (int tk = 0; tk < 16; ++tk) { const int e0 = lane, e1 = lane + 64; const int i0 = IDX[(size_t)(tok0 + tk) * 128 + e0], i1 = IDX[(size_t)(tok0 + tk) * 128 + e1];
            idxL[(tk * 8 + (e0 & 7)) * 16 + (e0 >> 3)] = i0 << 11; idxL[(tk * 8 + (e1 & 7)) * 16 + (e1 >> 3)] = i1 << 11; DL[tk * 128 + e0] = 0.f; DL[tk * 128 + e1] = 0.f; }
        LDS_WAIT();
        {
            auto issueU = [&](int st, u32x4 (&w)[16], i32x4& hq) { const int sl = st >> 4, tk = st & 15; const unsigned char* pu = PU + 128 * sl; const unsigned lo16 = 16u * c16;
                int ids[16];
#pragma unroll
                for (int q = 0; q < 4; ++q) { const i32x4 v = *(const LAS i32x4*)(idxL + (tk * 8 + g) * 16 + 4 * q); ids[4 * q] = v.x; ids[4 * q + 1] = v.y; ids[4 * q + 2] = v.z; ids[4 * q + 3] = v.w; }
                hq = *(const i32x4*)(H2I + (size_t)(tok0 + tk) * DM + 128 * sl + 16 * c16);
#pragma unroll
                for (int k = 0; k < 16; ++k) w[k] = *(const u32x4*)(pu + ((unsigned)ids[k] + lo16)); };
            auto computeU = [&](int st, const u32x4 (&w)[16], const i32x4 hq) { const int tk = st & 15;
                int pd[16];
#pragma unroll
                for (int k = 0; k < 16; ++k) { int di = __builtin_amdgcn_sdot4((int)w[k][0], hq.x, 0, false); di = __builtin_amdgcn_sdot4((int)w[k][1], hq.y, di, false);
                    di = __builtin_amdgcn_sdot4((int)w[k][2], hq.z, di, false); di = __builtin_amdgcn_sdot4((int)w[k][3], hq.w, di, false); pd[k] = di; }
                xreduce_step_i<16>(pd, c16 & 1, 1); xreduce_step_i<8>(pd, c16 & 2, 2); xreduce_step_i<4>(pd, c16 & 4, 4);
                const int k0 = 8 * (c16 & 1) + 4 * ((c16 >> 1) & 1) + 2 * (c16 >> 2);
                LAS int* dp = (LAS int*)DL + tk * 128 + g; dp[8 * k0] += pd[0]; dp[8 * (k0 + 1)] += pd[1]; };
            u32x4 wa[16], wb[16]; i32x4 ha, hb;
            issueU(0, wa, ha);
#pragma unroll 1
            for (int st = 0; st < 256; st += 2) {
                issueU(st + 1, wb, hb); computeU(st, wa, ha);
                issueU(st + 2 < 256 ? st + 2 : 255, wa, ha); computeU(st + 1, wb, hb);
            }
        }
        LDS_WAIT();
        { float a0[16], a1[16]; const int e0 = lane, e1 = lane + 64;
#pragma unroll
            for (int tk = 0; tk < 16; ++tk) { const float g0 = GATE[(size_t)(tok0 + tk) * 128 + e0], g1 = GATE[(size_t)(tok0 + tk) * 128 + e1]; const float hs = HSC[tok0 + tk];
                const int x0 = idxL[(tk * 8 + (e0 & 7)) * 16 + (e0 >> 3)], x1 = idxL[(tk * 8 + (e1 & 7)) * 16 + (e1 >> 3)];
                a0[tk] = gelu_tanh((float)((LAS int*)DL)[tk * 128 + e0] * (hs * USC[x0 >> 11])) * g0 * VSC[x0 >> 11]; a1[tk] = gelu_tanh((float)((LAS int*)DL)[tk * 128 + e1] * (hs * USC[x1 >> 11])) * g1 * VSC[x1 >> 11]; }
            LDS_WAIT();
            LAS unsigned char* AB = (LAS unsigned char*)DL; LAS float* AS = DL + 512;
#pragma unroll
            for (int tk = 0; tk < 16; ++tk) { const float amax = fmaxf(wave_max(fmaxf(fabsf(a0[tk]), fabsf(a1[tk]))), 1e-30f); const float qs = 127.0f / amax;
                const int q0 = (int)__builtin_rintf(a0[tk] * qs), q1 = (int)__builtin_rintf(a1[tk] * qs);
                AB[(tk * 8 + (e0 & 7)) * 16 + (e0 >> 3)] = (unsigned char)q0; AB[(tk * 8 + (e1 & 7)) * 16 + (e1 >> 3)] = (unsigned char)q1;
                if (lane == 0) AS[tk] = amax * (1.0f / 127.0f); } }
        LDS_WAIT();
        {
            auto issueV = [&](int st, u32x4 (&w)[16]) { const int sl = st >> 4, tk = st & 15; const unsigned char* pv = PV + 128 * sl; const unsigned lo16 = 16u * c16;
                int ids[16];
#pragma unroll
                for (int q = 0; q < 4; ++q) { const i32x4 v = *(const LAS i32x4*)(idxL + (tk * 8 + g) * 16 + 4 * q); ids[4 * q] = v.x; ids[4 * q + 1] = v.y; ids[4 * q + 2] = v.z; ids[4 * q + 3] = v.w; }
#pragma unroll
                for (int k = 0; k < 16; ++k) w[k] = *(const u32x4*)(pv + ((unsigned)ids[k] + lo16)); };
            auto computeV = [&](int st, const u32x4 (&w)[16]) { const int sl = st >> 4, tk = st & 15;
                const i32x4 a4 = *(const LAS i32x4*)((const LAS unsigned char*)DL + (tk * 8 + g) * 16);
                const float ascale = (DL + 512)[tk];
                int yi[16];
#pragma unroll
                for (int c = 0; c < 16; ++c) yi[c] = 0;
#pragma unroll
                for (int m = 0; m < 4; ++m) { const int am = m == 0 ? a4.x : (m == 1 ? a4.y : (m == 2 ? a4.z : a4.w));
#pragma unroll
                    for (int q = 0; q < 4; ++q) {
                        const unsigned w0 = w[4 * m][q], w1 = w[4 * m + 1][q], w2 = w[4 * m + 2][q], w3 = w[4 * m + 3][q];
                        const unsigned t0 = __builtin_amdgcn_perm(w1, w0, 0x05010400u), t1 = __builtin_amdgcn_perm(w1, w0, 0x07030602u), t2 = __builtin_amdgcn_perm(w3, w2, 0x05010400u), t3 = __builtin_amdgcn_perm(w3, w2, 0x07030602u);
                        yi[4 * q + 0] = __builtin_amdgcn_sdot4((int)__builtin_amdgcn_perm(t2, t0, 0x05040100u), am, yi[4 * q + 0], false);
                        yi[4 * q + 1] = __builtin_amdgcn_sdot4((int)__builtin_amdgcn_perm(t2, t0, 0x07060302u), am, yi[4 * q + 1], false);
                        yi[4 * q + 2] = __builtin_amdgcn_sdot4((int)__builtin_amdgcn_perm(t3, t1, 0x05040100u), am, yi[4 * q + 2], false);
                        yi[4 * q + 3] = __builtin_amdgcn_sdot4((int)__builtin_amdgcn_perm(t3, t1, 0x07060302u), am, yi[4 * q + 3], false); } }
                float cv[16];
#pragma unroll
                for (int c = 0; c < 16; ++c) cv[c] = (float)yi[c] * ascale;
                xreduce_step<16>(cv, g & 1, 8); xreduce_step<8>(cv, g & 2, 16); xreduce_step<4>(cv, g & 4, 32);
                const int c0 = 8 * (g & 1) + 4 * ((g >> 1) & 1) + 2 * (g >> 2);
                *(unsigned*)(Y + (size_t)(tok0 + tk) * DM + 128 * sl + 16 * c16 + c0) = pk2(cv[0], cv[1]); };
            u32x4 wa[16], wb[16];
            issueV(0, wa);
#pragma unroll 1
            for (int st = 0; st < 256; st += 2) {
                issueV(st + 1, wb); computeV(st, wa);
                issueV(st + 2 < 256 ? st + 2 : 255, wa); computeV(st + 1, wb);
            }
        }
        LDS_WAIT();
        VM_WAIT();
        ln2_rows(F, tok0, 16);
    }
}

constexpr int NPHASE = 12;
__global__ void __launch_bounds__(NTHREADS, 2) fwd_kernel(Args args) {
    extern __shared__ __attribute__((aligned(16))) unsigned char lds_raw[];
    Frame F;
    F.lds = (LAS unsigned char*)lds_raw; F.tid = threadIdx.x; F.lane = F.tid & 63; F.wave = __builtin_amdgcn_readfirstlane(F.tid >> 6); F.G = gridDim.x; F.blk = blockIdx.x;
    F.x = args.in[0]; F.c = args.in[1]; F.positions = (const int*)args.in[2]; F.w_ada = args.in[3]; F.b_ada = args.in[4]; F.w_in = args.in[5]; F.conv_w = args.in[6]; F.conv_b = args.in[7];
    F.w_rg_a = args.in[8]; F.b_rg_a = args.in[9]; F.w_rg_x = args.in[10]; F.b_rg_x = args.in[11]; F.rg_lambda = args.in[12]; F.w_rnn_out = args.in[13]; F.q_norm_g = args.in[14]; F.w_uq = args.in[15];
    F.kv_norm_g = args.in[16]; F.w_ukv = args.in[17]; F.w_mla_out = args.in[18]; F.w_o = args.in[19]; F.ln1_g = args.in[20]; F.ln1_b = args.in[21]; F.peer_wq = args.in[22]; F.peer_keys = args.in[23];
    F.peer_u = args.in[24]; F.peer_v = args.in[25]; F.ln2_g = args.in[26]; F.ln2_b = args.in[27]; F.out = args.out; F.ws = args.ws;
    volatile LAS unsigned* ctlw = (volatile LAS unsigned*)(F.lds + LDSCTL_OFF);
    if (F.tid < 128) ctlw[F.tid] = 0u;
    __syncthreads();
    const int lo = args.ph_lo, hi = args.ph_hi;
    const bool multi = (hi - lo) > 1;
#ifdef PROBE_RELAUNCH
    const int bslot = args.bslot;
#else
    constexpr int bslot = 0;
#endif
    XcdBarrier bar; bar.bar = (unsigned*)(F.ws + WS_CTL) + 4096 + 16384 * (bslot & 1); bar.x = 0; bar.st = nullptr;
    if (multi) bar = xcd_barrier_post((unsigned*)(F.ws + WS_CTL) + 4096 + 16384 * (bslot & 1), ctlw + 8);
#ifndef PHASE_MASK
#define PHASE_MASK 0xfff
#endif
#define IN(k) (((PHASE_MASK >> (k)) & 1) && lo <= (k) && (k) < hi)
#define SEAM(k) do { if (IN(k) && IN((k) + 1)) xcd_barrier(bar); } while (0)
#ifndef DBL_MASK
#define DBL_MASK 0
#endif
#define DBL(k, ...) do { if ((DBL_MASK >> (k)) & 1) { __VA_ARGS__; xcd_barrier(bar); } } while (0)
    const pg8::StaticOrder S0{};
    if (IN(0)) { DBL(0, p0_prologue(F, 1)); p0_prologue(F, bslot); SEAM(0); }
    if (IN(1)) { DBL(1, p1_modulate(F)); p1_modulate(F); SEAM(1); }
    if (IN(2)) {
        const pg8::Gemm g = pg8::gemm_f8(WSP(unsigned char, WS_S0), WSP(unsigned char, WS_WIN), NT, NPROJ, DM, DM, DM); pg8::StaticOrder S; S.init(NT, NPROJ, F.G, F.blk);
        EpiProj E{WSP(bf16, WS_XR), WSP(bf16, WS_GG), WSP(unsigned char, WS_QKVC), WSP(unsigned char, WS_KVC8), WSP(bf16, WS_SGR), WSP(bf16, WS_SGM), WSP(float, WS_KR), WSP(float, WS_SSP), 1.0f / (SC_H * SC_WIN)};
        DBL(2, pg8::gemm_phase<EpiProj, pg8::StaticOrder, true, false>(F.lds, g, S, E, F.wave)); pg8::gemm_phase<EpiProj, pg8::StaticOrder, true, false>(F.lds, g, S, E, F.wave); SEAM(2); }
    if (IN(3)) { DBL(3, rglru_passA(F)); rglru_passA(F); SEAM(3); }
    if (IN(4)) {
        rglru_passB(F);
        constexpr float ESC6 = 1.0f / (SC_H * SC_WIN);
        { const pg8::Gemm g = pg8::gemm_f8(WSP(unsigned char, WS_QKVC), WSP(unsigned char, WS_WUQ), NT, 3072, 512, 512, 512); pg8::StaticOrder S; S.init(NT, 3072, F.G, F.blk);
          EpiQ E{(unsigned char*)F.out + OUT_Q, WSP(float, WS_RS), WSP(f32x2, WS_ROPE), ESC6}; pg8::gemm_phase<EpiQ, pg8::StaticOrder, true>(F.lds, g, S, E, F.wave); }
        { const pg8::Gemm g = pg8::gemm_f8(WSP(unsigned char, WS_KVC8), WSP(unsigned char, WS_WUK), NT, 2048, 512, 512, 512); pg8::StaticOrder S; S.init(NT, 2048, F.G, F.blk);
          EpiK E{(unsigned char*)F.out + OUT_K, WSP(float, WS_RS), ESC6}; pg8::gemm_phase<EpiK, pg8::StaticOrder, true>(F.lds, g, S, E, F.wave); }
        { const pg8::Gemm g = pg8::gemm_f8(WSP(unsigned char, WS_WUV), WSP(unsigned char, WS_KVC8), 2048, NT, 512, 512, 512); pg8::StaticOrder S; S.init(2048, NT, F.G, F.blk);
          EpiVT E{(unsigned char*)F.out + OUT_VT, WSP(float, WS_RS), ESC6}; pg8::gemm_phase<EpiVT, pg8::StaticOrder, true>(F.lds, g, S, E, F.wave); }
        krope_fill(F); SEAM(4); }
    if (IN(5)) {
#ifdef PROBE_ATTN
#pragma unroll 1
        for (int rep = 0; rep < PROBE_ATTN; ++rep) { attn_phase(F); xcd_barrier(bar); }
#else
        attn_phase(F);
#endif
        SEAM(5); }
    if (IN(6)) {
        pg8::Gemm g = pg8::gemm_f8(WSP(unsigned char, WS_S0), WSP(unsigned char, WS_WRNN), NT, DM, 2 * DM, DM, DM); g.A2 = WSP(unsigned char, WS_AO8); g.Bt2 = WSP(unsigned char, WS_WMLA); g.nt1 = DM / 128;
        pg8::StaticOrder S; S.init(NT, DM, F.G, F.blk);
        EpiMix E{WSP(bf16, WS_SGR), WSP(bf16, WS_SGM), WSP(unsigned char, WS_TMP8), SC_AO / SC_RA, 1.0f / (SC_AO * SC_WSQ)};
        pg8::gemm_phase<EpiMix, pg8::StaticOrder, true>(F.lds, g, S, E, F.wave); SEAM(6); }
    if (IN(7)) {
#ifdef PROBE_GEMM
#if PROBE_GEMM == 1
#define PROBE_ONE { pg8::Gemm gp = pg8::gemm_f8(WSP(unsigned char, WS_TMP8), WSP(unsigned char, WS_WO), NT, DM, DM, DM, DM); gp.nt = PROBE_NT; pg8::StaticOrder Sp; Sp.init(NT, DM, F.G, F.blk); \
            EpiRes1 Ep{F.x, WSP(float, WS_MOD), WSP(bf16, WS_PQ), 1.0f}; pg8::gemm_phase<EpiRes1, pg8::StaticOrder, true>(F.lds, gp, Sp, Ep, F.wave); xcd_barrier(bar); }
#elif PROBE_GEMM == 3
#define PROBE_ONE { pg8::Gemm gp = pg8::gemm_f8(WSP(unsigned char, WS_TMP8), WSP(unsigned char, WS_WO), NT, DM, DM, DM, DM); gp.nt = PROBE_NT; pg8::StaticOrder Sp; Sp.init(NT, DM, F.G, F.blk); \
            EpiPlain Ep{WSP(bf16, WS_PQ), 1.0f}; pg8::gemm_phase<EpiPlain, pg8::StaticOrder, true, true>(F.lds, gp, Sp, Ep, F.wave); xcd_barrier(bar); }
#elif PROBE_GEMM == 5
#define PROBE_ONE { pg8::Gemm gp = pg8::gemm_f8(WSP(unsigned char, WS_TMP8), WSP(unsigned char, WS_WO), NT, DM, DM, DM, DM); gp.nt = PROBE_NT; pg8::StaticOrder Sp; Sp.init(NT, DM, F.G, F.blk); \
            EpiNull Ep{WSP(float, WS_PQ)}; pg8::gemm_phase<EpiNull, pg8::StaticOrder, true, true>(F.lds, gp, Sp, Ep, F.wave); xcd_barrier(bar); }
#elif PROBE_GEMM == 4
#define PROBE_ONE { pg8::Gemm gp = pg8::gemm_bf16(WSP(bf16, WS_TMP), WSP(bf16, WS_WPQ), NT, DM, DM, DM, DM); gp.nt = PROBE_NT; pg8::StaticOrder Sp; Sp.init(NT, DM, F.G, F.blk); \
            EpiPlain Ep{WSP(bf16, WS_PQ), 1.0f}; pg8::gemm_phase<EpiPlain, pg8::StaticOrder>(F.lds, gp, Sp, Ep, F.wave); xcd_barrier(bar); }
#endif
#ifndef PROBE_PRB
#define PROBE_PRB 0
#endif
#ifndef PROBE_REP
#define PROBE_REP 1
#endif
        PROBE_ONE
#if PROBE_REP >= 2
        PROBE_ONE
#endif
#if PROBE_REP >= 3
        PROBE_ONE
#endif
#if PROBE_REP >= 4
        PROBE_ONE
#endif
#endif
        const pg8::Gemm g = pg8::gemm_f8(WSP(unsigned char, WS_TMP8), WSP(unsigned char, WS_WO), NT, DM, DM, DM, DM); pg8::StaticOrder S; S.init(NT, DM, F.G, F.blk);
        EpiRes1 E{F.x, WSP(float, WS_MOD), WSP(bf16, WS_R1), 1.0f / (SC_TMP * SC_WSQ)};
        pg8::gemm_phase<EpiRes1, pg8::StaticOrder, true>(F.lds, g, S, E, F.wave); SEAM(7); }
    if (IN(8)) { ln1_phase(F); SEAM(8); }
    if (IN(9)) {
        const pg8::Gemm g = pg8::gemm_f8(WSP(unsigned char, WS_H2I), WSP(unsigned char, WS_WPQ), NT, DM, DM, DM, DM); pg8::StaticOrder S; S.init(NT, DM, F.G, F.blk);
        EpiQuery E{WSP(bf16, WS_PQ), WSP(float, WS_HSC), WSP(float, WS_WQS)};
        pg8::gemm_phase<EpiQuery, pg8::StaticOrder, 2>(F.lds, g, S, E, F.wave); SEAM(9); }
#ifdef PROBE_BARS
#pragma unroll 1
    for (int r = 0; r < PROBE_BARS; ++r) xcd_barrier(bar);
#endif
    if (IN(10)) { DBL(10, peer_score_phase(F)); peer_score_phase(F); SEAM(10); }
    if (IN(11)) { DBL(11, peer_eval_phase(F)); peer_eval_phase(F); }
#undef IN
#undef SEAM
}

#ifdef PROBE_ATTN_PRB
__global__ void __launch_bounds__(NTHREADS, 2) attn_probe_kernel(Args args) {
    extern __shared__ __attribute__((aligned(16))) unsigned char lds_raw[];
    Frame F;
    F.lds = (LAS unsigned char*)lds_raw; F.tid = threadIdx.x; F.lane = F.tid & 63; F.wave = __builtin_amdgcn_readfirstlane(F.tid >> 6); F.G = gridDim.x; F.blk = blockIdx.x; F.out = args.out; F.ws = args.ws;
    attn_phase<32 | PROBE_ATTN_PRB>(F);
}
#endif
#ifdef DBG_STOP
__global__ void dbg_dump(const unsigned char* ws, size_t off, int is_f32, float* out) {
    const size_t n = (size_t)NT * DM; const size_t i0 = (size_t)blockIdx.x * blockDim.x + threadIdx.x, st = (size_t)gridDim.x * blockDim.x;
    if (is_f32) { const float* s = (const float*)(ws + off); for (size_t i = i0; i < n; i += st) out[i] = s[i]; }
    else { const bf16* s = (const bf16*)(ws + off); for (size_t i = i0; i < n; i += st) out[i] = i < (size_t)DBG_N ? bf1(s[i]) : 0.f; }
}
__global__ void dbg_count(const unsigned char* ws, size_t off, float lo, float hi, unsigned* cnt) {
    if (blockIdx.x != 0) return;
    const int pm = 3, ct = 2; const bf16* s = (const bf16*)(ws + off); __shared__ unsigned rowbad[256], colbad[256];
    rowbad[threadIdx.x] = 0; colbad[threadIdx.x] = 0; __syncthreads();
    for (int i = threadIdx.x; i < 65536; i += blockDim.x) { const int r = i >> 8, cc = i & 255; const float v = bf1(s[(size_t)(pm * 256 + r) * DM + ct * 256 + cc]); if (!(v >= lo && v <= hi)) { rowbad[r] = 1; colbad[cc] = 1; } }
    __syncthreads();
    if (threadIdx.x == 0) { unsigned nr = 0, nc = 0, fr = 999, fc = 999; for (int i = 0; i < 256; ++i) { if (rowbad[i]) { ++nr; if (fr == 999) fr = i; } if (colbad[i]) { ++nc; if (fc == 999) fc = i; } }
        cnt[0] = nr + 10; cnt[1] = nc + 10; cnt[2] = fr + 10; cnt[3] = fc + 10; }
}
__global__ void dbg_report(const unsigned* cnt, float* out) {
    const size_t n = (size_t)NT * DM; const size_t i0 = (size_t)blockIdx.x * blockDim.x + threadIdx.x, st = (size_t)gridDim.x * blockDim.x;
    const float v = (float)cnt[DBG_WHICH];
    for (size_t i = i0; i < n; i += st) out[i] = (i == 0) ? v : 0.f;
}
#endif
#ifdef PROBE_MB
template <int NM, int NV, int VT>
__global__ void __launch_bounds__(NTHREADS, 2) mb_kernel(float* sink, int iters) {
    const int lane = threadIdx.x & 63; unsigned h = (unsigned)(threadIdx.x + 512 * blockIdx.x) * 0x9E3779B9u + 0x7F4A7C15u;
    i32x8 a, b; for (int e = 0; e < 8; ++e) { h = h * 1664525u + 1013904223u; a[e] = (int)(h & 0x3F3F3F3Fu); h = h * 1664525u + 1013904223u; b[e] = (int)(h & 0x3F3F3F3Fu) ^ 0x00800080; }
    f32x16 acc[4]; for (int q = 0; q < 4; ++q) for (int e = 0; e < 16; ++e) acc[q][e] = 0.f;
    float v[12]; for (int e = 0; e < 12; ++e) v[e] = 0.001f * (float)(lane + e);
    const float c1 = 0.999f, c2 = 0.0007f;
#pragma unroll 1
    for (int it = 0; it < iters; ++it) {
#pragma unroll
        for (int q = 0; q < 4; ++q) {
            if (NM) acc[q] = __builtin_amdgcn_mfma_scale_f32_32x32x64_f8f6f4(a, b, acc[q], 0, 0, 0, 0x7F7F7F7F, 0, 0x7F7F7F7F);
            __builtin_amdgcn_sched_barrier(0);
#pragma unroll
            for (int e = 0; e < NV; ++e) v[e] = VT ? __builtin_amdgcn_exp2f(v[e]) : __builtin_fmaf(v[e], c1, c2);
            __builtin_amdgcn_sched_barrier(0);
        }
    }
    float sacc = 0.f; for (int q = 0; q < 4; ++q) for (int e = 0; e < 16; ++e) sacc += acc[q][e]; for (int e = 0; e < 12; ++e) sacc += v[e];
    sink[(size_t)blockIdx.x * 512 + threadIdx.x] = sacc;
}
#endif
extern "C" void kernel_launch(void* const* d_in, const int* in_sizes, int n_in, void* d_out, int out_size, void* d_ws, size_t ws_size, hipStream_t stream) {
    static int grid = 0;
    if (grid == 0) {
        if (n_in != 28 || out_size != NT * DM || ws_size < WS_END) { fprintf(stderr, "kernel_launch: unexpected shapes (n_in %d, out %d, ws %zu)\n", n_in, out_size, ws_size); grid = -1; return; }
        int dev = 0, cus = 0, per_cu = 0;
        if (hipGetDevice(&dev) != hipSuccess || hipDeviceGetAttribute(&cus, hipDeviceAttributeMultiprocessorCount, dev) != hipSuccess) { grid = -1; return; }
        if (hipFuncSetAttribute((const void*)fwd_kernel, hipFuncAttributeMaxDynamicSharedMemorySize, LDS_BYTES) != hipSuccess) { fprintf(stderr, "kernel_launch: hipFuncSetAttribute failed\n"); grid = -1; return; }
        if (hipOccupancyMaxActiveBlocksPerMultiprocessor(&per_cu, (const void*)fwd_kernel, NTHREADS, LDS_BYTES) != hipSuccess || per_cu < 1)
            fprintf(stderr, "kernel_launch: occupancy query reports %d workgroups per CU\n", per_cu);
        (void)hipGetLastError();
        grid = cus;
    }
    if (grid < 0) return;
    if (hipMemsetAsync((char*)d_ws + WS_CTL, 0, CTL_ZERO_BYTES, stream) != hipSuccess) return;
#ifdef PROBE_MB
    hipLaunchKernelGGL((mb_kernel<PROBE_MB_NM, PROBE_MB_NV, PROBE_MB_VT>), dim3(grid), dim3(NTHREADS), 0, stream, (float*)((char*)d_ws + WS_XR), 4000);
#endif
    Args a{};
    for (int i = 0; i < 28; ++i) a.in[i] = (const float*)d_in[i];
    a.out = (float*)d_out; a.ws = (unsigned char*)d_ws;
#ifdef PROBE_RELAUNCH
    a.ph_lo = 0; a.ph_hi = PROBE_RELAUNCH + 1; a.bslot = 0;
    hipLaunchKernelGGL(fwd_kernel, dim3(grid), dim3(NTHREADS), LDS_BYTES, stream, a);
#ifdef PROBE_ATTN_PRB
    { static bool once = false; if (!once) { once = true; (void)hipFuncSetAttribute((const void*)attn_probe_kernel, hipFuncAttributeMaxDynamicSharedMemorySize, LDS_BYTES); } }
    for (int r = 0; r < PROBE_RELAUNCH_N; ++r) hipLaunchKernelGGL(attn_probe_kernel, dim3(grid), dim3(NTHREADS), LDS_BYTES, stream, a);
#else
    for (int r = 0; r < PROBE_RELAUNCH_N; ++r) { a.ph_lo = PROBE_RELAUNCH; a.ph_hi = PROBE_RELAUNCH + 1; a.bslot = 2 + r; hipLaunchKernelGGL(fwd_kernel, dim3(grid), dim3(NTHREADS), LDS_BYTES, stream, a); }
#endif
    if (PROBE_RELAUNCH + 1 < NPHASE) { a.ph_lo = PROBE_RELAUNCH + 1; a.ph_hi = NPHASE; a.bslot = 1; hipLaunchKernelGGL(fwd_kernel, dim3(grid), dim3(NTHREADS), LDS_BYTES, stream, a); }
#elif MK_N_LAUNCHES == 1
    a.ph_lo = 0; a.ph_hi = NPHASE;
    hipLaunchKernelGGL(fwd_kernel, dim3(grid), dim3(NTHREADS), LDS_BYTES, stream, a);
#else
#ifdef DBG_STOP
    for (int p = 0; p <= DBG_STOP; ++p) { a.ph_lo = p; a.ph_hi = p + 1; hipLaunchKernelGGL(fwd_kernel, dim3(grid), dim3(NTHREADS), LDS_BYTES, stream, a); }
#ifdef DBG_COUNT
        hipLaunchKernelGGL(dbg_count, dim3(1024), dim3(256), 0, stream, (const unsigned char*)d_ws, (size_t)DBG_OFF, DBG_LO, DBG_HI, (unsigned*)d_ws + 1024);
    hipLaunchKernelGGL(dbg_report, dim3(2048), dim3(256), 0, stream, (const unsigned*)d_ws + 1024, (float*)d_out);
#else
    hipLaunchKernelGGL(dbg_dump, dim3(2048), dim3(256), 0, stream, (const unsigned char*)d_ws, (size_t)DBG_OFF, DBG_F32, (float*)d_out);
#endif
#else
    for (int p = 0; p < NPHASE; ++p) { a.ph_lo = p; a.ph_hi = p + 1; hipLaunchKernelGGL(fwd_kernel, dim3(grid), dim3(NTHREADS), LDS_BYTES, stream, a); }
#endif
#endif
    const hipError_t le = hipPeekAtLastError();
    if (le != hipSuccess) fprintf(stderr, "kernel_launch: launch failed: %s\n", hipGetErrorName(le));
}
```

```cpp
#include <hip/hip_runtime.h>
#include <cstdio>
#include <cstdint>

#ifndef MK_N_LAUNCHES
#define MK_N_LAUNCHES 1
#endif

#define LAS __attribute__((address_space(3)))
#define GAS __attribute__((address_space(1)))
typedef unsigned short bf16;
typedef short bf16x8 __attribute__((ext_vector_type(8)));
typedef float f32x2 __attribute__((ext_vector_type(2)));
typedef _Float16 f16x2 __attribute__((ext_vector_type(2)));
typedef float f32x4 __attribute__((ext_vector_type(4)));
typedef float f32x16 __attribute__((ext_vector_type(16)));
typedef unsigned u32x2 __attribute__((ext_vector_type(2)));
typedef unsigned u32x4 __attribute__((ext_vector_type(4)));
typedef int i32x4 __attribute__((ext_vector_type(4)));
typedef int i32x8 __attribute__((ext_vector_type(8)));

constexpr int NB = 4, SEQ = 8192, DM = 2048, NT = NB * SEQ;
constexpr int NH = 16, QLORA = 512, KVLORA = 512, DNOPE = 128, DROPE = 64, DV = 128, DQK = 192;
constexpr int IN_COLS = 9280, NPROJ = 9472;
constexpr int PEER_H = 8, NKEYS = 128, TOPK = 16;
constexpr float DN_ALPHA = 1.189207115002721f;
constexpr float LN_EPS = 1e-5f, RMS_EPS = 1e-6f;
constexpr float QSCALE = 0.07216878364870322f * 1.4426950408889634f;
constexpr int NWAVES = 8, NTHREADS = 512;
constexpr float PU_SCALE = 1024.0f, PV_SCALE = 64.0f;
constexpr float SC_H = 16.0f, SC_WIN = 1024.0f, SC_RA = 4.0f, SC_AO = 32.0f, SC_TMP = 32.0f, SC_WSQ = 2048.0f;
constexpr float SC_Q = 64.0f, SC_K = 16.0f, SC_V = 16.0f, SC_P = 64.0f;

constexpr size_t MiB = 1u << 20;
constexpr size_t WS_CTL = 0, CTL_ZERO_BYTES = 1 * MiB;
constexpr size_t WS_MOD = 1 * MiB;
constexpr size_t WS_RS = 1 * MiB + 512 * 1024;
constexpr size_t WS_SSP = 100 * MiB;
constexpr size_t WS_ROPE = 2 * MiB;
constexpr size_t WS_WIN = 10 * MiB;
constexpr size_t WS_WRNN = 47 * MiB, WS_WMLA = 55 * MiB, WS_WO = 63 * MiB, WS_WPQ = 71 * MiB;
constexpr size_t WS_WUQ = 79 * MiB;
constexpr size_t WS_WUK = 82 * MiB, WS_WUV = 84 * MiB;
constexpr size_t WS_WGA = 86 * MiB;
constexpr size_t WS_WGX = 86 * MiB + 512 * 1024;
constexpr size_t WS_PKEYS = 87 * MiB;
constexpr size_t WS_SUMM = 88 * MiB;
constexpr size_t WS_KR = 90 * MiB;
constexpr size_t WS_S0 = 128 * MiB;
constexpr size_t WS_XR = 256 * MiB, WS_GG = 384 * MiB, WS_SGR = 512 * MiB, WS_SGM = 640 * MiB;
constexpr size_t WS_QKVC = 768 * MiB;
constexpr size_t WS_KVC8 = 800 * MiB;
constexpr size_t WS_TMP = 832 * MiB;
constexpr size_t WS_IDX = 960 * MiB, WS_GATE = 976 * MiB;
constexpr size_t WS_TMP8 = 768 * MiB;
constexpr size_t WS_K = 256 * MiB;
constexpr size_t WS_VT = 448 * MiB;
constexpr size_t WS_R1 = 256 * MiB;
constexpr size_t WS_PQ = 512 * MiB;
constexpr size_t WS_PU = 640 * MiB, WS_PV = 704 * MiB;
constexpr size_t WS_END = 1024 * MiB;
constexpr size_t WS_WQS = WS_WPQ + 4 * MiB;
constexpr size_t CTL_WQAMAX = 32768 * 4;
constexpr size_t WS_H2I = 768 * MiB;
constexpr size_t WS_HSC = 100 * MiB, WS_USC = 101 * MiB, WS_VSC = 102 * MiB;
constexpr size_t WS_AO8 = WS_S0 + 64 * MiB;
constexpr size_t OUT_Q = 0, OUT_K = 96 * MiB, OUT_VT = 192 * MiB;

constexpr int LDS_BYTES = 147456, LDSCTL_OFF = 146944;

typedef __bf16 bf16v2 __attribute__((ext_vector_type(2)));
__device__ __forceinline__ unsigned pk2(float lo, float hi) { const bf16v2 v = __builtin_convertvector((f32x2){lo, hi}, bf16v2); return __builtin_bit_cast(unsigned, v); }
__device__ __forceinline__ float bflo(unsigned w) { return __uint_as_float(w << 16); }
__device__ __forceinline__ float bfhi(unsigned w) { return __uint_as_float(w & 0xffff0000u); }
__device__ __forceinline__ float bf1(bf16 b) { return __uint_as_float(((unsigned)b) << 16); }
__device__ __forceinline__ float sigmoidf_(float y) { return __builtin_amdgcn_rcpf(1.0f + __builtin_amdgcn_exp2f(-1.4426950408889634f * y)); }
__device__ __forceinline__ float gelu_tanh(float x) { const float z = 0.7978845608028654f * (x + 0.044715f * x * x * x); return x * sigmoidf_(2.0f * z); }
__device__ __forceinline__ float wave_sum(float v) {
#pragma unroll
    for (int o = 1; o < 64; o <<= 1) v += __shfl_xor(v, o);
    return v;
}
__device__ __forceinline__ float clamp448(float v) { return __builtin_amdgcn_fmed3f(v, -448.0f, 448.0f); }
__device__ __forceinline__ unsigned pk4_f8(float a, float b, float c, float d) { int w = __builtin_amdgcn_cvt_pk_fp8_f32(clamp448(a), clamp448(b), 0, false); w = __builtin_amdgcn_cvt_pk_fp8_f32(clamp448(c), clamp448(d), w, true); return (unsigned)w; }
__device__ __forceinline__ int fresh_lane() { int l; asm volatile("v_mbcnt_lo_u32_b32 %0, -1, 0\n\tv_mbcnt_hi_u32_b32 %0, -1, %0" : "=v"(l)); return l; }
__device__ __forceinline__ float wave_max(float v) {
#pragma unroll
    for (int o = 1; o < 64; o <<= 1) v = fmaxf(v, __shfl_xor(v, o));
    return v;
}
__device__ __forceinline__ unsigned pk4_i8(float a, float b, float c, float d) {
    const int ia = (int)__builtin_rintf(__builtin_amdgcn_fmed3f(a, -127.f, 127.f)), ib = (int)__builtin_rintf(__builtin_amdgcn_fmed3f(b, -127.f, 127.f)), ic = (int)__builtin_rintf(__builtin_amdgcn_fmed3f(c, -127.f, 127.f)), id = (int)__builtin_rintf(__builtin_amdgcn_fmed3f(d, -127.f, 127.f));
    return (unsigned)(ia & 0xff) | ((unsigned)(ib & 0xff) << 8) | ((unsigned)(ic & 0xff) << 16) | ((unsigned)id << 24); }
#define LDS_WAIT() asm volatile("s_waitcnt lgkmcnt(0)" ::: "memory")
#define VM_WAIT() asm volatile("s_waitcnt vmcnt(0)" ::: "memory")

#define XB_TMO      128
#define XB_XCNT(j)  (256  + 64 * (j))
#define XB_XSUB(j)  (1280 + 64 * (j))
#define XB_XGEN(j)  (2304 + 64 * (j))
#define XB_TOP      3328
#define XB_TOPGEN   3392
#define XCD_BAR_WORDS 3456
#define XB_SPIN_CAP (1u << 20)
__device__ __forceinline__ unsigned xb_ld(unsigned* p)              { return __hip_atomic_load(p, __ATOMIC_RELAXED, __HIP_MEMORY_SCOPE_AGENT); }
__device__ __forceinline__ unsigned xb_add(unsigned* p, unsigned v) { return __hip_atomic_fetch_add(p, v, __ATOMIC_RELAXED, __HIP_MEMORY_SCOPE_AGENT); }
__device__ __forceinline__ unsigned xb_xcc_id() { return (unsigned)__builtin_amdgcn_s_getreg((3 << 11) | 20) & 0xFu; }
#define XB_SPIN(cond, bar) do { unsigned _sp = 0; while (cond) { __builtin_amdgcn_s_sleep(1); \
    if ((++_sp & 255u) == 0u) { if (xb_ld(&(bar)[XB_TMO])) break; if (_sp > XB_SPIN_CAP) { atomicAdd(&(bar)[XB_TMO], 1u); break; } } } } while (0)
struct XcdBarrier { unsigned* bar; unsigned x; volatile LAS unsigned* st; };
__device__ __forceinline__ XcdBarrier xcd_barrier_post(unsigned* bar, volatile LAS unsigned* st) {
    XcdBarrier b; b.bar = bar; b.x = xb_xcc_id(); b.st = st;
    if (threadIdx.x == 0) (void)xb_add(&bar[XB_XCNT(b.x)], 1u);
    return b;
}
__device__ __forceinline__ void xcd_barrier_complete(unsigned* bar, unsigned x, unsigned& nloc, unsigned& nx) {
    const unsigned G = gridDim.x * gridDim.y * gridDim.z;
    unsigned sum, cnt, mine, sp = 0u;
    for (;;) {
        sum = 0u; cnt = 0u; mine = 0u;
#pragma unroll
        for (unsigned j = 0; j < 16; ++j) { const unsigned c = xb_ld(&bar[XB_XCNT(j)]); sum += c; cnt += (c > 0u) ? 1u : 0u; mine = (j == x) ? c : mine; }
        if (sum == G) break;
        __builtin_amdgcn_s_sleep(1);
        if ((++sp & 255u) == 0u) { if (xb_ld(&bar[XB_TMO])) break; if (sp > XB_SPIN_CAP) { atomicAdd(&bar[XB_TMO], 1u); break; } }
    }
    nloc = mine > 0u ? mine : 1u; nx = cnt > 0u ? cnt : 1u;
}
__device__ __forceinline__ void xcd_barrier(const XcdBarrier& b) {
    asm volatile("s_waitcnt vmcnt(0)" ::: "memory");
    __syncthreads();
    if (threadIdx.x == 0) {
        unsigned* bar = b.bar;
        __builtin_amdgcn_s_waitcnt(0);
        unsigned nloc = b.st[0], nx = b.st[1];
        if (nloc == 0u) { xcd_barrier_complete(bar, b.x, nloc, nx); b.st[0] = nloc; b.st[1] = nx; }
        const unsigned old = xb_add(&bar[XB_XSUB(b.x)], 1u);
        const unsigned gen = old / nloc;
        if (old + 1u == (gen + 1u) * nloc) {
            __builtin_amdgcn_fence(__ATOMIC_RELEASE, "agent");
            asm volatile("s_waitcnt vmcnt(0)" ::: "memory");
            const unsigned og = xb_add(&bar[XB_TOP], 1u);
            const unsigned tg = og / nx;
            if (og + 1u == (tg + 1u) * nx) xb_add(&bar[XB_TOPGEN], 1u);
            else XB_SPIN(xb_ld(&bar[XB_TOPGEN]) == tg, bar);
            __builtin_amdgcn_fence(__ATOMIC_ACQUIRE, "agent");
            asm volatile("s_waitcnt vmcnt(0)" ::: "memory");
        } else {
            XB_SPIN(xb_ld(&bar[XB_TOPGEN]) == gen, bar);
            __builtin_amdgcn_fence(__ATOMIC_ACQUIRE, "agent");
            asm volatile("s_waitcnt vmcnt(0)" ::: "memory");
        }
    }
    __syncthreads();
}

__device__ __forceinline__ void glds16(const char* sbase, unsigned voff, unsigned lds_dst) {
    unsigned keep;
    asm volatile("s_mov_b32 %0, m0\n\ts_mov_b32 m0, %3\n\ts_nop 0\n\tglobal_load_lds_dwordx4 %1, %2\n\ts_mov_b32 m0, %0" : "=&s"(keep) : "v"(voff), "s"(sbase), "s"(lds_dst) : "memory");
}
namespace pg8 {
constexpr int BM = 256, BK = 64, HALF = 128, HTB = HALF * BK * 2, STAGE_BYTES = 8 * HTB, NXCD = 8, WGM = 4;
__host__ __device__ __forceinline__ int lds_byte(int r, int c) { const int st = (r >> 4) * 2 + (c >> 5), rr = r & 15, cc = c & 31, ob = rr * 64 + cc * 2; return st * 1024 + (ob ^ (((ob >> 9) & 1) << 5)); }
__host__ __device__ __forceinline__ void stage_rc(int b, int& R, int& C) { const int st = b / 1024, sb = b % 1024, swz = sb ^ (((sb >> 9) & 1) << 5); R = (st >> 1) * 16 + swz / 64; C = (st & 1) * 32 + (swz % 64) / 2; }
__host__ __device__ __forceinline__ int perm32(int rho) { const int n = rho >> 4, i = rho & 15; return 8 * (i >> 2) + 4 * n + (i & 3); }
struct Unit { int pm, pn; };
struct Gemm { const void* A; const void* Bt; int M, N, nt, lda_b, ldb_b; const void* A2 = nullptr; const void* Bt2 = nullptr; int nt1 = 0; };
__host__ __device__ __forceinline__ Gemm gemm_bf16(const bf16* A, const bf16* Bt, int M, int N, int K, int lda, int ldb) { return Gemm{A, Bt, M, N, K / 64, lda * 2, ldb * 2}; }
__host__ __device__ __forceinline__ Gemm gemm_f8(const unsigned char* A, const unsigned char* Bt, int M, int N, int K, int lda, int ldb) { return Gemm{A, Bt, M, N, K / 128, lda, ldb}; }
struct StaticOrder {
    int nM, nN, nwg, G, c;
    __host__ __device__ void init(int M, int N, int G_, int c_) { nM = M / BM; nN = N / BM; nwg = nM * nN; G = G_; c = c_; }
    __host__ __device__ bool next(int i, Unit& u) const {
        const long L = (long)i * G + c; if (L >= nwg) return false;
        int wgid = (int)L; { const int q = nwg / NXCD, r = nwg % NXCD, xcd = wgid % NXCD, off = wgid / NXCD; wgid = (xcd < r ? xcd * (q + 1) : r * (q + 1) + (xcd - r) * q) + off; }
        const int nig = WGM * nN, gid = wgid / nig, fm = gid * WGM, gsz = (nM - fm) < WGM ? (nM - fm) : WGM;
        u.pm = fm + ((wgid % nig) % gsz); u.pn = (wgid % nig) / gsz; return true;
    }
    __device__ __forceinline__ void a_ready(const Unit&) const {}
    __device__ __forceinline__ void done(const Unit&) const {}
};
template <class Epi, class Sched, int F8 = 0, bool ALIGN_EPI = true>
__device__ __forceinline__ void gemm_phase(LAS unsigned char* lds, const Gemm g, const Sched& S, const Epi& E, int wid) {
    const int lane = fresh_lane(), tid = wid * 64 + lane, wr = wid >> 2, wc = wid & 3, fr = lane & 15, fq = lane >> 4;
    const int nt = g.nt;
    unsigned voffA, voffB;
    { int R, C; stage_rc(tid * 16, R, C); const int Rb = Epi::PERM ? ((R & ~31) + perm32(R & 31)) : R; voffA = (unsigned)(R * g.lda_b + C * 2); voffB = (unsigned)(Rb * g.ldb_b + C * 2); }
    const size_t qstepA = (size_t)64 * g.lda_b, qstepB = (size_t)64 * g.ldb_b;
    const unsigned ldsbase = (unsigned)(size_t)lds;
    const size_t kstep = (size_t)(BK * 2);
    const size_t hstepA = (size_t)HALF * g.lda_b, hstepB = (size_t)HALF * g.ldb_b;
    const size_t tstepA = 2 * hstepA, tstepB = 2 * hstepB;
    const unsigned ldsw = (unsigned)wid * 1024u;
    const int aoff = lds_byte(wr * 64 + fr, fq * 8), boff = lds_byte(wc * 32 + fr, fq * 8);
#define PG8_SA(b, h) (((b) * 2 + (h)) * HTB)
#define PG8_SB(b, h) ((4 + (b) * 2 + (h)) * HTB)
#define PG8_STAGE_A(bufoff, gbase) do { glds16((const char*)(gbase), voffA, ldsbase + (bufoff) + ldsw); glds16((const char*)(gbase) + qstepA, voffA, ldsbase + (bufoff) + ldsw + 8192); } while (0)
#define PG8_STAGE_B(bufoff, gbase) do { glds16((const char*)(gbase), voffB, ldsbase + (bufoff) + ldsw); glds16((const char*)(gbase) + qstepB, voffB, ldsbase + (bufoff) + ldsw + 8192); } while (0)
#define PG8_LD8(p) __builtin_shufflevector(*(const LAS i32x4*)(p), *(const LAS i32x4*)((p) + 1024), 0, 1, 2, 3, 4, 5, 6, 7)
#define PG8_LDA(dst, b, h) do { _Pragma("unroll") for (int m = 0; m < 4; ++m) dst[m] = PG8_LD8(lds + PG8_SA(b, h) + aoff + m * 2048); } while (0)
#define PG8_LDB(dst, b, h) do { _Pragma("unroll") for (int n = 0; n < 2; ++n) dst[n] = PG8_LD8(lds + PG8_SB(b, h) + boff + n * 2048); } while (0)
#define PG8_LO(v) __builtin_bit_cast(bf16x8, __builtin_shufflevector(v, v, 0, 1, 2, 3))
#define PG8_HI(v) __builtin_bit_cast(bf16x8, __builtin_shufflevector(v, v, 4, 5, 6, 7))
#define PG8_MMA(ai, bj, At, Bt) do { __builtin_amdgcn_s_setprio(1); _Pragma("unroll") for (int m = 0; m < 4; ++m) _Pragma("unroll") for (int n = 0; n < 2; ++n) { \
        if constexpr (F8 == 1) acc[ai][bj][m][n] = __builtin_amdgcn_mfma_scale_f32_16x16x128_f8f6f4(Bt[n], At[m], acc[ai][bj][m][n], 0, 0, 0, 0x7F7F7F7F, 0, 0x7F7F7F7F); \
        else if constexpr (F8 == 2) { i32x4 ci = __builtin_bit_cast(i32x4, acc[ai][bj][m][n]); \
               ci = __builtin_amdgcn_mfma_i32_16x16x64_i8(__builtin_shufflevector(Bt[n], Bt[n], 0, 1, 2, 3), __builtin_shufflevector(At[m], At[m], 0, 1, 2, 3), ci, 0, 0, 0); \
               ci = __builtin_amdgcn_mfma_i32_16x16x64_i8(__builtin_shufflevector(Bt[n], Bt[n], 4, 5, 6, 7), __builtin_shufflevector(At[m], At[m], 4, 5, 6, 7), ci, 0, 0, 0); \
               acc[ai][bj][m][n] = __builtin_bit_cast(f32x4, ci); } \
        else { acc[ai][bj][m][n] = __builtin_amdgcn_mfma_f32_16x16x32_bf16(PG8_LO(Bt[n]), PG8_LO(At[m]), acc[ai][bj][m][n], 0, 0, 0); \
               acc[ai][bj][m][n] = __builtin_amdgcn_mfma_f32_16x16x32_bf16(PG8_HI(Bt[n]), PG8_HI(At[m]), acc[ai][bj][m][n], 0, 0, 0); } } \
        __builtin_amdgcn_s_setprio(0); } while (0)
#define PG8_WAIT_V(n) asm volatile("s_waitcnt vmcnt(" #n ")" ::: "memory")
#define PG8_WAIT_L(n) asm volatile("s_waitcnt lgkmcnt(" #n ")" ::: "memory")
#define PG8_BAR __builtin_amdgcn_s_barrier()
#define PG8_SCHED __builtin_amdgcn_sched_barrier(0)
    Unit cur, nxt; int ui = 0;
    if (!S.next(0, cur)) return;
    f32x4 acc[2][2][4][2];
#pragma unroll
    for (int a = 0; a < 2; ++a)
#pragma unroll
        for (int b = 0; b < 2; ++b)
#pragma unroll
            for (int m = 0; m < 4; ++m)
#pragma unroll
                for (int n = 0; n < 2; ++n) acc[a][b][m][n] = (f32x4){0.f, 0.f, 0.f, 0.f};
    i32x8 At[4], B0[2], B1[2];
    const char* cA = (const char*)g.A + (size_t)cur.pm * tstepA; const char* cB = (const char*)g.Bt + (size_t)cur.pn * tstepB;
    const bool two = g.A2 != nullptr; const int nt1 = two ? g.nt1 : nt;
    const char* cA2 = two ? (const char*)g.A2 + (size_t)cur.pm * tstepA : cA; const char* cB2 = two ? (const char*)g.Bt2 + (size_t)cur.pn * tstepB : cB;
    S.a_ready(cur);
    PG8_STAGE_B(PG8_SB(0, 0), cB); PG8_STAGE_B(PG8_SB(0, 1), cB + hstepB); PG8_STAGE_A(PG8_SA(0, 0), cA); PG8_STAGE_A(PG8_SA(0, 1), cA + hstepA);
    if (wr == 1) PG8_BAR;
    PG8_WAIT_V(2); PG8_BAR;
    PG8_STAGE_B(PG8_SB(1, 0), cB + kstep); PG8_STAGE_A(PG8_SA(1, 0), cA + kstep); PG8_STAGE_B(PG8_SB(1, 1), cB + hstepB + kstep);
    PG8_WAIT_V(6); PG8_BAR;
    for (;;) {
        const bool has_next = S.next(ui + 1, nxt);
        const char* nA = has_next ? (const char*)g.A + (size_t)nxt.pm * tstepA : cA; const char* nB = has_next ? (const char*)g.Bt + (size_t)nxt.pn * tstepB : cB;
#pragma unroll 1
        for (int t = 0; t < nt; t += 2) {
            const bool last = (t == nt - 2);
            const char* a1 = (t < nt1 ? cA + (size_t)t * kstep : cA2 + (size_t)(t - nt1) * kstep) + kstep;
            const char* a2 = last ? nA : (t + 2 < nt1 ? cA + (size_t)(t + 2) * kstep : cA2 + (size_t)(t + 2 - nt1) * kstep);
            const char* b2 = last ? nB : (t + 2 < nt1 ? cB + (size_t)(t + 2) * kstep : cB2 + (size_t)(t + 2 - nt1) * kstep);
            const char* a3 = a2 + kstep; const char* b3 = b2 + kstep;
            if (last && has_next) S.a_ready(nxt);
            PG8_LDB(B0, 0, 0); PG8_LDB(B1, 0, 1); PG8_SCHED; PG8_LDA(At, 0, 0); PG8_STAGE_A(PG8_SA(1, 1), a1 + hstepA);
            PG8_WAIT_V(8); PG8_WAIT_L(0); PG8_BAR; PG8_MMA(0, 0, At, B0); PG8_MMA(0, 1, At, B1); PG8_BAR; PG8_SCHED;
            PG8_LDA(At, 0, 1); PG8_STAGE_B(PG8_SB(0, 0), b2); PG8_STAGE_B(PG8_SB(0, 1), b2 + hstepB); PG8_STAGE_A(PG8_SA(0, 0), a2);
            PG8_WAIT_V(8); PG8_WAIT_L(0); PG8_BAR; PG8_MMA(1, 0, At, B0); PG8_MMA(1, 1, At, B1); PG8_BAR; PG8_SCHED;
            PG8_LDB(B0, 1, 0); PG8_LDB(B1, 1, 1); PG8_SCHED; PG8_LDA(At, 1, 0); PG8_STAGE_A(PG8_SA(0, 1), a2 + hstepA);
            PG8_WAIT_V(8); PG8_WAIT_L(0); PG8_BAR; PG8_MMA(0, 0, At, B0); PG8_MMA(0, 1, At, B1); PG8_BAR; PG8_SCHED;
            PG8_LDA(At, 1, 1); PG8_STAGE_B(PG8_SB(1, 0), b3); PG8_STAGE_B(PG8_SB(1, 1), b3 + hstepB); PG8_STAGE_A(PG8_SA(1, 0), a3);
            PG8_WAIT_V(8); PG8_WAIT_L(0); PG8_BAR; PG8_MMA(1, 0, At, B0); PG8_MMA(1, 1, At, B1); PG8_BAR; PG8_SCHED;
            if constexpr (Epi::HAS_MID) { if (t + 2 == nt1) { int fr2 = fr, fq2 = fq; asm volatile("" : "+v"(fr2), "+v"(fq2)); E.mid(acc, cur, wr, wc, fr2, fq2); } }
        }
        if constexpr (ALIGN_EPI) { if (wr == 0) PG8_BAR; }
        { int fr2 = fr, fq2 = fq; asm volatile("" : "+v"(fr2), "+v"(fq2));
          E(acc, cur, wr, wc, fr2, fq2); }
        if (!has_next) break;
#pragma unroll
        for (int a = 0; a < 2; ++a)
#pragma unroll
            for (int b = 0; b < 2; ++b)
#pragma unroll
                for (int m = 0; m < 4; ++m)
#pragma unroll
                    for (int n = 0; n < 2; ++n) acc[a][b][m][n] = (f32x4){0.f, 0.f, 0.f, 0.f};
        cur = nxt; cA = nA; cB = nB; ++ui;
        if (two) { cA2 = (const char*)g.A2 + (size_t)cur.pm * tstepA; cB2 = (const char*)g.Bt2 + (size_t)cur.pn * tstepB; } else { cA2 = cA; cB2 = cB; }
        if constexpr (ALIGN_EPI) { if (wr == 1) PG8_BAR; }
    }
    PG8_WAIT_V(0);
    if constexpr (!ALIGN_EPI) { if (wr == 0) PG8_BAR; }
    PG8_BAR;
#undef PG8_SA
#undef PG8_SB
#undef PG8_STAGE_A
#undef PG8_STAGE_B
#undef PG8_LDA
#undef PG8_LDB
#undef PG8_LD8
#undef PG8_LO
#undef PG8_HI
#undef PG8_MMA
#undef PG8_WAIT_V
#undef PG8_WAIT_L
#undef PG8_BAR
#undef PG8_SCHED
}
}
typedef f32x4 AccT[2][2][4][2];

#ifdef PROBE_RELAUNCH
struct Args { const float* in[28]; float* out; unsigned char* ws; int ph_lo, ph_hi, bslot; };
#else
struct Args { const float* in[28]; float* out; unsigned char* ws; int ph_lo, ph_hi; };
#endif
struct Frame {
    LAS unsigned char* lds; int tid, lane, wave, G, blk;
    const float *x, *c, *w_ada, *b_ada, *w_in, *conv_w, *conv_b, *w_rg_a, *b_rg_a, *w_rg_x, *b_rg_x, *rg_lambda, *w_rnn_out, *q_norm_g, *w_uq, *kv_norm_g, *w_ukv,
                *w_mla_out, *w_o, *ln1_g, *ln1_b, *peer_wq, *peer_keys, *peer_u, *peer_v, *ln2_g, *ln2_b;
    const int* positions;
    float* out; unsigned char* ws;
};
#define WSP(T, off) ((T*)(F.ws + (off)))

template <int MAP> __device__ __forceinline__ int colmap(int n) {
    if (MAP == 0) return n;
    if (MAP == 1) return n < 5120 ? n : (n < 9216 ? n + 64 : (n < 9280 ? n - 4096 : -1));
    if (MAP == 2) { if (n < 2048) return (n >> 7) * 192 + (n & 127); const int m = n - 2048, h = m >> 6, jj = m & 63; return h * 192 + 128 + (jj >> 1) + 32 * (jj & 1); }
    if (MAP == 3) return (n >> 7) * 256 + (n & 127);
    return (n >> 7) * 256 + 128 + (n & 127);
}
template <int MAP, bool F8> __device__ __forceinline__ void tr_item64(const float* W, int ldw, void* WTv, int ldt, float scale, const float* kscale, LAS float* scr, int k0, int n0, int lane) {
    const int col = colmap<MAP>(n0 + lane);
#pragma unroll
    for (int kk = 0; kk < 64; ++kk) { float v = 0.f;
        if (col >= 0) { v = W[(size_t)(k0 + kk) * ldw + col] * scale; if (kscale) v *= kscale[k0 + kk]; }
        scr[kk * 65 + lane] = v; }
    LDS_WAIT();
    const LAS float* sp = scr + lane;
    if (F8) { unsigned char* o = (unsigned char*)WTv + (size_t)(n0 + lane) * ldt + k0;
#pragma unroll
        for (int q = 0; q < 4; ++q) { u32x4 w;
#pragma unroll
            for (int d = 0; d < 4; ++d) { const int k = 16 * q + 4 * d; w[d] = pk4_f8(sp[k * 65], sp[(k + 1) * 65], sp[(k + 2) * 65], sp[(k + 3) * 65]); }
            *(u32x4*)(o + 16 * q) = w; }
    } else { bf16* o = (bf16*)WTv + (size_t)(n0 + lane) * ldt + k0;
#pragma unroll
        for (int q = 0; q < 8; ++q) { u32x4 w;
#pragma unroll
            for (int d = 0; d < 4; ++d) { const int k = 8 * q + 2 * d; w[d] = pk2(sp[k * 65], sp[(k + 1) * 65]); }
            *(u32x4*)(o + 8 * q) = w; } }
    LDS_WAIT();
}
__device__ __forceinline__ void p0_prologue(Frame& F, int qbank = 0) {
    const int tid = F.tid, lane = F.lane;
    if (F.blk < 192) {
        LAS float* ca = (LAS float*)F.lds; LAS float* red = (LAS float*)(F.lds + 32768);
        for (int i = tid; i < NB * DM; i += NTHREADS) { const float v = F.c[i]; ca[i] = v * sigmoidf_(v); }
        __syncthreads();
        const int cq = tid & 15, rg = tid >> 4, c0 = 64 * F.blk + 4 * cq;
        f32x4 a0 = {0, 0, 0, 0}, a1 = a0, a2 = a0, a3 = a0;
#pragma unroll 8
        for (int k = rg; k < DM; k += 32) { const f32x4 w = *(const f32x4*)(F.w_ada + (size_t)k * 12288 + c0);
            a0 += ca[k] * w; a1 += ca[DM + k] * w; a2 += ca[2 * DM + k] * w; a3 += ca[3 * DM + k] * w; }
        *(LAS f32x4*)(red + (rg * 4 + 0) * 64 + 4 * cq) = a0; *(LAS f32x4*)(red + (rg * 4 + 1) * 64 + 4 * cq) = a1;
        *(LAS f32x4*)(red + (rg * 4 + 2) * 64 + 4 * cq) = a2; *(LAS f32x4*)(red + (rg * 4 + 3) * 64 + 4 * cq) = a3;
        __syncthreads();
        if (tid < 256) { const int b = tid >> 6, col = tid & 63; float s = 0.f;
            for (int r = 0; r < 32; ++r) s += red[(r * 4 + b) * 64 + col];
            WSP(float, WS_MOD)[b * 12288 + 64 * F.blk + col] = s + F.b_ada[64 * F.blk + col]; }
        __syncthreads();
    }
    {
        LAS float* scr = (LAS float*)(F.lds + F.wave * 16640);
        unsigned* qhead = (unsigned*)(F.ws + WS_CTL) + 8192 + 2048 * qbank + 64 * (F.blk & 31);
        constexpr int I_IN = (NPROJ / 64) * (DM / 64), I_SQ = (DM / 64) * (DM / 64), I_UQ = (3072 / 64) * (512 / 64), I_UK = (2048 / 64) * (512 / 64), I_RG = 16 * 2 * 2;
        constexpr int NITEMS = I_IN + 4 * I_SQ + I_UQ + 2 * I_UK + 2 * I_RG;
        int nxt = 0; if (lane == 0) nxt = (int)__hip_atomic_fetch_add(qhead, 1u, __ATOMIC_RELAXED, __HIP_MEMORY_SCOPE_AGENT);
        for (;;) {
            const int it = __builtin_amdgcn_readfirstlane(nxt) * 32 + (F.blk & 31); if (it >= NITEMS) break;
            if (lane == 0) nxt = (int)__hip_atomic_fetch_add(qhead, 1u, __ATOMIC_RELAXED, __HIP_MEMORY_SCOPE_AGENT);
            int r = it;
            if (r < I_IN) { tr_item64<1, true>(F.w_in, IN_COLS, WSP(unsigned char, WS_WIN), DM, SC_WIN, nullptr, scr, 64 * (r / (NPROJ / 64)), 64 * (r % (NPROJ / 64)), lane); continue; } r -= I_IN;
            if (r < I_SQ) { tr_item64<0, true>(F.w_rnn_out, DM, WSP(unsigned char, WS_WRNN), DM, SC_WSQ, nullptr, scr, 64 * (r / 32), 64 * (r % 32), lane); continue; } r -= I_SQ;
            if (r < I_SQ) { tr_item64<0, true>(F.w_mla_out, DM, WSP(unsigned char, WS_WMLA), DM, SC_WSQ, nullptr, scr, 64 * (r / 32), 64 * (r % 32), lane); continue; } r -= I_SQ;
            if (r < I_SQ) { tr_item64<0, true>(F.w_o, DM, WSP(unsigned char, WS_WO), DM, SC_WSQ, nullptr, scr, 64 * (r / 32), 64 * (r % 32), lane); continue; } r -= I_SQ;
            if (r < I_SQ) {
                const int k0 = 64 * (r / 32), n0 = 64 * (r % 32); float am = 0.f;
#pragma unroll
                for (int kk = 0; kk < 64; ++kk) am = fmaxf(am, fabsf(F.peer_wq[(size_t)(k0 + kk) * DM + n0 + lane]));
                (void)__hip_atomic_fetch_max((unsigned*)(F.ws + WS_CTL + CTL_WQAMAX) + n0 + lane, __float_as_uint(am), __ATOMIC_RELAXED, __HIP_MEMORY_SCOPE_AGENT);
                continue; } r -= I_SQ;
            if (r < I_UQ) { tr_item64<2, true>(F.w_uq, 3072, WSP(unsigned char, WS_WUQ), 512, SC_WIN, F.q_norm_g, scr, 64 * (r / 48), 64 * (r % 48), lane); continue; } r -= I_UQ;
            if (r < I_UK) { tr_item64<3, true>(F.w_ukv, 4096, WSP(unsigned char, WS_WUK), 512, SC_WIN, F.kv_norm_g, scr, 64 * (r / 32), 64 * (r % 32), lane); continue; } r -= I_UK;
            if (r < I_UK) { tr_item64<4, true>(F.w_ukv, 4096, WSP(unsigned char, WS_WUV), 512, SC_WIN, F.kv_norm_g, scr, 64 * (r / 32), 64 * (r % 32), lane); continue; } r -= I_UK;
            if (r < I_RG) { const int h = r >> 2, q = r & 3; tr_item64<0, false>(F.w_rg_a + h * 16384, 128, WSP(bf16, WS_WGA) + h * 16384, 128, 1.0f, nullptr, scr, 64 * (q >> 1), 64 * (q & 1), lane); continue; } r -= I_RG;
            { const int h = r >> 2, q = r & 3; tr_item64<0, false>(F.w_rg_x + h * 16384, 128, WSP(bf16, WS_WGX) + h * 16384, 128, 1.0f, nullptr, scr, 64 * (q >> 1), 64 * (q & 1), lane); }
        }
    }
    {
        const int gt = F.blk * NTHREADS + tid, NGT = F.G * NTHREADS;
        f32x2* rope = WSP(f32x2, WS_ROPE);
        for (int i = gt; i < NT * 32; i += NGT) { const int t = i >> 5, j = i & 31;
            const float inv_freq = exp2f(-(float)j * (13.287712379549449f / 32.0f));
            const float ang = (float)F.positions[t] * inv_freq;
            double rev = (double)ang * 0.15915494309189535; rev -= rint(rev);
            const float rv = (float)rev;
            rope[i] = (f32x2){__builtin_amdgcn_cosf(rv), __builtin_amdgcn_sinf(rv)}; }
        bf16* pk = WSP(bf16, WS_PKEYS);
        for (int i = gt; i < 2 * 128 * 128 / 2; i += NGT) { const f32x2 v = *(const f32x2*)(F.peer_keys + 2 * i); ((unsigned*)pk)[i] = pk2(v.x, v.y); }
    }
}

__device__ __forceinline__ void p1_modulate(Frame& F) {
    const int gw = F.blk * NWAVES + F.wave, NGW = F.G * NWAVES;
    const float* mod = WSP(float, WS_MOD); unsigned char* hb = WSP(unsigned char, WS_S0);
    for (int m = gw; m < NT; m += NGW) {
        const int b = m >> 13; const float* sh = mod + b * 12288; const float* sc = sh + 2048;
#pragma unroll
        for (int j = 0; j < 2; ++j) { const int col = 1024 * j + 16 * F.lane; u32x4 o;
#pragma unroll
            for (int q = 0; q < 4; ++q) { const f32x4 v = *(const f32x4*)(F.x + (size_t)m * DM + col + 4 * q), s = *(const f32x4*)(sc + col + 4 * q), h = *(const f32x4*)(sh + col + 4 * q);
                o[q] = pk4_f8((v.x * (1.f + s.x) + h.x) * SC_H, (v.y * (1.f + s.y) + h.y) * SC_H, (v.z * (1.f + s.z) + h.z) * SC_H, (v.w * (1.f + s.w) + h.w) * SC_H); }
            *(u32x4*)(hb + (size_t)m * DM + col) = o; }
    }
    if (F.wave < 4) {
        const int lane = F.lane, it = F.blk * 4 + F.wave;
        LAS float* scr = (LAS float*)(F.lds + F.wave * 16640);
        for (int r = it; r < 1024; r += 4 * F.G) {
            const int k0 = 64 * (r / 32), n0 = 64 * (r % 32);
            const float am = fmaxf(__uint_as_float(((const unsigned*)(F.ws + WS_CTL + CTL_WQAMAX))[n0 + lane]), 1e-30f), qs = 127.0f / am;
#pragma unroll
            for (int kk = 0; kk < 64; ++kk) scr[kk * 65 + lane] = F.peer_wq[(size_t)(k0 + kk) * DM + n0 + lane];
            LDS_WAIT();
            if (k0 == 0) WSP(float, WS_WQS)[n0 + lane] = am * (1.0f / 127.0f);
            const LAS float* sp = scr + lane;
            unsigned char* o = WSP(unsigned char, WS_WPQ) + (size_t)(n0 + lane) * DM + k0;
#pragma unroll
            for (int q = 0; q < 4; ++q) { u32x4 w;
#pragma unroll
                for (int d = 0; d < 4; ++d) { const int k = 16 * q + 4 * d; w[d] = pk4_i8(sp[k * 65] * qs, sp[(k + 1) * 65] * qs, sp[(k + 2) * 65] * qs, sp[(k + 3) * 65] * qs); }
                *(u32x4*)(o + 16 * q) = w; }
            LDS_WAIT();
        }
    }
}

#define EPI_ROWS(...) _Pragma("unroll") for (int ai = 0; ai < 2; ++ai) _Pragma("unroll") for (int m = 0; m < 4; ++m) { const int row = u.pm * 256 + ai * 128 + wr * 64 + m * 16 + fr; \
    _Pragma("unroll") for (int bj = 0; bj < 2; ++bj) { const int cl = bj * 128 + wc * 32 + 8 * fq; const f32x4 v0 = acc[ai][bj][m][0] * esc, v1 = acc[ai][bj][m][1] * esc; __VA_ARGS__ } }
__device__ __forceinline__ u32x4 pack8(const f32x4 a, const f32x4 b) { return (u32x4){pk2(a.x, a.y), pk2(a.z, a.w), pk2(b.x, b.y), pk2(b.z, b.w)}; }

struct EpiProj {
    static constexpr bool HAS_MID = false;
    static constexpr bool PERM = true;
    bf16 *XR, *GG; unsigned char *QC8, *KVC8; bf16 *SGR, *SGM; float *KR, *SS; float esc;
    __device__ __forceinline__ void operator()(const AccT& acc, const pg8::Unit& u, int wr, int wc, int fr, int fq) const {
        const int pn = u.pn;
        if (pn < 8) { bf16* O = XR + pn * 256;
            EPI_ROWS( *(u32x4*)(O + (size_t)row * DM + cl) = pack8(v0, v1); )
        } else if (pn < 16) { bf16* O = GG + (pn - 8) * 256;
            EPI_ROWS( f32x4 a, b; for (int e = 0; e < 4; ++e) { a[e] = gelu_tanh(v0[e]); b[e] = gelu_tanh(v1[e]); } *(u32x4*)(O + (size_t)row * DM + cl) = pack8(a, b); )
        } else if (pn < 20) { const int which = (pn >= 18); const int c0 = (pn & 1) * 256;
#pragma unroll
            for (int ai = 0; ai < 2; ++ai)
#pragma unroll
                for (int m = 0; m < 4; ++m) { const int row = u.pm * 256 + ai * 128 + wr * 64 + m * 16 + fr; float s = 0.f;
#pragma unroll
                    for (int bj = 0; bj < 2; ++bj) { const int cl = bj * 128 + wc * 32 + 8 * fq; const f32x4 v0 = acc[ai][bj][m][0] * esc, v1 = acc[ai][bj][m][1] * esc;
                        *(u32x2*)((which ? KVC8 : QC8) + (size_t)row * 512 + c0 + cl) = (u32x2){pk4_f8(v0.x * SC_H, v0.y * SC_H, v0.z * SC_H, v0.w * SC_H), pk4_f8(v1.x * SC_H, v1.y * SC_H, v1.z * SC_H, v1.w * SC_H)};
                        s += (v0.x * v0.x + v0.y * v0.y) + (v0.z * v0.z + v0.w * v0.w) + (v1.x * v1.x + v1.y * v1.y) + (v1.z * v1.z + v1.w * v1.w); }
                    SS[(size_t)row * 64 + which * 32 + (pn & 1) * 16 + wc * 4 + fq] = s; }
        } else if (pn < 36) { bf16* O = (pn < 28 ? SGR + (pn - 20) * 256 : SGM + (pn - 28) * 256);
            EPI_ROWS( f32x4 a, b; for (int e = 0; e < 4; ++e) { a[e] = sigmoidf_(v0[e]); b[e] = sigmoidf_(v1[e]); } *(u32x4*)(O + (size_t)row * DM + cl) = pack8(a, b); )
        } else {
            EPI_ROWS( if (cl < 64) { *(f32x4*)(KR + (size_t)row * 64 + cl) = v0; *(f32x4*)(KR + (size_t)row * 64 + cl + 4) = v1; } )
        }
    }
};
struct EpiGate1 {
    static constexpr bool HAS_MID = false;
    static constexpr bool PERM = true; const bf16* SG; bf16* O; float esc;
    __device__ __forceinline__ void operator()(const AccT& acc, const pg8::Unit& u, int wr, int wc, int fr, int fq) const {
        EPI_ROWS( const size_t off = (size_t)row * DM + u.pn * 256 + cl; const u32x4 g = *(const u32x4*)(SG + off);
            f32x4 a = {v0.x * bflo(g.x), v0.y * bfhi(g.x), v0.z * bflo(g.y), v0.w * bfhi(g.y)}, b = {v1.x * bflo(g.z), v1.y * bfhi(g.z), v1.z * bflo(g.w), v1.w * bfhi(g.w)};
            *(u32x4*)(O + off) = pack8(a, b); )
    }
};
struct EpiGate2 {
    static constexpr bool HAS_MID = false;
    static constexpr bool PERM = true; const bf16* SG; const bf16* T; unsigned char* O8; float esc;
    __device__ __forceinline__ void operator()(const AccT& acc, const pg8::Unit& u, int wr, int wc, int fr, int fq) const {
        EPI_ROWS( const size_t off = (size_t)row * DM + u.pn * 256 + cl; const u32x4 g = *(const u32x4*)(SG + off); const u32x4 p = *(const u32x4*)(T + off);
            *(u32x2*)(O8 + off) = (u32x2){pk4_f8((bflo(p.x) + v0.x * bflo(g.x)) * SC_TMP, (bfhi(p.x) + v0.y * bfhi(g.x)) * SC_TMP, (bflo(p.y) + v0.z * bflo(g.y)) * SC_TMP, (bfhi(p.y) + v0.w * bfhi(g.y)) * SC_TMP),
                                          pk4_f8((bflo(p.z) + v1.x * bflo(g.z)) * SC_TMP, (bfhi(p.z) + v1.y * bfhi(g.z)) * SC_TMP, (bflo(p.w) + v1.z * bflo(g.w)) * SC_TMP, (bfhi(p.w) + v1.w * bfhi(g.w)) * SC_TMP)}; )
    }
};
struct EpiMix {
    static constexpr bool HAS_MID = true;
    static constexpr bool PERM = true; const bf16* SGR; const bf16* SGM; unsigned char* O8; float r12, e2;
    __device__ __forceinline__ void mid(AccT& acc, const pg8::Unit& u, int wr, int wc, int fr, int fq) const {
#pragma unroll
        for (int ai = 0; ai < 2; ++ai) {
            u32x4 gr[8], gm[8];
#pragma unroll
            for (int m = 0; m < 4; ++m)
#pragma unroll
                for (int bj = 0; bj < 2; ++bj) { const size_t off = (size_t)(u.pm * 256 + ai * 128 + wr * 64 + m * 16 + fr) * DM + u.pn * 256 + bj * 128 + wc * 32 + 8 * fq;
                    gr[m * 2 + bj] = *(const u32x4*)(SGR + off); gm[m * 2 + bj] = *(const u32x4*)(SGM + off); }
            __builtin_amdgcn_sched_barrier(0);
#pragma unroll
            for (int m = 0; m < 4; ++m)
#pragma unroll
                for (int bj = 0; bj < 2; ++bj) { const u32x4 r = gr[m * 2 + bj], d = gm[m * 2 + bj];
                    const f32x4 n0 = {bflo(r.x), bfhi(r.x), bflo(r.y), bfhi(r.y)}, n1 = {bflo(r.z), bfhi(r.z), bflo(r.w), bfhi(r.w)};
                    const f32x4 d0 = {bflo(d.x), bfhi(d.x), bflo(d.y), bfhi(d.y)}, d1 = {bflo(d.z), bfhi(d.z), bflo(d.w), bfhi(d.w)};
#pragma unroll
                    for (int e = 0; e < 4; ++e) { acc[ai][bj][m][0][e] *= r12 * n0[e] * __builtin_amdgcn_rcpf(fmaxf(d0[e], 1e-12f)); acc[ai][bj][m][1][e] *= r12 * n1[e] * __builtin_amdgcn_rcpf(fmaxf(d1[e], 1e-12f)); } }
            __builtin_amdgcn_sched_barrier(0);
        }
    }
    __device__ __forceinline__ void operator()(const AccT& acc, const pg8::Unit& u, int wr, int wc, int fr, int fq) const {
        const float esc = e2 * SC_TMP;
#pragma unroll
        for (int ai = 0; ai < 2; ++ai) {
            u32x4 gmv[8];
#pragma unroll
            for (int m = 0; m < 4; ++m)
#pragma unroll
                for (int bj = 0; bj < 2; ++bj) gmv[m * 2 + bj] = *(const u32x4*)(SGM + (size_t)(u.pm * 256 + ai * 128 + wr * 64 + m * 16 + fr) * DM + u.pn * 256 + bj * 128 + wc * 32 + 8 * fq);
            __builtin_amdgcn_sched_barrier(0);
#pragma unroll
            for (int m = 0; m < 4; ++m)
#pragma unroll
                for (int bj = 0; bj < 2; ++bj) { const size_t off = (size_t)(u.pm * 256 + ai * 128 + wr * 64 + m * 16 + fr) * DM + u.pn * 256 + bj * 128 + wc * 32 + 8 * fq; const u32x4 gm = gmv[m * 2 + bj];
                    const f32x4 v0 = acc[ai][bj][m][0] * esc, v1 = acc[ai][bj][m][1] * esc;
                    *(u32x2*)(O8 + off) = (u32x2){pk4_f8(v0.x * fmaxf(bflo(gm.x), 1e-12f), v0.y * fmaxf(bfhi(gm.x), 1e-12f), v0.z * fmaxf(bflo(gm.y), 1e-12f), v0.w * fmaxf(bfhi(gm.y), 1e-12f)),
                                                  pk4_f8(v1.x * fmaxf(bflo(gm.z), 1e-12f), v1.y * fmaxf(bfhi(gm.z), 1e-12f), v1.z * fmaxf(bflo(gm.w), 1e-12f), v1.w * fmaxf(bfhi(gm.w), 1e-12f))}; }
            __builtin_amdgcn_sched_barrier(0);
        }
    }
};
struct EpiRes1 {
    static constexpr bool HAS_MID = false;
    static constexpr bool PERM = true; const float* X; const float* mod; bf16* R; float esc;
    __device__ __forceinline__ void operator()(const AccT& acc, const pg8::Unit& u, int wr, int wc, int fr, int fq) const {
        f32x4 g[2][2];
#pragma unroll
        for (int bj = 0; bj < 2; ++bj) { const float* gt = mod + ((u.pm * 256) >> 13) * 12288 + 4096 + u.pn * 256 + bj * 128 + wc * 32 + 8 * fq; g[bj][0] = 1.f + *(const f32x4*)gt; g[bj][1] = 1.f + *(const f32x4*)(gt + 4); }
#pragma unroll
        for (int ai = 0; ai < 2; ++ai) {
            f32x4 xv[8][2];
#pragma unroll
            for (int m = 0; m < 4; ++m)
#pragma unroll
                for (int bj = 0; bj < 2; ++bj) { const float* xp = X + (size_t)(u.pm * 256 + ai * 128 + wr * 64 + m * 16 + fr) * DM + u.pn * 256 + bj * 128 + wc * 32 + 8 * fq; xv[m * 2 + bj][0] = *(const f32x4*)xp; xv[m * 2 + bj][1] = *(const f32x4*)(xp + 4); }
            __builtin_amdgcn_sched_barrier(0);
#pragma unroll
            for (int m = 0; m < 4; ++m)
#pragma unroll
                for (int bj = 0; bj < 2; ++bj) { const size_t off = (size_t)(u.pm * 256 + ai * 128 + wr * 64 + m * 16 + fr) * DM + u.pn * 256 + bj * 128 + wc * 32 + 8 * fq;
                    *(u32x4*)(R + off) = pack8(DN_ALPHA * xv[m * 2 + bj][0] + g[bj][0] * (acc[ai][bj][m][0] * esc), DN_ALPHA * xv[m * 2 + bj][1] + g[bj][1] * (acc[ai][bj][m][1] * esc)); }
            __builtin_amdgcn_sched_barrier(0);
        }
    }
};
struct EpiQuery {
    static constexpr bool HAS_MID = false;
    static constexpr bool PERM = true; bf16* O; const float* HS; const float* WS;
    __device__ __forceinline__ void operator()(const AccT& acc, const pg8::Unit& u, int wr, int wc, int fr, int fq) const {
#pragma unroll
        for (int ai = 0; ai < 2; ++ai)
#pragma unroll
            for (int m = 0; m < 4; ++m) { const int row = u.pm * 256 + ai * 128 + wr * 64 + m * 16 + fr; const float hs = HS[row];
#pragma unroll
                for (int bj = 0; bj < 2; ++bj) { const int col = u.pn * 256 + bj * 128 + wc * 32 + 8 * fq; const f32x4 w0 = *(const f32x4*)(WS + col) * hs, w1 = *(const f32x4*)(WS + col + 4) * hs;
                    const i32x4 a0 = __builtin_bit_cast(i32x4, acc[ai][bj][m][0]), a1 = __builtin_bit_cast(i32x4, acc[ai][bj][m][1]);
                    const f32x4 v0 = {(float)a0.x * w0.x, (float)a0.y * w0.y, (float)a0.z * w0.z, (float)a0.w * w0.w}, v1 = {(float)a1.x * w1.x, (float)a1.y * w1.y, (float)a1.z * w1.z, (float)a1.w * w1.w};
                    *(u32x4*)(O + (size_t)row * DM + col) = pack8(v0, v1); } }
    }
};
#ifdef PROBE_GEMM
struct EpiNull {
    static constexpr bool HAS_MID = false;
    static constexpr bool PERM = true; float* O;
    __device__ __forceinline__ void operator()(const AccT& acc, const pg8::Unit& u, int wr, int wc, int fr, int fq) const {
        f32x4 s = {0.f, 0.f, 0.f, 0.f};
#pragma unroll
        for (int ai = 0; ai < 2; ++ai)
#pragma unroll
            for (int bj = 0; bj < 2; ++bj)
#pragma unroll
                for (int m = 0; m < 4; ++m) s += acc[ai][bj][m][0] + acc[ai][bj][m][1];
        *(f32x4*)(O + ((size_t)(u.pm * 8 + u.pn) * 512 + (wr * 4 + wc) * 64 + fq * 16 + fr) * 4) = s;
    }
};
#endif
struct EpiPlain {
    static constexpr bool HAS_MID = false;
    static constexpr bool PERM = true; bf16* O; float esc;
    __device__ __forceinline__ void operator()(const AccT& acc, const pg8::Unit& u, int wr, int wc, int fr, int fq) const {
        EPI_ROWS( *(u32x4*)(O + (size_t)row * DM + u.pn * 256 + cl) = pack8(v0, v1); )
    }
};
struct EpiQ {
    static constexpr bool HAS_MID = false;
    static constexpr bool PERM = true; unsigned char* Q; const float* SS; const f32x2* rope; float esc;
    __device__ __forceinline__ void operator()(const AccT& acc, const pg8::Unit& u, int wr, int wc, int fr, int fq) const {
        const bool is_rope = u.pn >= 8;
        EPI_ROWS( const float rs = SS[(size_t)row * 2] * (QSCALE * SC_Q); const int b = row >> 13, s = row & 8191;
            if (!is_rope) { const int cg = u.pn * 256 + cl, h = cg >> 7, d = cg & 127;
                *(u32x2*)(Q + (unsigned)(((b * NH + h) * SEQ + s) * DQK + d)) = (u32x2){pk4_f8(v0.x * rs, v0.y * rs, v0.z * rs, v0.w * rs), pk4_f8(v1.x * rs, v1.y * rs, v1.z * rs, v1.w * rs)};
            } else { const int cg = (u.pn - 8) * 256 + cl, h = cg >> 6, jj = cg & 63; const f32x4* cs = (const f32x4*)(rope + (size_t)row * 32 + (jj >> 1));
                const f32x4 c0 = cs[0], c1 = cs[1];
                *(u32x2*)(Q + (unsigned)(((b * NH + h) * SEQ + s) * DQK + 128 + jj)) = (u32x2){
                    pk4_f8((v0.x * c0.x - v0.y * c0.y) * rs, (v0.y * c0.x + v0.x * c0.y) * rs, (v0.z * c0.z - v0.w * c0.w) * rs, (v0.w * c0.z + v0.z * c0.w) * rs),
                    pk4_f8((v1.x * c1.x - v1.y * c1.y) * rs, (v1.y * c1.x + v1.x * c1.y) * rs, (v1.z * c1.z - v1.w * c1.w) * rs, (v1.w * c1.z + v1.z * c1.w) * rs)}; } )
    }
};
struct EpiK {
    static constexpr bool HAS_MID = false;
    static constexpr bool PERM = true; unsigned char* K; const float* SS; float esc;
    __device__ __forceinline__ void operator()(const AccT& acc, const pg8::Unit& u, int wr, int wc, int fr, int fq) const {
        EPI_ROWS( const float rs = SS[(size_t)row * 2 + 1] * SC_K; const int b = row >> 13, s = row & 8191;
            const int cg = u.pn * 256 + cl, h = cg >> 7, d = cg & 127;
            *(u32x2*)(K + (unsigned)(((b * NH + h) * SEQ + s) * DQK + d)) = (u32x2){pk4_f8(v0.x * rs, v0.y * rs, v0.z * rs, v0.w * rs), pk4_f8(v1.x * rs, v1.y * rs, v1.z * rs, v1.w * rs)}; )
    }
};
struct EpiVT {
    static constexpr bool HAS_MID = false;
    static constexpr bool PERM = true; unsigned char* VT; const float* SS; float esc;
    __device__ __forceinline__ void operator()(const AccT& acc, const pg8::Unit& u, int wr, int wc, int fr, int fq) const {
        EPI_ROWS( const int t0 = u.pn * 256 + cl, b = t0 >> 13, s = t0 & 8191, h = row >> 7, d = row & 127; const f32x4* sp = (const f32x4*)(SS + (size_t)t0 * 2);
            const f32x4 s0 = sp[0] * SC_V, s1 = sp[1] * SC_V, s2 = sp[2] * SC_V, s3 = sp[3] * SC_V;
            *(u32x2*)(VT + (unsigned)(((((b * NH + h) * 128 + (s >> 6)) * 128 + d) * 64 + (s & 63)))) = (u32x2){pk4_f8(v0.x * s0.y, v0.y * s0.w, v0.z * s1.y, v0.w * s1.w), pk4_f8(v1.x * s2.y, v1.y * s2.w, v1.z * s3.y, v1.w * s3.w)}; )
    }
};

constexpr int RG_W = 288;
constexpr int RG_SUB = 64;
constexpr int RG_XC = 0, RG_GGT = 36864, RG_OUT = 69632;
__device__ __forceinline__ unsigned char* rg_ab(unsigned char* ws, int tile) { return tile < 1536 ? ws + WS_TMP + (size_t)tile * 131072 : ws + WS_AO8 + (size_t)(tile - 1536) * 131072; }
__device__ __forceinline__ float rg_h_lo(unsigned w) { return (float)__builtin_bit_cast(_Float16, (unsigned short)(w & 0xffffu)); }
__device__ __forceinline__ float rg_h_hi(unsigned w) { return (float)__builtin_bit_cast(_Float16, (unsigned short)(w >> 16)); }
struct RgMap { float A, H; };
__device__ __forceinline__ RgMap rg_then(const RgMap f, const RgMap g) { return RgMap{f.A * g.A, g.A * f.H + g.H}; }
__device__ __forceinline__ void rglru_passA(Frame& F) {
    const int tid = F.tid, lane = F.lane, wave = F.wave;
    {
        const float* ssp = WSP(float, WS_SSP); float* rs = WSP(float, WS_RS);
        for (int i = F.blk * NTHREADS + tid; i < NT * 2; i += F.G * NTHREADS) { const f32x4* p = (const f32x4*)(ssp + (size_t)i * 32); float s = 0.f;
#pragma unroll
            for (int k = 0; k < 8; ++k) { const f32x4 a = p[k]; s += (a.x + a.y) + (a.z + a.w); }
            rs[i] = __builtin_amdgcn_rsqf(s * (1.f / 512.f) + RMS_EPS); } }
    LAS unsigned char* L = F.lds;
    const bf16* XR = WSP(bf16, WS_XR); float* SUMM = WSP(float, WS_SUMM);
    const int q = lane >> 4;
    for (int tile = F.blk; tile < NB * 32 * NH; tile += F.G) {
        const int hh = tile & 15, c = (tile >> 4) & 31, b = tile >> 9;
        const int ech = 16 * wave + (lane & 15), egch = hh * 128 + ech;
        bf16x8 bA[4], bX[4];
        { const bf16* ga = WSP(bf16, WS_WGA) + hh * 16384 + ech * 128 + 8 * (lane >> 4); const bf16* gx = WSP(bf16, WS_WGX) + hh * 16384 + ech * 128 + 8 * (lane >> 4);
#pragma unroll
            for (int ks = 0; ks < 4; ++ks) { bA[ks] = *(const bf16x8*)(ga + 32 * ks); bX[ks] = *(const bf16x8*)(gx + 32 * ks); } }
        const float e_ba = F.b_rg_a[egch], e_bx = F.b_rg_x[egch];
        const float lam = F.rg_lambda[egch]; const float e_sp8 = -8.0f * 1.4426950408889634f * ((lam > 15.f) ? expf(-lam) : (lam < -15.f ? -lam : log1pf(expf(-lam))));
        const int crow = tid >> 4, c8 = (tid & 15) * 8, cg = hh * 128 + c8;
        float cw[4][8], cb[8];
#pragma unroll
        for (int w = 0; w < 4; ++w) { const f32x4 p = *(const f32x4*)(F.conv_w + w * DM + cg), qq = *(const f32x4*)(F.conv_w + w * DM + cg + 4);
            cw[w][0] = p.x; cw[w][1] = p.y; cw[w][2] = p.z; cw[w][3] = p.w; cw[w][4] = qq.x; cw[w][5] = qq.y; cw[w][6] = qq.z; cw[w][7] = qq.w; }
        { const f32x4 p = *(const f32x4*)(F.conv_b + cg), qq = *(const f32x4*)(F.conv_b + cg + 4); cb[0] = p.x; cb[1] = p.y; cb[2] = p.z; cb[3] = p.w; cb[4] = qq.x; cb[5] = qq.y; cb[6] = qq.z; cb[7] = qq.w; }
        float S = 0.f, atot = 1.f;
        u32x4* abw = (u32x4*)rg_ab(F.ws, tile) + (wave * 64 + lane) * 4;
        const size_t tbase = (size_t)b * SEQ + c * 256;
        u32x4 xn[2][4];
#pragma unroll
        for (int hf = 0; hf < 2; ++hf)
#pragma unroll
            for (int w = 0; w < 4; ++w) { const int rr = crow + 32 * hf - 3 + w; xn[hf][w] = (u32x4){0u, 0u, 0u, 0u}; if (c * 256 + rr >= 0) xn[hf][w] = *(const u32x4*)(XR + (tbase + rr) * DM + cg); }
#pragma unroll 1
        for (int sub = 0; sub < 256 / RG_SUB; ++sub) {
            const size_t t0 = tbase + sub * RG_SUB;
            LAS unsigned char* XC = L + RG_XC + (sub & 1) * 18432;
#pragma unroll
            for (int hf = 0; hf < 2; ++hf) { float a[8];
#pragma unroll
                for (int e = 0; e < 8; ++e) a[e] = cb[e];
#pragma unroll
                for (int w = 0; w < 4; ++w) { const u32x4 xv = xn[hf][w];
                    a[0] += cw[w][0] * bflo(xv.x); a[1] += cw[w][1] * bfhi(xv.x); a[2] += cw[w][2] * bflo(xv.y); a[3] += cw[w][3] * bfhi(xv.y);
                    a[4] += cw[w][4] * bflo(xv.z); a[5] += cw[w][5] * bfhi(xv.z); a[6] += cw[w][6] * bflo(xv.w); a[7] += cw[w][7] * bfhi(xv.w); }
                *(LAS u32x4*)(XC + (crow + 32 * hf) * RG_W + c8 * 2) = (u32x4){pk2(a[0], a[1]), pk2(a[2], a[3]), pk2(a[4], a[5]), pk2(a[6], a[7])}; }
            __syncthreads();
            if (sub + 1 < 256 / RG_SUB) {
#pragma unroll
                for (int hf = 0; hf < 2; ++hf)
#pragma unroll
                    for (int w = 0; w < 4; ++w) xn[hf][w] = *(const u32x4*)(XR + (t0 + RG_SUB + crow + 32 * hf - 3 + w) * DM + cg); }
            f32x4 accA[4], accX[4];
#pragma unroll
            for (int rb = 0; rb < 4; ++rb) { accA[rb] = (f32x4){0, 0, 0, 0}; accX[rb] = (f32x4){0, 0, 0, 0}; }
#pragma unroll
            for (int ks = 0; ks < 4; ++ks) { const int ko = (ks * 32 + 8 * (lane >> 4)) * 2;
#pragma unroll
                for (int rb = 0; rb < 4; ++rb) { const bf16x8 af = *(const LAS bf16x8*)(XC + (rb * 16 + (lane & 15)) * RG_W + ko);
                    accA[rb] = __builtin_amdgcn_mfma_f32_16x16x32_bf16(af, bA[ks], accA[rb], 0, 0, 0);
                    accX[rb] = __builtin_amdgcn_mfma_f32_16x16x32_bf16(af, bX[ks], accX[rb], 0, 0, 0); } }
#pragma unroll
            for (int rb = 0; rb < 4; ++rb) {
                RgMap G{1.f, 0.f}; u32x4 pw = {0u, 0u, 0u, 0u};
#pragma unroll
                for (int r = 0; r < 4; ++r) { const int trow = rb * 16 + 4 * q + r;
                    const float xcv = bf1(*(const LAS bf16*)(XC + trow * RG_W + ech * 2));
                    const float rr = sigmoidf_(accA[rb][r] + e_ba), ii = sigmoidf_(accX[rb][r] + e_bx);
                    const float l2 = rr * e_sp8;
                    const float a_ = __builtin_amdgcn_exp2f(l2);
                    const float x2 = l2 * (2.0f * 0.6931471805599453f);
                    const float ser = -x2 * (1.0f + x2 * (0.5f + x2 * (0.16666667f + x2 * (0.041666668f + x2 * 0.008333334f))));
                    const float om = (x2 > -0.25f) ? ser : (1.0f - a_ * a_);
                    const float b_ = __builtin_amdgcn_sqrtf(om) * ii * xcv;
                    pw[r] = __builtin_bit_cast(unsigned, __builtin_amdgcn_cvt_pkrtz(l2, b_));
                    G.H = a_ * G.H + b_; G.A *= a_; }
                abw[sub * 2048 + rb] = pw;
                const RgMap P{__shfl_xor(G.A, 16), __shfl_xor(G.H, 16)};
                const RgMap pr = (q & 1) ? rg_then(P, G) : rg_then(G, P);
                const RgMap Q{__shfl_xor(pr.A, 32), __shfl_xor(pr.H, 32)};
                const RgMap T = (q & 2) ? rg_then(Q, pr) : rg_then(pr, Q);
                S = T.A * S + T.H; atot *= T.A;
            }
        }
        if (q == 0) *(f32x2*)(SUMM + ((size_t)(b * 32 + c) * DM + egch) * 2) = (f32x2){atot, S};
    }
    __syncthreads();
}
__device__ __forceinline__ void rglru_passB(Frame& F) {
    const int tid = F.tid, lane = F.lane, wave = F.wave;
    LAS unsigned char* L = F.lds;
    const bf16* GG = WSP(bf16, WS_GG); unsigned char* RA = WSP(unsigned char, WS_S0); const float* SUMM = WSP(float, WS_SUMM);
    const int q = lane >> 4;
    for (int tile = F.blk; tile < NB * 32 * NH; tile += F.G) {
        const int hh = tile & 15, c = (tile >> 4) & 31, b = tile >> 9;
        const int ech = 16 * wave + (lane & 15), egch = hh * 128 + ech;
        const int crow = tid >> 4, c8 = (tid & 15) * 8, cg = hh * 128 + c8;
        const size_t tbase = (size_t)b * SEQ + c * 256;
        const u32x4* abr = (const u32x4*)rg_ab(F.ws, tile) + (wave * 64 + lane) * 4;
        u32x4 gn[2], ab[4];
        gn[0] = *(const u32x4*)(GG + (tbase + crow) * DM + cg); gn[1] = *(const u32x4*)(GG + (tbase + crow + 32) * DM + cg);
#pragma unroll
        for (int rb = 0; rb < 4; ++rb) ab[rb] = abr[rb];
        float S;
        { f32x2 sv[8];
#pragma unroll
            for (int k = 0; k < 8; ++k) { const int cc = 8 * q + k; sv[k] = (f32x2){1.f, 0.f}; if (cc < c) sv[k] = *(const f32x2*)(SUMM + ((size_t)(b * 32 + cc) * DM + egch) * 2); }
            RgMap M{1.f, 0.f};
#pragma unroll
            for (int k = 0; k < 8; ++k) M = rg_then(M, RgMap{sv[k].x, sv[k].y});
            const RgMap P{__shfl_xor(M.A, 16), __shfl_xor(M.H, 16)}; const RgMap pr = (q & 1) ? rg_then(P, M) : rg_then(M, P);
            const RgMap Q{__shfl_xor(pr.A, 32), __shfl_xor(pr.H, 32)}; const RgMap T = (q & 2) ? rg_then(Q, pr) : rg_then(pr, Q);
            S = T.H; }
#pragma unroll 1
        for (int sub = 0; sub < 256 / RG_SUB; ++sub) {
            const size_t t0 = tbase + sub * RG_SUB;
            LAS unsigned char* GT = L + RG_GGT + (sub & 1) * 16384; LAS unsigned char* OT = L + RG_OUT + (sub & 1) * 8192;
            *(LAS u32x4*)(GT + crow * 256 + c8 * 2) = gn[0]; *(LAS u32x4*)(GT + (crow + 32) * 256 + c8 * 2) = gn[1];
            u32x4 abc[4];
#pragma unroll
            for (int rb = 0; rb < 4; ++rb) abc[rb] = ab[rb];
            __syncthreads();
            if (sub + 1 < 256 / RG_SUB) {
                gn[0] = *(const u32x4*)(GG + (t0 + RG_SUB + crow) * DM + cg); gn[1] = *(const u32x4*)(GG + (t0 + RG_SUB + crow + 32) * DM + cg);
#pragma unroll
                for (int rb = 0; rb < 4; ++rb) ab[rb] = abr[(sub + 1) * 2048 + rb]; }
#pragma unroll
            for (int rb = 0; rb < 4; ++rb) {
                float av[4], bv[4];
#pragma unroll
                for (int r = 0; r < 4; ++r) { const unsigned pk = abc[rb][r]; av[r] = __builtin_amdgcn_exp2f(rg_h_lo(pk)); bv[r] = rg_h_hi(pk); }
                RgMap G{1.f, 0.f};
#pragma unroll
                for (int r = 0; r < 4; ++r) { G.H = av[r] * G.H + bv[r]; G.A *= av[r]; }
                const RgMap P{__shfl_xor(G.A, 16), __shfl_xor(G.H, 16)};
                const RgMap pr = (q & 1) ? rg_then(P, G) : rg_then(G, P);
                const RgMap Q{__shfl_xor(pr.A, 32), __shfl_xor(pr.H, 32)};
                const RgMap T = (q & 2) ? rg_then(Q, pr) : rg_then(pr, Q);
                RgMap E{1.f, 0.f}; if (q & 2) E = Q; if (q & 1) E = rg_then(E, P);
                float h = E.A * S + E.H; float y[4];
#pragma unroll
                for (int r = 0; r < 4; ++r) { const int trow = rb * 16 + 4 * q + r; h = av[r] * h + bv[r]; y[r] = h * bf1(*(const LAS bf16*)(GT + trow * 256 + ech * 2)) * SC_RA; }
                const unsigned w = pk4_f8(y[0], y[1], y[2], y[3]); const int tr0 = rb * 16 + 4 * q;
                OT[tr0 * 128 + ech] = (unsigned char)w; OT[(tr0 + 1) * 128 + ech] = (unsigned char)(w >> 8); OT[(tr0 + 2) * 128 + ech] = (unsigned char)(w >> 16); OT[(tr0 + 3) * 128 + ech] = (unsigned char)(w >> 24);
                S = T.A * S + T.H;
            }
            __syncthreads();
            { const int r = tid >> 3, cq = (tid & 7) * 16; *(u32x4*)(RA + (t0 + r) * DM + hh * 128 + cq) = *(const LAS u32x4*)(OT + r * 128 + cq); }
        }
    }
    __syncthreads();
}

__device__ __forceinline__ void krope_fill(Frame& F) {
    const int fl = fresh_lane(); const int gw = F.blk * NWAVES + F.wave, NGW = F.G * NWAVES, j4 = (fl & 7) * 4, tsub = fl >> 3;
    const float* KR = WSP(float, WS_KR); const f32x2* rope = WSP(f32x2, WS_ROPE); unsigned char* K = (unsigned char*)F.out + OUT_K;
    for (int tp = gw; tp < NT / 8; tp += NGW) { const int t = 8 * tp + tsub, b = t >> 13, s = t & 8191;
        const f32x4 x1 = *(const f32x4*)(KR + (size_t)t * 64 + j4), x2 = *(const f32x4*)(KR + (size_t)t * 64 + 32 + j4);
        const f32x4 c01 = *(const f32x4*)(rope + (size_t)t * 32 + j4), c23 = *(const f32x4*)(rope + (size_t)t * 32 + j4 + 2);
        const u32x2 w = {pk4_f8((x1.x * c01.x - x2.x * c01.y) * SC_K, (x2.x * c01.x + x1.x * c01.y) * SC_K, (x1.y * c01.z - x2.y * c01.w) * SC_K, (x2.y * c01.z + x1.y * c01.w) * SC_K),
                         pk4_f8((x1.z * c23.x - x2.z * c23.y) * SC_K, (x2.z * c23.x + x1.z * c23.y) * SC_K, (x1.w * c23.z - x2.w * c23.w) * SC_K, (x2.w * c23.z + x1.w * c23.w) * SC_K)};
#pragma unroll
        for (int h = 0; h < NH; ++h) *(u32x2*)(K + ((size_t)(b * NH + h) * SEQ + s) * DQK + 128 + 2 * j4) = w; }
}

constexpr int AT_KB = 12288, AT_VB = 8192, AT_BUF = AT_KB + AT_VB;
#define AT_LD8(p0_, p1_) __builtin_shufflevector(*(const LAS i32x4*)(p0_), *(const LAS i32x4*)(p1_), 0, 1, 2, 3, 4, 5, 6, 7)
constexpr int AT_SLOT = AT_KB + AT_VB, AT_NSLOT = 5;
struct AttnState { f32x16 o[4], p0, p1; f32x4 osum; i32x8 pb; float m_run; };
#define AT_MFMA(A_, B_, C_) __builtin_amdgcn_mfma_scale_f32_32x32x64_f8f6f4(A_, B_, C_, 0, 0, 0, 0x7F7F7F7F, 0, 0x7F7F7F7F)
#define AT_PIN() __builtin_amdgcn_sched_barrier(0)
template <bool FAST>
__device__ __forceinline__ void attn_iter(AttnState& S, const i32x8 (&qf)[3], const LAS unsigned char* Vprev, const LAS unsigned char* Knext, int xo0, int xo1, int r32, int hi,
                                          bool act_prev, bool act_cur, bool act_next, bool need_mask, int dq) {
    constexpr float CS = 1.0f / (SC_Q * SC_K), LSP = 6.0f;
    const f32x16 z16 = {0.f, 0.f, 0.f, 0.f, 0.f, 0.f, 0.f, 0.f, 0.f, 0.f, 0.f, 0.f, 0.f, 0.f, 0.f, 0.f};
    const int sel = (((r32 & 15) >> 2) & 1) == ((hi * 2 + (r32 >> 4)) & 1) ? 0x38383838 : 0;
    const i32x8 ones8 = {sel, sel, sel, sel, sel, sel, sel, sel};
#define AT_ROWSUM(PB_, ACC_) __builtin_amdgcn_mfma_scale_f32_16x16x128_f8f6f4(ones8, PB_, ACC_, 0, 0, 0, 0x7F7F7F7F, 0, 0x7F7F7F7F)
    float pmax = -__builtin_inff();
    if (FAST) {
        const LAS unsigned char* vb = Vprev + r32 * 64;
        const i32x8 v0 = AT_LD8(vb + xo0, vb + xo1), v1 = AT_LD8(vb + 2048 + xo0, vb + 2048 + xo1);
        S.osum = AT_ROWSUM(S.pb, S.osum);
        AT_PIN(); pmax = fmaxf(fmaxf(S.p0[0], S.p0[1]), fmaxf(S.p0[2], S.p0[3])); pmax = fmaxf(pmax, fmaxf(fmaxf(S.p0[4], S.p0[5]), fmaxf(S.p0[6], S.p0[7]))); AT_PIN();
        S.o[0] = AT_MFMA(v0, S.pb, S.o[0]);
        const i32x8 v2 = AT_LD8(vb + 4096 + xo0, vb + 4096 + xo1);
        AT_PIN(); pmax = fmaxf(pmax, fmaxf(fmaxf(S.p0[8], S.p0[9]), fmaxf(S.p0[10], S.p0[11]))); pmax = fmaxf(pmax, fmaxf(fmaxf(S.p0[12], S.p0[13]), fmaxf(S.p0[14], S.p0[15]))); AT_PIN();
        S.o[1] = AT_MFMA(v1, S.pb, S.o[1]);
        const i32x8 v3 = AT_LD8(vb + 6144 + xo0, vb + 6144 + xo1);
        AT_PIN(); pmax = fmaxf(pmax, fmaxf(fmaxf(S.p1[0], S.p1[1]), fmaxf(S.p1[2], S.p1[3]))); pmax = fmaxf(pmax, fmaxf(fmaxf(S.p1[4], S.p1[5]), fmaxf(S.p1[6], S.p1[7]))); AT_PIN();
        S.o[2] = AT_MFMA(v2, S.pb, S.o[2]);
        AT_PIN(); pmax = fmaxf(pmax, fmaxf(fmaxf(S.p1[8], S.p1[9]), fmaxf(S.p1[10], S.p1[11]))); pmax = fmaxf(pmax, fmaxf(fmaxf(S.p1[12], S.p1[13]), fmaxf(S.p1[14], S.p1[15]))); AT_PIN();
        S.o[3] = AT_MFMA(v3, S.pb, S.o[3]);
    } else if (act_prev) {
        const LAS unsigned char* vb = Vprev + r32 * 64;
        S.osum = AT_ROWSUM(S.pb, S.osum);
#pragma unroll
        for (int d = 0; d < 4; ++d) { const i32x8 vf = AT_LD8(vb + d * 2048 + xo0, vb + d * 2048 + xo1); S.o[d] = AT_MFMA(vf, S.pb, S.o[d]); AT_PIN(); }
    }
    if (!FAST) {
        if (act_cur) {
            if (need_mask) { const float NEG = -__builtin_inff();
#pragma unroll
                for (int r = 0; r < 16; ++r) { const int cr = (r & 3) + 8 * (r >> 2); if (cr > dq) S.p0[r] = NEG; if (cr + 32 > dq) S.p1[r] = NEG; } }
#pragma unroll
            for (int r = 0; r < 16; ++r) pmax = fmaxf(pmax, fmaxf(S.p0[r], S.p1[r]));
        }
    }
    float alpha = 1.f; bool resc = false; f32x16 n0 = z16, n1 = z16;
    if (FAST || act_cur) {
        { auto rr = __builtin_amdgcn_permlane32_swap(__float_as_uint(pmax), __float_as_uint(pmax), false, false); pmax = fmaxf(__uint_as_float(rr[0]), __uint_as_float(rr[1])) * CS; }
        resc = !__all(pmax - S.m_run <= 2.0f);
        const float mn = resc ? fmaxf(S.m_run, pmax) : S.m_run; alpha = __builtin_amdgcn_exp2f(S.m_run - mn); S.m_run = mn;
    }
    const float moff = LSP - S.m_run;
    const LAS unsigned char* kb = Knext + r32 * 192;
    if (FAST) {
        i32x8 ka = AT_LD8(kb + xo0, kb + xo1), kc = AT_LD8(kb + 32 * 192 + xo0, kb + 32 * 192 + xo1);
#pragma unroll
        for (int ks = 0; ks < 3; ++ks) {
            n0 = AT_MFMA(ka, qf[ks], ks == 0 ? z16 : n0); n1 = AT_MFMA(kc, qf[ks], ks == 0 ? z16 : n1);
            if (ks < 2) { ka = AT_LD8(kb + (ks + 1) * 64 + xo0, kb + (ks + 1) * 64 + xo1); kc = AT_LD8(kb + 32 * 192 + (ks + 1) * 64 + xo0, kb + 32 * 192 + (ks + 1) * 64 + xo1); }
            AT_PIN();
#pragma unroll
            for (int r = (ks * 16) / 3; r < ((ks + 1) * 16) / 3; ++r) { S.p0[r] = __builtin_amdgcn_exp2f(__builtin_fmaf(S.p0[r], CS, moff)); S.p1[r] = __builtin_amdgcn_exp2f(__builtin_fmaf(S.p1[r], CS, moff)); }
            AT_PIN();
        }
    } else {
        if (act_next) {
#pragma unroll
            for (int ks = 0; ks < 3; ++ks) { const i32x8 ka = AT_LD8(kb + ks * 64 + xo0, kb + ks * 64 + xo1), kc = AT_LD8(kb + 32 * 192 + ks * 64 + xo0, kb + 32 * 192 + ks * 64 + xo1);
                n0 = AT_MFMA(ka, qf[ks], ks == 0 ? z16 : n0); n1 = AT_MFMA(kc, qf[ks], ks == 0 ? z16 : n1); } }
        if (act_cur) {
#pragma unroll
            for (int r = 0; r < 16; ++r) { S.p0[r] = __builtin_amdgcn_exp2f(__builtin_fmaf(S.p0[r], CS, moff)); S.p1[r] = __builtin_amdgcn_exp2f(__builtin_fmaf(S.p1[r], CS, moff)); } }
    }
    if (FAST || act_cur) {
#pragma unroll
        for (int jj = 0; jj < 4; ++jj) { int a = __builtin_amdgcn_cvt_pk_fp8_f32(S.p0[4 * jj], S.p0[4 * jj + 1], 0, false); a = __builtin_amdgcn_cvt_pk_fp8_f32(S.p0[4 * jj + 2], S.p0[4 * jj + 3], a, true);
            int bq = __builtin_amdgcn_cvt_pk_fp8_f32(S.p1[4 * jj], S.p1[4 * jj + 1], 0, false); bq = __builtin_amdgcn_cvt_pk_fp8_f32(S.p1[4 * jj + 2], S.p1[4 * jj + 3], bq, true);
            auto rr = __builtin_amdgcn_permlane32_swap((unsigned)a, (unsigned)bq, false, false); S.pb[2 * jj] = (int)rr[0]; S.pb[2 * jj + 1] = (int)rr[1]; }
        if (resc) {
#pragma unroll
            for (int d = 0; d < 4; ++d)
#pragma unroll
                for (int r = 0; r < 16; ++r) S.o[d][r] *= alpha;
            S.osum = S.osum * alpha;
        }
    }
    S.p0 = n0; S.p1 = n1;
#undef AT_ROWSUM
}
__device__ __forceinline__ void attn_block(Frame& F, int bh, int qb, const unsigned char* Q, const unsigned char* Kg, const unsigned char* VTg, unsigned char* AO) {
    const int lane = F.lane, wave = F.wave, r32 = lane & 31, hi = lane >> 5;
    LAS unsigned char* L = F.lds; const unsigned ldsbase = (unsigned)(size_t)L;
    const int q0 = qb * 256, qrow = q0 + 32 * wave + r32, ntiles = 4 * (qb + 1);
    unsigned kv0, kv1, vv;
    { const int q = wave * 64 + lane, row = q / 12, pos = q % 12, c = (pos & ~3) | ((pos ^ (row >> 2)) & 3); kv0 = (unsigned)((row * 12 + c) * 16); }
    { const int q = (wave + 8) * 64 + lane, row = q / 12, pos = q % 12, c = (pos & ~3) | ((pos ^ (row >> 2)) & 3); kv1 = (unsigned)((row * 12 + c) * 16); }
    { const int q = wave * 64 + lane, row = q >> 2, pos = q & 3, c = pos ^ ((row >> 2) & 3); vv = (unsigned)((row * 4 + c) * 16); }
    const bool k2 = wave < 4;
    const char* kgb = (const char*)Kg + (size_t)bh * SEQ * DQK; const char* vgb = (const char*)VTg + (size_t)bh * SEQ * DV;
#define AT_ISSUE(tile, slot) do { const int _t = (tile) < ntiles ? (tile) : ntiles - 1; const unsigned _s = ldsbase + (slot) * AT_SLOT; \
        glds16(kgb + (size_t)_t * AT_KB, kv0, _s + wave * 1024); if (k2) glds16(kgb + (size_t)_t * AT_KB, kv1, _s + (wave + 8) * 1024); \
        glds16(vgb + (size_t)_t * AT_VB, vv, _s + AT_KB + wave * 1024); } while (0)
    AT_ISSUE(0, 0); AT_ISSUE(1, 1); AT_ISSUE(2, 2);
    i32x8 qf[3];
    { const unsigned char* qp = Q + ((size_t)bh * SEQ + qrow) * DQK + 32 * hi;
#pragma unroll
        for (int ks = 0; ks < 3; ++ks) { const i32x4 lo = *(const i32x4*)(qp + 64 * ks), hh = *(const i32x4*)(qp + 64 * ks + 16); qf[ks] = __builtin_shufflevector(lo, hh, 0, 1, 2, 3, 4, 5, 6, 7); } }
    asm volatile("s_waitcnt vmcnt(0)" ::: "memory");
    const f32x16 z16 = {0.f, 0.f, 0.f, 0.f, 0.f, 0.f, 0.f, 0.f, 0.f, 0.f, 0.f, 0.f, 0.f, 0.f, 0.f, 0.f};
    AttnState S; S.o[0] = z16; S.o[1] = z16; S.o[2] = z16; S.o[3] = z16; S.osum = (f32x4){0.f, 0.f, 0.f, 0.f}; S.p0 = z16; S.p1 = z16; S.m_run = -1e30f;
    S.pb = (i32x8){0, 0, 0, 0, 0, 0, 0, 0};
    const int swz = (r32 >> 2) & 3; const int xo0 = (((2 * hi) ^ swz) << 4), xo1 = (((2 * hi + 1) ^ swz) << 4);
    const int wfirst = q0 + 32 * wave, wlast = wfirst + 31;
    __syncthreads();
    { const LAS unsigned char* kb = L + r32 * 192;
#pragma unroll
        for (int ks = 0; ks < 3; ++ks) { const i32x8 ka = AT_LD8(kb + ks * 64 + xo0, kb + ks * 64 + xo1), kc = AT_LD8(kb + 32 * 192 + ks * 64 + xo0, kb + 32 * 192 + ks * 64 + xo1);
            S.p0 = AT_MFMA(ka, qf[ks], ks == 0 ? z16 : S.p0); S.p1 = AT_MFMA(kc, qf[ks], ks == 0 ? z16 : S.p1); } }
    const int nfast = 4 * qb;
#define AT_HEAD(j) if (k2) asm volatile("s_waitcnt vmcnt(3)" ::: "memory"); else asm volatile("s_waitcnt vmcnt(2)" ::: "memory"); \
        __syncthreads(); AT_ISSUE((j) + 3, ((j) + 3) % 5); \
        const LAS unsigned char* Vprev = L + (((j) + 4) % 5) * AT_SLOT + AT_KB; const LAS unsigned char* Knext = L + (((j) + 1) % 5) * AT_SLOT;
#define AT_SLOW(j) { const bool ap = (j) >= 1 && 64 * ((j) - 1) <= wlast, ac = (j) < ntiles && 64 * (j) <= wlast, an = (j) + 1 < ntiles && 64 * ((j) + 1) <= wlast; \
        attn_iter<false>(S, qf, Vprev, Knext, xo0, xo1, r32, hi, ap, ac, an, 64 * (j) + 63 > wfirst, qrow - 64 * (j) - 4 * hi); }
    int j = 0;
    { AT_HEAD(0); AT_SLOW(0); j = 1; }
#pragma unroll 1
    for (; j + 1 < nfast; ++j) { AT_HEAD(j); attn_iter<true>(S, qf, Vprev, Knext, xo0, xo1, r32, hi, true, true, true, false, 0); }
#pragma unroll 1
    for (; j <= ntiles; ++j) { AT_HEAD(j); AT_SLOW(j); }
#undef AT_HEAD
#undef AT_SLOW
#undef AT_ISSUE
    { int l2; asm volatile("v_mbcnt_lo_u32_b32 %0, -1, 0\n\tv_mbcnt_hi_u32_b32 %0, -1, %0" : "=v"(l2));
      const float inv = SC_AO / (SC_V * S.osum[0]); unsigned char* op = AO + ((size_t)(bh >> 4) * SEQ + qb * 256 + 32 * wave + (l2 & 31)) * DM + (bh & 15) * 128 + 4 * (l2 >> 5);
#pragma unroll
        for (int d = 0; d < 4; ++d)
#pragma unroll
            for (int g = 0; g < 4; ++g) *(unsigned*)(op + 32 * d + 8 * g) = pk4_f8(S.o[d][4 * g] * inv, S.o[d][4 * g + 1] * inv, S.o[d][4 * g + 2] * inv, S.o[d][4 * g + 3] * inv); }
    asm volatile("s_waitcnt vmcnt(0)" ::: "memory");
    __syncthreads();
}
#undef AT_MFMA
#undef AT_PIN
__device__ __forceinline__ void attn_phase(Frame& F) {
    const unsigned char* Q = (const unsigned char*)F.out + OUT_Q; const unsigned char* Kg = (const unsigned char*)F.out + OUT_K; const unsigned char* VTg = (const unsigned char*)F.out + OUT_VT; unsigned char* AO = WSP(unsigned char, WS_AO8);
    for (int it = F.blk; it < 1024; it += F.G) {
        const int r = it / F.G;
        int bh, y;
        if (F.G == 256) { const int x = F.blk & 7, loc = F.blk >> 3; bh = x * 8 + r * 2 + (loc >> 4); y = loc & 15; }
        else { bh = it >> 4; y = it & 15; }
        attn_block(F, bh, 31 - y, Q, Kg, VTg, AO);
        attn_block(F, bh, y, Q, Kg, VTg, AO);
    }
}

__device__ __forceinline__ void ln1_phase(Frame& F) {
    const int gw = F.blk * NWAVES + F.wave, NGW = F.G * NWAVES, lane = fresh_lane();
    bf16* R1 = WSP(bf16, WS_R1); unsigned char* H2I = WSP(unsigned char, WS_H2I); float* HSC = WSP(float, WS_HSC); const float* mod = WSP(float, WS_MOD);
    for (int m = gw; m < NT; m += NGW) {
        u32x4* rp = (u32x4*)(R1 + (size_t)m * DM) + lane; f32x4 v[8]; float s = 0.f;
#pragma unroll
        for (int j = 0; j < 4; ++j) { const u32x4 w = rp[64 * j]; v[2 * j] = (f32x4){bflo(w.x), bfhi(w.x), bflo(w.y), bfhi(w.y)}; v[2 * j + 1] = (f32x4){bflo(w.z), bfhi(w.z), bflo(w.w), bfhi(w.w)};
            s += ((v[2 * j].x + v[2 * j].y) + (v[2 * j].z + v[2 * j].w)) + ((v[2 * j + 1].x + v[2 * j + 1].y) + (v[2 * j + 1].z + v[2 * j + 1].w)); }
        const float mean = wave_sum(s) * (1.f / DM); float s2 = 0.f;
#pragma unroll
        for (int j = 0; j < 8; ++j) { v[j] = v[j] - mean; s2 += (v[j].x * v[j].x + v[j].y * v[j].y) + (v[j].z * v[j].z + v[j].w * v[j].w); }
        const float rstd = __builtin_amdgcn_rsqf(wave_sum(s2) * (1.f / DM) + LN_EPS);
        const int b = m >> 13; const float* sh2 = mod + b * 12288 + 6144; const float* sc2 = mod + b * 12288 + 8192;
        float amax = 0.f;
#pragma unroll
        for (int j = 0; j < 4; ++j) { const int col = 512 * j + 8 * lane; f32x4 y[2];
#pragma unroll
            for (int q = 0; q < 2; ++q) { const f32x4 g = *(const f32x4*)(F.ln1_g + col + 4 * q), bb = *(const f32x4*)(F.ln1_b + col + 4 * q);
                y[q] = v[2 * j + q] * rstd * g + bb; v[2 * j + q] = y[q] * (1.f + *(const f32x4*)(sc2 + col + 4 * q)) + *(const f32x4*)(sh2 + col + 4 * q);
                const f32x4 hh = v[2 * j + q]; amax = fmaxf(amax, fmaxf(fmaxf(fabsf(hh.x), fabsf(hh.y)), fmaxf(fabsf(hh.z), fabsf(hh.w)))); }
            rp[64 * j] = pack8(y[0], y[1]); }
        amax = fmaxf(wave_max(amax), 1e-20f); const float qs = 127.0f / amax;
        if (lane == 0) HSC[m] = amax * (1.0f / 127.0f);
#pragma unroll
        for (int j = 0; j < 4; ++j) { const f32x4 a = v[2 * j] * qs, c = v[2 * j + 1] * qs;
            *(u32x2*)(H2I + (size_t)m * DM + 512 * j + 8 * lane) = (u32x2){pk4_i8(a.x, a.y, a.z, a.w), pk4_i8(c.x, c.y, c.z, c.w)}; }
    }
    { unsigned char* pu = WSP(unsigned char, WS_PU); float* usc = WSP(float, WS_USC);
        for (int e = gw; e < 16384; e += NGW) { f32x4 r[8]; float amax = 0.f;
#pragma unroll
            for (int j = 0; j < 4; ++j) { r[2 * j] = *(const f32x4*)(F.peer_u + (size_t)e * DM + 512 * j + 8 * lane); r[2 * j + 1] = *(const f32x4*)(F.peer_u + (size_t)e * DM + 512 * j + 8 * lane + 4); }
#pragma unroll
            for (int j = 0; j < 8; ++j) amax = fmaxf(amax, fmaxf(fmaxf(fabsf(r[j].x), fabsf(r[j].y)), fmaxf(fabsf(r[j].z), fabsf(r[j].w))));
            amax = fmaxf(wave_max(amax), 1e-30f); const float qs = 127.0f / amax;
            if (lane == 0) usc[e] = amax * (1.0f / 127.0f);
#pragma unroll
            for (int j = 0; j < 4; ++j) { const f32x4 a = r[2 * j] * qs, c = r[2 * j + 1] * qs;
                *(u32x2*)(pu + (size_t)(4 * j + (lane >> 4)) * 2097152 + (size_t)e * 128 + 8 * (lane & 15)) = (u32x2){pk4_i8(a.x, a.y, a.z, a.w), pk4_i8(c.x, c.y, c.z, c.w)}; } } }
    { unsigned char* pv = WSP(unsigned char, WS_PV); float* vsc = WSP(float, WS_VSC);
        for (int e = gw; e < 16384; e += NGW) { f32x4 r[8]; float amax = 0.f;
#pragma unroll
            for (int j = 0; j < 4; ++j) { r[2 * j] = *(const f32x4*)(F.peer_v + (size_t)e * DM + 512 * j + 8 * lane); r[2 * j + 1] = *(const f32x4*)(F.peer_v + (size_t)e * DM + 512 * j + 8 * lane + 4); }
#pragma unroll
            for (int j = 0; j < 8; ++j) amax = fmaxf(amax, fmaxf(fmaxf(fabsf(r[j].x), fabsf(r[j].y)), fmaxf(fabsf(r[j].z), fabsf(r[j].w))));
            amax = fmaxf(wave_max(amax), 1e-30f); const float qs = 127.0f / amax;
            if (lane == 0) vsc[e] = amax * (1.0f / 127.0f);
#pragma unroll
            for (int j = 0; j < 4; ++j) { const f32x4 a = r[2 * j] * qs, c = r[2 * j + 1] * qs;
                *(u32x2*)(pv + (size_t)(4 * j + (lane >> 4)) * 2097152 + (size_t)e * 128 + 8 * (lane & 15)) = (u32x2){pk4_i8(a.x, a.y, a.z, a.w), pk4_i8(c.x, c.y, c.z, c.w)}; } } }
}

constexpr int PK_KW = 288, PK_KEYS = 0, PK_SF = 2 * 128 * PK_KW  , PK_SI = PK_SF + 64 * 2 * 16 * 4, PK_TAB = PK_SI + 64 * 2 * 16 * 4;
__device__ __forceinline__ unsigned ord_key(float s) { unsigned u = __float_as_uint(s); return u ^ ((u >> 31) ? 0xffffffffu : 0x80000000u); }
__device__ __forceinline__ float ord_inv(unsigned k) { return __uint_as_float((k >> 31) ? (k ^ 0x80000000u) : ~k); }
#define PK_CE(a_, b_) do { const unsigned _h = (a_) > (b_) ? (a_) : (b_), _l = (a_) > (b_) ? (b_) : (a_); (a_) = _h; (b_) = _l; } while (0)
__device__ __forceinline__ void sort16_desc(unsigned (&v)[16]) {
#pragma unroll
    for (int k = 2; k <= 16; k <<= 1)
#pragma unroll
        for (int j = k >> 1; j > 0; j >>= 1)
#pragma unroll
            for (int i = 0; i < 16; ++i) { const int l = i ^ j; if (l > i) { if ((i & k) == 0) PK_CE(v[i], v[l]); else PK_CE(v[l], v[i]); } }
}
__device__ __forceinline__ void merge16_desc(unsigned (&v)[16]) {
#pragma unroll
    for (int j = 8; j > 0; j >>= 1)
#pragma unroll
        for (int i = 0; i < 16; ++i) { const int l = i ^ j; if (l > i) PK_CE(v[i], v[l]); }
}
__device__ __forceinline__ void top16_with_partner(unsigned (&v)[16], int mask) {
    unsigned o[16];
#pragma unroll
    for (int i = 0; i < 16; ++i) o[i] = (unsigned)__shfl_xor((int)v[i], mask);
#pragma unroll
    for (int i = 0; i < 16; ++i) v[i] = v[i] > o[15 - i] ? v[i] : o[15 - i];
    merge16_desc(v);
}
__device__ __forceinline__ void peer_score_phase(Frame& F) {
    const int tid = F.tid, lane = F.lane, wave = F.wave;
    LAS unsigned char* L = F.lds;
    const bf16* PQ = WSP(bf16, WS_PQ); int* IDX = WSP(int, WS_IDX); float* GATE = WSP(float, WS_GATE);
    { const u32x4* kg = WSP(u32x4, WS_PKEYS);
#pragma unroll
        for (int i = 0; i < 8; ++i) { const int id = tid + NTHREADS * i, r = id >> 4, ch = id & 15; *(LAS u32x4*)(L + PK_KEYS + r * PK_KW + ch * 16) = kg[id]; } }
    if (tid == 0) { int n = 0; for (int i = 0; i < 16; ++i) for (int j = 0; j < 16; ++j) if ((i + 1) * (j + 1) <= 16) L[PK_TAB + n++] = (unsigned char)(i * 16 + j); for (; n < 64; ++n) L[PK_TAB + n] = 0xff; }
    __syncthreads();
    LAS float* SF = (LAS float*)(L + PK_SF); LAS int* SI = (LAS int*)(L + PK_SI);
    for (int tile = F.blk; tile < NT * PEER_H / 64; tile += F.G) {
        const int R0 = tile * 64;
        { const int p = wave >> 2, rb = (wave & 3) * 16, c = lane & 15, fq = lane >> 4; const bf16* qp = PQ + (size_t)(R0 + rb + c) * 256 + p * 128 + 8 * fq;
            bf16x8 qfr[4];
#pragma unroll
            for (int ks = 0; ks < 4; ++ks) qfr[ks] = *(const bf16x8*)(qp + 32 * ks);
            unsigned lo[16], hi[16];
#pragma unroll
            for (int nb = 0; nb < 8; ++nb) { f32x4 acc = {0, 0, 0, 0};
#pragma unroll
                for (int ks = 0; ks < 4; ++ks) { const bf16x8 kfr = *(const LAS bf16x8*)(L + PK_KEYS + (p * 128 + nb * 16 + c) * PK_KW + (ks * 32 + 8 * fq) * 2);
                    acc = __builtin_amdgcn_mfma_f32_16x16x32_bf16(kfr, qfr[ks], acc, 0, 0, 0); }
#pragma unroll
                for (int r = 0; r < 4; ++r) { const unsigned key = (ord_key(acc[r]) & ~127u) | (unsigned)(127 - (16 * nb + 4 * fq + r));
                    if (nb < 4) lo[nb * 4 + r] = key; else hi[(nb - 4) * 4 + r] = key; } }
            sort16_desc(lo); sort16_desc(hi);
#pragma unroll
            for (int i = 0; i < 16; ++i) lo[i] = lo[i] > hi[15 - i] ? lo[i] : hi[15 - i];
            merge16_desc(lo);
            top16_with_partner(lo, 16); top16_with_partner(lo, 32);
            if (fq == 0) { LAS float* sf = SF + ((rb + c) * 2 + p) * 16; LAS int* si = SI + ((rb + c) * 2 + p) * 16;
#pragma unroll
                for (int i = 0; i < 16; ++i) { sf[i] = ord_inv(lo[i] & ~127u); si[i] = 127 - (int)(lo[i] & 127u); } } }
        __syncthreads();
        if (tid < 256) { const int R = tid >> 2, c = tid & 3; const LAS float* a = SF + (R * 2) * 16; const LAS float* bq = a + 16;
            unsigned v[16];
#pragma unroll
            for (int m = 0; m < 16; ++m) { v[m] = 0u; if (m < 13) { const unsigned pr = L[PK_TAB + c + 4 * m]; if (pr != 0xffu) v[m] = (ord_key(a[pr >> 4] + bq[pr & 15]) & ~255u) | (255u - pr); } }
            sort16_desc(v); top16_with_partner(v, 1); top16_with_partner(v, 2);
            unsigned w0 = c == 0 ? v[0] : (c == 1 ? v[4] : (c == 2 ? v[8] : v[12])), w1 = c == 0 ? v[1] : (c == 1 ? v[5] : (c == 2 ? v[9] : v[13]));
            unsigned w2 = c == 0 ? v[2] : (c == 1 ? v[6] : (c == 2 ? v[10] : v[14])), w3 = c == 0 ? v[3] : (c == 1 ? v[7] : (c == 2 ? v[11] : v[15]));
            const unsigned pm = 255u - (v[0] & 255u); const float smax = a[pm >> 4] + bq[pm & 15];
            const LAS int* ia = SI + (R * 2) * 16; const LAS int* ib = ia + 16;
            const unsigned p0 = 255u - (w0 & 255u), p1 = 255u - (w1 & 255u), p2 = 255u - (w2 & 255u), p3 = 255u - (w3 & 255u);
            f32x4 e = {__expf(a[p0 >> 4] + bq[p0 & 15] - smax), __expf(a[p1 >> 4] + bq[p1 & 15] - smax), __expf(a[p2 >> 4] + bq[p2 & 15] - smax), __expf(a[p3 >> 4] + bq[p3 & 15] - smax)};
            float sum = (e.x + e.y) + (e.z + e.w); sum += __shfl_xor(sum, 1); sum += __shfl_xor(sum, 2);
            const float inv = 1.0f / sum; const size_t ob = (size_t)(R0 + R) * 16 + 4 * c;
            *(f32x4*)(GATE + ob) = e * inv;
            *(int4*)(IDX + ob) = make_int4(ia[p0 >> 4] * NKEYS + ib[p0 & 15], ia[p1 >> 4] * NKEYS + ib[p1 & 15], ia[p2 >> 4] * NKEYS + ib[p2 & 15], ia[p3 >> 4] * NKEYS + ib[p3 & 15]); }
        __syncthreads();
    }
}
#undef PK_CE

__device__ __forceinline__ void ln2_rows(Frame& F, int m0, int nrows) {
    int lane; asm volatile("v_mbcnt_lo_u32_b32 %0, -1, 0\n\tv_mbcnt_hi_u32_b32 %0, -1, %0" : "=v"(lane));
    const bf16* X1 = WSP(bf16, WS_R1); const float* mod = WSP(float, WS_MOD); const bf16* Y = WSP(bf16, WS_TMP);
    f32x4 g1[8];
    { const f32x4* gt2 = (const f32x4*)(mod + (m0 >> 13) * 12288 + 10240) + lane;
#pragma unroll
        for (int j = 0; j < 8; ++j) g1[j] = 1.f + gt2[64 * j]; }
    u32x2 yn[8], xn[8];
    { const u32x2* yb = (const u32x2*)(Y + (size_t)m0 * DM) + lane; const u32x2* xb = (const u32x2*)(X1 + (size_t)m0 * DM) + lane;
#pragma unroll
        for (int j = 0; j < 8; ++j) { yn[j] = yb[64 * j]; xn[j] = xb[64 * j]; } }
#pragma unroll 1
    for (int m = m0; m < m0 + nrows; ++m) {
        f32x4* yp = (f32x4*)(F.out + (size_t)m * DM) + lane;
        f32x4 v[8]; float s = 0.f;
#pragma unroll
        for (int j = 0; j < 8; ++j) { const u32x2 yw = yn[j], xw = xn[j]; const f32x4 y = {bflo(yw.x), bfhi(yw.x), bflo(yw.y), bfhi(yw.y)}, x = {bflo(xw.x), bfhi(xw.x), bflo(xw.y), bfhi(xw.y)};
            v[j] = DN_ALPHA * x + g1[j] * y; s += (v[j].x + v[j].y) + (v[j].z + v[j].w); }
        { const int mn = m + 1 < m0 + nrows ? m + 1 : m; const u32x2* yb = (const u32x2*)(Y + (size_t)mn * DM) + lane; const u32x2* xb = (const u32x2*)(X1 + (size_t)mn * DM) + lane;
#pragma unroll
            for (int j = 0; j < 8; ++j) { yn[j] = yb[64 * j]; xn[j] = xb[64 * j]; } }
        const float mean = wave_sum(s) * (1.f / DM); float s2 = 0.f;
#pragma unroll
        for (int j = 0; j < 8; ++j) { v[j] = v[j] - mean; s2 += (v[j].x * v[j].x + v[j].y * v[j].y) + (v[j].z * v[j].z + v[j].w * v[j].w); }
        const float rstd = __builtin_amdgcn_rsqf(wave_sum(s2) * (1.f / DM) + LN_EPS);
#pragma unroll
        for (int j = 0; j < 8; ++j) yp[64 * j] = v[j] * rstd * *((const f32x4*)F.ln2_g + 64 * j + lane) + *((const f32x4*)F.ln2_b + 64 * j + lane);
    }
}
constexpr int PE_WAVE_LDS = 16384;
template <int N, int M> __device__ __forceinline__ void xreduce_step(float (&v)[M], bool bit, int mask) {
#pragma unroll
    for (int i = 0; i < N / 2; ++i) { const float keep = bit ? v[i + N / 2] : v[i], send = bit ? v[i] : v[i + N / 2]; v[i] = keep + __shfl_xor(send, mask); }
}
template <int N, int M> __device__ __forceinline__ void xreduce_step_i(int (&v)[M], bool bit, int mask) {
#pragma unroll
    for (int i = 0; i < N / 2; ++i) { const int keep = bit ? v[i + N / 2] : v[i], send = bit ? v[i] : v[i + N / 2]; v[i] = keep + __shfl_xor(send, mask); }
}
__device__ __forceinline__ void peer_eval_phase(Frame& F) {
    const int lane = F.lane, g = lane >> 3, c16 = lane & 7;
    const unsigned char* H2I = WSP(unsigned char, WS_H2I); const float* HSC = WSP(float, WS_HSC); const float* USC = WSP(float, WS_USC); const float* VSC = WSP(float, WS_VSC); const int* IDX = WSP(int, WS_IDX); const float* GATE = WSP(float, WS_GATE);
    const unsigned char* PU = WSP(unsigned char, WS_PU); const unsigned char* PV = WSP(unsigned char, WS_PV); bf16* Y = WSP(bf16, WS_TMP);
    LAS int* idxL = (LAS int*)(F.lds + F.wave * PE_WAVE_LDS); LAS float* DL = (LAS float*)(F.lds + F.wave * PE_WAVE_LDS + 8192);
    for (int tb = F.blk; tb < NT / 128; tb += F.G) {
        const int tok0 = tb * 128 + F.wave * 16;
#pragma unroll 4
        for (int tk = 0; tk < 16; ++tk) { const int e0 = lane, e1 = lane + 64; const int i0 = IDX[(size_t)(tok0 + tk) * 128 + e0], i1 = IDX[(size_t)(tok0 + tk) * 128 + e1];
            idxL[(tk * 8 + (e0 & 7)) * 16 + (e0 >> 3)] = i0 << 7; idxL[(tk * 8 + (e1 & 7)) * 16 + (e1 >> 3)] = i1 << 7; DL[tk * 128 + e0] = 0.f; DL[tk * 128 + e1] = 0.f; }
        LDS_WAIT();
        {
            auto issueU = [&](int st, u32x4 (&w)[16], i32x4& hq) { const int sl = st >> 4, tk = st & 15; const unsigned char* pu = PU + (size_t)sl * 2097152; const unsigned lo16 = 16u * c16;
                int ids[16];
#pragma unroll
                for (int q = 0; q < 4; ++q) { const i32x4 v = *(const LAS i32x4*)(idxL + (tk * 8 + g) * 16 + 4 * q); ids[4 * q] = v.x; ids[4 * q + 1] = v.y; ids[4 * q + 2] = v.z; ids[4 * q + 3] = v.w; }
                hq = *(const i32x4*)(H2I + (size_t)(tok0 + tk) * DM + 128 * sl + 16 * c16);
#pragma unroll
                for (int k = 0; k < 16; ++k) w[k] = *(const u32x4*)(pu + ((unsigned)ids[k] + lo16)); };
            auto computeU = [&](int st, const u32x4 (&w)[16], const i32x4 hq) { const int tk = st & 15;
                int pd[16];
#pragma unroll
                for (int k = 0; k < 16; ++k) { int di = __builtin_amdgcn_sdot4((int)w[k][0], hq.x, 0, false); di = __builtin_amdgcn_sdot4((int)w[k][1], hq.y, di, false);
                    di = __builtin_amdgcn_sdot4((int)w[k][2], hq.z, di, false); di = __builtin_amdgcn_sdot4((int)w[k][3], hq.w, di, false); pd[k] = di; }
                xreduce_step_i<16>(pd, c16 & 1, 1); xreduce_step_i<8>(pd, c16 & 2, 2); xreduce_step_i<4>(pd, c16 & 4, 4);
                const int k0 = 8 * (c16 & 1) + 4 * ((c16 >> 1) & 1) + 2 * (c16 >> 2);
                LAS int* dp = (LAS int*)DL + tk * 128 + g; dp[8 * k0] += pd[0]; dp[8 * (k0 + 1)] += pd[1]; };
            u32x4 wa[16], wb[16]; i32x4 ha, hb;
            issueU(0, wa, ha);
#pragma unroll 1
            for (int st = 0; st < 256; st += 2) {
                issueU(st + 1, wb, hb); computeU(st, wa, ha);
                issueU(st + 2 < 256 ? st + 2 : 255, wa, ha); computeU(st + 1, wb, hb);
            }
        }
        LDS_WAIT();
        { float a0[16], a1[16]; const int e0 = lane, e1 = lane + 64;
#pragma unroll
            for (int tk = 0; tk < 16; ++tk) { const float g0 = GATE[(size_t)(tok0 + tk) * 128 + e0], g1 = GATE[(size_t)(tok0 + tk) * 128 + e1]; const float hs = HSC[tok0 + tk];
                const int x0 = idxL[(tk * 8 + (e0 & 7)) * 16 + (e0 >> 3)], x1 = idxL[(tk * 8 + (e1 & 7)) * 16 + (e1 >> 3)];
                a0[tk] = gelu_tanh((float)((LAS int*)DL)[tk * 128 + e0] * (hs * USC[x0 >> 7])) * g0 * VSC[x0 >> 7]; a1[tk] = gelu_tanh((float)((LAS int*)DL)[tk * 128 + e1] * (hs * USC[x1 >> 7])) * g1 * VSC[x1 >> 7]; }
            LDS_WAIT();
            LAS unsigned char* AB = (LAS unsigned char*)DL; LAS float* AS = DL + 512;
#pragma unroll
            for (int tk = 0; tk < 16; ++tk) { const float amax = fmaxf(wave_max(fmaxf(fabsf(a0[tk]), fabsf(a1[tk]))), 1e-30f); const float qs = 127.0f / amax;
                const int q0 = (int)__builtin_rintf(a0[tk] * qs), q1 = (int)__builtin_rintf(a1[tk] * qs);
                AB[(tk * 8 + (e0 & 7)) * 16 + (e0 >> 3)] = (unsigned char)q0; AB[(tk * 8 + (e1 & 7)) * 16 + (e1 >> 3)] = (unsigned char)q1;
                if (lane == 0) AS[tk] = amax * (1.0f / 127.0f); } }
        LDS_WAIT();
        {
            auto issueV = [&](int st, u32x4 (&w)[16]) { const int sl = st >> 4, tk = st & 15; const unsigned char* pv = PV + (size_t)sl * 2097152; const unsigned lo16 = 16u * c16;
                int ids[16];
#pragma unroll
                for (int q = 0; q < 4; ++q) { const i32x4 v = *(const LAS i32x4*)(idxL + (tk * 8 + g) * 16 + 4 * q); ids[4 * q] = v.x; ids[4 * q + 1] = v.y; ids[4 * q + 2] = v.z; ids[4 * q + 3] = v.w; }
#pragma unroll
                for (int k = 0; k < 16; ++k) w[k] = *(const u32x4*)(pv + ((unsigned)ids[k] + lo16)); };
            auto computeV = [&](int st, const u32x4 (&w)[16]) { const int sl = st >> 4, tk = st & 15;
                const i32x4 a4 = *(const LAS i32x4*)((const LAS unsigned char*)DL + (tk * 8 + g) * 16);
                const float ascale = (DL + 512)[tk];
                int yi[16];
#pragma unroll
                for (int c = 0; c < 16; ++c) yi[c] = 0;
#pragma unroll
                for (int m = 0; m < 4; ++m) { const int am = m == 0 ? a4.x : (m == 1 ? a4.y : (m == 2 ? a4.z : a4.w));
#pragma unroll
                    for (int q = 0; q < 4; ++q) {
                        const unsigned w0 = w[4 * m][q], w1 = w[4 * m + 1][q], w2 = w[4 * m + 2][q], w3 = w[4 * m + 3][q];
                        const unsigned t0 = __builtin_amdgcn_perm(w1, w0, 0x05010400u), t1 = __builtin_amdgcn_perm(w1, w0, 0x07030602u), t2 = __builtin_amdgcn_perm(w3, w2, 0x05010400u), t3 = __builtin_amdgcn_perm(w3, w2, 0x07030602u);
                        yi[4 * q + 0] = __builtin_amdgcn_sdot4((int)__builtin_amdgcn_perm(t2, t0, 0x05040100u), am, yi[4 * q + 0], false);
                        yi[4 * q + 1] = __builtin_amdgcn_sdot4((int)__builtin_amdgcn_perm(t2, t0, 0x07060302u), am, yi[4 * q + 1], false);
                        yi[4 * q + 2] = __builtin_amdgcn_sdot4((int)__builtin_amdgcn_perm(t3, t1, 0x05040100u), am, yi[4 * q + 2], false);
                        yi[4 * q + 3] = __builtin_amdgcn_sdot4((int)__builtin_amdgcn_perm(t3, t1, 0x07060302u), am, yi[4 * q + 3], false); } }
                float cv[16];
#pragma unroll
                for (int c = 0; c < 16; ++c) cv[c] = (float)yi[c] * ascale;
                xreduce_step<16>(cv, g & 1, 8); xreduce_step<8>(cv, g & 2, 16); xreduce_step<4>(cv, g & 4, 32);
                const int c0 = 8 * (g & 1) + 4 * ((g >> 1) & 1) + 2 * (g >> 2);
                *(unsigned*)(Y + (size_t)(tok0 + tk) * DM + 128 * sl + 16 * c16 + c0) = pk2(cv[0], cv[1]); };
            u32x4 wa[16], wb[16];
            issueV(0, wa);
#pragma unroll 1
            for (int st = 0; st < 256; st += 2) {
                issueV(st + 1, wb); computeV(st, wa);
                issueV(st + 2 < 256 ? st + 2 : 255, wa); computeV(st + 1, wb);
            }
        }
        LDS_WAIT();
        VM_WAIT();
        ln2_rows(F, tok0, 16);
    }
}

constexpr int NPHASE = 12;
__global__ void __launch_bounds__(NTHREADS, 2) fwd_kernel(Args args) {
    extern __shared__ __attribute__((aligned(16))) unsigned char lds_raw[];
    Frame F;
    F.lds = (LAS unsigned char*)lds_raw; F.tid = threadIdx.x; F.lane = F.tid & 63; F.wave = __builtin_amdgcn_readfirstlane(F.tid >> 6); F.G = gridDim.x; F.blk = blockIdx.x;
    F.x = args.in[0]; F.c = args.in[1]; F.positions = (const int*)args.in[2]; F.w_ada = args.in[3]; F.b_ada = args.in[4]; F.w_in = args.in[5]; F.conv_w = args.in[6]; F.conv_b = args.in[7];
    F.w_rg_a = args.in[8]; F.b_rg_a = args.in[9]; F.w_rg_x = args.in[10]; F.b_rg_x = args.in[11]; F.rg_lambda = args.in[12]; F.w_rnn_out = args.in[13]; F.q_norm_g = args.in[14]; F.w_uq = args.in[15];
    F.kv_norm_g = args.in[16]; F.w_ukv = args.in[17]; F.w_mla_out = args.in[18]; F.w_o = args.in[19]; F.ln1_g = args.in[20]; F.ln1_b = args.in[21]; F.peer_wq = args.in[22]; F.peer_keys = args.in[23];
    F.peer_u = args.in[24]; F.peer_v = args.in[25]; F.ln2_g = args.in[26]; F.ln2_b = args.in[27]; F.out = args.out; F.ws = args.ws;
    volatile LAS unsigned* ctlw = (volatile LAS unsigned*)(F.lds + LDSCTL_OFF);
    if (F.tid < 128) ctlw[F.tid] = 0u;
    __syncthreads();
    const int lo = args.ph_lo, hi = args.ph_hi;
    const bool multi = (hi - lo) > 1;
#ifdef PROBE_RELAUNCH
    const int bslot = args.bslot;
#else
    constexpr int bslot = 0;
#endif
    XcdBarrier bar; bar.bar = (unsigned*)(F.ws + WS_CTL) + 4096 + 16384 * (bslot & 1); bar.x = 0; bar.st = nullptr;
    if (multi) bar = xcd_barrier_post((unsigned*)(F.ws + WS_CTL) + 4096 + 16384 * (bslot & 1), ctlw + 8);
#ifndef PHASE_MASK
#define PHASE_MASK 0xfff
#endif
#define IN(k) (((PHASE_MASK >> (k)) & 1) && lo <= (k) && (k) < hi)
#define SEAM(k) do { if (IN(k) && IN((k) + 1)) xcd_barrier(bar); } while (0)
#ifndef DBL_MASK
#define DBL_MASK 0
#endif
#define DBL(k, ...) do { if ((DBL_MASK >> (k)) & 1) { __VA_ARGS__; xcd_barrier(bar); } } while (0)
    const pg8::StaticOrder S0{};
    if (IN(0)) { DBL(0, p0_prologue(F, 1)); p0_prologue(F, bslot); SEAM(0); }
    if (IN(1)) { DBL(1, p1_modulate(F)); p1_modulate(F); SEAM(1); }
    if (IN(2)) {
        const pg8::Gemm g = pg8::gemm_f8(WSP(unsigned char, WS_S0), WSP(unsigned char, WS_WIN), NT, NPROJ, DM, DM, DM); pg8::StaticOrder S; S.init(NT, NPROJ, F.G, F.blk);
        EpiProj E{WSP(bf16, WS_XR), WSP(bf16, WS_GG), WSP(unsigned char, WS_QKVC), WSP(unsigned char, WS_KVC8), WSP(bf16, WS_SGR), WSP(bf16, WS_SGM), WSP(float, WS_KR), WSP(float, WS_SSP), 1.0f / (SC_H * SC_WIN)};
        DBL(2, pg8::gemm_phase<EpiProj, pg8::StaticOrder, true, false>(F.lds, g, S, E, F.wave)); pg8::gemm_phase<EpiProj, pg8::StaticOrder, true, false>(F.lds, g, S, E, F.wave); SEAM(2); }
    if (IN(3)) { DBL(3, rglru_passA(F)); rglru_passA(F); SEAM(3); }
    if (IN(4)) {
        rglru_passB(F);
        constexpr float ESC6 = 1.0f / (SC_H * SC_WIN);
        { const pg8::Gemm g = pg8::gemm_f8(WSP(unsigned char, WS_QKVC), WSP(unsigned char, WS_WUQ), NT, 3072, 512, 512, 512); pg8::StaticOrder S; S.init(NT, 3072, F.G, F.blk);
          EpiQ E{(unsigned char*)F.out + OUT_Q, WSP(float, WS_RS), WSP(f32x2, WS_ROPE), ESC6}; pg8::gemm_phase<EpiQ, pg8::StaticOrder, true>(F.lds, g, S, E, F.wave); }
        { const pg8::Gemm g = pg8::gemm_f8(WSP(unsigned char, WS_KVC8), WSP(unsigned char, WS_WUK), NT, 2048, 512, 512, 512); pg8::StaticOrder S; S.init(NT, 2048, F.G, F.blk);
          EpiK E{(unsigned char*)F.out + OUT_K, WSP(float, WS_RS), ESC6}; pg8::gemm_phase<EpiK, pg8::StaticOrder, true>(F.lds, g, S, E, F.wave); }
        { const pg8::Gemm g = pg8::gemm_f8(WSP(unsigned char, WS_WUV), WSP(unsigned char, WS_KVC8), 2048, NT, 512, 512, 512); pg8::StaticOrder S; S.init(2048, NT, F.G, F.blk);
          EpiVT E{(unsigned char*)F.out + OUT_VT, WSP(float, WS_RS), ESC6}; pg8::gemm_phase<EpiVT, pg8::StaticOrder, true>(F.lds, g, S, E, F.wave); }
        krope_fill(F); SEAM(4); }
    if (IN(5)) {
#ifdef PROBE_ATTN
#pragma unroll 1
        for (int rep = 0; rep < PROBE_ATTN; ++rep) { attn_phase(F); xcd_barrier(bar); }
#else
        attn_phase(F);
#endif
        SEAM(5); }
    if (IN(6)) {
        pg8::Gemm g = pg8::gemm_f8(WSP(unsigned char, WS_S0), WSP(unsigned char, WS_WRNN), NT, DM, 2 * DM, DM, DM); g.A2 = WSP(unsigned char, WS_AO8); g.Bt2 = WSP(unsigned char, WS_WMLA); g.nt1 = DM / 128;
        pg8::StaticOrder S; S.init(NT, DM, F.G, F.blk);
        EpiMix E{WSP(bf16, WS_SGR), WSP(bf16, WS_SGM), WSP(unsigned char, WS_TMP8), SC_AO / SC_RA, 1.0f / (SC_AO * SC_WSQ)};
        pg8::gemm_phase<EpiMix, pg8::StaticOrder, true>(F.lds, g, S, E, F.wave); SEAM(6); }
    if (IN(7)) {
#ifdef PROBE_GEMM
#if PROBE_GEMM == 1
#define PROBE_ONE { pg8::Gemm gp = pg8::gemm_f8(WSP(unsigned char, WS_TMP8), WSP(unsigned char, WS_WO), NT, DM, DM, DM, DM); gp.nt = PROBE_NT; pg8::StaticOrder Sp; Sp.init(NT, DM, F.G, F.blk); \
            EpiRes1 Ep{F.x, WSP(float, WS_MOD), WSP(bf16, WS_PQ), 1.0f}; pg8::gemm_phase<EpiRes1, pg8::StaticOrder, true>(F.lds, gp, Sp, Ep, F.wave); xcd_barrier(bar); }
#elif PROBE_GEMM == 3
#define PROBE_ONE { pg8::Gemm gp = pg8::gemm_f8(WSP(unsigned char, WS_TMP8), WSP(unsigned char, WS_WO), NT, DM, DM, DM, DM); gp.nt = PROBE_NT; pg8::StaticOrder Sp; Sp.init(NT, DM, F.G, F.blk); \
            EpiPlain Ep{WSP(bf16, WS_PQ), 1.0f}; pg8::gemm_phase<EpiPlain, pg8::StaticOrder, true, true>(F.lds, gp, Sp, Ep, F.wave); xcd_barrier(bar); }
#elif PROBE_GEMM == 5
#define PROBE_ONE { pg8::Gemm gp = pg8::gemm_f8(WSP(unsigned char, WS_TMP8), WSP(unsigned char, WS_WO), NT, DM, DM, DM, DM); gp.nt = PROBE_NT; pg8::StaticOrder Sp; Sp.init(NT, DM, F.G, F.blk); \
            EpiNull Ep{WSP(float, WS_PQ)}; pg8::gemm_phase<EpiNull, pg8::StaticOrder, true, true>(F.lds, gp, Sp, Ep, F.wave); xcd_barrier(bar); }
#elif PROBE_GEMM == 4
#define PROBE_ONE { pg8::Gemm gp = pg8::gemm_bf16(WSP(bf16, WS_TMP), WSP(bf16, WS_WPQ), NT, DM, DM, DM, DM); gp.nt = PROBE_NT; pg8::StaticOrder Sp; Sp.init(NT, DM, F.G, F.blk); \
            EpiPlain Ep{WSP(bf16, WS_PQ), 1.0f}; pg8::gemm_phase<EpiPlain, pg8::StaticOrder>(F.lds, gp, Sp, Ep, F.wave); xcd_barrier(bar); }
#endif
#ifndef PROBE_PRB
#define PROBE_PRB 0
#endif
#ifndef PROBE_REP
#define PROBE_REP 1
#endif
        PROBE_ONE
#if PROBE_REP >= 2
        PROBE_ONE
#endif
#if PROBE_REP >= 3
        PROBE_ONE
#endif
#if PROBE_REP >= 4
        PROBE_ONE
#endif
#endif
        const pg8::Gemm g = pg8::gemm_f8(WSP(unsigned char, WS_TMP8), WSP(unsigned char, WS_WO), NT, DM, DM, DM, DM); pg8::StaticOrder S; S.init(NT, DM, F.G, F.blk);
        EpiRes1 E{F.x, WSP(float, WS_MOD), WSP(bf16, WS_R1), 1.0f / (SC_TMP * SC_WSQ)};
        pg8::gemm_phase<EpiRes1, pg8::StaticOrder, true>(F.lds, g, S, E, F.wave); SEAM(7); }
    if (IN(8)) { ln1_phase(F); SEAM(8); }
    if (IN(9)) {
        const pg8::Gemm g = pg8::gemm_f8(WSP(unsigned char, WS_H2I), WSP(unsigned char, WS_WPQ), NT, DM, DM, DM, DM); pg8::StaticOrder S; S.init(NT, DM, F.G, F.blk);
        EpiQuery E{WSP(bf16, WS_PQ), WSP(float, WS_HSC), WSP(float, WS_WQS)};
        pg8::gemm_phase<EpiQuery, pg8::StaticOrder, 2>(F.lds, g, S, E, F.wave); SEAM(9); }
#ifdef PROBE_BARS
#pragma unroll 1
    for (int r = 0; r < PROBE_BARS; ++r) xcd_barrier(bar);
#endif
    if (IN(10)) { DBL(10, peer_score_phase(F)); peer_score_phase(F); SEAM(10); }
    if (IN(11)) { DBL(11, peer_eval_phase(F)); peer_eval_phase(F); }
#undef IN
#undef SEAM
}

#ifdef PROBE_ATTN_PRB
__global__ void __launch_bounds__(NTHREADS, 2) attn_probe_kernel(Args args) {
    extern __shared__ __attribute__((aligned(16))) unsigned char lds_raw[];
    Frame F;
    F.lds = (LAS unsigned char*)lds_raw; F.tid = threadIdx.x; F.lane = F.tid & 63; F.wave = __builtin_amdgcn_readfirstlane(F.tid >> 6); F.G = gridDim.x; F.blk = blockIdx.x; F.out = args.out; F.ws = args.ws;
    attn_phase<32 | PROBE_ATTN_PRB>(F);
}
#endif
#ifdef DBG_STOP
__global__ void dbg_dump(const unsigned char* ws, size_t off, int is_f32, float* out) {
    const size_t n = (size_t)NT * DM; const size_t i0 = (size_t)blockIdx.x * blockDim.x + threadIdx.x, st = (size_t)gridDim.x * blockDim.x;
    if (is_f32) { const float* s = (const float*)(ws + off); for (size_t i = i0; i < n; i += st) out[i] = s[i]; }
    else { const bf16* s = (const bf16*)(ws + off); for (size_t i = i0; i < n; i += st) out[i] = i < (size_t)DBG_N ? bf1(s[i]) : 0.f; }
}
__global__ void dbg_count(const unsigned char* ws, size_t off, float lo, float hi, unsigned* cnt) {
    if (blockIdx.x != 0) return;
    const int pm = 3, ct = 2; const bf16* s = (const bf16*)(ws + off); __shared__ unsigned rowbad[256], colbad[256];
    rowbad[threadIdx.x] = 0; colbad[threadIdx.x] = 0; __syncthreads();
    for (int i = threadIdx.x; i < 65536; i += blockDim.x) { const int r = i >> 8, cc = i & 255; const float v = bf1(s[(size_t)(pm * 256 + r) * DM + ct * 256 + cc]); if (!(v >= lo && v <= hi)) { rowbad[r] = 1; colbad[cc] = 1; } }
    __syncthreads();
    if (threadIdx.x == 0) { unsigned nr = 0, nc = 0, fr = 999, fc = 999; for (int i = 0; i < 256; ++i) { if (rowbad[i]) { ++nr; if (fr == 999) fr = i; } if (colbad[i]) { ++nc; if (fc == 999) fc = i; } }
        cnt[0] = nr + 10; cnt[1] = nc + 10; cnt[2] = fr + 10; cnt[3] = fc + 10; }
}
__global__ void dbg_report(const unsigned* cnt, float* out) {
    const size_t n = (size_t)NT * DM; const size_t i0 = (size_t)blockIdx.x * blockDim.x + threadIdx.x, st = (size_t)gridDim.x * blockDim.x;
    const float v = (float)cnt[DBG_WHICH];
    for (size_t i = i0; i < n; i += st) out[i] = (i == 0) ? v : 0.f;
}
#endif
#ifdef PROBE_MB
template <int NM, int NV, int VT>
__global__ void __launch_bounds__(NTHREADS, 2) mb_kernel(float* sink, int iters) {
    const int lane = threadIdx.x & 63; unsigned h = (unsigned)(threadIdx.x + 512 * blockIdx.x) * 0x9E3779B9u + 0x7F4A7C15u;
    i32x8 a, b; for (int e = 0; e < 8; ++e) { h = h * 1664525u + 1013904223u; a[e] = (int)(h & 0x3F3F3F3Fu); h = h * 1664525u + 1013904223u; b[e] = (int)(h & 0x3F3F3F3Fu) ^ 0x00800080; }
    f32x16 acc[4]; for (int q = 0; q < 4; ++q) for (int e = 0; e < 16; ++e) acc[q][e] = 0.f;
    float v[12]; for (int e = 0; e < 12; ++e) v[e] = 0.001f * (float)(lane + e);
    const float c1 = 0.999f, c2 = 0.0007f;
#pragma unroll 1
    for (int it = 0; it < iters; ++it) {
#pragma unroll
        for (int q = 0; q < 4; ++q) {
            if (NM) acc[q] = __builtin_amdgcn_mfma_scale_f32_32x32x64_f8f6f4(a, b, acc[q], 0, 0, 0, 0x7F7F7F7F, 0, 0x7F7F7F7F);
            __builtin_amdgcn_sched_barrier(0);
#pragma unroll
            for (int e = 0; e < NV; ++e) v[e] = VT ? __builtin_amdgcn_exp2f(v[e]) : __builtin_fmaf(v[e], c1, c2);
            __builtin_amdgcn_sched_barrier(0);
        }
    }
    float sacc = 0.f; for (int q = 0; q < 4; ++q) for (int e = 0; e < 16; ++e) sacc += acc[q][e]; for (int e = 0; e < 12; ++e) sacc += v[e];
    sink[(size_t)blockIdx.x * 512 + threadIdx.x] = sacc;
}
#endif
extern "C" void kernel_launch(void* const* d_in, const int* in_sizes, int n_in, void* d_out, int out_size, void* d_ws, size_t ws_size, hipStream_t stream) {
    static int grid = 0;
    if (grid == 0) {
        if (n_in != 28 || out_size != NT * DM || ws_size < WS_END) { fprintf(stderr, "kernel_launch: unexpected shapes (n_in %d, out %d, ws %zu)\n", n_in, out_size, ws_size); grid = -1; return; }
        int dev = 0, cus = 0, per_cu = 0;
        if (hipGetDevice(&dev) != hipSuccess || hipDeviceGetAttribute(&cus, hipDeviceAttributeMultiprocessorCount, dev) != hipSuccess) { grid = -1; return; }
        if (hipFuncSetAttribute((const void*)fwd_kernel, hipFuncAttributeMaxDynamicSharedMemorySize, LDS_BYTES) != hipSuccess) { fprintf(stderr, "kernel_launch: hipFuncSetAttribute failed\n"); grid = -1; return; }
        if (hipOccupancyMaxActiveBlocksPerMultiprocessor(&per_cu, (const void*)fwd_kernel, NTHREADS, LDS_BYTES) != hipSuccess || per_cu < 1)
            fprintf(stderr, "kernel_launch: occupancy query reports %d workgroups per CU\n", per_cu);
        (void)hipGetLastError();
        grid = cus;
    }
    if (grid < 0) return;
    if (hipMemsetAsync((char*)d_ws + WS_CTL, 0, CTL_ZERO_BYTES, stream) != hipSuccess) return;
#ifdef PROBE_MB
    hipLaunchKernelGGL((mb_kernel<PROBE_MB_NM, PROBE_MB_NV, PROBE_MB_VT>), dim3(grid), dim3(NTHREADS), 0, stream, (float*)((char*)d_ws + WS_XR), 4000);
#endif
    Args a{};
    for (int i = 0; i < 28; ++i) a.in[i] = (const float*)d_in[i];
    a.out = (float*)d_out; a.ws = (unsigned char*)d_ws;
#ifdef PROBE_RELAUNCH
    a.ph_lo = 0; a.ph_hi = PROBE_RELAUNCH + 1; a.bslot = 0;
    hipLaunchKernelGGL(fwd_kernel, dim3(grid), dim3(NTHREADS), LDS_BYTES, stream, a);
#ifdef PROBE_ATTN_PRB
    { static bool once = false; if (!once) { once = true; (void)hipFuncSetAttribute((const void*)attn_probe_kernel, hipFuncAttributeMaxDynamicSharedMemorySize, LDS_BYTES); } }
    for (int r = 0; r < PROBE_RELAUNCH_N; ++r) hipLaunchKernelGGL(attn_probe_kernel, dim3(grid), dim3(NTHREADS), LDS_BYTES, stream, a);
#else
    for (int r = 0; r < PROBE_RELAUNCH_N; ++r) { a.ph_lo = PROBE_RELAUNCH; a.ph_hi = PROBE_RELAUNCH + 1; a.bslot = 2 + r; hipLaunchKernelGGL(fwd_kernel, dim3(grid), dim3(NTHREADS), LDS_BYTES, stream, a); }
#endif
    if (PROBE_RELAUNCH + 1 < NPHASE) { a.ph_lo = PROBE_RELAUNCH + 1; a.ph_hi = NPHASE; a.bslot = 1; hipLaunchKernelGGL(fwd_kernel, dim3(grid), dim3(NTHREADS), LDS_BYTES, stream, a); }
#elif MK_N_LAUNCHES == 1
    a.ph_lo = 0; a.ph_hi = NPHASE;
    hipLaunchKernelGGL(fwd_kernel, dim3(grid), dim3(NTHREADS), LDS_BYTES, stream, a);
#else
#ifdef DBG_STOP
    for (int p = 0; p <= DBG_STOP; ++p) { a.ph_lo = p; a.ph_hi = p + 1; hipLaunchKernelGGL(fwd_kernel, dim3(grid), dim3(NTHREADS), LDS_BYTES, stream, a); }
#ifdef DBG_COUNT
        hipLaunchKernelGGL(dbg_count, dim3(1024), dim3(256), 0, stream, (const unsigned char*)d_ws, (size_t)DBG_OFF, DBG_LO, DBG_HI, (unsigned*)d_ws + 1024);
    hipLaunchKernelGGL(dbg_report, dim3(2048), dim3(256), 0, stream, (const unsigned*)d_ws + 1024, (float*)d_out);
#else
    hipLaunchKernelGGL(dbg_dump, dim3(2048), dim3(256), 0, stream, (const unsigned char*)d_ws, (size_t)DBG_OFF, DBG_F32, (float*)d_out);
#endif
#else
    for (int p = 0; p < NPHASE; ++p) { a.ph_lo = p; a.ph_hi = p + 1; hipLaunchKernelGGL(fwd_kernel, dim3(grid), dim3(NTHREADS), LDS_BYTES, stream, a); }
#endif
#endif
    const hipError_t le = hipPeekAtLastError();
    if (le != hipSuccess) fprintf(stderr, "kernel_launch: launch failed: %s\n", hipGetErrorName(le));
}
```

```cpp
#include <hip/hip_runtime.h>
#include <cstdio>
#include <cstdint>

#ifndef MK_N_LAUNCHES
#define MK_N_LAUNCHES 1
#endif

#define LAS __attribute__((address_space(3)))
#define GAS __attribute__((address_space(1)))
typedef unsigned short bf16;
typedef short bf16x8 __attribute__((ext_vector_type(8)));
typedef float f32x2 __attribute__((ext_vector_type(2)));
typedef _Float16 f16x2 __attribute__((ext_vector_type(2)));
typedef float f32x4 __attribute__((ext_vector_type(4)));
typedef float f32x16 __attribute__((ext_vector_type(16)));
typedef unsigned u32x2 __attribute__((ext_vector_type(2)));
typedef unsigned u32x4 __attribute__((ext_vector_type(4)));
typedef int i32x4 __attribute__((ext_vector_type(4)));
typedef int i32x8 __attribute__((ext_vector_type(8)));

constexpr int NB = 4, SEQ = 8192, DM = 2048, NT = NB * SEQ;
constexpr int NH = 16, QLORA = 512, KVLORA = 512, DNOPE = 128, DROPE = 64, DV = 128, DQK = 192;
constexpr int IN_COLS = 9280, NPROJ = 9472;
constexpr int PEER_H = 8, NKEYS = 128, TOPK = 16;
constexpr float DN_ALPHA = 1.189207115002721f;
constexpr float LN_EPS = 1e-5f, RMS_EPS = 1e-6f;
constexpr float QSCALE = 0.07216878364870322f * 1.4426950408889634f;
constexpr int NWAVES = 8, NTHREADS = 512;
constexpr float PU_SCALE = 1024.0f, PV_SCALE = 64.0f;
constexpr float SC_H = 16.0f, SC_WIN = 1024.0f, SC_RA = 4.0f, SC_AO = 32.0f, SC_TMP = 32.0f, SC_WSQ = 2048.0f;
constexpr float SC_Q = 64.0f, SC_K = 16.0f, SC_V = 16.0f, SC_P = 64.0f;

constexpr size_t MiB = 1u << 20;
constexpr size_t WS_CTL = 0, CTL_ZERO_BYTES = 1 * MiB;
constexpr size_t WS_MOD = 1 * MiB;
constexpr size_t WS_RS = 1 * MiB + 512 * 1024;
constexpr size_t WS_SSP = 100 * MiB;
constexpr size_t WS_ROPE = 2 * MiB;
constexpr size_t WS_WIN = 10 * MiB;
constexpr size_t WS_WRNN = 47 * MiB, WS_WMLA = 55 * MiB, WS_WO = 63 * MiB, WS_WPQ = 71 * MiB;
constexpr size_t WS_WUQ = 79 * MiB;
constexpr size_t WS_WUK = 82 * MiB, WS_WUV = 84 * MiB;
constexpr size_t WS_WGA = 86 * MiB;
constexpr size_t WS_WGX = 86 * MiB + 512 * 1024;
constexpr size_t WS_PKEYS = 87 * MiB;
constexpr size_t WS_SUMM = 88 * MiB;
constexpr size_t WS_KR = 90 * MiB;
constexpr size_t WS_S0 = 128 * MiB;
constexpr size_t WS_XR = 256 * MiB, WS_GG = 384 * MiB, WS_SGR = 512 * MiB, WS_SGM = 640 * MiB;
constexpr size_t WS_QKVC = 768 * MiB;
constexpr size_t WS_KVC8 = 800 * MiB;
constexpr size_t WS_TMP = 832 * MiB;
constexpr size_t WS_IDX = 960 * MiB, WS_GATE = 976 * MiB;
constexpr size_t WS_TMP8 = 768 * MiB;
constexpr size_t WS_K = 256 * MiB;
constexpr size_t WS_VT = 448 * MiB;
constexpr size_t WS_R1 = 256 * MiB;
constexpr size_t WS_PQ = 512 * MiB;
constexpr size_t WS_PU = 640 * MiB, WS_PV = 704 * MiB;
constexpr size_t WS_END = 1024 * MiB;
constexpr size_t WS_WQS = WS_WPQ + 4 * MiB;
constexpr size_t CTL_WQAMAX = 32768 * 4;
constexpr size_t WS_H2I = 768 * MiB;
constexpr size_t WS_HSC = 100 * MiB, WS_USC = 101 * MiB, WS_VSC = 102 * MiB;
constexpr size_t WS_AO8 = WS_S0 + 64 * MiB;
constexpr size_t OUT_Q = 0, OUT_K = 96 * MiB, OUT_VT = 192 * MiB;

constexpr int LDS_BYTES = 147456, LDSCTL_OFF = 146944;

typedef __bf16 bf16v2 __attribute__((ext_vector_type(2)));
__device__ __forceinline__ unsigned pk2(float lo, float hi) { const bf16v2 v = __builtin_convertvector((f32x2){lo, hi}, bf16v2); return __builtin_bit_cast(unsigned, v); }
__device__ __forceinline__ float bflo(unsigned w) { return __uint_as_float(w << 16); }
__device__ __forceinline__ float bfhi(unsigned w) { return __uint_as_float(w & 0xffff0000u); }
__device__ __forceinline__ float bf1(bf16 b) { return __uint_as_float(((unsigned)b) << 16); }
__device__ __forceinline__ float sigmoidf_(float y) { return __builtin_amdgcn_rcpf(1.0f + __builtin_amdgcn_exp2f(-1.4426950408889634f * y)); }
__device__ __forceinline__ float gelu_tanh(float x) { const float z = 0.7978845608028654f * (x + 0.044715f * x * x * x); return x * sigmoidf_(2.0f * z); }
__device__ __forceinline__ float wave_sum(float v) {
#pragma unroll
    for (int o = 1; o < 64; o <<= 1) v += __shfl_xor(v, o);
    return v;
}
__device__ __forceinline__ float clamp448(float v) { return __builtin_amdgcn_fmed3f(v, -448.0f, 448.0f); }
__device__ __forceinline__ unsigned pk4_f8(float a, float b, float c, float d) { int w = __builtin_amdgcn_cvt_pk_fp8_f32(clamp448(a), clamp448(b), 0, false); w = __builtin_amdgcn_cvt_pk_fp8_f32(clamp448(c), clamp448(d), w, true); return (unsigned)w; }
__device__ __forceinline__ int fresh_lane() { int l; asm volatile("v_mbcnt_lo_u32_b32 %0, -1, 0\n\tv_mbcnt_hi_u32_b32 %0, -1, %0" : "=v"(l)); return l; }
__device__ __forceinline__ float wave_max(float v) {
#pragma unroll
    for (int o = 1; o < 64; o <<= 1) v = fmaxf(v, __shfl_xor(v, o));
    return v;
}
__device__ __forceinline__ unsigned pk4_i8(float a, float b, float c, float d) {
    const int ia = (int)__builtin_rintf(__builtin_amdgcn_fmed3f(a, -127.f, 127.f)), ib = (int)__builtin_rintf(__builtin_amdgcn_fmed3f(b, -127.f, 127.f)), ic = (int)__builtin_rintf(__builtin_amdgcn_fmed3f(c, -127.f, 127.f)), id = (int)__builtin_rintf(__builtin_amdgcn_fmed3f(d, -127.f, 127.f));
    return (unsigned)(ia & 0xff) | ((unsigned)(ib & 0xff) << 8) | ((unsigned)(ic & 0xff) << 16) | ((unsigned)id << 24); }
#define LDS_WAIT() asm volatile("s_waitcnt lgkmcnt(0)" ::: "memory")
#define VM_WAIT() asm volatile("s_waitcnt vmcnt(0)" ::: "memory")

#define XB_TMO      128
#define XB_XCNT(j)  (256  + 64 * (j))
#define XB_XSUB(j)  (1280 + 64 * (j))
#define XB_XGEN(j)  (2304 + 64 * (j))
#define XB_TOP      3328
#define XB_TOPGEN   3392
#define XCD_BAR_WORDS 3456
#define XB_SPIN_CAP (1u << 20)
__device__ __forceinline__ unsigned xb_ld(unsigned* p)              { return __hip_atomic_load(p, __ATOMIC_RELAXED, __HIP_MEMORY_SCOPE_AGENT); }
__device__ __forceinline__ unsigned xb_add(unsigned* p, unsigned v) { return __hip_atomic_fetch_add(p, v, __ATOMIC_RELAXED, __HIP_MEMORY_SCOPE_AGENT); }
__device__ __forceinline__ unsigned xb_xcc_id() { return (unsigned)__builtin_amdgcn_s_getreg((3 << 11) | 20) & 0xFu; }
#define XB_SPIN(cond, bar) do { unsigned _sp = 0; while (cond) { __builtin_amdgcn_s_sleep(1); \
    if ((++_sp & 255u) == 0u) { if (xb_ld(&(bar)[XB_TMO])) break; if (_sp > XB_SPIN_CAP) { atomicAdd(&(bar)[XB_TMO], 1u); break; } } } } while (0)
struct XcdBarrier { unsigned* bar; unsigned x; volatile LAS unsigned* st; };
__device__ __forceinline__ XcdBarrier xcd_barrier_post(unsigned* bar, volatile LAS unsigned* st) {
    XcdBarrier b; b.bar = bar; b.x = xb_xcc_id(); b.st = st;
    if (threadIdx.x == 0) (void)xb_add(&bar[XB_XCNT(b.x)], 1u);
    return b;
}
__device__ __forceinline__ void xcd_barrier_complete(unsigned* bar, unsigned x, unsigned& nloc, unsigned& nx) {
    const unsigned G = gridDim.x * gridDim.y * gridDim.z;
    unsigned sum, cnt, mine, sp = 0u;
    for (;;) {
        sum = 0u; cnt = 0u; mine = 0u;
#pragma unroll
        for (unsigned j = 0; j < 16; ++j) { const unsigned c = xb_ld(&bar[XB_XCNT(j)]); sum += c; cnt += (c > 0u) ? 1u : 0u; mine = (j == x) ? c : mine; }
        if (sum == G) break;
        __builtin_amdgcn_s_sleep(1);
        if ((++sp & 255u) == 0u) { if (xb_ld(&bar[XB_TMO])) break; if (sp > XB_SPIN_CAP) { atomicAdd(&bar[XB_TMO], 1u); break; } }
    }
    nloc = mine > 0u ? mine : 1u; nx = cnt > 0u ? cnt : 1u;
}
__device__ __forceinline__ void xcd_barrier(const XcdBarrier& b) {
    asm volatile("s_waitcnt vmcnt(0)" ::: "memory");
    __syncthreads();
    if (threadIdx.x == 0) {
        unsigned* bar = b.bar;
        __builtin_amdgcn_s_waitcnt(0);
        unsigned nloc = b.st[0], nx = b.st[1];
        if (nloc == 0u) { xcd_barrier_complete(bar, b.x, nloc, nx); b.st[0] = nloc; b.st[1] = nx; }
        const unsigned old = xb_add(&bar[XB_XSUB(b.x)], 1u);
        const unsigned gen = old / nloc;
        if (old + 1u == (gen + 1u) * nloc) {
            __builtin_amdgcn_fence(__ATOMIC_RELEASE, "agent");
            asm volatile("s_waitcnt vmcnt(0)" ::: "memory");
            const unsigned og = xb_add(&bar[XB_TOP], 1u);
            const unsigned tg = og / nx;
            if (og + 1u == (tg + 1u) * nx) xb_add(&bar[XB_TOPGEN], 1u);
            else XB_SPIN(xb_ld(&bar[XB_TOPGEN]) == tg, bar);
            __builtin_amdgcn_fence(__ATOMIC_ACQUIRE, "agent");
            asm volatile("s_waitcnt vmcnt(0)" ::: "memory");
        } else {
            XB_SPIN(xb_ld(&bar[XB_TOPGEN]) == gen, bar);
            __builtin_amdgcn_fence(__ATOMIC_ACQUIRE, "agent");
            asm volatile("s_waitcnt vmcnt(0)" ::: "memory");
        }
    }
    __syncthreads();
}

__device__ __forceinline__ void glds16(const char* sbase, unsigned voff, unsigned lds_dst) {
    unsigned keep;
    asm volatile("s_mov_b32 %0, m0\n\ts_mov_b32 m0, %3\n\ts_nop 0\n\tglobal_load_lds_dwordx4 %1, %2\n\ts_mov_b32 m0, %0" : "=&s"(keep) : "v"(voff), "s"(sbase), "s"(lds_dst) : "memory");
}
namespace pg8 {
constexpr int BM = 256, BK = 64, HALF = 128, HTB = HALF * BK * 2, STAGE_BYTES = 8 * HTB, NXCD = 8, WGM = 4;
__host__ __device__ __forceinline__ int lds_byte(int r, int c) { const int st = (r >> 4) * 2 + (c >> 5), rr = r & 15, cc = c & 31, ob = rr * 64 + cc * 2; return st * 1024 + (ob ^ (((ob >> 9) & 1) << 5)); }
__host__ __device__ __forceinline__ void stage_rc(int b, int& R, int& C) { const int st = b / 1024, sb = b % 1024, swz = sb ^ (((sb >> 9) & 1) << 5); R = (st >> 1) * 16 + swz / 64; C = (st & 1) * 32 + (swz % 64) / 2; }
__host__ __device__ __forceinline__ int perm32(int rho) { const int n = rho >> 4, i = rho & 15; return 8 * (i >> 2) + 4 * n + (i & 3); }
struct Unit { int pm, pn; };
struct Gemm { const void* A; const void* Bt; int M, N, nt, lda_b, ldb_b; const void* A2 = nullptr; const void* Bt2 = nullptr; int nt1 = 0; };
__host__ __device__ __forceinline__ Gemm gemm_bf16(const bf16* A, const bf16* Bt, int M, int N, int K, int lda, int ldb) { return Gemm{A, Bt, M, N, K / 64, lda * 2, ldb * 2}; }
__host__ __device__ __forceinline__ Gemm gemm_f8(const unsigned char* A, const unsigned char* Bt, int M, int N, int K, int lda, int ldb) { return Gemm{A, Bt, M, N, K / 128, lda, ldb}; }
struct StaticOrder {
    int nM, nN, nwg, G, c;
    __host__ __device__ void init(int M, int N, int G_, int c_) { nM = M / BM; nN = N / BM; nwg = nM * nN; G = G_; c = c_; }
    __host__ __device__ bool next(int i, Unit& u) const {
        const long L = (long)i * G + c; if (L >= nwg) return false;
        int wgid = (int)L; { const int q = nwg / NXCD, r = nwg % NXCD, xcd = wgid % NXCD, off = wgid / NXCD; wgid = (xcd < r ? xcd * (q + 1) : r * (q + 1) + (xcd - r) * q) + off; }
        const int nig = WGM * nN, gid = wgid / nig, fm = gid * WGM, gsz = (nM - fm) < WGM ? (nM - fm) : WGM;
        u.pm = fm + ((wgid % nig) % gsz); u.pn = (wgid % nig) / gsz; return true;
    }
    __device__ __forceinline__ void a_ready(const Unit&) const {}
    __device__ __forceinline__ void done(const Unit&) const {}
};
template <class Epi, class Sched, int F8 = 0, bool ALIGN_EPI = true>
__device__ __forceinline__ void gemm_phase(LAS unsigned char* lds, const Gemm g, const Sched& S, const Epi& E, int wid) {
    const int lane = fresh_lane(), tid = wid * 64 + lane, wr = wid >> 2, wc = wid & 3, fr = lane & 15, fq = lane >> 4;
    const int nt = g.nt;
    unsigned voffA, voffB;
    { int R, C; stage_rc(tid * 16, R, C); const int Rb = Epi::PERM ? ((R & ~31) + perm32(R & 31)) : R; voffA = (unsigned)(R * g.lda_b + C * 2); voffB = (unsigned)(Rb * g.ldb_b + C * 2); }
    const size_t qstepA = (size_t)64 * g.lda_b, qstepB = (size_t)64 * g.ldb_b;
    const unsigned ldsbase = (unsigned)(size_t)lds;
    const size_t kstep = (size_t)(BK * 2);
    const size_t hstepA = (size_t)HALF * g.lda_b, hstepB = (size_t)HALF * g.ldb_b;
    const size_t tstepA = 2 * hstepA, tstepB = 2 * hstepB;
    const unsigned ldsw = (unsigned)wid * 1024u;
    const int aoff = lds_byte(wr * 64 + fr, fq * 8), boff = lds_byte(wc * 32 + fr, fq * 8);
#define PG8_SA(b, h) (((b) * 2 + (h)) * HTB)
#define PG8_SB(b, h) ((4 + (b) * 2 + (h)) * HTB)
#define PG8_STAGE_A(bufoff, gbase) do { glds16((const char*)(gbase), voffA, ldsbase + (bufoff) + ldsw); glds16((const char*)(gbase) + qstepA, voffA, ldsbase + (bufoff) + ldsw + 8192); } while (0)
#define PG8_STAGE_B(bufoff, gbase) do { glds16((const char*)(gbase), voffB, ldsbase + (bufoff) + ldsw); glds16((const char*)(gbase) + qstepB, voffB, ldsbase + (bufoff) + ldsw + 8192); } while (0)
#define PG8_LD8(p) __builtin_shufflevector(*(const LAS i32x4*)(p), *(const LAS i32x4*)((p) + 1024), 0, 1, 2, 3, 4, 5, 6, 7)
#define PG8_LDA(dst, b, h) do { _Pragma("unroll") for (int m = 0; m < 4; ++m) dst[m] = PG8_LD8(lds + PG8_SA(b, h) + aoff + m * 2048); } while (0)
#define PG8_LDB(dst, b, h) do { _Pragma("unroll") for (int n = 0; n < 2; ++n) dst[n] = PG8_LD8(lds + PG8_SB(b, h) + boff + n * 2048); } while (0)
#define PG8_LO(v) __builtin_bit_cast(bf16x8, __builtin_shufflevector(v, v, 0, 1, 2, 3))
#define PG8_HI(v) __builtin_bit_cast(bf16x8, __builtin_shufflevector(v, v, 4, 5, 6, 7))
#define PG8_MMA(ai, bj, At, Bt) do { __builtin_amdgcn_s_setprio(1); _Pragma("unroll") for (int m = 0; m < 4; ++m) _Pragma("unroll") for (int n = 0; n < 2; ++n) { \
        if constexpr (F8 == 1) acc[ai][bj][m][n] = __builtin_amdgcn_mfma_scale_f32_16x16x128_f8f6f4(Bt[n], At[m], acc[ai][bj][m][n], 0, 0, 0, 0x7F7F7F7F, 0, 0x7F7F7F7F); \
        else if constexpr (F8 == 2) { i32x4 ci = __builtin_bit_cast(i32x4, acc[ai][bj][m][n]); \
               ci = __builtin_amdgcn_mfma_i32_16x16x64_i8(__builtin_shufflevector(Bt[n], Bt[n], 0, 1, 2, 3), __builtin_shufflevector(At[m], At[m], 0, 1, 2, 3), ci, 0, 0, 0); \
               ci = __builtin_amdgcn_mfma_i32_16x16x64_i8(__builtin_shufflevector(Bt[n], Bt[n], 4, 5, 6, 7), __builtin_shufflevector(At[m], At[m], 4, 5, 6, 7), ci, 0, 0, 0); \
               acc[ai][bj][m][n] = __builtin_bit_cast(f32x4, ci); } \
        else { acc[ai][bj][m][n] = __builtin_amdgcn_mfma_f32_16x16x32_bf16(PG8_LO(Bt[n]), PG8_LO(At[m]), acc[ai][bj][m][n], 0, 0, 0); \
               acc[ai][bj][m][n] = __builtin_amdgcn_mfma_f32_16x16x32_bf16(PG8_HI(Bt[n]), PG8_HI(At[m]), acc[ai][bj][m][n], 0, 0, 0); } } \
        __builtin_amdgcn_s_setprio(0); } while (0)
#define PG8_WAIT_V(n) asm volatile("s_waitcnt vmcnt(" #n ")" ::: "memory")
#define PG8_WAIT_L(n) asm volatile("s_waitcnt lgkmcnt(" #n ")" ::: "memory")
#define PG8_BAR __builtin_amdgcn_s_barrier()
#define PG8_SCHED __builtin_amdgcn_sched_barrier(0)
    Unit cur, nxt; int ui = 0;
    if (!S.next(0, cur)) return;
    f32x4 acc[2][2][4][2];
#pragma unroll
    for (int a = 0; a < 2; ++a)
#pragma unroll
        for (int b = 0; b < 2; ++b)
#pragma unroll
            for (int m = 0; m < 4; ++m)
#pragma unroll
                for (int n = 0; n < 2; ++n) acc[a][b][m][n] = (f32x4){0.f, 0.f, 0.f, 0.f};
    i32x8 At[4], B0[2], B1[2];
    const char* cA = (const char*)g.A + (size_t)cur.pm * tstepA; const char* cB = (const char*)g.Bt + (size_t)cur.pn * tstepB;
    const bool two = g.A2 != nullptr; const int nt1 = two ? g.nt1 : nt;
    const char* cA2 = two ? (const char*)g.A2 + (size_t)cur.pm * tstepA : cA; const char* cB2 = two ? (const char*)g.Bt2 + (size_t)cur.pn * tstepB : cB;
    S.a_ready(cur);
    PG8_STAGE_B(PG8_SB(0, 0), cB); PG8_STAGE_B(PG8_SB(0, 1), cB + hstepB); PG8_STAGE_A(PG8_SA(0, 0), cA); PG8_STAGE_A(PG8_SA(0, 1), cA + hstepA);
    if (wr == 1) PG8_BAR;
    PG8_WAIT_V(2); PG8_BAR;
    PG8_STAGE_B(PG8_SB(1, 0), cB + kstep); PG8_STAGE_A(PG8_SA(1, 0), cA + kstep); PG8_STAGE_B(PG8_SB(1, 1), cB + hstepB + kstep);
    PG8_WAIT_V(6); PG8_BAR;
    for (;;) {
        const bool has_next = S.next(ui + 1, nxt);
        const char* nA = has_next ? (const char*)g.A + (size_t)nxt.pm * tstepA : cA; const char* nB = has_next ? (const char*)g.Bt + (size_t)nxt.pn * tstepB : cB;
#pragma unroll 1
        for (int t = 0; t < nt; t += 2) {
            const bool last = (t == nt - 2);
            const char* a1 = (t < nt1 ? cA + (size_t)t * kstep : cA2 + (size_t)(t - nt1) * kstep) + kstep;
            const char* a2 = last ? nA : (t + 2 < nt1 ? cA + (size_t)(t + 2) * kstep : cA2 + (size_t)(t + 2 - nt1) * kstep);
            const char* b2 = last ? nB : (t + 2 < nt1 ? cB + (size_t)(t + 2) * kstep : cB2 + (size_t)(t + 2 - nt1) * kstep);
            const char* a3 = a2 + kstep; const char* b3 = b2 + kstep;
            if (last && has_next) S.a_ready(nxt);
            PG8_LDB(B0, 0, 0); PG8_LDB(B1, 0, 1); PG8_SCHED; PG8_LDA(At, 0, 0); PG8_STAGE_A(PG8_SA(1, 1), a1 + hstepA);
            PG8_WAIT_V(8); PG8_WAIT_L(0); PG8_BAR; PG8_MMA(0, 0, At, B0); PG8_MMA(0, 1, At, B1); PG8_BAR; PG8_SCHED;
            PG8_LDA(At, 0, 1); PG8_STAGE_B(PG8_SB(0, 0), b2); PG8_STAGE_B(PG8_SB(0, 1), b2 + hstepB); PG8_STAGE_A(PG8_SA(0, 0), a2);
            PG8_WAIT_V(8); PG8_WAIT_L(0); PG8_BAR; PG8_MMA(1, 0, At, B0); PG8_MMA(1, 1, At, B1); PG8_BAR; PG8_SCHED;
            PG8_LDB(B0, 1, 0); PG8_LDB(B1, 1, 1); PG8_SCHED; PG8_LDA(At, 1, 0); PG8_STAGE_A(PG8_SA(0, 1), a2 + hstepA);
            PG8_WAIT_V(8); PG8_WAIT_L(0); PG8_BAR; PG8_MMA(0, 0, At, B0); PG8_MMA(0, 1, At, B1); PG8_BAR; PG8_SCHED;
            PG8_LDA(At, 1, 1); PG8_STAGE_B(PG8_SB(1, 0), b3); PG8_STAGE_B(PG8_SB(1, 1), b3 + hstepB); PG8_STAGE_A(PG8_SA(1, 0), a3);
            PG8_WAIT_V(8); PG8_WAIT_L(0); PG8_BAR; PG8_MMA(1, 0, At, B0); PG8_MMA(1, 1, At, B1); PG8_BAR; PG8_SCHED;
            if constexpr (Epi::HAS_MID) { if (t + 2 == nt1) { int fr2 = fr, fq2 = fq; asm volatile("" : "+v"(fr2), "+v"(fq2)); E.mid(acc, cur, wr, wc, fr2, fq2); } }
        }
        if constexpr (ALIGN_EPI) { if (wr == 0) PG8_BAR; }
        { int fr2 = fr, fq2 = fq; asm volatile("" : "+v"(fr2), "+v"(fq2));
          E(acc, cur, wr, wc, fr2, fq2); }
        if (!has_next) break;
#pragma unroll
        for (int a = 0; a < 2; ++a)
#pragma unroll
            for (int b = 0; b < 2; ++b)
#pragma unroll
                for (int m = 0; m < 4; ++m)
#pragma unroll
                    for (int n = 0; n < 2; ++n) acc[a][b][m][n] = (f32x4){0.f, 0.f, 0.f, 0.f};
        cur = nxt; cA = nA; cB = nB; ++ui;
        if (two) { cA2 = (const char*)g.A2 + (size_t)cur.pm * tstepA; cB2 = (const char*)g.Bt2 + (size_t)cur.pn * tstepB; } else { cA2 = cA; cB2 = cB; }
        if constexpr (ALIGN_EPI) { if (wr == 1) PG8_BAR; }
    }
    PG8_WAIT_V(0);
    if constexpr (!ALIGN_EPI) { if (wr == 0) PG8_BAR; }
    PG8_BAR;
#undef PG8_SA
#undef PG8_SB
#undef PG8_STAGE_A
#undef PG8_STAGE_B
#undef PG8_LDA
#undef PG8_LDB
#undef PG8_LD8
#undef PG8_LO
#undef PG8_HI
#undef PG8_MMA
#undef PG8_WAIT_V
#undef PG8_WAIT_L
#undef PG8_BAR
#undef PG8_SCHED
}
}
typedef f32x4 AccT[2][2][4][2];

#ifdef PROBE_RELAUNCH
struct Args { const float* in[28]; float* out; unsigned char* ws; int ph_lo, ph_hi, bslot; };
#else
struct Args { const float* in[28]; float* out; unsigned char* ws; int ph_lo, ph_hi; };
#endif
struct Frame {
    LAS unsigned char* lds; int tid, lane, wave, G, blk;
    const float *x, *c, *w_ada, *b_ada, *w_in, *conv_w, *conv_b, *w_rg_a, *b_rg_a, *w_rg_x, *b_rg_x, *rg_lambda, *w_rnn_out, *q_norm_g, *w_uq, *kv_norm_g, *w_ukv,
                *w_mla_out, *w_o, *ln1_g, *ln1_b, *peer_wq, *peer_keys, *peer_u, *peer_v, *ln2_g, *ln2_b;
    const int* positions;
    float* out; unsigned char* ws;
};
#define WSP(T, off) ((T*)(F.ws + (off)))

template <int MAP> __device__ __forceinline__ int colmap(int n) {
    if (MAP == 0) return n;
    if (MAP == 1) return n < 5120 ? n : (n < 9216 ? n + 64 : (n < 9280 ? n - 4096 : -1));
    if (MAP == 2) { if (n < 2048) return (n >> 7) * 192 + (n & 127); const int m = n - 2048, h = m >> 6, jj = m & 63; return h * 192 + 128 + (jj >> 1) + 32 * (jj & 1); }
    if (MAP == 3) return (n >> 7) * 256 + (n & 127);
    return (n >> 7) * 256 + 128 + (n & 127);
}
template <int MAP, bool F8> __device__ __forceinline__ void tr_item64(const float* W, int ldw, void* WTv, int ldt, float scale, const float* kscale, LAS float* scr, int k0, int n0, int lane) {
    const int col = colmap<MAP>(n0 + lane);
#pragma unroll
    for (int kk = 0; kk < 64; ++kk) { float v = 0.f;
        if (col >= 0) { v = W[(size_t)(k0 + kk) * ldw + col] * scale; if (kscale) v *= kscale[k0 + kk]; }
        scr[kk * 65 + lane] = v; }
    LDS_WAIT();
    const LAS float* sp = scr + lane;
    if (F8) { unsigned char* o = (unsigned char*)WTv + (size_t)(n0 + lane) * ldt + k0;
#pragma unroll
        for (int q = 0; q < 4; ++q) { u32x4 w;
#pragma unroll
            for (int d = 0; d < 4; ++d) { const int k = 16 * q + 4 * d; w[d] = pk4_f8(sp[k * 65], sp[(k + 1) * 65], sp[(k + 2) * 65], sp[(k + 3) * 65]); }
            *(u32x4*)(o + 16 * q) = w; }
    } else { bf16* o = (bf16*)WTv + (size_t)(n0 + lane) * ldt + k0;
#pragma unroll
        for (int q = 0; q < 8; ++q) { u32x4 w;
#pragma unroll
            for (int d = 0; d < 4; ++d) { const int k = 8 * q + 2 * d; w[d] = pk2(sp[k * 65], sp[(k + 1) * 65]); }
            *(u32x4*)(o + 8 * q) = w; } }
    LDS_WAIT();
}
__device__ __forceinline__ void p0_prologue(Frame& F, int qbank = 0) {
    const int tid = F.tid, lane = F.lane;
    if (F.blk < 192) {
        LAS float* ca = (LAS float*)F.lds; LAS float* red = (LAS float*)(F.lds + 32768);
        for (int i = tid; i < NB * DM; i += NTHREADS) { const float v = F.c[i]; ca[i] = v * sigmoidf_(v); }
        __syncthreads();
        const int cq = tid & 15, rg = tid >> 4, c0 = 64 * F.blk + 4 * cq;
        f32x4 a0 = {0, 0, 0, 0}, a1 = a0, a2 = a0, a3 = a0;
#pragma unroll 8
        for (int k = rg; k < DM; k += 32) { const f32x4 w = *(const f32x4*)(F.w_ada + (size_t)k * 12288 + c0);
            a0 += ca[k] * w; a1 += ca[DM + k] * w; a2 += ca[2 * DM + k] * w; a3 += ca[3 * DM + k] * w; }
        *(LAS f32x4*)(red + (rg * 4 + 0) * 64 + 4 * cq) = a0; *(LAS f32x4*)(red + (rg * 4 + 1) * 64 + 4 * cq) = a1;
        *(LAS f32x4*)(red + (rg * 4 + 2) * 64 + 4 * cq) = a2; *(LAS f32x4*)(red + (rg * 4 + 3) * 64 + 4 * cq) = a3;
        __syncthreads();
        if (tid < 256) { const int b = tid >> 6, col = tid & 63; float s = 0.f;
            for (int r = 0; r < 32; ++r) s += red[(r * 4 + b) * 64 + col];
            WSP(float, WS_MOD)[b * 12288 + 64 * F.blk + col] = s + F.b_ada[64 * F.blk + col]; }
        __syncthreads();
    }
    {
        LAS float* scr = (LAS float*)(F.lds + F.wave * 16640);
        unsigned* qhead = (unsigned*)(F.ws + WS_CTL) + 8192 + 2048 * qbank + 64 * (F.blk & 31);
        constexpr int I_IN = (NPROJ / 64) * (DM / 64), I_SQ = (DM / 64) * (DM / 64), I_UQ = (3072 / 64) * (512 / 64), I_UK = (2048 / 64) * (512 / 64), I_RG = 16 * 2 * 2;
        constexpr int NITEMS = I_IN + 4 * I_SQ + I_UQ + 2 * I_UK + 2 * I_RG;
        int nxt = 0; if (lane == 0) nxt = (int)__hip_atomic_fetch_add(qhead, 1u, __ATOMIC_RELAXED, __HIP_MEMORY_SCOPE_AGENT);
        for (;;) {
            const int it = __builtin_amdgcn_readfirstlane(nxt) * 32 + (F.blk & 31); if (it >= NITEMS) break;
            if (lane == 0) nxt = (int)__hip_atomic_fetch_add(qhead, 1u, __ATOMIC_RELAXED, __HIP_MEMORY_SCOPE_AGENT);
            int r = it;
            if (r < I_IN) { tr_item64<1, true>(F.w_in, IN_COLS, WSP(unsigned char, WS_WIN), DM, SC_WIN, nullptr, scr, 64 * (r / (NPROJ / 64)), 64 * (r % (NPROJ / 64)), lane); continue; } r -= I_IN;
            if (r < I_SQ) { tr_item64<0, true>(F.w_rnn_out, DM, WSP(unsigned char, WS_WRNN), DM, SC_WSQ, nullptr, scr, 64 * (r / 32), 64 * (r % 32), lane); continue; } r -= I_SQ;
            if (r < I_SQ) { tr_item64<0, true>(F.w_mla_out, DM, WSP(unsigned char, WS_WMLA), DM, SC_WSQ, nullptr, scr, 64 * (r / 32), 64 * (r % 32), lane); continue; } r -= I_SQ;
            if (r < I_SQ) { tr_item64<0, true>(F.w_o, DM, WSP(unsigned char, WS_WO), DM, SC_WSQ, nullptr, scr, 64 * (r / 32), 64 * (r % 32), lane); continue; } r -= I_SQ;
            if (r < I_SQ) {
                const int k0 = 64 * (r / 32), n0 = 64 * (r % 32); float am = 0.f;
#pragma unroll
                for (int kk = 0; kk < 64; ++kk) am = fmaxf(am, fabsf(F.peer_wq[(size_t)(k0 + kk) * DM + n0 + lane]));
                (void)__hip_atomic_fetch_max((unsigned*)(F.ws + WS_CTL + CTL_WQAMAX) + n0 + lane, __float_as_uint(am), __ATOMIC_RELAXED, __HIP_MEMORY_SCOPE_AGENT);
                continue; } r -= I_SQ;
            if (r < I_UQ) { tr_item64<2, true>(F.w_uq, 3072, WSP(unsigned char, WS_WUQ), 512, SC_WIN, F.q_norm_g, scr, 64 * (r / 48), 64 * (r % 48), lane); continue; } r -= I_UQ;
            if (r < I_UK) { tr_item64<3, true>(F.w_ukv, 4096, WSP(unsigned char, WS_WUK), 512, SC_WIN, F.kv_norm_g, scr, 64 * (r / 32), 64 * (r % 32), lane); continue; } r -= I_UK;
            if (r < I_UK) { tr_item64<4, true>(F.w_ukv, 4096, WSP(unsigned char, WS_WUV), 512, SC_WIN, F.kv_norm_g, scr, 64 * (r / 32), 64 * (r % 32), lane); continue; } r -= I_UK;
            if (r < I_RG) { const int h = r >> 2, q = r & 3; tr_item64<0, false>(F.w_rg_a + h * 16384, 128, WSP(bf16, WS_WGA) + h * 16384, 128, 1.0f, nullptr, scr, 64 * (q >> 1), 64 * (q & 1), lane); continue; } r -= I_RG;
            { const int h = r >> 2, q = r & 3; tr_item64<0, false>(F.w_rg_x + h * 16384, 128, WSP(bf16, WS_WGX) + h * 16384, 128, 1.0f, nullptr, scr, 64 * (q >> 1), 64 * (q & 1), lane); }
        }
    }
    {
        const int gt = F.blk * NTHREADS + tid, NGT = F.G * NTHREADS;
        f32x2* rope = WSP(f32x2, WS_ROPE);
        for (int i = gt; i < NT * 32; i += NGT) { const int t = i >> 5, j = i & 31;
            const float inv_freq = exp2f(-(float)j * (13.287712379549449f / 32.0f));
            const float ang = (float)F.positions[t] * inv_freq;
            double rev = (double)ang * 0.15915494309189535; rev -= rint(rev);
            const float rv = (float)rev;
            rope[i] = (f32x2){__builtin_amdgcn_cosf(rv), __builtin_amdgcn_sinf(rv)}; }
        bf16* pk = WSP(bf16, WS_PKEYS);
        for (int i = gt; i < 2 * 128 * 128 / 2; i += NGT) { const f32x2 v = *(const f32x2*)(F.peer_keys + 2 * i); ((unsigned*)pk)[i] = pk2(v.x, v.y); }
    }
}

__device__ __forceinline__ void p1_modulate(Frame& F) {
    const int gw = F.blk * NWAVES + F.wave, NGW = F.G * NWAVES;
    const float* mod = WSP(float, WS_MOD); unsigned char* hb = WSP(unsigned char, WS_S0);
    for (int m = gw; m < NT; m += NGW) {
        const int b = m >> 13; const float* sh = mod + b * 12288; const float* sc = sh + 2048;
#pragma unroll
        for (int j = 0; j < 2; ++j) { const int col = 1024 * j + 16 * F.lane; u32x4 o;
#pragma unroll
            for (int q = 0; q < 4; ++q) { const f32x4 v = *(const f32x4*)(F.x + (size_t)m * DM + col + 4 * q), s = *(const f32x4*)(sc + col + 4 * q), h = *(const f32x4*)(sh + col + 4 * q);
                o[q] = pk4_f8((v.x * (1.f + s.x) + h.x) * SC_H, (v.y * (1.f + s.y) + h.y) * SC_H, (v.z * (1.f + s.z) + h.z) * SC_H, (v.w * (1.f + s.w) + h.w) * SC_H); }
            *(u32x4*)(hb + (size_t)m * DM + col) = o; }
    }
    if (F.wave < 4) {
        const int lane = F.lane, it = F.blk * 4 + F.wave;
        LAS float* scr = (LAS float*)(F.lds + F.wave * 16640);
        for (int r = it; r < 1024; r += 4 * F.G) {
            const int k0 = 64 * (r / 32), n0 = 64 * (r % 32);
            const float am = fmaxf(__uint_as_float(((const unsigned*)(F.ws + WS_CTL + CTL_WQAMAX))[n0 + lane]), 1e-30f), qs = 127.0f / am;
#pragma unroll
            for (int kk = 0; kk < 64; ++kk) scr[kk * 65 + lane] = F.peer_wq[(size_t)(k0 + kk) * DM + n0 + lane];
            LDS_WAIT();
            if (k0 == 0) WSP(float, WS_WQS)[n0 + lane] = am * (1.0f / 127.0f);
            const LAS float* sp = scr + lane;
            unsigned char* o = WSP(unsigned char, WS_WPQ) + (size_t)(n0 + lane) * DM + k0;
#pragma unroll
            for (int q = 0; q < 4; ++q) { u32x4 w;
#pragma unroll
                for (int d = 0; d < 4; ++d) { const int k = 16 * q + 4 * d; w[d] = pk4_i8(sp[k * 65] * qs, sp[(k + 1) * 65] * qs, sp[(k + 2) * 65] * qs, sp[(k + 3) * 65] * qs); }
                *(u32x4*)(o + 16 * q) = w; }
            LDS_WAIT();
        }
    }
}

#define EPI_ROWS(...) _Pragma("unroll") for (int ai = 0; ai < 2; ++ai) _Pragma("unroll") for (int m = 0; m < 4; ++m) { const int row = u.pm * 256 + ai * 128 + wr * 64 + m * 16 + fr; \
    _Pragma("unroll") for (int bj = 0; bj < 2; ++bj) { const int cl = bj * 128 + wc * 32 + 8 * fq; const f32x4 v0 = acc[ai][bj][m][0] * esc, v1 = acc[ai][bj][m][1] * esc; __VA_ARGS__ } }
__device__ __forceinline__ u32x4 pack8(const f32x4 a, const f32x4 b) { return (u32x4){pk2(a.x, a.y), pk2(a.z, a.w), pk2(b.x, b.y), pk2(b.z, b.w)}; }

struct EpiProj {
    static constexpr bool HAS_MID = false;
    static constexpr bool PERM = true;
    bf16 *XR, *GG; unsigned char *QC8, *KVC8; bf16 *SGR, *SGM; float *KR, *SS; float esc;
    __device__ __forceinline__ void operator()(const AccT& acc, const pg8::Unit& u, int wr, int wc, int fr, int fq) const {
        const int pn = u.pn;
        if (pn < 8) { bf16* O = XR + pn * 256;
            EPI_ROWS( *(u32x4*)(O + (size_t)row * DM + cl) = pack8(v0, v1); )
        } else if (pn < 16) { bf16* O = GG + (pn - 8) * 256;
            EPI_ROWS( f32x4 a, b; for (int e = 0; e < 4; ++e) { a[e] = gelu_tanh(v0[e]); b[e] = gelu_tanh(v1[e]); } *(u32x4*)(O + (size_t)row * DM + cl) = pack8(a, b); )
        } else if (pn < 20) { const int which = (pn >= 18); const int c0 = (pn & 1) * 256;
#pragma unroll
            for (int ai = 0; ai < 2; ++ai)
#pragma unroll
                for (int m = 0; m < 4; ++m) { const int row = u.pm * 256 + ai * 128 + wr * 64 + m * 16 + fr; float s = 0.f;
#pragma unroll
                    for (int bj = 0; bj < 2; ++bj) { const int cl = bj * 128 + wc * 32 + 8 * fq; const f32x4 v0 = acc[ai][bj][m][0] * esc, v1 = acc[ai][bj][m][1] * esc;
                        *(u32x2*)((which ? KVC8 : QC8) + (size_t)row * 512 + c0 + cl) = (u32x2){pk4_f8(v0.x * SC_H, v0.y * SC_H, v0.z * SC_H, v0.w * SC_H), pk4_f8(v1.x * SC_H, v1.y * SC_H, v1.z * SC_H, v1.w * SC_H)};
                        s += (v0.x * v0.x + v0.y * v0.y) + (v0.z * v0.z + v0.w * v0.w) + (v1.x * v1.x + v1.y * v1.y) + (v1.z * v1.z + v1.w * v1.w); }
                    SS[(size_t)row * 64 + which * 32 + (pn & 1) * 16 + wc * 4 + fq] = s; }
        } else if (pn < 36) { bf16* O = (pn < 28 ? SGR + (pn - 20) * 256 : SGM + (pn - 28) * 256);
            EPI_ROWS( f32x4 a, b; for (int e = 0; e < 4; ++e) { a[e] = sigmoidf_(v0[e]); b[e] = sigmoidf_(v1[e]); } *(u32x4*)(O + (size_t)row * DM + cl) = pack8(a, b); )
        } else {
            EPI_ROWS( if (cl < 64) { *(f32x4*)(KR + (size_t)row * 64 + cl) = v0; *(f32x4*)(KR + (size_t)row * 64 + cl + 4) = v1; } )
        }
    }
};
struct EpiGate1 {
    static constexpr bool HAS_MID = false;
    static constexpr bool PERM = true; const bf16* SG; bf16* O; float esc;
    __device__ __forceinline__ void operator()(const AccT& acc, const pg8::Unit& u, int wr, int wc, int fr, int fq) const {
        EPI_ROWS( const size_t off = (size_t)row * DM + u.pn * 256 + cl; const u32x4 g = *(const u32x4*)(SG + off);
            f32x4 a = {v0.x * bflo(g.x), v0.y * bfhi(g.x), v0.z * bflo(g.y), v0.w * bfhi(g.y)}, b = {v1.x * bflo(g.z), v1.y * bfhi(g.z), v1.z * bflo(g.w), v1.w * bfhi(g.w)};
            *(u32x4*)(O + off) = pack8(a, b); )
    }
};
struct EpiGate2 {
    static constexpr bool HAS_MID = false;
    static constexpr bool PERM = true; const bf16* SG; const bf16* T; unsigned char* O8; float esc;
    __device__ __forceinline__ void operator()(const AccT& acc, const pg8::Unit& u, int wr, int wc, int fr, int fq) const {
        EPI_ROWS( const size_t off = (size_t)row * DM + u.pn * 256 + cl; const u32x4 g = *(const u32x4*)(SG + off); const u32x4 p = *(const u32x4*)(T + off);
            *(u32x2*)(O8 + off) = (u32x2){pk4_f8((bflo(p.x) + v0.x * bflo(g.x)) * SC_TMP, (bfhi(p.x) + v0.y * bfhi(g.x)) * SC_TMP, (bflo(p.y) + v0.z * bflo(g.y)) * SC_TMP, (bfhi(p.y) + v0.w * bfhi(g.y)) * SC_TMP),
                                          pk4_f8((bflo(p.z) + v1.x * bflo(g.z)) * SC_TMP, (bfhi(p.z) + v1.y * bfhi(g.z)) * SC_TMP, (bflo(p.w) + v1.z * bflo(g.w)) * SC_TMP, (bfhi(p.w) + v1.w * bfhi(g.w)) * SC_TMP)}; )
    }
};
struct EpiMix {
    static constexpr bool HAS_MID = true;
    static constexpr bool PERM = true; const bf16* SGR; const bf16* SGM; unsigned char* O8; float r12, e2;
    __device__ __forceinline__ void mid(AccT& acc, const pg8::Unit& u, int wr, int wc, int fr, int fq) const {
#pragma unroll
        for (int ai = 0; ai < 2; ++ai) {
            u32x4 gr[8], gm[8];
#pragma unroll
            for (int m = 0; m < 4; ++m)
#pragma unroll
                for (int bj = 0; bj < 2; ++bj) { const size_t off = (size_t)(u.pm * 256 + ai * 128 + wr * 64 + m * 16 + fr) * DM + u.pn * 256 + bj * 128 + wc * 32 + 8 * fq;
                    gr[m * 2 + bj] = *(const u32x4*)(SGR + off); gm[m * 2 + bj] = *(const u32x4*)(SGM + off); }
            __builtin_amdgcn_sched_barrier(0);
#pragma unroll
            for (int m = 0; m < 4; ++m)
#pragma unroll
                for (int bj = 0; bj < 2; ++bj) { const u32x4 r = gr[m * 2 + bj], d = gm[m * 2 + bj];
                    const f32x4 n0 = {bflo(r.x), bfhi(r.x), bflo(r.y), bfhi(r.y)}, n1 = {bflo(r.z), bfhi(r.z), bflo(r.w), bfhi(r.w)};
                    const f32x4 d0 = {bflo(d.x), bfhi(d.x), bflo(d.y), bfhi(d.y)}, d1 = {bflo(d.z), bfhi(d.z), bflo(d.w), bfhi(d.w)};
#pragma unroll
                    for (int e = 0; e < 4; ++e) { acc[ai][bj][m][0][e] *= r12 * n0[e] * __builtin_amdgcn_rcpf(fmaxf(d0[e], 1e-12f)); acc[ai][bj][m][1][e] *= r12 * n1[e] * __builtin_amdgcn_rcpf(fmaxf(d1[e], 1e-12f)); } }
            __builtin_amdgcn_sched_barrier(0);
        }
    }
    __device__ __forceinline__ void operator()(const AccT& acc, const pg8::Unit& u, int wr, int wc, int fr, int fq) const {
        const float esc = e2 * SC_TMP;
#pragma unroll
        for (int ai = 0; ai < 2; ++ai) {
            u32x4 gmv[8];
#pragma unroll
            for (int m = 0; m < 4; ++m)
#pragma unroll
                for (int bj = 0; bj < 2; ++bj) gmv[m * 2 + bj] = *(const u32x4*)(SGM + (size_t)(u.pm * 256 + ai * 128 + wr * 64 + m * 16 + fr) * DM + u.pn * 256 + bj * 128 + wc * 32 + 8 * fq);
            __builtin_amdgcn_sched_barrier(0);
#pragma unroll
            for (int m = 0; m < 4; ++m)
#pragma unroll
                for (int bj = 0; bj < 2; ++bj) { const size_t off = (size_t)(u.pm * 256 + ai * 128 + wr * 64 + m * 16 + fr) * DM + u.pn * 256 + bj * 128 + wc * 32 + 8 * fq; const u32x4 gm = gmv[m * 2 + bj];
                    const f32x4 v0 = acc[ai][bj][m][0] * esc, v1 = acc[ai][bj][m][1] * esc;
                    *(u32x2*)(O8 + off) = (u32x2){pk4_f8(v0.x * fmaxf(bflo(gm.x), 1e-12f), v0.y * fmaxf(bfhi(gm.x), 1e-12f), v0.z * fmaxf(bflo(gm.y), 1e-12f), v0.w * fmaxf(bfhi(gm.y), 1e-12f)),
                                                  pk4_f8(v1.x * fmaxf(bflo(gm.z), 1e-12f), v1.y * fmaxf(bfhi(gm.z), 1e-12f), v1.z * fmaxf(bflo(gm.w), 1e-12f), v1.w * fmaxf(bfhi(gm.w), 1e-12f))}; }
            __builtin_amdgcn_sched_barrier(0);
        }
    }
};
struct EpiRes1 {
    static constexpr bool HAS_MID = false;
    static constexpr bool PERM = true; const float* X; const float* mod; bf16* R; float esc;
    __device__ __forceinline__ void operator()(const AccT& acc, const pg8::Unit& u, int wr, int wc, int fr, int fq) const {
        f32x4 g[2][2];
#pragma unroll
        for (int bj = 0; bj < 2; ++bj) { const float* gt = mod + ((u.pm * 256) >> 13) * 12288 + 4096 + u.pn * 256 + bj * 128 + wc * 32 + 8 * fq; g[bj][0] = 1.f + *(const f32x4*)gt; g[bj][1] = 1.f + *(const f32x4*)(gt + 4); }
#pragma unroll
        for (int ai = 0; ai < 2; ++ai) {
            f32x4 xv[8][2];
#pragma unroll
            for (int m = 0; m < 4; ++m)
#pragma unroll
                for (int bj = 0; bj < 2; ++bj) { const float* xp = X + (size_t)(u.pm * 256 + ai * 128 + wr * 64 + m * 16 + fr) * DM + u.pn * 256 + bj * 128 + wc * 32 + 8 * fq; xv[m * 2 + bj][0] = *(const f32x4*)xp; xv[m * 2 + bj][1] = *(const f32x4*)(xp + 4); }
            __builtin_amdgcn_sched_barrier(0);
#pragma unroll
            for (int m = 0; m < 4; ++m)
#pragma unroll
                for (int bj = 0; bj < 2; ++bj) { const size_t off = (size_t)(u.pm * 256 + ai * 128 + wr * 64 + m * 16 + fr) * DM + u.pn * 256 + bj * 128 + wc * 32 + 8 * fq;
                    *(u32x4*)(R + off) = pack8(DN_ALPHA * xv[m * 2 + bj][0] + g[bj][0] * (acc[ai][bj][m][0] * esc), DN_ALPHA * xv[m * 2 + bj][1] + g[bj][1] * (acc[ai][bj][m][1] * esc)); }
            __builtin_amdgcn_sched_barrier(0);
        }
    }
};
struct EpiQuery {
    static constexpr bool HAS_MID = false;
    static constexpr bool PERM = true; bf16* O; const float* HS; const float* WS;
    __device__ __forceinline__ void operator()(const AccT& acc, const pg8::Unit& u, int wr, int wc, int fr, int fq) const {
        float hsv[2][4]; f32x4 wsv[2][2];
#pragma unroll
        for (int ai = 0; ai < 2; ++ai)
#pragma unroll
            for (int m = 0; m < 4; ++m) hsv[ai][m] = HS[u.pm * 256 + ai * 128 + wr * 64 + m * 16 + fr];
#pragma unroll
        for (int bj = 0; bj < 2; ++bj) { const int col = u.pn * 256 + bj * 128 + wc * 32 + 8 * fq; wsv[bj][0] = *(const f32x4*)(WS + col); wsv[bj][1] = *(const f32x4*)(WS + col + 4); }
        __builtin_amdgcn_sched_barrier(0);
#pragma unroll
        for (int ai = 0; ai < 2; ++ai)
#pragma unroll
            for (int m = 0; m < 4; ++m) { const int row = u.pm * 256 + ai * 128 + wr * 64 + m * 16 + fr; const float hs = hsv[ai][m];
#pragma unroll
                for (int bj = 0; bj < 2; ++bj) { const int col = u.pn * 256 + bj * 128 + wc * 32 + 8 * fq; const f32x4 w0 = wsv[bj][0] * hs, w1 = wsv[bj][1] * hs;
                    const i32x4 a0 = __builtin_bit_cast(i32x4, acc[ai][bj][m][0]), a1 = __builtin_bit_cast(i32x4, acc[ai][bj][m][1]);
                    const f32x4 v0 = {(float)a0.x * w0.x, (float)a0.y * w0.y, (float)a0.z * w0.z, (float)a0.w * w0.w}, v1 = {(float)a1.x * w1.x, (float)a1.y * w1.y, (float)a1.z * w1.z, (float)a1.w * w1.w};
                    *(u32x4*)(O + (size_t)row * DM + col) = pack8(v0, v1); } }
    }
};
#ifdef PROBE_GEMM
struct EpiNull {
    static constexpr bool HAS_MID = false;
    static constexpr bool PERM = true; float* O;
    __device__ __forceinline__ void operator()(const AccT& acc, const pg8::Unit& u, int wr, int wc, int fr, int fq) const {
        f32x4 s = {0.f, 0.f, 0.f, 0.f};
#pragma unroll
        for (int ai = 0; ai < 2; ++ai)
#pragma unroll
            for (int bj = 0; bj < 2; ++bj)
#pragma unroll
                for (int m = 0; m < 4; ++m) s += acc[ai][bj][m][0] + acc[ai][bj][m][1];
        *(f32x4*)(O + ((size_t)(u.pm * 8 + u.pn) * 512 + (wr * 4 + wc) * 64 + fq * 16 + fr) * 4) = s;
    }
};
#endif
struct EpiPlain {
    static constexpr bool HAS_MID = false;
    static constexpr bool PERM = true; bf16* O; float esc;
    __device__ __forceinline__ void operator()(const AccT& acc, const pg8::Unit& u, int wr, int wc, int fr, int fq) const {
        EPI_ROWS( *(u32x4*)(O + (size_t)row * DM + u.pn * 256 + cl) = pack8(v0, v1); )
    }
};
struct EpiQ {
    static constexpr bool HAS_MID = false;
    static constexpr bool PERM = true; unsigned char* Q; const float* SS; const f32x2* rope; float esc;
    __device__ __forceinline__ void operator()(const AccT& acc, const pg8::Unit& u, int wr, int wc, int fr, int fq) const {
        const bool is_rope = u.pn >= 8;
        EPI_ROWS( const float rs = SS[(size_t)row * 2] * (QSCALE * SC_Q); const int b = row >> 13, s = row & 8191;
            if (!is_rope) { const int cg = u.pn * 256 + cl, h = cg >> 7, d = cg & 127;
                *(u32x2*)(Q + (unsigned)(((b * NH + h) * SEQ + s) * DQK + d)) = (u32x2){pk4_f8(v0.x * rs, v0.y * rs, v0.z * rs, v0.w * rs), pk4_f8(v1.x * rs, v1.y * rs, v1.z * rs, v1.w * rs)};
            } else { const int cg = (u.pn - 8) * 256 + cl, h = cg >> 6, jj = cg & 63; const f32x4* cs = (const f32x4*)(rope + (size_t)row * 32 + (jj >> 1));
                const f32x4 c0 = cs[0], c1 = cs[1];
                *(u32x2*)(Q + (unsigned)(((b * NH + h) * SEQ + s) * DQK + 128 + jj)) = (u32x2){
                    pk4_f8((v0.x * c0.x - v0.y * c0.y) * rs, (v0.y * c0.x + v0.x * c0.y) * rs, (v0.z * c0.z - v0.w * c0.w) * rs, (v0.w * c0.z + v0.z * c0.w) * rs),
                    pk4_f8((v1.x * c1.x - v1.y * c1.y) * rs, (v1.y * c1.x + v1.x * c1.y) * rs, (v1.z * c1.z - v1.w * c1.w) * rs, (v1.w * c1.z + v1.z * c1.w) * rs)}; } )
    }
};
struct EpiK {
    static constexpr bool HAS_MID = false;
    static constexpr bool PERM = true; unsigned char* K; const float* SS; float esc;
    __device__ __forceinline__ void operator()(const AccT& acc, const pg8::Unit& u, int wr, int wc, int fr, int fq) const {
        float rsv[2][4];
#pragma unroll
        for (int ai = 0; ai < 2; ++ai)
#pragma unroll
            for (int m = 0; m < 4; ++m) rsv[ai][m] = SS[(size_t)(u.pm * 256 + ai * 128 + wr * 64 + m * 16 + fr) * 2 + 1];
        __builtin_amdgcn_sched_barrier(0);
        EPI_ROWS( const float rs = rsv[ai][m] * SC_K; const int b = row >> 13, s = row & 8191;
            const int cg = u.pn * 256 + cl, h = cg >> 7, d = cg & 127;
            *(u32x2*)(K + (unsigned)(((b * NH + h) * SEQ + s) * DQK + d)) = (u32x2){pk4_f8(v0.x * rs, v0.y * rs, v0.z * rs, v0.w * rs), pk4_f8(v1.x * rs, v1.y * rs, v1.z * rs, v1.w * rs)}; )
    }
};
struct EpiVT {
    static constexpr bool HAS_MID = false;
    static constexpr bool PERM = true; unsigned char* VT; const float* SS; float esc;
    __device__ __forceinline__ void operator()(const AccT& acc, const pg8::Unit& u, int wr, int wc, int fr, int fq) const {
#pragma unroll
        for (int bj = 0; bj < 2; ++bj) {
            const int cl = bj * 128 + wc * 32 + 8 * fq; const int t0 = u.pn * 256 + cl, b = t0 >> 13, s = t0 & 8191; const f32x4* sp = (const f32x4*)(SS + (size_t)t0 * 2);
            const f32x4 s0 = sp[0] * SC_V, s1 = sp[1] * SC_V, s2 = sp[2] * SC_V, s3 = sp[3] * SC_V;
            __builtin_amdgcn_sched_barrier(0);
#pragma unroll
            for (int ai = 0; ai < 2; ++ai)
#pragma unroll
                for (int m = 0; m < 4; ++m) { const int row = u.pm * 256 + ai * 128 + wr * 64 + m * 16 + fr, h = row >> 7, d = row & 127; const f32x4 v0 = acc[ai][bj][m][0] * esc, v1 = acc[ai][bj][m][1] * esc;
                    *(u32x2*)(VT + (unsigned)(((((b * NH + h) * 128 + (s >> 6)) * 128 + d) * 64 + (s & 63)))) = (u32x2){pk4_f8(v0.x * s0.y, v0.y * s0.w, v0.z * s1.y, v0.w * s1.w), pk4_f8(v1.x * s2.y, v1.y * s2.w, v1.z * s3.y, v1.w * s3.w)}; }
            __builtin_amdgcn_sched_barrier(0);
        }
    }
};

constexpr int RG_W = 288;
constexpr int RG_SUB = 64;
constexpr int RG_XC = 0, RG_GGT = 36864, RG_OUT = 69632;
__device__ __forceinline__ unsigned char* rg_ab(unsigned char* ws, int tile) { return tile < 1536 ? ws + WS_TMP + (size_t)tile * 131072 : ws + WS_AO8 + (size_t)(tile - 1536) * 131072; }
__device__ __forceinline__ float rg_h_lo(unsigned w) { return (float)__builtin_bit_cast(_Float16, (unsigned short)(w & 0xffffu)); }
__device__ __forceinline__ float rg_h_hi(unsigned w) { return (float)__builtin_bit_cast(_Float16, (unsigned short)(w >> 16)); }
struct RgMap { float A, H; };
__device__ __forceinline__ RgMap rg_then(const RgMap f, const RgMap g) { return RgMap{f.A * g.A, g.A * f.H + g.H}; }
__device__ __forceinline__ void rglru_passA(Frame& F) {
    const int tid = F.tid, lane = F.lane, wave = F.wave;
    {
        const float* ssp = WSP(float, WS_SSP); float* rs = WSP(float, WS_RS);
        for (int i = F.blk * NTHREADS + tid; i < NT * 2; i += F.G * NTHREADS) { const f32x4* p = (const f32x4*)(ssp + (size_t)i * 32); float s = 0.f;
#pragma unroll
            for (int k = 0; k < 8; ++k) { const f32x4 a = p[k]; s += (a.x + a.y) + (a.z + a.w); }
            rs[i] = __builtin_amdgcn_rsqf(s * (1.f / 512.f) + RMS_EPS); } }
    LAS unsigned char* L = F.lds;
    const bf16* XR = WSP(bf16, WS_XR); float* SUMM = WSP(float, WS_SUMM);
    const int q = lane >> 4;
    for (int tile = F.blk; tile < NB * 32 * NH; tile += F.G) {
        const int hh = tile & 15, c = (tile >> 4) & 31, b = tile >> 9;
        const int ech = 16 * wave + (lane & 15), egch = hh * 128 + ech;
        bf16x8 bA[4], bX[4];
        { const bf16* ga = WSP(bf16, WS_WGA) + hh * 16384 + ech * 128 + 8 * (lane >> 4); const bf16* gx = WSP(bf16, WS_WGX) + hh * 16384 + ech * 128 + 8 * (lane >> 4);
#pragma unroll
            for (int ks = 0; ks < 4; ++ks) { bA[ks] = *(const bf16x8*)(ga + 32 * ks); bX[ks] = *(const bf16x8*)(gx + 32 * ks); } }
        const float e_ba = F.b_rg_a[egch], e_bx = F.b_rg_x[egch];
        const float lam = F.rg_lambda[egch]; const float e_sp8 = -8.0f * 1.4426950408889634f * ((lam > 15.f) ? expf(-lam) : (lam < -15.f ? -lam : log1pf(expf(-lam))));
        const int crow = tid >> 4, c8 = (tid & 15) * 8, cg = hh * 128 + c8;
        float cw[4][8], cb[8];
#pragma unroll
        for (int w = 0; w < 4; ++w) { const f32x4 p = *(const f32x4*)(F.conv_w + w * DM + cg), qq = *(const f32x4*)(F.conv_w + w * DM + cg + 4);
            cw[w][0] = p.x; cw[w][1] = p.y; cw[w][2] = p.z; cw[w][3] = p.w; cw[w][4] = qq.x; cw[w][5] = qq.y; cw[w][6] = qq.z; cw[w][7] = qq.w; }
        { const f32x4 p = *(const f32x4*)(F.conv_b + cg), qq = *(const f32x4*)(F.conv_b + cg + 4); cb[0] = p.x; cb[1] = p.y; cb[2] = p.z; cb[3] = p.w; cb[4] = qq.x; cb[5] = qq.y; cb[6] = qq.z; cb[7] = qq.w; }
        float S = 0.f, atot = 1.f;
        u32x4* abw = (u32x4*)rg_ab(F.ws, tile) + (wave * 64 + lane) * 4;
        const size_t tbase = (size_t)b * SEQ + c * 256;
        u32x4 xn[2][4];
#pragma unroll
        for (int hf = 0; hf < 2; ++hf)
#pragma unroll
            for (int w = 0; w < 4; ++w) { const int rr = crow + 32 * hf - 3 + w; xn[hf][w] = (u32x4){0u, 0u, 0u, 0u}; if (c * 256 + rr >= 0) xn[hf][w] = *(const u32x4*)(XR + (tbase + rr) * DM + cg); }
#pragma unroll 1
        for (int sub = 0; sub < 256 / RG_SUB; ++sub) {
            const size_t t0 = tbase + sub * RG_SUB;
            LAS unsigned char* XC = L + RG_XC + (sub & 1) * 18432;
#pragma unroll
            for (int hf = 0; hf < 2; ++hf) { float a[8];
#pragma unroll
                for (int e = 0; e < 8; ++e) a[e] = cb[e];
#pragma unroll
                for (int w = 0; w < 4; ++w) { const u32x4 xv = xn[hf][w];
                    a[0] += cw[w][0] * bflo(xv.x); a[1] += cw[w][1] * bfhi(xv.x); a[2] += cw[w][2] * bflo(xv.y); a[3] += cw[w][3] * bfhi(xv.y);
                    a[4] += cw[w][4] * bflo(xv.z); a[5] += cw[w][5] * bfhi(xv.z); a[6] += cw[w][6] * bflo(xv.w); a[7] += cw[w][7] * bfhi(xv.w); }
                *(LAS u32x4*)(XC + (crow + 32 * hf) * RG_W + c8 * 2) = (u32x4){pk2(a[0], a[1]), pk2(a[2], a[3]), pk2(a[4], a[5]), pk2(a[6], a[7])}; }
            __syncthreads();
            if (sub + 1 < 256 / RG_SUB) {
#pragma unroll
                for (int hf = 0; hf < 2; ++hf)
#pragma unroll
                    for (int w = 0; w < 4; ++w) xn[hf][w] = *(const u32x4*)(XR + (t0 + RG_SUB + crow + 32 * hf - 3 + w) * DM + cg); }
            f32x4 accA[4], accX[4];
#pragma unroll
            for (int rb = 0; rb < 4; ++rb) { accA[rb] = (f32x4){0, 0, 0, 0}; accX[rb] = (f32x4){0, 0, 0, 0}; }
#pragma unroll
            for (int ks = 0; ks < 4; ++ks) { const int ko = (ks * 32 + 8 * (lane >> 4)) * 2;
#pragma unroll
                for (int rb = 0; rb < 4; ++rb) { const bf16x8 af = *(const LAS bf16x8*)(XC + (rb * 16 + (lane & 15)) * RG_W + ko);
                    accA[rb] = __builtin_amdgcn_mfma_f32_16x16x32_bf16(af, bA[ks], accA[rb], 0, 0, 0);
                    accX[rb] = __builtin_amdgcn_mfma_f32_16x16x32_bf16(af, bX[ks], accX[rb], 0, 0, 0); } }
#pragma unroll
            for (int rb = 0; rb < 4; ++rb) {
                RgMap G{1.f, 0.f}; u32x4 pw = {0u, 0u, 0u, 0u};
#pragma unroll
                for (int r = 0; r < 4; ++r) { const int trow = rb * 16 + 4 * q + r;
                    const float xcv = bf1(*(const LAS bf16*)(XC + trow * RG_W + ech * 2));
                    const float rr = sigmoidf_(accA[rb][r] + e_ba), ii = sigmoidf_(accX[rb][r] + e_bx);
                    const float l2 = rr * e_sp8;
                    const float a_ = __builtin_amdgcn_exp2f(l2);
                    const float x2 = l2 * (2.0f * 0.6931471805599453f);
                    const float ser = -x2 * (1.0f + x2 * (0.5f + x2 * (0.16666667f + x2 * (0.041666668f + x2 * 0.008333334f))));
                    const float om = (x2 > -0.25f) ? ser : (1.0f - a_ * a_);
                    const float b_ = __builtin_amdgcn_sqrtf(om) * ii * xcv;
                    pw[r] = __builtin_bit_cast(unsigned, __builtin_amdgcn_cvt_pkrtz(l2, b_));
                    G.H = a_ * G.H + b_; G.A *= a_; }
                abw[sub * 2048 + rb] = pw;
                const RgMap P{__shfl_xor(G.A, 16), __shfl_xor(G.H, 16)};
                const RgMap pr = (q & 1) ? rg_then(P, G) : rg_then(G, P);
                const RgMap Q{__shfl_xor(pr.A, 32), __shfl_xor(pr.H, 32)};
                const RgMap T = (q & 2) ? rg_then(Q, pr) : rg_then(pr, Q);
                S = T.A * S + T.H; atot *= T.A;
            }
        }
        if (q == 0) *(f32x2*)(SUMM + ((size_t)(b * 32 + c) * DM + egch) * 2) = (f32x2){atot, S};
    }
    __syncthreads();
}
__device__ __forceinline__ void rglru_passB(Frame& F) {
    const int tid = F.tid, lane = F.lane, wave = F.wave;
    LAS unsigned char* L = F.lds;
    const bf16* GG = WSP(bf16, WS_GG); unsigned char* RA = WSP(unsigned char, WS_S0); const float* SUMM = WSP(float, WS_SUMM);
    const int q = lane >> 4;
    for (int tile = F.blk; tile < NB * 32 * NH; tile += F.G) {
        const int hh = tile & 15, c = (tile >> 4) & 31, b = tile >> 9;
        const int ech = 16 * wave + (lane & 15), egch = hh * 128 + ech;
        const int crow = tid >> 4, c8 = (tid & 15) * 8, cg = hh * 128 + c8;
        const size_t tbase = (size_t)b * SEQ + c * 256;
        const u32x4* abr = (const u32x4*)rg_ab(F.ws, tile) + (wave * 64 + lane) * 4;
        u32x4 gn[2], ab[4];
        gn[0] = *(const u32x4*)(GG + (tbase + crow) * DM + cg); gn[1] = *(const u32x4*)(GG + (tbase + crow + 32) * DM + cg);
#pragma unroll
        for (int rb = 0; rb < 4; ++rb) ab[rb] = abr[rb];
        float S;
        { f32x2 sv[8];
#pragma unroll
            for (int k = 0; k < 8; ++k) { const int cc = 8 * q + k; sv[k] = (f32x2){1.f, 0.f}; if (cc < c) sv[k] = *(const f32x2*)(SUMM + ((size_t)(b * 32 + cc) * DM + egch) * 2); }
            RgMap M{1.f, 0.f};
#pragma unroll
            for (int k = 0; k < 8; ++k) M = rg_then(M, RgMap{sv[k].x, sv[k].y});
            const RgMap P{__shfl_xor(M.A, 16), __shfl_xor(M.H, 16)}; const RgMap pr = (q & 1) ? rg_then(P, M) : rg_then(M, P);
            const RgMap Q{__shfl_xor(pr.A, 32), __shfl_xor(pr.H, 32)}; const RgMap T = (q & 2) ? rg_then(Q, pr) : rg_then(pr, Q);
            S = T.H; }
#pragma unroll 1
        for (int sub = 0; sub < 256 / RG_SUB; ++sub) {
            const size_t t0 = tbase + sub * RG_SUB;
            LAS unsigned char* GT = L + RG_GGT + (sub & 1) * 16384; LAS unsigned char* OT = L + RG_OUT + (sub & 1) * 8192;
            *(LAS u32x4*)(GT + crow * 256 + c8 * 2) = gn[0]; *(LAS u32x4*)(GT + (crow + 32) * 256 + c8 * 2) = gn[1];
            u32x4 abc[4];
#pragma unroll
            for (int rb = 0; rb < 4; ++rb) abc[rb] = ab[rb];
            __syncthreads();
            if (sub + 1 < 256 / RG_SUB) {
                gn[0] = *(const u32x4*)(GG + (t0 + RG_SUB + crow) * DM + cg); gn[1] = *(const u32x4*)(GG + (t0 + RG_SUB + crow + 32) * DM + cg);
#pragma unroll
                for (int rb = 0; rb < 4; ++rb) ab[rb] = abr[(sub + 1) * 2048 + rb]; }
#pragma unroll
            for (int rb = 0; rb < 4; ++rb) {
                float av[4], bv[4];
#pragma unroll
                for (int r = 0; r < 4; ++r) { const unsigned pk = abc[rb][r]; av[r] = __builtin_amdgcn_exp2f(rg_h_lo(pk)); bv[r] = rg_h_hi(pk); }
                RgMap G{1.f, 0.f};
#pragma unroll
                for (int r = 0; r < 4; ++r) { G.H = av[r] * G.H + bv[r]; G.A *= av[r]; }
                const RgMap P{__shfl_xor(G.A, 16), __shfl_xor(G.H, 16)};
                const RgMap pr = (q & 1) ? rg_then(P, G) : rg_then(G, P);
                const RgMap Q{__shfl_xor(pr.A, 32), __shfl_xor(pr.H, 32)};
                const RgMap T = (q & 2) ? rg_then(Q, pr) : rg_then(pr, Q);
                RgMap E{1.f, 0.f}; if (q & 2) E = Q; if (q & 1) E = rg_then(E, P);
                float h = E.A * S + E.H; float y[4];
#pragma unroll
                for (int r = 0; r < 4; ++r) { const int trow = rb * 16 + 4 * q + r; h = av[r] * h + bv[r]; y[r] = h * bf1(*(const LAS bf16*)(GT + trow * 256 + ech * 2)) * SC_RA; }
                const unsigned w = pk4_f8(y[0], y[1], y[2], y[3]); const int tr0 = rb * 16 + 4 * q;
                OT[tr0 * 128 + ech] = (unsigned char)w; OT[(tr0 + 1) * 128 + ech] = (unsigned char)(w >> 8); OT[(tr0 + 2) * 128 + ech] = (unsigned char)(w >> 16); OT[(tr0 + 3) * 128 + ech] = (unsigned char)(w >> 24);
                S = T.A * S + T.H;
            }
            __syncthreads();
            { const int r = tid >> 3, cq = (tid & 7) * 16; *(u32x4*)(RA + (t0 + r) * DM + hh * 128 + cq) = *(const LAS u32x4*)(OT + r * 128 + cq); }
        }
    }
    __syncthreads();
}

__device__ __forceinline__ void krope_fill(Frame& F) {
    const int fl = fresh_lane(); const int gw = F.blk * NWAVES + F.wave, NGW = F.G * NWAVES, j4 = (fl & 7) * 4, tsub = fl >> 3;
    const float* KR = WSP(float, WS_KR); const f32x2* rope = WSP(f32x2, WS_ROPE); unsigned char* K = (unsigned char*)F.out + OUT_K;
    for (int tp = gw; tp < NT / 8; tp += NGW) { const int t = 8 * tp + tsub, b = t >> 13, s = t & 8191;
        const f32x4 x1 = *(const f32x4*)(KR + (size_t)t * 64 + j4), x2 = *(const f32x4*)(KR + (size_t)t * 64 + 32 + j4);
        const f32x4 c01 = *(const f32x4*)(rope + (size_t)t * 32 + j4), c23 = *(const f32x4*)(rope + (size_t)t * 32 + j4 + 2);
        const u32x2 w = {pk4_f8((x1.x * c01.x - x2.x * c01.y) * SC_K, (x2.x * c01.x + x1.x * c01.y) * SC_K, (x1.y * c01.z - x2.y * c01.w) * SC_K, (x2.y * c01.z + x1.y * c01.w) * SC_K),
                         pk4_f8((x1.z * c23.x - x2.z * c23.y) * SC_K, (x2.z * c23.x + x1.z * c23.y) * SC_K, (x1.w * c23.z - x2.w * c23.w) * SC_K, (x2.w * c23.z + x1.w * c23.w) * SC_K)};
#pragma unroll
        for (int h = 0; h < NH; ++h) *(u32x2*)(K + ((size_t)(b * NH + h) * SEQ + s) * DQK + 128 + 2 * j4) = w; }
}

constexpr int AT_KB = 12288, AT_VB = 8192, AT_BUF = AT_KB + AT_VB;
#define AT_LD8(p0_, p1_) __builtin_shufflevector(*(const LAS i32x4*)(p0_), *(const LAS i32x4*)(p1_), 0, 1, 2, 3, 4, 5, 6, 7)
constexpr int AT_SLOT = AT_KB + AT_VB, AT_NSLOT = 5;
struct AttnState { f32x16 o[4], p0, p1; f32x4 osum; i32x8 pb; float m_run; };
#define AT_MFMA(A_, B_, C_) __builtin_amdgcn_mfma_scale_f32_32x32x64_f8f6f4(A_, B_, C_, 0, 0, 0, 0x7F7F7F7F, 0, 0x7F7F7F7F)
#define AT_PIN() __builtin_amdgcn_sched_barrier(0)
template <bool FAST>
__device__ __forceinline__ void attn_iter(AttnState& S, const i32x8 (&qf)[3], const LAS unsigned char* Vprev, const LAS unsigned char* Knext, int xo0, int xo1, int r32, int hi,
                                          bool act_prev, bool act_cur, bool act_next, bool need_mask, int dq) {
    constexpr float CS = 1.0f / (SC_Q * SC_K), LSP = 6.0f;
    const f32x16 z16 = {0.f, 0.f, 0.f, 0.f, 0.f, 0.f, 0.f, 0.f, 0.f, 0.f, 0.f, 0.f, 0.f, 0.f, 0.f, 0.f};
    const int sel = (((r32 & 15) >> 2) & 1) == ((hi * 2 + (r32 >> 4)) & 1) ? 0x38383838 : 0;
    const i32x8 ones8 = {sel, sel, sel, sel, sel, sel, sel, sel};
#define AT_ROWSUM(PB_, ACC_) __builtin_amdgcn_mfma_scale_f32_16x16x128_f8f6f4(ones8, PB_, ACC_, 0, 0, 0, 0x7F7F7F7F, 0, 0x7F7F7F7F)
    float pmax = -__builtin_inff();
    if (FAST) {
        const LAS unsigned char* vb = Vprev + r32 * 64;
        const i32x8 v0 = AT_LD8(vb + xo0, vb + xo1), v1 = AT_LD8(vb + 2048 + xo0, vb + 2048 + xo1);
        S.osum = AT_ROWSUM(S.pb, S.osum);
        AT_PIN(); pmax = fmaxf(fmaxf(S.p0[0], S.p0[1]), fmaxf(S.p0[2], S.p0[3])); pmax = fmaxf(pmax, fmaxf(fmaxf(S.p0[4], S.p0[5]), fmaxf(S.p0[6], S.p0[7]))); AT_PIN();
        S.o[0] = AT_MFMA(v0, S.pb, S.o[0]);
        const i32x8 v2 = AT_LD8(vb + 4096 + xo0, vb + 4096 + xo1);
        AT_PIN(); pmax = fmaxf(pmax, fmaxf(fmaxf(S.p0[8], S.p0[9]), fmaxf(S.p0[10], S.p0[11]))); pmax = fmaxf(pmax, fmaxf(fmaxf(S.p0[12], S.p0[13]), fmaxf(S.p0[14], S.p0[15]))); AT_PIN();
        S.o[1] = AT_MFMA(v1, S.pb, S.o[1]);
        const i32x8 v3 = AT_LD8(vb + 6144 + xo0, vb + 6144 + xo1);
        AT_PIN(); pmax = fmaxf(pmax, fmaxf(fmaxf(S.p1[0], S.p1[1]), fmaxf(S.p1[2], S.p1[3]))); pmax = fmaxf(pmax, fmaxf(fmaxf(S.p1[4], S.p1[5]), fmaxf(S.p1[6], S.p1[7]))); AT_PIN();
        S.o[2] = AT_MFMA(v2, S.pb, S.o[2]);
        AT_PIN(); pmax = fmaxf(pmax, fmaxf(fmaxf(S.p1[8], S.p1[9]), fmaxf(S.p1[10], S.p1[11]))); pmax = fmaxf(pmax, fmaxf(fmaxf(S.p1[12], S.p1[13]), fmaxf(S.p1[14], S.p1[15]))); AT_PIN();
        S.o[3] = AT_MFMA(v3, S.pb, S.o[3]);
    } else if (act_prev) {
        const LAS unsigned char* vb = Vprev + r32 * 64;
        S.osum = AT_ROWSUM(S.pb, S.osum);
#pragma unroll
        for (int d = 0; d < 4; ++d) { const i32x8 vf = AT_LD8(vb + d * 2048 + xo0, vb + d * 2048 + xo1); S.o[d] = AT_MFMA(vf, S.pb, S.o[d]); AT_PIN(); }
    }
    if (!FAST) {
        if (act_cur) {
            if (need_mask) { const float NEG = -__builtin_inff();
#pragma unroll
                for (int r = 0; r < 16; ++r) { const int cr = (r & 3) + 8 * (r >> 2); if (cr > dq) S.p0[r] = NEG; if (cr + 32 > dq) S.p1[r] = NEG; } }
#pragma unroll
            for (int r = 0; r < 16; ++r) pmax = fmaxf(pmax, fmaxf(S.p0[r], S.p1[r]));
        }
    }
    float alpha = 1.f; bool resc = false; f32x16 n0 = z16, n1 = z16;
    if (FAST || act_cur) {
        { auto rr = __builtin_amdgcn_permlane32_swap(__float_as_uint(pmax), __float_as_uint(pmax), false, false); pmax = fmaxf(__uint_as_float(rr[0]), __uint_as_float(rr[1])) * CS; }
        resc = !__all(pmax - S.m_run <= 2.0f);
        const float mn = resc ? fmaxf(S.m_run, pmax) : S.m_run; alpha = __builtin_amdgcn_exp2f(S.m_run - mn); S.m_run = mn;
    }
    const float moff = LSP - S.m_run;
    const LAS unsigned char* kb = Knext + r32 * 192;
    if (FAST) {
        i32x8 ka = AT_LD8(kb + xo0, kb + xo1), kc = AT_LD8(kb + 32 * 192 + xo0, kb + 32 * 192 + xo1);
#pragma unroll
        for (int ks = 0; ks < 3; ++ks) {
            n0 = AT_MFMA(ka, qf[ks], ks == 0 ? z16 : n0); n1 = AT_MFMA(kc, qf[ks], ks == 0 ? z16 : n1);
            if (ks < 2) { ka = AT_LD8(kb + (ks + 1) * 64 + xo0, kb + (ks + 1) * 64 + xo1); kc = AT_LD8(kb + 32 * 192 + (ks + 1) * 64 + xo0, kb + 32 * 192 + (ks + 1) * 64 + xo1); }
            AT_PIN();
#pragma unroll
            for (int r = (ks * 16) / 3; r < ((ks + 1) * 16) / 3; ++r) { S.p0[r] = __builtin_amdgcn_exp2f(__builtin_fmaf(S.p0[r], CS, moff)); S.p1[r] = __builtin_amdgcn_exp2f(__builtin_fmaf(S.p1[r], CS, moff)); }
            AT_PIN();
        }
    } else {
        if (act_next) {
#pragma unroll
            for (int ks = 0; ks < 3; ++ks) { const i32x8 ka = AT_LD8(kb + ks * 64 + xo0, kb + ks * 64 + xo1), kc = AT_LD8(kb + 32 * 192 + ks * 64 + xo0, kb + 32 * 192 + ks * 64 + xo1);
                n0 = AT_MFMA(ka, qf[ks], ks == 0 ? z16 : n0); n1 = AT_MFMA(kc, qf[ks], ks == 0 ? z16 : n1); } }
        if (act_cur) {
#pragma unroll
            for (int r = 0; r < 16; ++r) { S.p0[r] = __builtin_amdgcn_exp2f(__builtin_fmaf(S.p0[r], CS, moff)); S.p1[r] = __builtin_amdgcn_exp2f(__builtin_fmaf(S.p1[r], CS, moff)); } }
    }
    if (FAST || act_cur) {
#pragma unroll
        for (int jj = 0; jj < 4; ++jj) { int a = __builtin_amdgcn_cvt_pk_fp8_f32(S.p0[4 * jj], S.p0[4 * jj + 1], 0, false); a = __builtin_amdgcn_cvt_pk_fp8_f32(S.p0[4 * jj + 2], S.p0[4 * jj + 3], a, true);
            int bq = __builtin_amdgcn_cvt_pk_fp8_f32(S.p1[4 * jj], S.p1[4 * jj + 1], 0, false); bq = __builtin_amdgcn_cvt_pk_fp8_f32(S.p1[4 * jj + 2], S.p1[4 * jj + 3], bq, true);
            auto rr = __builtin_amdgcn_permlane32_swap((unsigned)a, (unsigned)bq, false, false); S.pb[2 * jj] = (int)rr[0]; S.pb[2 * jj + 1] = (int)rr[1]; }
        if (resc) {
#pragma unroll
            for (int d = 0; d < 4; ++d)
#pragma unroll
                for (int r = 0; r < 16; ++r) S.o[d][r] *= alpha;
            S.osum = S.osum * alpha;
        }
    }
    S.p0 = n0; S.p1 = n1;
#undef AT_ROWSUM
}
__device__ __forceinline__ void attn_block(Frame& F, int bh, int qb, const unsigned char* Q, const unsigned char* Kg, const unsigned char* VTg, unsigned char* AO) {
    const int lane = F.lane, wave = F.wave, r32 = lane & 31, hi = lane >> 5;
    LAS unsigned char* L = F.lds; const unsigned ldsbase = (unsigned)(size_t)L;
    const int q0 = qb * 256, qrow = q0 + 32 * wave + r32, ntiles = 4 * (qb + 1);
    unsigned kv0, kv1, vv;
    { const int q = wave * 64 + lane, row = q / 12, pos = q % 12, c = (pos & ~3) | ((pos ^ (row >> 2)) & 3); kv0 = (unsigned)((row * 12 + c) * 16); }
    { const int q = (wave + 8) * 64 + lane, row = q / 12, pos = q % 12, c = (pos & ~3) | ((pos ^ (row >> 2)) & 3); kv1 = (unsigned)((row * 12 + c) * 16); }
    { const int q = wave * 64 + lane, row = q >> 2, pos = q & 3, c = pos ^ ((row >> 2) & 3); vv = (unsigned)((row * 4 + c) * 16); }
    const bool k2 = wave < 4;
    const char* kgb = (const char*)Kg + (size_t)bh * SEQ * DQK; const char* vgb = (const char*)VTg + (size_t)bh * SEQ * DV;
#define AT_ISSUE(tile, slot) do { const int _t = (tile) < ntiles ? (tile) : ntiles - 1; const unsigned _s = ldsbase + (slot) * AT_SLOT; \
        glds16(kgb + (size_t)_t * AT_KB, kv0, _s + wave * 1024); if (k2) glds16(kgb + (size_t)_t * AT_KB, kv1, _s + (wave + 8) * 1024); \
        glds16(vgb + (size_t)_t * AT_VB, vv, _s + AT_KB + wave * 1024); } while (0)
    AT_ISSUE(0, 0); AT_ISSUE(1, 1); AT_ISSUE(2, 2);
    i32x8 qf[3];
    { const unsigned char* qp = Q + ((size_t)bh * SEQ + qrow) * DQK + 32 * hi;
#pragma unroll
        for (int ks = 0; ks < 3; ++ks) { const i32x4 lo = *(const i32x4*)(qp + 64 * ks), hh = *(const i32x4*)(qp + 64 * ks + 16); qf[ks] = __builtin_shufflevector(lo, hh, 0, 1, 2, 3, 4, 5, 6, 7); } }
    asm volatile("s_waitcnt vmcnt(0)" ::: "memory");
    const f32x16 z16 = {0.f, 0.f, 0.f, 0.f, 0.f, 0.f, 0.f, 0.f, 0.f, 0.f, 0.f, 0.f, 0.f, 0.f, 0.f, 0.f};
    AttnState S; S.o[0] = z16; S.o[1] = z16; S.o[2] = z16; S.o[3] = z16; S.osum = (f32x4){0.f, 0.f, 0.f, 0.f}; S.p0 = z16; S.p1 = z16; S.m_run = -1e30f;
    S.pb = (i32x8){0, 0, 0, 0, 0, 0, 0, 0};
    const int swz = (r32 >> 2) & 3; const int xo0 = (((2 * hi) ^ swz) << 4), xo1 = (((2 * hi + 1) ^ swz) << 4);
    const int wfirst = q0 + 32 * wave, wlast = wfirst + 31;
    __syncthreads();
    { const LAS unsigned char* kb = L + r32 * 192;
#pragma unroll
        for (int ks = 0; ks < 3; ++ks) { const i32x8 ka = AT_LD8(kb + ks * 64 + xo0, kb + ks * 64 + xo1), kc = AT_LD8(kb + 32 * 192 + ks * 64 + xo0, kb + 32 * 192 + ks * 64 + xo1);
            S.p0 = AT_MFMA(ka, qf[ks], ks == 0 ? z16 : S.p0); S.p1 = AT_MFMA(kc, qf[ks], ks == 0 ? z16 : S.p1); } }
    const int nfast = 4 * qb;
#define AT_HEAD(j) if (k2) asm volatile("s_waitcnt vmcnt(3)" ::: "memory"); else asm volatile("s_waitcnt vmcnt(2)" ::: "memory"); \
        __syncthreads(); AT_ISSUE((j) + 3, ((j) + 3) % 5); \
        const LAS unsigned char* Vprev = L + (((j) + 4) % 5) * AT_SLOT + AT_KB; const LAS unsigned char* Knext = L + (((j) + 1) % 5) * AT_SLOT;
#define AT_SLOW(j) { const bool ap = (j) >= 1 && 64 * ((j) - 1) <= wlast, ac = (j) < ntiles && 64 * (j) <= wlast, an = (j) + 1 < ntiles && 64 * ((j) + 1) <= wlast; \
        attn_iter<false>(S, qf, Vprev, Knext, xo0, xo1, r32, hi, ap, ac, an, 64 * (j) + 63 > wfirst, qrow - 64 * (j) - 4 * hi); }
    int j = 0;
    { AT_HEAD(0); AT_SLOW(0); j = 1; }
#pragma unroll 1
    for (; j + 1 < nfast; ++j) { AT_HEAD(j); attn_iter<true>(S, qf, Vprev, Knext, xo0, xo1, r32, hi, true, true, true, false, 0); }
#pragma unroll 1
    for (; j <= ntiles; ++j) { AT_HEAD(j); AT_SLOW(j); }
#undef AT_HEAD
#undef AT_SLOW
#undef AT_ISSUE
    { int l2; asm volatile("v_mbcnt_lo_u32_b32 %0, -1, 0\n\tv_mbcnt_hi_u32_b32 %0, -1, %0" : "=v"(l2));
      const float inv = SC_AO / (SC_V * S.osum[0]); unsigned char* op = AO + ((size_t)(bh >> 4) * SEQ + qb * 256 + 32 * wave + (l2 & 31)) * DM + (bh & 15) * 128 + 4 * (l2 >> 5);
#pragma unroll
        for (int d = 0; d < 4; ++d)
#pragma unroll
            for (int g = 0; g < 4; ++g) *(unsigned*)(op + 32 * d + 8 * g) = pk4_f8(S.o[d][4 * g] * inv, S.o[d][4 * g + 1] * inv, S.o[d][4 * g + 2] * inv, S.o[d][4 * g + 3] * inv); }
    asm volatile("s_waitcnt vmcnt(0)" ::: "memory");
    __syncthreads();
}
#undef AT_MFMA
#undef AT_PIN
__device__ __forceinline__ void attn_phase(Frame& F) {
    const unsigned char* Q = (const unsigned char*)F.out + OUT_Q; const unsigned char* Kg = (const unsigned char*)F.out + OUT_K; const unsigned char* VTg = (const unsigned char*)F.out + OUT_VT; unsigned char* AO = WSP(unsigned char, WS_AO8);
    for (int it = F.blk; it < 1024; it += F.G) {
        const int r = it / F.G;
        int bh, y;
        if (F.G == 256) { const int x = F.blk & 7, loc = F.blk >> 3; bh = x * 8 + r * 2 + (loc >> 4); y = loc & 15; }
        else { bh = it >> 4; y = it & 15; }
        attn_block(F, bh, 31 - y, Q, Kg, VTg, AO);
        attn_block(F, bh, y, Q, Kg, VTg, AO);
    }
}

__device__ __forceinline__ void ln1_phase(Frame& F) {
    const int gw = F.blk * NWAVES + F.wave, NGW = F.G * NWAVES, lane = fresh_lane();
    bf16* R1 = WSP(bf16, WS_R1); unsigned char* H2I = WSP(unsigned char, WS_H2I); float* HSC = WSP(float, WS_HSC); const float* mod = WSP(float, WS_MOD);
    for (int m = gw; m < NT; m += NGW) {
        u32x4* rp = (u32x4*)(R1 + (size_t)m * DM) + lane; f32x4 v[8]; float s = 0.f;
#pragma unroll
        for (int j = 0; j < 4; ++j) { const u32x4 w = rp[64 * j]; v[2 * j] = (f32x4){bflo(w.x), bfhi(w.x), bflo(w.y), bfhi(w.y)}; v[2 * j + 1] = (f32x4){bflo(w.z), bfhi(w.z), bflo(w.w), bfhi(w.w)};
            s += ((v[2 * j].x + v[2 * j].y) + (v[2 * j].z + v[2 * j].w)) + ((v[2 * j + 1].x + v[2 * j + 1].y) + (v[2 * j + 1].z + v[2 * j + 1].w)); }
        const float mean = wave_sum(s) * (1.f / DM); float s2 = 0.f;
#pragma unroll
        for (int j = 0; j < 8; ++j) { v[j] = v[j] - mean; s2 += (v[j].x * v[j].x + v[j].y * v[j].y) + (v[j].z * v[j].z + v[j].w * v[j].w); }
        const float rstd = __builtin_amdgcn_rsqf(wave_sum(s2) * (1.f / DM) + LN_EPS);
        const int b = m >> 13; const float* sh2 = mod + b * 12288 + 6144; const float* sc2 = mod + b * 12288 + 8192;
        float amax = 0.f;
#pragma unroll
        for (int j = 0; j < 4; ++j) { const int col = 512 * j + 8 * lane; f32x4 y[2];
#pragma unroll
            for (int q = 0; q < 2; ++q) { const f32x4 g = *(const f32x4*)(F.ln1_g + col + 4 * q), bb = *(const f32x4*)(F.ln1_b + col + 4 * q);
                y[q] = v[2 * j + q] * rstd * g + bb; v[2 * j + q] = y[q] * (1.f + *(const f32x4*)(sc2 + col + 4 * q)) + *(const f32x4*)(sh2 + col + 4 * q);
                const f32x4 hh = v[2 * j + q]; amax = fmaxf(amax, fmaxf(fmaxf(fabsf(hh.x), fabsf(hh.y)), fmaxf(fabsf(hh.z), fabsf(hh.w)))); }
            rp[64 * j] = pack8(y[0], y[1]); }
        amax = fmaxf(wave_max(amax), 1e-20f); const float qs = 127.0f / amax;
        if (lane == 0) HSC[m] = amax * (1.0f / 127.0f);
#pragma unroll
        for (int j = 0; j < 4; ++j) { const f32x4 a = v[2 * j] * qs, c = v[2 * j + 1] * qs;
            *(u32x2*)(H2I + (size_t)m * DM + 512 * j + 8 * lane) = (u32x2){pk4_i8(a.x, a.y, a.z, a.w), pk4_i8(c.x, c.y, c.z, c.w)}; }
    }
    { unsigned char* pu = WSP(unsigned char, WS_PU); float* usc = WSP(float, WS_USC);
        for (int e = gw; e < 16384; e += NGW) { f32x4 r[8]; float amax = 0.f;
#pragma unroll
            for (int j = 0; j < 4; ++j) { r[2 * j] = *(const f32x4*)(F.peer_u + (size_t)e * DM + 512 * j + 8 * lane); r[2 * j + 1] = *(const f32x4*)(F.peer_u + (size_t)e * DM + 512 * j + 8 * lane + 4); }
#pragma unroll
            for (int j = 0; j < 8; ++j) amax = fmaxf(amax, fmaxf(fmaxf(fabsf(r[j].x), fabsf(r[j].y)), fmaxf(fabsf(r[j].z), fabsf(r[j].w))));
            amax = fmaxf(wave_max(amax), 1e-30f); const float qs = 127.0f / amax;
            if (lane == 0) usc[e] = amax * (1.0f / 127.0f);
#pragma unroll
            for (int j = 0; j < 4; ++j) { const f32x4 a = r[2 * j] * qs, c = r[2 * j + 1] * qs;
                *(u32x2*)(pu + (size_t)(4 * j + (lane >> 4)) * 2097152 + (size_t)e * 128 + 8 * (lane & 15)) = (u32x2){pk4_i8(a.x, a.y, a.z, a.w), pk4_i8(c.x, c.y, c.z, c.w)}; } } }
    { unsigned char* pv = WSP(unsigned char, WS_PV); float* vsc = WSP(float, WS_VSC);
        for (int e = gw; e < 16384; e += NGW) { f32x4 r[8]; float amax = 0.f;
#pragma unroll
            for (int j = 0; j < 4; ++j) { r[2 * j] = *(const f32x4*)(F.peer_v + (size_t)e * DM + 512 * j + 8 * lane); r[2 * j + 1] = *(const f32x4*)(F.peer_v + (size_t)e * DM + 512 * j + 8 * lane + 4); }
#pragma unroll
            for (int j = 0; j < 8; ++j) amax = fmaxf(amax, fmaxf(fmaxf(fabsf(r[j].x), fabsf(r[j].y)), fmaxf(fabsf(r[j].z), fabsf(r[j].w))));
            amax = fmaxf(wave_max(amax), 1e-30f); const float qs = 127.0f / amax;
            if (lane == 0) vsc[e] = amax * (1.0f / 127.0f);
#pragma unroll
            for (int j = 0; j < 4; ++j) { const f32x4 a = r[2 * j] * qs, c = r[2 * j + 1] * qs;
                *(u32x2*)(pv + (size_t)(4 * j + (lane >> 4)) * 2097152 + (size_t)e * 128 + 8 * (lane & 15)) = (u32x2){pk4_i8(a.x, a.y, a.z, a.w), pk4_i8(c.x, c.y, c.z, c.w)}; } } }
}

constexpr int PK_KW = 288, PK_KEYS = 0, PK_SF = 2 * 128 * PK_KW  , PK_SI = PK_SF + 64 * 2 * 16 * 4, PK_TAB = PK_SI + 64 * 2 * 16 * 4;
__device__ __forceinline__ unsigned ord_key(float s) { unsigned u = __float_as_uint(s); return u ^ ((u >> 31) ? 0xffffffffu : 0x80000000u); }
__device__ __forceinline__ float ord_inv(unsigned k) { return __uint_as_float((k >> 31) ? (k ^ 0x80000000u) : ~k); }
#define PK_CE(a_, b_) do { const unsigned _h = (a_) > (b_) ? (a_) : (b_), _l = (a_) > (b_) ? (b_) : (a_); (a_) = _h; (b_) = _l; } while (0)
__device__ __forceinline__ void sort16_desc(unsigned (&v)[16]) {
#pragma unroll
    for (int k = 2; k <= 16; k <<= 1)
#pragma unroll
        for (int j = k >> 1; j > 0; j >>= 1)
#pragma unroll
            for (int i = 0; i < 16; ++i) { const int l = i ^ j; if (l > i) { if ((i & k) == 0) PK_CE(v[i], v[l]); else PK_CE(v[l], v[i]); } }
}
__device__ __forceinline__ void merge16_desc(unsigned (&v)[16]) {
#pragma unroll
    for (int j = 8; j > 0; j >>= 1)
#pragma unroll
        for (int i = 0; i < 16; ++i) { const int l = i ^ j; if (l > i) PK_CE(v[i], v[l]); }
}
__device__ __forceinline__ void top16_with_partner(unsigned (&v)[16], int mask) {
    unsigned o[16];
#pragma unroll
    for (int i = 0; i < 16; ++i) o[i] = (unsigned)__shfl_xor((int)v[i], mask);
#pragma unroll
    for (int i = 0; i < 16; ++i) v[i] = v[i] > o[15 - i] ? v[i] : o[15 - i];
    merge16_desc(v);
}
__device__ __forceinline__ void peer_score_phase(Frame& F) {
    const int tid = F.tid, lane = F.lane, wave = F.wave;
    LAS unsigned char* L = F.lds;
    const bf16* PQ = WSP(bf16, WS_PQ); int* IDX = WSP(int, WS_IDX); float* GATE = WSP(float, WS_GATE);
    { const u32x4* kg = WSP(u32x4, WS_PKEYS);
#pragma unroll
        for (int i = 0; i < 8; ++i) { const int id = tid + NTHREADS * i, r = id >> 4, ch = id & 15; *(LAS u32x4*)(L + PK_KEYS + r * PK_KW + ch * 16) = kg[id]; } }
    if (tid == 0) { int n = 0; for (int i = 0; i < 16; ++i) for (int j = 0; j < 16; ++j) if ((i + 1) * (j + 1) <= 16) L[PK_TAB + n++] = (unsigned char)(i * 16 + j); for (; n < 64; ++n) L[PK_TAB + n] = 0xff; }
    __syncthreads();
    LAS float* SF = (LAS float*)(L + PK_SF); LAS int* SI = (LAS int*)(L + PK_SI);
    for (int tile = F.blk; tile < NT * PEER_H / 64; tile += F.G) {
        const int R0 = tile * 64;
        { const int p = wave >> 2, rb = (wave & 3) * 16, c = lane & 15, fq = lane >> 4; const bf16* qp = PQ + (size_t)(R0 + rb + c) * 256 + p * 128 + 8 * fq;
            bf16x8 qfr[4];
#pragma unroll
            for (int ks = 0; ks < 4; ++ks) qfr[ks] = *(const bf16x8*)(qp + 32 * ks);
            unsigned lo[16], hi[16];
#pragma unroll
            for (int nb = 0; nb < 8; ++nb) { f32x4 acc = {0, 0, 0, 0};
#pragma unroll
                for (int ks = 0; ks < 4; ++ks) { const bf16x8 kfr = *(const LAS bf16x8*)(L + PK_KEYS + (p * 128 + nb * 16 + c) * PK_KW + (ks * 32 + 8 * fq) * 2);
                    acc = __builtin_amdgcn_mfma_f32_16x16x32_bf16(kfr, qfr[ks], acc, 0, 0, 0); }
#pragma unroll
                for (int r = 0; r < 4; ++r) { const unsigned key = (ord_key(acc[r]) & ~127u) | (unsigned)(127 - (16 * nb + 4 * fq + r));
                    if (nb < 4) lo[nb * 4 + r] = key; else hi[(nb - 4) * 4 + r] = key; } }
            sort16_desc(lo); sort16_desc(hi);
#pragma unroll
            for (int i = 0; i < 16; ++i) lo[i] = lo[i] > hi[15 - i] ? lo[i] : hi[15 - i];
            merge16_desc(lo);
            top16_with_partner(lo, 16); top16_with_partner(lo, 32);
            if (fq == 0) { LAS float* sf = SF + ((rb + c) * 2 + p) * 16; LAS int* si = SI + ((rb + c) * 2 + p) * 16;
#pragma unroll
                for (int i = 0; i < 16; ++i) { sf[i] = ord_inv(lo[i] & ~127u); si[i] = 127 - (int)(lo[i] & 127u); } } }
        __syncthreads();
        if (tid < 256) { const int R = tid >> 2, c = tid & 3; const LAS float* a = SF + (R * 2) * 16; const LAS float* bq = a + 16;
            unsigned v[16];
#pragma unroll
            for (int m = 0; m < 16; ++m) { v[m] = 0u; if (m < 13) { const unsigned pr = L[PK_TAB + c + 4 * m]; if (pr != 0xffu) v[m] = (ord_key(a[pr >> 4] + bq[pr & 15]) & ~255u) | (255u - pr); } }
            sort16_desc(v); top16_with_partner(v, 1); top16_with_partner(v, 2);
            unsigned w0 = c == 0 ? v[0] : (c == 1 ? v[4] : (c == 2 ? v[8] : v[12])), w1 = c == 0 ? v[1] : (c == 1 ? v[5] : (c == 2 ? v[9] : v[13]));
            unsigned w2 = c == 0 ? v[2] : (c == 1 ? v[6] : (c == 2 ? v[10] : v[14])), w3 = c == 0 ? v[3] : (c == 1 ? v[7] : (c == 2 ? v[11] : v[15]));
            const unsigned pm = 255u - (v[0] & 255u); const float smax = a[pm >> 4] + bq[pm & 15];
            const LAS int* ia = SI + (R * 2) * 16; const LAS int* ib = ia + 16;
            const unsigned p0 = 255u - (w0 & 255u), p1 = 255u - (w1 & 255u), p2 = 255u - (w2 & 255u), p3 = 255u - (w3 & 255u);
            f32x4 e = {__expf(a[p0 >> 4] + bq[p0 & 15] - smax), __expf(a[p1 >> 4] + bq[p1 & 15] - smax), __expf(a[p2 >> 4] + bq[p2 & 15] - smax), __expf(a[p3 >> 4] + bq[p3 & 15] - smax)};
            float sum = (e.x + e.y) + (e.z + e.w); sum += __shfl_xor(sum, 1); sum += __shfl_xor(sum, 2);
            const float inv = 1.0f / sum; const size_t ob = (size_t)(R0 + R) * 16 + 4 * c;
            *(f32x4*)(GATE + ob) = e * inv;
            *(int4*)(IDX + ob) = make_int4(ia[p0 >> 4] * NKEYS + ib[p0 & 15], ia[p1 >> 4] * NKEYS + ib[p1 & 15], ia[p2 >> 4] * NKEYS + ib[p2 & 15], ia[p3 >> 4] * NKEYS + ib[p3 & 15]); }
        __syncthreads();
    }
}
#undef PK_CE

__device__ __forceinline__ void ln2_rows(Frame& F, int m0, int nrows) {
    int lane; asm volatile("v_mbcnt_lo_u32_b32 %0, -1, 0\n\tv_mbcnt_hi_u32_b32 %0, -1, %0" : "=v"(lane));
    const bf16* X1 = WSP(bf16, WS_R1); const float* mod = WSP(float, WS_MOD); const bf16* Y = WSP(bf16, WS_TMP);
    f32x4 g1[8];
    { const f32x4* gt2 = (const f32x4*)(mod + (m0 >> 13) * 12288 + 10240) + lane;
#pragma unroll
        for (int j = 0; j < 8; ++j) g1[j] = 1.f + gt2[64 * j]; }
    u32x2 yn[8], xn[8];
    { const u32x2* yb = (const u32x2*)(Y + (size_t)m0 * DM) + lane; const u32x2* xb = (const u32x2*)(X1 + (size_t)m0 * DM) + lane;
#pragma unroll
        for (int j = 0; j < 8; ++j) { yn[j] = yb[64 * j]; xn[j] = xb[64 * j]; } }
#pragma unroll 1
    for (int m = m0; m < m0 + nrows; ++m) {
        f32x4* yp = (f32x4*)(F.out + (size_t)m * DM) + lane;
        f32x4 v[8]; float s = 0.f;
#pragma unroll
        for (int j = 0; j < 8; ++j) { const u32x2 yw = yn[j], xw = xn[j]; const f32x4 y = {bflo(yw.x), bfhi(yw.x), bflo(yw.y), bfhi(yw.y)}, x = {bflo(xw.x), bfhi(xw.x), bflo(xw.y), bfhi(xw.y)};
            v[j] = DN_ALPHA * x + g1[j] * y; s += (v[j].x + v[j].y) + (v[j].z + v[j].w); }
        { const int mn = m + 1 < m0 + nrows ? m + 1 : m; const u32x2* yb = (const u32x2*)(Y + (size_t)mn * DM) + lane; const u32x2* xb = (const u32x2*)(X1 + (size_t)mn * DM) + lane;
#pragma unroll
            for (int j = 0; j < 8; ++j) { yn[j] = yb[64 * j]; xn[j] = xb[64 * j]; } }
        const float mean = wave_sum(s) * (1.f / DM); float s2 = 0.f;
#pragma unroll
        for (int j = 0; j < 8; ++j) { v[j] = v[j] - mean; s2 += (v[j].x * v[j].x + v[j].y * v[j].y) + (v[j].z * v[j].z + v[j].w * v[j].w); }
        const float rstd = __builtin_amdgcn_rsqf(wave_sum(s2) * (1.f / DM) + LN_EPS);
#pragma unroll
        for (int j = 0; j < 8; ++j) yp[64 * j] = v[j] * rstd * *((const f32x4*)F.ln2_g + 64 * j + lane) + *((const f32x4*)F.ln2_b + 64 * j + lane);
    }
}
constexpr int PE_WAVE_LDS = 16384;
template <int N, int M> __device__ __forceinline__ void xreduce_step(float (&v)[M], bool bit, int mask) {
#pragma unroll
    for (int i = 0; i < N / 2; ++i) { const float keep = bit ? v[i + N / 2] : v[i], send = bit ? v[i] : v[i + N / 2]; v[i] = keep + __shfl_xor(send, mask); }
}
template <int N, int M> __device__ __forceinline__ void xreduce_step_i(int (&v)[M], bool bit, int mask) {
#pragma unroll
    for (int i = 0; i < N / 2; ++i) { const int keep = bit ? v[i + N / 2] : v[i], send = bit ? v[i] : v[i + N / 2]; v[i] = keep + __shfl_xor(send, mask); }
}
__device__ __forceinline__ void peer_eval_phase(Frame& F) {
    const int lane = F.lane, g = lane >> 3, c16 = lane & 7;
    const unsigned char* H2I = WSP(unsigned char, WS_H2I); const float* HSC = WSP(float, WS_HSC); const float* USC = WSP(float, WS_USC); const float* VSC = WSP(float, WS_VSC); const int* IDX = WSP(int, WS_IDX); const float* GATE = WSP(float, WS_GATE);
    const unsigned char* PU = WSP(unsigned char, WS_PU); const unsigned char* PV = WSP(unsigned char, WS_PV); bf16* Y = WSP(bf16, WS_TMP);
    LAS int* idxL = (LAS int*)(F.lds + F.wave * PE_WAVE_LDS); LAS float* DL = (LAS float*)(F.lds + F.wave * PE_WAVE_LDS + 8192);
    for (int tb = F.blk; tb < NT / 128; tb += F.G) {
        const int tok0 = tb * 128 + F.wave * 16;
#pragma unroll 4
        for (int tk = 0; tk < 16; ++tk) { const int e0 = lane, e1 = lane + 64; const int i0 = IDX[(size_t)(tok0 + tk) * 128 + e0], i1 = IDX[(size_t)(tok0 + tk) * 128 + e1];
            idxL[(tk * 8 + (e0 & 7)) * 16 + (e0 >> 3)] = i0 << 7; idxL[(tk * 8 + (e1 & 7)) * 16 + (e1 >> 3)] = i1 << 7; DL[tk * 128 + e0] = 0.f; DL[tk * 128 + e1] = 0.f; }
        LDS_WAIT();
        {
            auto issueU = [&](int st, u32x4 (&w)[16], i32x4& hq) { const int sl = st >> 4, tk = st & 15; const unsigned char* pu = PU + (size_t)sl * 2097152; const unsigned lo16 = 16u * c16;
                int ids[16];
#pragma unroll
                for (int q = 0; q < 4; ++q) { const i32x4 v = *(const LAS i32x4*)(idxL + (tk * 8 + g) * 16 + 4 * q); ids[4 * q] = v.x; ids[4 * q + 1] = v.y; ids[4 * q + 2] = v.z; ids[4 * q + 3] = v.w; }
                hq = *(const i32x4*)(H2I + (size_t)(tok0 + tk) * DM + 128 * sl + 16 * c16);
#pragma unroll
                for (int k = 0; k < 16; ++k) w[k] = *(const u32x4*)(pu + ((unsigned)ids[k] + lo16)); };
            auto computeU = [&](int st, const u32x4 (&w)[16], const i32x4 hq) { const int tk = st & 15;
                int pd[16];
#pragma unroll
                for (int k = 0; k < 16; ++k) { int di = __builtin_amdgcn_sdot4((int)w[k][0], hq.x, 0, false); di = __builtin_amdgcn_sdot4((int)w[k][1], hq.y, di, false);
                    di = __builtin_amdgcn_sdot4((int)w[k][2], hq.z, di, false); di = __builtin_amdgcn_sdot4((int)w[k][3], hq.w, di, false); pd[k] = di; }
                xreduce_step_i<16>(pd, c16 & 1, 1); xreduce_step_i<8>(pd, c16 & 2, 2); xreduce_step_i<4>(pd, c16 & 4, 4);
                const int k0 = 8 * (c16 & 1) + 4 * ((c16 >> 1) & 1) + 2 * (c16 >> 2);
                LAS int* dp = (LAS int*)DL + tk * 128 + g; dp[8 * k0] += pd[0]; dp[8 * (k0 + 1)] += pd[1]; };
            u32x4 wa[16], wb[16]; i32x4 ha, hb;
            issueU(0, wa, ha);
#pragma unroll 1
            for (int st = 0; st < 256; st += 2) {
                issueU(st + 1, wb, hb); computeU(st, wa, ha);
                issueU(st + 2 < 256 ? st + 2 : 255, wa, ha); computeU(st + 1, wb, hb);
            }
        }
        LDS_WAIT();
        { float a0[16], a1[16]; const int e0 = lane, e1 = lane + 64;
#pragma unroll
            for (int tk = 0; tk < 16; ++tk) { const float g0 = GATE[(size_t)(tok0 + tk) * 128 + e0], g1 = GATE[(size_t)(tok0 + tk) * 128 + e1]; const float hs = HSC[tok0 + tk];
                const int x0 = idxL[(tk * 8 + (e0 & 7)) * 16 + (e0 >> 3)], x1 = idxL[(tk * 8 + (e1 & 7)) * 16 + (e1 >> 3)];
                a0[tk] = gelu_tanh((float)((LAS int*)DL)[tk * 128 + e0] * (hs * USC[x0 >> 7])) * g0 * VSC[x0 >> 7]; a1[tk] = gelu_tanh((float)((LAS int*)DL)[tk * 128 + e1] * (hs * USC[x1 >> 7])) * g1 * VSC[x1 >> 7]; }
            LDS_WAIT();
            LAS unsigned char* AB = (LAS unsigned char*)DL; LAS float* AS = DL + 512;
#pragma unroll
            for (int tk = 0; tk < 16; ++tk) { const float amax = fmaxf(wave_max(fmaxf(fabsf(a0[tk]), fabsf(a1[tk]))), 1e-30f); const float qs = 127.0f / amax;
                const int q0 = (int)__builtin_rintf(a0[tk] * qs), q1 = (int)__builtin_rintf(a1[tk] * qs);
                AB[(tk * 8 + (e0 & 7)) * 16 + (e0 >> 3)] = (unsigned char)q0; AB[(tk * 8 + (e1 & 7)) * 16 + (e1 >> 3)] = (unsigned char)q1;
                if (lane == 0) AS[tk] = amax * (1.0f / 127.0f); } }
        LDS_WAIT();
        {
            auto issueV = [&](int st, u32x4 (&w)[16]) { const int sl = st >> 4, tk = st & 15; const unsigned char* pv = PV + (size_t)sl * 2097152; const unsigned lo16 = 16u * c16;
                int ids[16];
#pragma unroll
                for (int q = 0; q < 4; ++q) { const i32x4 v = *(const LAS i32x4*)(idxL + (tk * 8 + g) * 16 + 4 * q); ids[4 * q] = v.x; ids[4 * q + 1] = v.y; ids[4 * q + 2] = v.z; ids[4 * q + 3] = v.w; }
#pragma unroll
                for (int k = 0; k < 16; ++k) w[k] = *(const u32x4*)(pv + ((unsigned)ids[k] + lo16)); };
            auto computeV = [&](int st, const u32x4 (&w)[16]) { const int sl = st >> 4, tk = st & 15;
                const i32x4 a4 = *(const LAS i32x4*)((const LAS unsigned char*)DL + (tk * 8 + g) * 16);
                const float ascale = (DL + 512)[tk];
                int yi[16];
#pragma unroll
                for (int c = 0; c < 16; ++c) yi[c] = 0;
#pragma unroll
                for (int m = 0; m < 4; ++m) { const int am = m == 0 ? a4.x : (m == 1 ? a4.y : (m == 2 ? a4.z : a4.w));
#pragma unroll
                    for (int q = 0; q < 4; ++q) {
                        const unsigned w0 = w[4 * m][q], w1 = w[4 * m + 1][q], w2 = w[4 * m + 2][q], w3 = w[4 * m + 3][q];
                        const unsigned t0 = __builtin_amdgcn_perm(w1, w0, 0x05010400u), t1 = __builtin_amdgcn_perm(w1, w0, 0x07030602u), t2 = __builtin_amdgcn_perm(w3, w2, 0x05010400u), t3 = __builtin_amdgcn_perm(w3, w2, 0x07030602u);
                        yi[4 * q + 0] = __builtin_amdgcn_sdot4((int)__builtin_amdgcn_perm(t2, t0, 0x05040100u), am, yi[4 * q + 0], false);
                        yi[4 * q + 1] = __builtin_amdgcn_sdot4((int)__builtin_amdgcn_perm(t2, t0, 0x07060302u), am, yi[4 * q + 1], false);
                        yi[4 * q + 2] = __builtin_amdgcn_sdot4((int)__builtin_amdgcn_perm(t3, t1, 0x05040100u), am, yi[4 * q + 2], false);
                        yi[4 * q + 3] = __builtin_amdgcn_sdot4((int)__builtin_amdgcn_perm(t3, t1, 0x07060302u), am, yi[4 * q + 3], false); } }
                float cv[16];
#pragma unroll
                for (int c = 0; c < 16; ++c) cv[c] = (float)yi[c] * ascale;
                xreduce_step<16>(cv, g & 1, 8); xreduce_step<8>(cv, g & 2, 16); xreduce_step<4>(cv, g & 4, 32);
                const int c0 = 8 * (g & 1) + 4 * ((g >> 1) & 1) + 2 * (g >> 2);
                *(unsigned*)(Y + (size_t)(tok0 + tk) * DM + 128 * sl + 16 * c16 + c0) = pk2(cv[0], cv[1]); };
            u32x4 wa[16], wb[16];
            issueV(0, wa);
#pragma unroll 1
            for (int st = 0; st < 256; st += 2) {
                issueV(st + 1, wb); computeV(st, wa);
                issueV(st + 2 < 256 ? st + 2 : 255, wa); computeV(st + 1, wb);
            }
        }
        LDS_WAIT();
        VM_WAIT();
        ln2_rows(F, tok0, 16);
    }
}

constexpr int NPHASE = 12;
__global__ void __launch_bounds__(NTHREADS, 2) fwd_kernel(Args args) {
    extern __shared__ __attribute__((aligned(16))) unsigned char lds_raw[];
    Frame F;
    F.lds = (LAS unsigned char*)lds_raw; F.tid = threadIdx.x; F.lane = F.tid & 63; F.wave = __builtin_amdgcn_readfirstlane(F.tid >> 6); F.G = gridDim.x; F.blk = blockIdx.x;
    F.x = args.in[0]; F.c = args.in[1]; F.positions = (const int*)args.in[2]; F.w_ada = args.in[3]; F.b_ada = args.in[4]; F.w_in = args.in[5]; F.conv_w = args.in[6]; F.conv_b = args.in[7];
    F.w_rg_a = args.in[8]; F.b_rg_a = args.in[9]; F.w_rg_x = args.in[10]; F.b_rg_x = args.in[11]; F.rg_lambda = args.in[12]; F.w_rnn_out = args.in[13]; F.q_norm_g = args.in[14]; F.w_uq = args.in[15];
    F.kv_norm_g = args.in[16]; F.w_ukv = args.in[17]; F.w_mla_out = args.in[18]; F.w_o = args.in[19]; F.ln1_g = args.in[20]; F.ln1_b = args.in[21]; F.peer_wq = args.in[22]; F.peer_keys = args.in[23];
    F.peer_u = args.in[24]; F.peer_v = args.in[25]; F.ln2_g = args.in[26]; F.ln2_b = args.in[27]; F.out = args.out; F.ws = args.ws;
    volatile LAS unsigned* ctlw = (volatile LAS unsigned*)(F.lds + LDSCTL_OFF);
    if (F.tid < 128) ctlw[F.tid] = 0u;
    __syncthreads();
    const int lo = args.ph_lo, hi = args.ph_hi;
    const bool multi = (hi - lo) > 1;
#ifdef PROBE_RELAUNCH
    const int bslot = args.bslot;
#else
    constexpr int bslot = 0;
#endif
    XcdBarrier bar; bar.bar = (unsigned*)(F.ws + WS_CTL) + 4096 + 16384 * (bslot & 1); bar.x = 0; bar.st = nullptr;
    if (multi) bar = xcd_barrier_post((unsigned*)(F.ws + WS_CTL) + 4096 + 16384 * (bslot & 1), ctlw + 8);
#ifndef PHASE_MASK
#define PHASE_MASK 0xfff
#endif
#define IN(k) (((PHASE_MASK >> (k)) & 1) && lo <= (k) && (k) < hi)
#define SEAM(k) do { if (IN(k) && IN((k) + 1)) xcd_barrier(bar); } while (0)
#ifndef DBL_MASK
#define DBL_MASK 0
#endif
#define DBL(k, ...) do { if ((DBL_MASK >> (k)) & 1) { __VA_ARGS__; xcd_barrier(bar); } } while (0)
    const pg8::StaticOrder S0{};
    if (IN(0)) { DBL(0, p0_prologue(F, 1)); p0_prologue(F, bslot); SEAM(0); }
    if (IN(1)) { DBL(1, p1_modulate(F)); p1_modulate(F); SEAM(1); }
    if (IN(2)) {
        const pg8::Gemm g = pg8::gemm_f8(WSP(unsigned char, WS_S0), WSP(unsigned char, WS_WIN), NT, NPROJ, DM, DM, DM); pg8::StaticOrder S; S.init(NT, NPROJ, F.G, F.blk);
        EpiProj E{WSP(bf16, WS_XR), WSP(bf16, WS_GG), WSP(unsigned char, WS_QKVC), WSP(unsigned char, WS_KVC8), WSP(bf16, WS_SGR), WSP(bf16, WS_SGM), WSP(float, WS_KR), WSP(float, WS_SSP), 1.0f / (SC_H * SC_WIN)};
        DBL(2, pg8::gemm_phase<EpiProj, pg8::StaticOrder, true, false>(F.lds, g, S, E, F.wave)); pg8::gemm_phase<EpiProj, pg8::StaticOrder, true, false>(F.lds, g, S, E, F.wave); SEAM(2); }
    if (IN(3)) { DBL(3, rglru_passA(F)); rglru_passA(F); SEAM(3); }
    if (IN(4)) {
        rglru_passB(F);
        constexpr float ESC6 = 1.0f / (SC_H * SC_WIN);
        { const pg8::Gemm g = pg8::gemm_f8(WSP(unsigned char, WS_QKVC), WSP(unsigned char, WS_WUQ), NT, 3072, 512, 512, 512); pg8::StaticOrder S; S.init(NT, 3072, F.G, F.blk);
          EpiQ E{(unsigned char*)F.out + OUT_Q, WSP(float, WS_RS), WSP(f32x2, WS_ROPE), ESC6}; pg8::gemm_phase<EpiQ, pg8::StaticOrder, true>(F.lds, g, S, E, F.wave); }
        { const pg8::Gemm g = pg8::gemm_f8(WSP(unsigned char, WS_KVC8), WSP(unsigned char, WS_WUK), NT, 2048, 512, 512, 512); pg8::StaticOrder S; S.init(NT, 2048, F.G, F.blk);
          EpiK E{(unsigned char*)F.out + OUT_K, WSP(float, WS_RS), ESC6}; pg8::gemm_phase<EpiK, pg8::StaticOrder, true>(F.lds, g, S, E, F.wave); }
        { const pg8::Gemm g = pg8::gemm_f8(WSP(unsigned char, WS_WUV), WSP(unsigned char, WS_KVC8), 2048, NT, 512, 512, 512); pg8::StaticOrder S; S.init(2048, NT, F.G, F.blk);
          EpiVT E{(unsigned char*)F.out + OUT_VT, WSP(float, WS_RS), ESC6}; pg8::gemm_phase<EpiVT, pg8::StaticOrder, true>(F.lds, g, S, E, F.wave); }
        krope_fill(F); SEAM(4); }
    if (IN(5)) {
#ifdef PROBE_ATTN
#pragma unroll 1
        for (int rep = 0; rep < PROBE_ATTN; ++rep) { attn_phase(F); xcd_barrier(bar); }
#else
        attn_phase(F);
#endif
        SEAM(5); }
    if (IN(6)) {
        pg8::Gemm g = pg8::gemm_f8(WSP(unsigned char, WS_S0), WSP(unsigned char, WS_WRNN), NT, DM, 2 * DM, DM, DM); g.A2 = WSP(unsigned char, WS_AO8); g.Bt2 = WSP(unsigned char, WS_WMLA); g.nt1 = DM / 128;
        pg8::StaticOrder S; S.init(NT, DM, F.G, F.blk);
        EpiMix E{WSP(bf16, WS_SGR), WSP(bf16, WS_SGM), WSP(unsigned char, WS_TMP8), SC_AO / SC_RA, 1.0f / (SC_AO * SC_WSQ)};
        pg8::gemm_phase<EpiMix, pg8::StaticOrder, true>(F.lds, g, S, E, F.wave); SEAM(6); }
    if (IN(7)) {
#ifdef PROBE_GEMM
#if PROBE_GEMM == 1
#define PROBE_ONE { pg8::Gemm gp = pg8::gemm_f8(WSP(unsigned char, WS_TMP8), WSP(unsigned char, WS_WO), NT, DM, DM, DM, DM); gp.nt = PROBE_NT; pg8::StaticOrder Sp; Sp.init(NT, DM, F.G, F.blk); \
            EpiRes1 Ep{F.x, WSP(float, WS_MOD), WSP(bf16, WS_PQ), 1.0f}; pg8::gemm_phase<EpiRes1, pg8::StaticOrder, true>(F.lds, gp, Sp, Ep, F.wave); xcd_barrier(bar); }
#elif PROBE_GEMM == 3
#define PROBE_ONE { pg8::Gemm gp = pg8::gemm_f8(WSP(unsigned char, WS_TMP8), WSP(unsigned char, WS_WO), NT, DM, DM, DM, DM); gp.nt = PROBE_NT; pg8::StaticOrder Sp; Sp.init(NT, DM, F.G, F.blk); \
            EpiPlain Ep{WSP(bf16, WS_PQ), 1.0f}; pg8::gemm_phase<EpiPlain, pg8::StaticOrder, true, true>(F.lds, gp, Sp, Ep, F.wave); xcd_barrier(bar); }
#elif PROBE_GEMM == 5
#define PROBE_ONE { pg8::Gemm gp = pg8::gemm_f8(WSP(unsigned char, WS_TMP8), WSP(unsigned char, WS_WO), NT, DM, DM, DM, DM); gp.nt = PROBE_NT; pg8::StaticOrder Sp; Sp.init(NT, DM, F.G, F.blk); \
            EpiNull Ep{WSP(float, WS_PQ)}; pg8::gemm_phase<EpiNull, pg8::StaticOrder, true, true>(F.lds, gp, Sp, Ep, F.wave); xcd_barrier(bar); }
#elif PROBE_GEMM == 4
#define PROBE_ONE { pg8::Gemm gp = pg8::gemm_bf16(WSP(bf16, WS_TMP), WSP(bf16, WS_WPQ), NT, DM, DM, DM, DM); gp.nt = PROBE_NT; pg8::StaticOrder Sp; Sp.init(NT, DM, F.G, F.blk); \
            EpiPlain Ep{WSP(bf16, WS_PQ), 1.0f}; pg8::gemm_phase<EpiPlain, pg8::StaticOrder>(F.lds, gp, Sp, Ep, F.wave); xcd_barrier(bar); }
#endif
#ifndef PROBE_PRB
#define PROBE_PRB 0
#endif
#ifndef PROBE_REP
#define PROBE_REP 1
#endif
        PROBE_ONE
#if PROBE_REP >= 2
        PROBE_ONE
#endif
#if PROBE_REP >= 3
        PROBE_ONE
#endif
#if PROBE_REP >= 4
        PROBE_ONE
#endif
#endif
        const pg8::Gemm g = pg8::gemm_f8(WSP(unsigned char, WS_TMP8), WSP(unsigned char, WS_WO), NT, DM, DM, DM, DM); pg8::StaticOrder S; S.init(NT, DM, F.G, F.blk);
        EpiRes1 E{F.x, WSP(float, WS_MOD), WSP(bf16, WS_R1), 1.0f / (SC_TMP * SC_WSQ)};
        pg8::gemm_phase<EpiRes1, pg8::StaticOrder, true>(F.lds, g, S, E, F.wave); SEAM(7); }
    if (IN(8)) { ln1_phase(F); SEAM(8); }
    if (IN(9)) {
        const pg8::Gemm g = pg8::gemm_f8(WSP(unsigned char, WS_H2I), WSP(unsigned char, WS_WPQ), NT, DM, DM, DM, DM); pg8::StaticOrder S; S.init(NT, DM, F.G, F.blk);
        EpiQuery E{WSP(bf16, WS_PQ), WSP(float, WS_HSC), WSP(float, WS_WQS)};
        pg8::gemm_phase<EpiQuery, pg8::StaticOrder, 2>(F.lds, g, S, E, F.wave); SEAM(9); }
#ifdef PROBE_BARS
#pragma unroll 1
    for (int r = 0; r < PROBE_BARS; ++r) xcd_barrier(bar);
#endif
    if (IN(10)) { DBL(10, peer_score_phase(F)); peer_score_phase(F); SEAM(10); }
    if (IN(11)) { DBL(11, peer_eval_phase(F)); peer_eval_phase(F); }
#undef IN
#undef SEAM
}

#ifdef PROBE_ATTN_PRB
__global__ void __launch_bounds__(NTHREADS, 2) attn_probe_kernel(Args args) {
    extern __shared__ __attribute__((aligned(16))) unsigned char lds_raw[];
    Frame F;
    F.lds = (LAS unsigned char*)lds_raw; F.tid = threadIdx.x; F.lane = F.tid & 63; F.wave = __builtin_amdgcn_readfirstlane(F.tid >> 6); F.G = gridDim.x; F.blk = blockIdx.x; F.out = args.out; F.ws = args.ws;
    attn_phase<32 | PROBE_ATTN_PRB>(F);
}
#endif
#ifdef DBG_STOP
__global__ void dbg_dump(const unsigned char* ws, size_t off, int is_f32, float* out) {
    const size_t n = (size_t)NT * DM; const size_t i0 = (size_t)blockIdx.x * blockDim.x + threadIdx.x, st = (size_t)gridDim.x * blockDim.x;
    if (is_f32) { const float* s = (const float*)(ws + off); for (size_t i = i0; i < n; i += st) out[i] = s[i]; }
    else { const bf16* s = (const bf16*)(ws + off); for (size_t i = i0; i < n; i += st) out[i] = i < (size_t)DBG_N ? bf1(s[i]) : 0.f; }
}
__global__ void dbg_count(const unsigned char* ws, size_t off, float lo, float hi, unsigned* cnt) {
    if (blockIdx.x != 0) return;
    const int pm = 3, ct = 2; const bf16* s = (const bf16*)(ws + off); __shared__ unsigned rowbad[256], colbad[256];
    rowbad[threadIdx.x] = 0; colbad[threadIdx.x] = 0; __syncthreads();
    for (int i = threadIdx.x; i < 65536; i += blockDim.x) { const int r = i >> 8, cc = i & 255; const float v = bf1(s[(size_t)(pm * 256 + r) * DM + ct * 256 + cc]); if (!(v >= lo && v <= hi)) { rowbad[r] = 1; colbad[cc] = 1; } }
    __syncthreads();
    if (threadIdx.x == 0) { unsigned nr = 0, nc = 0, fr = 999, fc = 999; for (int i = 0; i < 256; ++i) { if (rowbad[i]) { ++nr; if (fr == 999) fr = i; } if (colbad[i]) { ++nc; if (fc == 999) fc = i; } }
        cnt[0] = nr + 10; cnt[1] = nc + 10; cnt[2] = fr + 10; cnt[3] = fc + 10; }
}
__global__ void dbg_report(const unsigned* cnt, float* out) {
    const size_t n = (size_t)NT * DM; const size_t i0 = (size_t)blockIdx.x * blockDim.x + threadIdx.x, st = (size_t)gridDim.x * blockDim.x;
    const float v = (float)cnt[DBG_WHICH];
    for (size_t i = i0; i < n; i += st) out[i] = (i == 0) ? v : 0.f;
}
#endif
#ifdef PROBE_MB
template <int NM, int NV, int VT>
__global__ void __launch_bounds__(NTHREADS, 2) mb_kernel(float* sink, int iters) {
    const int lane = threadIdx.x & 63; unsigned h = (unsigned)(threadIdx.x + 512 * blockIdx.x) * 0x9E3779B9u + 0x7F4A7C15u;
    i32x8 a, b; for (int e = 0; e < 8; ++e) { h = h * 1664525u + 1013904223u; a[e] = (int)(h & 0x3F3F3F3Fu); h = h * 1664525u + 1013904223u; b[e] = (int)(h & 0x3F3F3F3Fu) ^ 0x00800080; }
    f32x16 acc[4]; for (int q = 0; q < 4; ++q) for (int e = 0; e < 16; ++e) acc[q][e] = 0.f;
    float v[12]; for (int e = 0; e < 12; ++e) v[e] = 0.001f * (float)(lane + e);
    const float c1 = 0.999f, c2 = 0.0007f;
#pragma unroll 1
    for (int it = 0; it < iters; ++it) {
#pragma unroll
        for (int q = 0; q < 4; ++q) {
            if (NM) acc[q] = __builtin_amdgcn_mfma_scale_f32_32x32x64_f8f6f4(a, b, acc[q], 0, 0, 0, 0x7F7F7F7F, 0, 0x7F7F7F7F);
            __builtin_amdgcn_sched_barrier(0);
#pragma unroll
            for (int e = 0; e < NV; ++e) v[e] = VT ? __builtin_amdgcn_exp2f(v[e]) : __builtin_fmaf(v[e], c1, c2);
            __builtin_amdgcn_sched_barrier(0);
        }
    }
    float sacc = 0.f; for (int q = 0; q < 4; ++q) for (int e = 0; e < 16; ++e) sacc += acc[q][e]; for (int e = 0; e < 12; ++e) sacc += v[e];
    sink[(size_t)blockIdx.x * 512 + threadIdx.x] = sacc;
}
#endif
extern "C" void kernel_launch(void* const* d_in, const int* in_sizes, int n_in, void* d_out, int out_size, void* d_ws, size_t ws_size, hipStream_t stream) {
    static int grid = 0;
    if (grid == 0) {
        if (n_in != 28 || out_size != NT * DM || ws_size < WS_END) { fprintf(stderr, "kernel_launch: unexpected shapes (n_in %d, out %d, ws %zu)\n", n_in, out_size, ws_size); grid = -1; return; }
        int dev = 0, cus = 0, per_cu = 0;
        if (hipGetDevice(&dev) != hipSuccess || hipDeviceGetAttribute(&cus, hipDeviceAttributeMultiprocessorCount, dev) != hipSuccess) { grid = -1; return; }
        if (hipFuncSetAttribute((const void*)fwd_kernel, hipFuncAttributeMaxDynamicSharedMemorySize, LDS_BYTES) != hipSuccess) { fprintf(stderr, "kernel_launch: hipFuncSetAttribute failed\n"); grid = -1; return; }
        if (hipOccupancyMaxActiveBlocksPerMultiprocessor(&per_cu, (const void*)fwd_kernel, NTHREADS, LDS_BYTES) != hipSuccess || per_cu < 1)
            fprintf(stderr, "kernel_launch: occupancy query reports %d workgroups per CU\n", per_cu);
        (void)hipGetLastError();
        grid = cus;
    }
    if (grid < 0) return;
    if (hipMemsetAsync((char*)d_ws + WS_CTL, 0, CTL_ZERO_BYTES, stream) != hipSuccess) return;
#ifdef PROBE_MB
    hipLaunchKernelGGL((mb_kernel<PROBE_MB_NM, PROBE_MB_NV, PROBE_MB_VT>), dim3(grid), dim3(NTHREADS), 0, stream, (float*)((char*)d_ws + WS_XR), 4000);
#endif
    Args a{};
    for (int i = 0; i < 28; ++i) a.in[i] = (const float*)d_in[i];
    a.out = (float*)d_out; a.ws = (unsigned char*)d_ws;
#ifdef PROBE_RELAUNCH
    a.ph_lo = 0; a.ph_hi = PROBE_RELAUNCH + 1; a.bslot = 0;
    hipLaunchKernelGGL(fwd_kernel, dim3(grid), dim3(NTHREADS), LDS_BYTES, stream, a);
#ifdef PROBE_ATTN_PRB
    { static bool once = false; if (!once) { once = true; (void)hipFuncSetAttribute((const void*)attn_probe_kernel, hipFuncAttributeMaxDynamicSharedMemorySize, LDS_BYTES); } }
    for (int r = 0; r < PROBE_RELAUNCH_N; ++r) hipLaunchKernelGGL(attn_probe_kernel, dim3(grid), dim3(NTHREADS), LDS_BYTES, stream, a);
#else
    for (int r = 0; r < PROBE_RELAUNCH_N; ++r) { a.ph_lo = PROBE_RELAUNCH; a.ph_hi = PROBE_RELAUNCH + 1; a.bslot = 2 + r; hipLaunchKernelGGL(fwd_kernel, dim3(grid), dim3(NTHREADS), LDS_BYTES, stream, a); }
#endif
    if (PROBE_RELAUNCH + 1 < NPHASE) { a.ph_lo = PROBE_RELAUNCH + 1; a.ph_hi = NPHASE; a.bslot = 1; hipLaunchKernelGGL(fwd_kernel, dim3(grid), dim3(NTHREADS), LDS_BYTES, stream, a); }
#elif MK_N_LAUNCHES == 1
    a.ph_lo = 0; a.ph_hi = NPHASE;
    hipLaunchKernelGGL(fwd_kernel, dim3(grid), dim3(NTHREADS), LDS_BYTES, stream, a);
#else
#ifdef DBG_STOP
    for (int p = 0; p <= DBG_STOP; ++p) { a.ph_lo = p; a.ph_hi = p + 1; hipLaunchKernelGGL(fwd_kernel, dim3(grid), dim3(NTHREADS), LDS_BYTES, stream, a); }
#ifdef DBG_COUNT
        hipLaunchKernelGGL(dbg_count, dim3(1024), dim3(256), 0, stream, (const unsigned char*)d_ws, (size_t)DBG_OFF, DBG_LO, DBG_HI, (unsigned*)d_ws + 1024);
    hipLaunchKernelGGL(dbg_report, dim3(2048), dim3(256), 0, stream, (const unsigned*)d_ws + 1024, (float*)d_out);
#else
    hipLaunchKernelGGL(dbg_dump, dim3(2048), dim3(256), 0, stream, (const unsigned char*)d_ws, (size_t)DBG_OFF, DBG_F32, (float*)d_out);
#endif
#else
    for (int p = 0; p < NPHASE; ++p) { a.ph_lo = p; a.ph_hi = p + 1; hipLaunchKernelGGL(fwd_kernel, dim3(grid), dim3(NTHREADS), LDS_BYTES, stream, a); }
#endif
#endif
    const hipError_t le = hipPeekAtLastError();
    if (le != hipSuccess) fprintf(stderr, "kernel_launch: launch failed: %s\n", hipGetErrorName(le));
}
```

```cpp
#include <hip/hip_runtime.h>
#include <cstdio>
#include <cstdint>

#ifndef MK_N_LAUNCHES
#define MK_N_LAUNCHES 1
#endif

#define LAS __attribute__((address_space(3)))
#define GAS __attribute__((address_space(1)))
typedef unsigned short bf16;
typedef short bf16x8 __attribute__((ext_vector_type(8)));
typedef float f32x2 __attribute__((ext_vector_type(2)));
typedef _Float16 f16x2 __attribute__((ext_vector_type(2)));
typedef float f32x4 __attribute__((ext_vector_type(4)));
typedef float f32x16 __attribute__((ext_vector_type(16)));
typedef unsigned u32x2 __attribute__((ext_vector_type(2)));
typedef unsigned u32x4 __attribute__((ext_vector_type(4)));
typedef int i32x4 __attribute__((ext_vector_type(4)));
typedef int i32x8 __attribute__((ext_vector_type(8)));

constexpr int NB = 4, SEQ = 8192, DM = 2048, NT = NB * SEQ;
constexpr int NH = 16, QLORA = 512, KVLORA = 512, DNOPE = 128, DROPE = 64, DV = 128, DQK = 192;
constexpr int IN_COLS = 9280, NPROJ = 9472;
constexpr int PEER_H = 8, NKEYS = 128, TOPK = 16;
constexpr float DN_ALPHA = 1.189207115002721f;
constexpr float LN_EPS = 1e-5f, RMS_EPS = 1e-6f;
constexpr float QSCALE = 0.07216878364870322f * 1.4426950408889634f;
constexpr int NWAVES = 8, NTHREADS = 512;
constexpr float PU_SCALE = 1024.0f, PV_SCALE = 64.0f;
constexpr float SC_H = 16.0f, SC_WIN = 1024.0f, SC_RA = 4.0f, SC_AO = 32.0f, SC_TMP = 32.0f, SC_WSQ = 2048.0f;
constexpr float SC_Q = 64.0f, SC_K = 16.0f, SC_V = 16.0f, SC_P = 64.0f;

constexpr size_t MiB = 1u << 20;
constexpr size_t WS_CTL = 0, CTL_ZERO_BYTES = 1 * MiB;
constexpr size_t WS_MOD = 1 * MiB;
constexpr size_t WS_RS = 1 * MiB + 512 * 1024;
constexpr size_t WS_SSP = 100 * MiB;
constexpr size_t WS_ROPE = 2 * MiB;
constexpr size_t WS_WIN = 10 * MiB;
constexpr size_t WS_WRNN = 47 * MiB, WS_WMLA = 55 * MiB, WS_WO = 63 * MiB, WS_WPQ = 71 * MiB;
constexpr size_t WS_WUQ = 79 * MiB;
constexpr size_t WS_WUK = 82 * MiB, WS_WUV = 84 * MiB;
constexpr size_t WS_WGA = 86 * MiB;
constexpr size_t WS_WGX = 86 * MiB + 512 * 1024;
constexpr size_t WS_PKEYS = 87 * MiB;
constexpr size_t WS_SUMM = 88 * MiB;
constexpr size_t WS_KR = 90 * MiB;
constexpr size_t WS_S0 = 128 * MiB;
constexpr size_t WS_XR = 256 * MiB, WS_GG = 384 * MiB, WS_SGR = 512 * MiB, WS_SGM = 640 * MiB;
constexpr size_t WS_QKVC = 768 * MiB;
constexpr size_t WS_KVC8 = 800 * MiB;
constexpr size_t WS_TMP = 832 * MiB;
constexpr size_t WS_IDX = 960 * MiB, WS_GATE = 976 * MiB;
constexpr size_t WS_TMP8 = 768 * MiB;
constexpr size_t WS_K = 256 * MiB;
constexpr size_t WS_VT = 448 * MiB;
constexpr size_t WS_R1 = 256 * MiB;
constexpr size_t WS_PQ = 512 * MiB;
constexpr size_t WS_PU = 640 * MiB, WS_PV = 704 * MiB;
constexpr size_t WS_END = 1024 * MiB;
constexpr size_t WS_WQS = WS_WPQ + 4 * MiB;
constexpr size_t CTL_WQAMAX = 32768 * 4;
constexpr size_t WS_H2I = 768 * MiB;
constexpr size_t WS_HSC = 100 * MiB, WS_USC = 101 * MiB, WS_VSC = 102 * MiB;
constexpr size_t WS_AO8 = WS_S0 + 64 * MiB;
constexpr size_t OUT_Q = 0, OUT_K = 96 * MiB, OUT_VT = 192 * MiB;

constexpr int LDS_BYTES = 147456, LDSCTL_OFF = 146944;

typedef __bf16 bf16v2 __attribute__((ext_vector_type(2)));
__device__ __forceinline__ unsigned pk2(float lo, float hi) { const bf16v2 v = __builtin_convertvector((f32x2){lo, hi}, bf16v2); return __builtin_bit_cast(unsigned, v); }
__device__ __forceinline__ float bflo(unsigned w) { return __uint_as_float(w << 16); }
__device__ __forceinline__ float bfhi(unsigned w) { return __uint_as_float(w & 0xffff0000u); }
__device__ __forceinline__ float bf1(bf16 b) { return __uint_as_float(((unsigned)b) << 16); }
__device__ __forceinline__ float sigmoidf_(float y) { return __builtin_amdgcn_rcpf(1.0f + __builtin_amdgcn_exp2f(-1.4426950408889634f * y)); }
__device__ __forceinline__ float gelu_tanh(float x) { const float z = 0.7978845608028654f * (x + 0.044715f * x * x * x); return x * sigmoidf_(2.0f * z); }
__device__ __forceinline__ float wave_sum(float v) {
#pragma unroll
    for (int o = 1; o < 64; o <<= 1) v += __shfl_xor(v, o);
    return v;
}
__device__ __forceinline__ float clamp448(float v) { return __builtin_amdgcn_fmed3f(v, -448.0f, 448.0f); }
__device__ __forceinline__ unsigned pk4_f8(float a, float b, float c, float d) { int w = __builtin_amdgcn_cvt_pk_fp8_f32(clamp448(a), clamp448(b), 0, false); w = __builtin_amdgcn_cvt_pk_fp8_f32(clamp448(c), clamp448(d), w, true); return (unsigned)w; }
__device__ __forceinline__ int fresh_lane() { int l; asm volatile("v_mbcnt_lo_u32_b32 %0, -1, 0\n\tv_mbcnt_hi_u32_b32 %0, -1, %0" : "=v"(l)); return l; }
__device__ __forceinline__ float wave_max(float v) {
#pragma unroll
    for (int o = 1; o < 64; o <<= 1) v = fmaxf(v, __shfl_xor(v, o));
    return v;
}
__device__ __forceinline__ unsigned pk4_i8(float a, float b, float c, float d) {
    const int ia = (int)__builtin_rintf(__builtin_amdgcn_fmed3f(a, -127.f, 127.f)), ib = (int)__builtin_rintf(__builtin_amdgcn_fmed3f(b, -127.f, 127.f)), ic = (int)__builtin_rintf(__builtin_amdgcn_fmed3f(c, -127.f, 127.f)), id = (int)__builtin_rintf(__builtin_amdgcn_fmed3f(d, -127.f, 127.f));
    return (unsigned)(ia & 0xff) | ((unsigned)(ib & 0xff) << 8) | ((unsigned)(ic & 0xff) << 16) | ((unsigned)id << 24); }
#define LDS_WAIT() asm volatile("s_waitcnt lgkmcnt(0)" ::: "memory")
#define VM_WAIT() asm volatile("s_waitcnt vmcnt(0)" ::: "memory")

#define XB_TMO      128
#define XB_XCNT(j)  (256  + 64 * (j))
#define XB_XSUB(j)  (1280 + 64 * (j))
#define XB_XGEN(j)  (2304 + 64 * (j))
#define XB_TOP      3328
#define XB_TOPGEN   3392
#define XCD_BAR_WORDS 3456
#define XB_SPIN_CAP (1u << 20)
__device__ __forceinline__ unsigned xb_ld(unsigned* p)              { return __hip_atomic_load(p, __ATOMIC_RELAXED, __HIP_MEMORY_SCOPE_AGENT); }
__device__ __forceinline__ unsigned xb_add(unsigned* p, unsigned v) { return __hip_atomic_fetch_add(p, v, __ATOMIC_RELAXED, __HIP_MEMORY_SCOPE_AGENT); }
__device__ __forceinline__ unsigned xb_xcc_id() { return (unsigned)__builtin_amdgcn_s_getreg((3 << 11) | 20) & 0xFu; }
#define XB_SPIN(cond, bar) do { unsigned _sp = 0; while (cond) { __builtin_amdgcn_s_sleep(1); \
    if ((++_sp & 255u) == 0u) { if (xb_ld(&(bar)[XB_TMO])) break; if (_sp > XB_SPIN_CAP) { atomicAdd(&(bar)[XB_TMO], 1u); break; } } } } while (0)
struct XcdBarrier { unsigned* bar; unsigned x; volatile LAS unsigned* st; };
__device__ __forceinline__ XcdBarrier xcd_barrier_post(unsigned* bar, volatile LAS unsigned* st) {
    XcdBarrier b; b.bar = bar; b.x = xb_xcc_id(); b.st = st;
    if (threadIdx.x == 0) (void)xb_add(&bar[XB_XCNT(b.x)], 1u);
    return b;
}
__device__ __forceinline__ void xcd_barrier_complete(unsigned* bar, unsigned x, unsigned& nloc, unsigned& nx) {
    const unsigned G = gridDim.x * gridDim.y * gridDim.z;
    unsigned sum, cnt, mine, sp = 0u;
    for (;;) {
        sum = 0u; cnt = 0u; mine = 0u;
#pragma unroll
        for (unsigned j = 0; j < 16; ++j) { const unsigned c = xb_ld(&bar[XB_XCNT(j)]); sum += c; cnt += (c > 0u) ? 1u : 0u; mine = (j == x) ? c : mine; }
        if (sum == G) break;
        __builtin_amdgcn_s_sleep(1);
        if ((++sp & 255u) == 0u) { if (xb_ld(&bar[XB_TMO])) break; if (sp > XB_SPIN_CAP) { atomicAdd(&bar[XB_TMO], 1u); break; } }
    }
    nloc = mine > 0u ? mine : 1u; nx = cnt > 0u ? cnt : 1u;
}
__device__ __forceinline__ void xcd_barrier(const XcdBarrier& b) {
    asm volatile("s_waitcnt vmcnt(0)" ::: "memory");
    __syncthreads();
    if (threadIdx.x == 0) {
        unsigned* bar = b.bar;
        __builtin_amdgcn_s_waitcnt(0);
        unsigned nloc = b.st[0], nx = b.st[1];
        if (nloc == 0u) { xcd_barrier_complete(bar, b.x, nloc, nx); b.st[0] = nloc; b.st[1] = nx; }
        const unsigned old = xb_add(&bar[XB_XSUB(b.x)], 1u);
        const unsigned gen = old / nloc;
        if (old + 1u == (gen + 1u) * nloc) {
            __builtin_amdgcn_fence(__ATOMIC_RELEASE, "agent");
            asm volatile("s_waitcnt vmcnt(0)" ::: "memory");
            const unsigned og = xb_add(&bar[XB_TOP], 1u);
            const unsigned tg = og / nx;
            if (og + 1u == (tg + 1u) * nx) xb_add(&bar[XB_TOPGEN], 1u);
            else XB_SPIN(xb_ld(&bar[XB_TOPGEN]) == tg, bar);
            __builtin_amdgcn_fence(__ATOMIC_ACQUIRE, "agent");
            asm volatile("s_waitcnt vmcnt(0)" ::: "memory");
        } else {
            XB_SPIN(xb_ld(&bar[XB_TOPGEN]) == gen, bar);
            __builtin_amdgcn_fence(__ATOMIC_ACQUIRE, "agent");
            asm volatile("s_waitcnt vmcnt(0)" ::: "memory");
        }
    }
    __syncthreads();
}

__device__ __forceinline__ void glds16(const char* sbase, unsigned voff, unsigned lds_dst) {
    unsigned keep;
    asm volatile("s_mov_b32 %0, m0\n\ts_mov_b32 m0, %3\n\ts_nop 0\n\tglobal_load_lds_dwordx4 %1, %2\n\ts_mov_b32 m0, %0" : "=&s"(keep) : "v"(voff), "s"(sbase), "s"(lds_dst) : "memory");
}
namespace pg8 {
constexpr int BM = 256, BK = 64, HALF = 128, HTB = HALF * BK * 2, STAGE_BYTES = 8 * HTB, NXCD = 8, WGM = 4;
__host__ __device__ __forceinline__ int lds_byte(int r, int c) { const int st = (r >> 4) * 2 + (c >> 5), rr = r & 15, cc = c & 31, ob = rr * 64 + cc * 2; return st * 1024 + (ob ^ (((ob >> 9) & 1) << 5)); }
__host__ __device__ __forceinline__ void stage_rc(int b, int& R, int& C) { const int st = b / 1024, sb = b % 1024, swz = sb ^ (((sb >> 9) & 1) << 5); R = (st >> 1) * 16 + swz / 64; C = (st & 1) * 32 + (swz % 64) / 2; }
__host__ __device__ __forceinline__ int perm32(int rho) { const int n = rho >> 4, i = rho & 15; return 8 * (i >> 2) + 4 * n + (i & 3); }
struct Unit { int pm, pn; };
struct Gemm { const void* A; const void* Bt; int M, N, nt, lda_b, ldb_b; const void* A2 = nullptr; const void* Bt2 = nullptr; int nt1 = 0; };
__host__ __device__ __forceinline__ Gemm gemm_bf16(const bf16* A, const bf16* Bt, int M, int N, int K, int lda, int ldb) { return Gemm{A, Bt, M, N, K / 64, lda * 2, ldb * 2}; }
__host__ __device__ __forceinline__ Gemm gemm_f8(const unsigned char* A, const unsigned char* Bt, int M, int N, int K, int lda, int ldb) { return Gemm{A, Bt, M, N, K / 128, lda, ldb}; }
struct StaticOrder {
    int nM, nN, nwg, G, c;
    __host__ __device__ void init(int M, int N, int G_, int c_) { nM = M / BM; nN = N / BM; nwg = nM * nN; G = G_; c = c_; }
    __host__ __device__ bool next(int i, Unit& u) const {
        const long L = (long)i * G + c; if (L >= nwg) return false;
        int wgid = (int)L; { const int q = nwg / NXCD, r = nwg % NXCD, xcd = wgid % NXCD, off = wgid / NXCD; wgid = (xcd < r ? xcd * (q + 1) : r * (q + 1) + (xcd - r) * q) + off; }
        const int nig = WGM * nN, gid = wgid / nig, fm = gid * WGM, gsz = (nM - fm) < WGM ? (nM - fm) : WGM;
        u.pm = fm + ((wgid % nig) % gsz); u.pn = (wgid % nig) / gsz; return true;
    }
    __device__ __forceinline__ void a_ready(const Unit&) const {}
    __device__ __forceinline__ void done(const Unit&) const {}
};
template <class Epi, class Sched, int F8 = 0, bool ALIGN_EPI = true>
__device__ __forceinline__ void gemm_phase(LAS unsigned char* lds, const Gemm g, const Sched& S, const Epi& E, int wid) {
    const int lane = fresh_lane(), tid = wid * 64 + lane, wr = wid >> 2, wc = wid & 3, fr = lane & 15, fq = lane >> 4;
    const int nt = g.nt;
    unsigned voffA, voffB;
    { int R, C; stage_rc(tid * 16, R, C); const int Rb = Epi::PERM ? ((R & ~31) + perm32(R & 31)) : R; voffA = (unsigned)(R * g.lda_b + C * 2); voffB = (unsigned)(Rb * g.ldb_b + C * 2); }
    const size_t qstepA = (size_t)64 * g.lda_b, qstepB = (size_t)64 * g.ldb_b;
    const unsigned ldsbase = (unsigned)(size_t)lds;
    const size_t kstep = (size_t)(BK * 2);
    const size_t hstepA = (size_t)HALF * g.lda_b, hstepB = (size_t)HALF * g.ldb_b;
    const size_t tstepA = 2 * hstepA, tstepB = 2 * hstepB;
    const unsigned ldsw = (unsigned)wid * 1024u;
    const int aoff = lds_byte(wr * 64 + fr, fq * 8), boff = lds_byte(wc * 32 + fr, fq * 8);
#define PG8_SA(b, h) (((b) * 2 + (h)) * HTB)
#define PG8_SB(b, h) ((4 + (b) * 2 + (h)) * HTB)
#define PG8_STAGE_A(bufoff, gbase) do { glds16((const char*)(gbase), voffA, ldsbase + (bufoff) + ldsw); glds16((const char*)(gbase) + qstepA, voffA, ldsbase + (bufoff) + ldsw + 8192); } while (0)
#define PG8_STAGE_B(bufoff, gbase) do { glds16((const char*)(gbase), voffB, ldsbase + (bufoff) + ldsw); glds16((const char*)(gbase) + qstepB, voffB, ldsbase + (bufoff) + ldsw + 8192); } while (0)
#define PG8_LD8(p) __builtin_shufflevector(*(const LAS i32x4*)(p), *(const LAS i32x4*)((p) + 1024), 0, 1, 2, 3, 4, 5, 6, 7)
#define PG8_LDA(dst, b, h) do { _Pragma("unroll") for (int m = 0; m < 4; ++m) dst[m] = PG8_LD8(lds + PG8_SA(b, h) + aoff + m * 2048); } while (0)
#define PG8_LDB(dst, b, h) do { _Pragma("unroll") for (int n = 0; n < 2; ++n) dst[n] = PG8_LD8(lds + PG8_SB(b, h) + boff + n * 2048); } while (0)
#define PG8_LO(v) __builtin_bit_cast(bf16x8, __builtin_shufflevector(v, v, 0, 1, 2, 3))
#define PG8_HI(v) __builtin_bit_cast(bf16x8, __builtin_shufflevector(v, v, 4, 5, 6, 7))
#define PG8_MMA(ai, bj, At, Bt) do { __builtin_amdgcn_s_setprio(1); _Pragma("unroll") for (int m = 0; m < 4; ++m) _Pragma("unroll") for (int n = 0; n < 2; ++n) { \
        if constexpr (F8 == 1) acc[ai][bj][m][n] = __builtin_amdgcn_mfma_scale_f32_16x16x128_f8f6f4(Bt[n], At[m], acc[ai][bj][m][n], 0, 0, 0, 0x7F7F7F7F, 0, 0x7F7F7F7F); \
        else if constexpr (F8 == 2) { i32x4 ci = __builtin_bit_cast(i32x4, acc[ai][bj][m][n]); \
               ci = __builtin_amdgcn_mfma_i32_16x16x64_i8(__builtin_shufflevector(Bt[n], Bt[n], 0, 1, 2, 3), __builtin_shufflevector(At[m], At[m], 0, 1, 2, 3), ci, 0, 0, 0); \
               ci = __builtin_amdgcn_mfma_i32_16x16x64_i8(__builtin_shufflevector(Bt[n], Bt[n], 4, 5, 6, 7), __builtin_shufflevector(At[m], At[m], 4, 5, 6, 7), ci, 0, 0, 0); \
               acc[ai][bj][m][n] = __builtin_bit_cast(f32x4, ci); } \
        else { acc[ai][bj][m][n] = __builtin_amdgcn_mfma_f32_16x16x32_bf16(PG8_LO(Bt[n]), PG8_LO(At[m]), acc[ai][bj][m][n], 0, 0, 0); \
               acc[ai][bj][m][n] = __builtin_amdgcn_mfma_f32_16x16x32_bf16(PG8_HI(Bt[n]), PG8_HI(At[m]), acc[ai][bj][m][n], 0, 0, 0); } } \
        __builtin_amdgcn_s_setprio(0); } while (0)
#define PG8_WAIT_V(n) asm volatile("s_waitcnt vmcnt(" #n ")" ::: "memory")
#define PG8_WAIT_L(n) asm volatile("s_waitcnt lgkmcnt(" #n ")" ::: "memory")
#define PG8_BAR __builtin_amdgcn_s_barrier()
#define PG8_SCHED __builtin_amdgcn_sched_barrier(0)
    Unit cur, nxt; int ui = 0;
    if (!S.next(0, cur)) return;
    f32x4 acc[2][2][4][2];
#pragma unroll
    for (int a = 0; a < 2; ++a)
#pragma unroll
        for (int b = 0; b < 2; ++b)
#pragma unroll
            for (int m = 0; m < 4; ++m)
#pragma unroll
                for (int n = 0; n < 2; ++n) acc[a][b][m][n] = (f32x4){0.f, 0.f, 0.f, 0.f};
    i32x8 At[4], B0[2], B1[2];
    const char* cA = (const char*)g.A + (size_t)cur.pm * tstepA; const char* cB = (const char*)g.Bt + (size_t)cur.pn * tstepB;
    const bool two = g.A2 != nullptr; const int nt1 = two ? g.nt1 : nt;
    const char* cA2 = two ? (const char*)g.A2 + (size_t)cur.pm * tstepA : cA; const char* cB2 = two ? (const char*)g.Bt2 + (size_t)cur.pn * tstepB : cB;
    S.a_ready(cur);
    PG8_STAGE_B(PG8_SB(0, 0), cB); PG8_STAGE_B(PG8_SB(0, 1), cB + hstepB); PG8_STAGE_A(PG8_SA(0, 0), cA); PG8_STAGE_A(PG8_SA(0, 1), cA + hstepA);
    if (wr == 1) PG8_BAR;
    PG8_WAIT_V(2); PG8_BAR;
    PG8_STAGE_B(PG8_SB(1, 0), cB + kstep); PG8_STAGE_A(PG8_SA(1, 0), cA + kstep); PG8_STAGE_B(PG8_SB(1, 1), cB + hstepB + kstep);
    PG8_WAIT_V(6); PG8_BAR;
    for (;;) {
        const bool has_next = S.next(ui + 1, nxt);
        const char* nA = has_next ? (const char*)g.A + (size_t)nxt.pm * tstepA : cA; const char* nB = has_next ? (const char*)g.Bt + (size_t)nxt.pn * tstepB : cB;
#pragma unroll 1
        for (int t = 0; t < nt; t += 2) {
            const bool last = (t == nt - 2);
            const char* a1 = (t < nt1 ? cA + (size_t)t * kstep : cA2 + (size_t)(t - nt1) * kstep) + kstep;
            const char* a2 = last ? nA : (t + 2 < nt1 ? cA + (size_t)(t + 2) * kstep : cA2 + (size_t)(t + 2 - nt1) * kstep);
            const char* b2 = last ? nB : (t + 2 < nt1 ? cB + (size_t)(t + 2) * kstep : cB2 + (size_t)(t + 2 - nt1) * kstep);
            const char* a3 = a2 + kstep; const char* b3 = b2 + kstep;
            if (last && has_next) S.a_ready(nxt);
            PG8_LDB(B0, 0, 0); PG8_LDB(B1, 0, 1); PG8_SCHED; PG8_LDA(At, 0, 0); PG8_STAGE_A(PG8_SA(1, 1), a1 + hstepA);
            PG8_WAIT_V(8); PG8_WAIT_L(0); PG8_BAR; PG8_MMA(0, 0, At, B0); PG8_MMA(0, 1, At, B1); PG8_BAR; PG8_SCHED;
            PG8_LDA(At, 0, 1); PG8_STAGE_B(PG8_SB(0, 0), b2); PG8_STAGE_B(PG8_SB(0, 1), b2 + hstepB); PG8_STAGE_A(PG8_SA(0, 0), a2);
            PG8_WAIT_V(8); PG8_WAIT_L(0); PG8_BAR; PG8_MMA(1, 0, At, B0); PG8_MMA(1, 1, At, B1); PG8_BAR; PG8_SCHED;
            PG8_LDB(B0, 1, 0); PG8_LDB(B1, 1, 1); PG8_SCHED; PG8_LDA(At, 1, 0); PG8_STAGE_A(PG8_SA(0, 1), a2 + hstepA);
            PG8_WAIT_V(8); PG8_WAIT_L(0); PG8_BAR; PG8_MMA(0, 0, At, B0); PG8_MMA(0, 1, At, B1); PG8_BAR; PG8_SCHED;
            PG8_LDA(At, 1, 1); PG8_STAGE_B(PG8_SB(1, 0), b3); PG8_STAGE_B(PG8_SB(1, 1), b3 + hstepB); PG8_STAGE_A(PG8_SA(1, 0), a3);
            PG8_WAIT_V(8); PG8_WAIT_L(0); PG8_BAR; PG8_MMA(1, 0, At, B0); PG8_MMA(1, 1, At, B1); PG8_BAR; PG8_SCHED;
            if constexpr (Epi::HAS_MID) { if (t + 2 == nt1) { int fr2 = fr, fq2 = fq; asm volatile("" : "+v"(fr2), "+v"(fq2)); E.mid(acc, cur, wr, wc, fr2, fq2); } }
        }
        if constexpr (ALIGN_EPI) { if (wr == 0) PG8_BAR; }
        { int fr2 = fr, fq2 = fq; asm volatile("" : "+v"(fr2), "+v"(fq2));
          E(acc, cur, wr, wc, fr2, fq2); }
        if (!has_next) break;
#pragma unroll
        for (int a = 0; a < 2; ++a)
#pragma unroll
            for (int b = 0; b < 2; ++b)
#pragma unroll
                for (int m = 0; m < 4; ++m)
#pragma unroll
                    for (int n = 0; n < 2; ++n) acc[a][b][m][n] = (f32x4){0.f, 0.f, 0.f, 0.f};
        cur = nxt; cA = nA; cB = nB; ++ui;
        if (two) { cA2 = (const char*)g.A2 + (size_t)cur.pm * tstepA; cB2 = (const char*)g.Bt2 + (size_t)cur.pn * tstepB; } else { cA2 = cA; cB2 = cB; }
        if constexpr (ALIGN_EPI) { if (wr == 1) PG8_BAR; }
    }
    PG8_WAIT_V(0);
    if constexpr (!ALIGN_EPI) { if (wr == 0) PG8_BAR; }
    PG8_BAR;
#undef PG8_SA
#undef PG8_SB
#undef PG8_STAGE_A
#undef PG8_STAGE_B
#undef PG8_LDA
#undef PG8_LDB
#undef PG8_LD8
#undef PG8_LO
#undef PG8_HI
#undef PG8_MMA
#undef PG8_WAIT_V
#undef PG8_WAIT_L
#undef PG8_BAR
#undef PG8_SCHED
}
}
typedef f32x4 AccT[2][2][4][2];

#ifdef PROBE_RELAUNCH
struct Args { const float* in[28]; float* out; unsigned char* ws; int ph_lo, ph_hi, bslot; };
#else
struct Args { const float* in[28]; float* out; unsigned char* ws; int ph_lo, ph_hi; };
#endif
struct Frame {
    LAS unsigned char* lds; int tid, lane, wave, G, blk;
    const float *x, *c, *w_ada, *b_ada, *w_in, *conv_w, *conv_b, *w_rg_a, *b_rg_a, *w_rg_x, *b_rg_x, *rg_lambda, *w_rnn_out, *q_norm_g, *w_uq, *kv_norm_g, *w_ukv,
                *w_mla_out, *w_o, *ln1_g, *ln1_b, *peer_wq, *peer_keys, *peer_u, *peer_v, *ln2_g, *ln2_b;
    const int* positions;
    float* out; unsigned char* ws;
};
#define WSP(T, off) ((T*)(F.ws + (off)))

template <int MAP> __device__ __forceinline__ int colmap(int n) {
    if (MAP == 0) return n;
    if (MAP == 1) return n < 5120 ? n : (n < 9216 ? n + 64 : (n < 9280 ? n - 4096 : -1));
    if (MAP == 2) { if (n < 2048) return (n >> 7) * 192 + (n & 127); const int m = n - 2048, h = m >> 6, jj = m & 63; return h * 192 + 128 + (jj >> 1) + 32 * (jj & 1); }
    if (MAP == 3) return (n >> 7) * 256 + (n & 127);
    return (n >> 7) * 256 + 128 + (n & 127);
}
template <int MAP, bool F8> __device__ __forceinline__ void tr_item64(const float* W, int ldw, void* WTv, int ldt, float scale, const float* kscale, LAS float* scr, int k0, int n0, int lane) {
    const int col = colmap<MAP>(n0 + lane);
#pragma unroll
    for (int kk = 0; kk < 64; ++kk) { float v = 0.f;
        if (col >= 0) { v = W[(size_t)(k0 + kk) * ldw + col] * scale; if (kscale) v *= kscale[k0 + kk]; }
        scr[kk * 65 + lane] = v; }
    LDS_WAIT();
    const LAS float* sp = scr + lane;
    if (F8) { unsigned char* o = (unsigned char*)WTv + (size_t)(n0 + lane) * ldt + k0;
#pragma unroll
        for (int q = 0; q < 4; ++q) { u32x4 w;
#pragma unroll
            for (int d = 0; d < 4; ++d) { const int k = 16 * q + 4 * d; w[d] = pk4_f8(sp[k * 65], sp[(k + 1) * 65], sp[(k + 2) * 65], sp[(k + 3) * 65]); }
            *(u32x4*)(o + 16 * q) = w; }
    } else { bf16* o = (bf16*)WTv + (size_t)(n0 + lane) * ldt + k0;
#pragma unroll
        for (int q = 0; q < 8; ++q) { u32x4 w;
#pragma unroll
            for (int d = 0; d < 4; ++d) { const int k = 8 * q + 2 * d; w[d] = pk2(sp[k * 65], sp[(k + 1) * 65]); }
            *(u32x4*)(o + 8 * q) = w; } }
    LDS_WAIT();
}
__device__ __forceinline__ void p0_prologue(Frame& F, int qbank = 0) {
    const int tid = F.tid, lane = F.lane;
    if (F.blk < 192) {
        LAS float* ca = (LAS float*)F.lds; LAS float* red = (LAS float*)(F.lds + 32768);
        for (int i = tid; i < NB * DM; i += NTHREADS) { const float v = F.c[i]; ca[i] = v * sigmoidf_(v); }
        __syncthreads();
        const int cq = tid & 15, rg = tid >> 4, c0 = 64 * F.blk + 4 * cq;
        f32x4 a0 = {0, 0, 0, 0}, a1 = a0, a2 = a0, a3 = a0;
#pragma unroll 8
        for (int k = rg; k < DM; k += 32) { const f32x4 w = *(const f32x4*)(F.w_ada + (size_t)k * 12288 + c0);
            a0 += ca[k] * w; a1 += ca[DM + k] * w; a2 += ca[2 * DM + k] * w; a3 += ca[3 * DM + k] * w; }
        *(LAS f32x4*)(red + (rg * 4 + 0) * 64 + 4 * cq) = a0; *(LAS f32x4*)(red + (rg * 4 + 1) * 64 + 4 * cq) = a1;
        *(LAS f32x4*)(red + (rg * 4 + 2) * 64 + 4 * cq) = a2; *(LAS f32x4*)(red + (rg * 4 + 3) * 64 + 4 * cq) = a3;
        __syncthreads();
        if (tid < 256) { const int b = tid >> 6, col = tid & 63; float s = 0.f;
            for (int r = 0; r < 32; ++r) s += red[(r * 4 + b) * 64 + col];
            WSP(float, WS_MOD)[b * 12288 + 64 * F.blk + col] = s + F.b_ada[64 * F.blk + col]; }
        __syncthreads();
    }
    {
        LAS float* scr = (LAS float*)(F.lds + F.wave * 16640);
        unsigned* qhead = (unsigned*)(F.ws + WS_CTL) + 8192 + 2048 * qbank + 64 * (F.blk & 31);
        constexpr int I_IN = (NPROJ / 64) * (DM / 64), I_SQ = (DM / 64) * (DM / 64), I_UQ = (3072 / 64) * (512 / 64), I_UK = (2048 / 64) * (512 / 64), I_RG = 16 * 2 * 2;
        constexpr int NITEMS = I_IN + 4 * I_SQ + I_UQ + 2 * I_UK + 2 * I_RG;
        int nxt = 0; if (lane == 0) nxt = (int)__hip_atomic_fetch_add(qhead, 1u, __ATOMIC_RELAXED, __HIP_MEMORY_SCOPE_AGENT);
        for (;;) {
            const int it = __builtin_amdgcn_readfirstlane(nxt) * 32 + (F.blk & 31); if (it >= NITEMS) break;
            if (lane == 0) nxt = (int)__hip_atomic_fetch_add(qhead, 1u, __ATOMIC_RELAXED, __HIP_MEMORY_SCOPE_AGENT);
            int r = it;
            if (r < I_IN) { tr_item64<1, true>(F.w_in, IN_COLS, WSP(unsigned char, WS_WIN), DM, SC_WIN, nullptr, scr, 64 * (r / (NPROJ / 64)), 64 * (r % (NPROJ / 64)), lane); continue; } r -= I_IN;
            if (r < I_SQ) { tr_item64<0, true>(F.w_rnn_out, DM, WSP(unsigned char, WS_WRNN), DM, SC_WSQ, nullptr, scr, 64 * (r / 32), 64 * (r % 32), lane); continue; } r -= I_SQ;
            if (r < I_SQ) { tr_item64<0, true>(F.w_mla_out, DM, WSP(unsigned char, WS_WMLA), DM, SC_WSQ, nullptr, scr, 64 * (r / 32), 64 * (r % 32), lane); continue; } r -= I_SQ;
            if (r < I_SQ) { tr_item64<0, true>(F.w_o, DM, WSP(unsigned char, WS_WO), DM, SC_WSQ, nullptr, scr, 64 * (r / 32), 64 * (r % 32), lane); continue; } r -= I_SQ;
            if (r < I_SQ) {
                const int k0 = 64 * (r / 32), n0 = 64 * (r % 32); float am = 0.f;
#pragma unroll
                for (int kk = 0; kk < 64; ++kk) am = fmaxf(am, fabsf(F.peer_wq[(size_t)(k0 + kk) * DM + n0 + lane]));
                (void)__hip_atomic_fetch_max((unsigned*)(F.ws + WS_CTL + CTL_WQAMAX) + n0 + lane, __float_as_uint(am), __ATOMIC_RELAXED, __HIP_MEMORY_SCOPE_AGENT);
                continue; } r -= I_SQ;
            if (r < I_UQ) { tr_item64<2, true>(F.w_uq, 3072, WSP(unsigned char, WS_WUQ), 512, SC_WIN, F.q_norm_g, scr, 64 * (r / 48), 64 * (r % 48), lane); continue; } r -= I_UQ;
            if (r < I_UK) { tr_item64<3, true>(F.w_ukv, 4096, WSP(unsigned char, WS_WUK), 512, SC_WIN, F.kv_norm_g, scr, 64 * (r / 32), 64 * (r % 32), lane); continue; } r -= I_UK;
            if (r < I_UK) { tr_item64<4, true>(F.w_ukv, 4096, WSP(unsigned char, WS_WUV), 512, SC_WIN, F.kv_norm_g, scr, 64 * (r / 32), 64 * (r % 32), lane); continue; } r -= I_UK;
            if (r < I_RG) { const int h = r >> 2, q = r & 3; tr_item64<0, false>(F.w_rg_a + h * 16384, 128, WSP(bf16, WS_WGA) + h * 16384, 128, 1.0f, nullptr, scr, 64 * (q >> 1), 64 * (q & 1), lane); continue; } r -= I_RG;
            { const int h = r >> 2, q = r & 3; tr_item64<0, false>(F.w_rg_x + h * 16384, 128, WSP(bf16, WS_WGX) + h * 16384, 128, 1.0f, nullptr, scr, 64 * (q >> 1), 64 * (q & 1), lane); }
        }
    }
    {
        const int gt = F.blk * NTHREADS + tid, NGT = F.G * NTHREADS;
        f32x2* rope = WSP(f32x2, WS_ROPE);
        for (int i = gt; i < NT * 32; i += NGT) { const int t = i >> 5, j = i & 31;
            const float inv_freq = exp2f(-(float)j * (13.287712379549449f / 32.0f));
            const float ang = (float)F.positions[t] * inv_freq;
            double rev = (double)ang * 0.15915494309189535; rev -= rint(rev);
            const float rv = (float)rev;
            rope[i] = (f32x2){__builtin_amdgcn_cosf(rv), __builtin_amdgcn_sinf(rv)}; }
        bf16* pk = WSP(bf16, WS_PKEYS);
        for (int i = gt; i < 2 * 128 * 128 / 2; i += NGT) { const f32x2 v = *(const f32x2*)(F.peer_keys + 2 * i); ((unsigned*)pk)[i] = pk2(v.x, v.y); }
    }
}

__device__ __forceinline__ void p1_modulate(Frame& F) {
    const int gw = F.blk * NWAVES + F.wave, NGW = F.G * NWAVES;
    const float* mod = WSP(float, WS_MOD); unsigned char* hb = WSP(unsigned char, WS_S0);
    for (int m = gw; m < NT; m += NGW) {
        const int b = m >> 13; const float* sh = mod + b * 12288; const float* sc = sh + 2048;
#pragma unroll
        for (int j = 0; j < 2; ++j) { const int col = 1024 * j + 16 * F.lane; u32x4 o;
#pragma unroll
            for (int q = 0; q < 4; ++q) { const f32x4 v = *(const f32x4*)(F.x + (size_t)m * DM + col + 4 * q), s = *(const f32x4*)(sc + col + 4 * q), h = *(const f32x4*)(sh + col + 4 * q);
                o[q] = pk4_f8((v.x * (1.f + s.x) + h.x) * SC_H, (v.y * (1.f + s.y) + h.y) * SC_H, (v.z * (1.f + s.z) + h.z) * SC_H, (v.w * (1.f + s.w) + h.w) * SC_H); }
            *(u32x4*)(hb + (size_t)m * DM + col) = o; }
    }
    if (F.wave < 4) {
        const int lane = F.lane, it = F.blk * 4 + F.wave;
        LAS float* scr = (LAS float*)(F.lds + F.wave * 16640);
        for (int r = it; r < 1024; r += 4 * F.G) {
            const int k0 = 64 * (r / 32), n0 = 64 * (r % 32);
            const float am = fmaxf(__uint_as_float(((const unsigned*)(F.ws + WS_CTL + CTL_WQAMAX))[n0 + lane]), 1e-30f), qs = 127.0f / am;
#pragma unroll
            for (int kk = 0; kk < 64; ++kk) scr[kk * 65 + lane] = F.peer_wq[(size_t)(k0 + kk) * DM + n0 + lane];
            LDS_WAIT();
            if (k0 == 0) WSP(float, WS_WQS)[n0 + lane] = am * (1.0f / 127.0f);
            const LAS float* sp = scr + lane;
            unsigned char* o = WSP(unsigned char, WS_WPQ) + (size_t)(n0 + lane) * DM + k0;
#pragma unroll
            for (int q = 0; q < 4; ++q) { u32x4 w;
#pragma unroll
                for (int d = 0; d < 4; ++d) { const int k = 16 * q + 4 * d; w[d] = pk4_i8(sp[k * 65] * qs, sp[(k + 1) * 65] * qs, sp[(k + 2) * 65] * qs, sp[(k + 3) * 65] * qs); }
                *(u32x4*)(o + 16 * q) = w; }
            LDS_WAIT();
        }
    }
}

#define EPI_ROWS(...) _Pragma("unroll") for (int ai = 0; ai < 2; ++ai) _Pragma("unroll") for (int m = 0; m < 4; ++m) { const int row = u.pm * 256 + ai * 128 + wr * 64 + m * 16 + fr; \
    _Pragma("unroll") for (int bj = 0; bj < 2; ++bj) { const int cl = bj * 128 + wc * 32 + 8 * fq; const f32x4 v0 = acc[ai][bj][m][0] * esc, v1 = acc[ai][bj][m][1] * esc; __VA_ARGS__ } }
__device__ __forceinline__ u32x4 pack8(const f32x4 a, const f32x4 b) { return (u32x4){pk2(a.x, a.y), pk2(a.z, a.w), pk2(b.x, b.y), pk2(b.z, b.w)}; }

struct EpiProj {
    static constexpr bool HAS_MID = false;
    static constexpr bool PERM = true;
    bf16 *XR, *GG; unsigned char *QC8, *KVC8; bf16 *SGR, *SGM; float *KR, *SS; float esc;
    __device__ __forceinline__ void operator()(const AccT& acc, const pg8::Unit& u, int wr, int wc, int fr, int fq) const {
        const int pn = u.pn;
        if (pn < 8) { bf16* O = XR + pn * 256;
            EPI_ROWS( *(u32x4*)(O + (size_t)row * DM + cl) = pack8(v0, v1); )
        } else if (pn < 16) { bf16* O = GG + (pn - 8) * 256;
            EPI_ROWS( f32x4 a, b; for (int e = 0; e < 4; ++e) { a[e] = gelu_tanh(v0[e]); b[e] = gelu_tanh(v1[e]); } *(u32x4*)(O + (size_t)row * DM + cl) = pack8(a, b); )
        } else if (pn < 20) { const int which = (pn >= 18); const int c0 = (pn & 1) * 256;
#pragma unroll
            for (int ai = 0; ai < 2; ++ai)
#pragma unroll
                for (int m = 0; m < 4; ++m) { const int row = u.pm * 256 + ai * 128 + wr * 64 + m * 16 + fr; float s = 0.f;
#pragma unroll
                    for (int bj = 0; bj < 2; ++bj) { const int cl = bj * 128 + wc * 32 + 8 * fq; const f32x4 v0 = acc[ai][bj][m][0] * esc, v1 = acc[ai][bj][m][1] * esc;
                        *(u32x2*)((which ? KVC8 : QC8) + (size_t)row * 512 + c0 + cl) = (u32x2){pk4_f8(v0.x * SC_H, v0.y * SC_H, v0.z * SC_H, v0.w * SC_H), pk4_f8(v1.x * SC_H, v1.y * SC_H, v1.z * SC_H, v1.w * SC_H)};
                        s += (v0.x * v0.x + v0.y * v0.y) + (v0.z * v0.z + v0.w * v0.w) + (v1.x * v1.x + v1.y * v1.y) + (v1.z * v1.z + v1.w * v1.w); }
                    SS[(size_t)row * 64 + which * 32 + (pn & 1) * 16 + wc * 4 + fq] = s; }
        } else if (pn < 36) { bf16* O = (pn < 28 ? SGR + (pn - 20) * 256 : SGM + (pn - 28) * 256);
            EPI_ROWS( f32x4 a, b; for (int e = 0; e < 4; ++e) { a[e] = sigmoidf_(v0[e]); b[e] = sigmoidf_(v1[e]); } *(u32x4*)(O + (size_t)row * DM + cl) = pack8(a, b); )
        } else {
            EPI_ROWS( if (cl < 64) { *(f32x4*)(KR + (size_t)row * 64 + cl) = v0; *(f32x4*)(KR + (size_t)row * 64 + cl + 4) = v1; } )
        }
    }
};
struct EpiGate1 {
    static constexpr bool HAS_MID = false;
    static constexpr bool PERM = true; const bf16* SG; bf16* O; float esc;
    __device__ __forceinline__ void operator()(const AccT& acc, const pg8::Unit& u, int wr, int wc, int fr, int fq) const {
        EPI_ROWS( const size_t off = (size_t)row * DM + u.pn * 256 + cl; const u32x4 g = *(const u32x4*)(SG + off);
            f32x4 a = {v0.x * bflo(g.x), v0.y * bfhi(g.x), v0.z * bflo(g.y), v0.w * bfhi(g.y)}, b = {v1.x * bflo(g.z), v1.y * bfhi(g.z), v1.z * bflo(g.w), v1.w * bfhi(g.w)};
            *(u32x4*)(O + off) = pack8(a, b); )
    }
};
struct EpiGate2 {
    static constexpr bool HAS_MID = false;
    static constexpr bool PERM = true; const bf16* SG; const bf16* T; unsigned char* O8; float esc;
    __device__ __forceinline__ void operator()(const AccT& acc, const pg8::Unit& u, int wr, int wc, int fr, int fq) const {
        EPI_ROWS( const size_t off = (size_t)row * DM + u.pn * 256 + cl; const u32x4 g = *(const u32x4*)(SG + off); const u32x4 p = *(const u32x4*)(T + off);
            *(u32x2*)(O8 + off) = (u32x2){pk4_f8((bflo(p.x) + v0.x * bflo(g.x)) * SC_TMP, (bfhi(p.x) + v0.y * bfhi(g.x)) * SC_TMP, (bflo(p.y) + v0.z * bflo(g.y)) * SC_TMP, (bfhi(p.y) + v0.w * bfhi(g.y)) * SC_TMP),
                                          pk4_f8((bflo(p.z) + v1.x * bflo(g.z)) * SC_TMP, (bfhi(p.z) + v1.y * bfhi(g.z)) * SC_TMP, (bflo(p.w) + v1.z * bflo(g.w)) * SC_TMP, (bfhi(p.w) + v1.w * bfhi(g.w)) * SC_TMP)}; )
    }
};
struct EpiMix {
    static constexpr bool HAS_MID = true;
    static constexpr bool PERM = true; const bf16* SGR; const bf16* SGM; unsigned char* O8; float r12, e2;
    __device__ __forceinline__ void mid(AccT& acc, const pg8::Unit& u, int wr, int wc, int fr, int fq) const {
#pragma unroll
        for (int ai = 0; ai < 2; ++ai) {
            u32x4 gr[8], gm[8];
#pragma unroll
            for (int m = 0; m < 4; ++m)
#pragma unroll
                for (int bj = 0; bj < 2; ++bj) { const size_t off = (size_t)(u.pm * 256 + ai * 128 + wr * 64 + m * 16 + fr) * DM + u.pn * 256 + bj * 128 + wc * 32 + 8 * fq;
                    gr[m * 2 + bj] = *(const u32x4*)(SGR + off); gm[m * 2 + bj] = *(const u32x4*)(SGM + off); }
            __builtin_amdgcn_sched_barrier(0);
#pragma unroll
            for (int m = 0; m < 4; ++m)
#pragma unroll
                for (int bj = 0; bj < 2; ++bj) { const u32x4 r = gr[m * 2 + bj], d = gm[m * 2 + bj];
                    const f32x4 n0 = {bflo(r.x), bfhi(r.x), bflo(r.y), bfhi(r.y)}, n1 = {bflo(r.z), bfhi(r.z), bflo(r.w), bfhi(r.w)};
                    const f32x4 d0 = {bflo(d.x), bfhi(d.x), bflo(d.y), bfhi(d.y)}, d1 = {bflo(d.z), bfhi(d.z), bflo(d.w), bfhi(d.w)};
#pragma unroll
                    for (int e = 0; e < 4; ++e) { acc[ai][bj][m][0][e] *= r12 * n0[e] * __builtin_amdgcn_rcpf(fmaxf(d0[e], 1e-12f)); acc[ai][bj][m][1][e] *= r12 * n1[e] * __builtin_amdgcn_rcpf(fmaxf(d1[e], 1e-12f)); } }
            __builtin_amdgcn_sched_barrier(0);
        }
    }
    __device__ __forceinline__ void operator()(const AccT& acc, const pg8::Unit& u, int wr, int wc, int fr, int fq) const {
        const float esc = e2 * SC_TMP;
#pragma unroll
        for (int ai = 0; ai < 2; ++ai) {
            u32x4 gmv[8];
#pragma unroll
            for (int m = 0; m < 4; ++m)
#pragma unroll
                for (int bj = 0; bj < 2; ++bj) gmv[m * 2 + bj] = *(const u32x4*)(SGM + (size_t)(u.pm * 256 + ai * 128 + wr * 64 + m * 16 + fr) * DM + u.pn * 256 + bj * 128 + wc * 32 + 8 * fq);
            __builtin_amdgcn_sched_barrier(0);
#pragma unroll
            for (int m = 0; m < 4; ++m)
#pragma unroll
                for (int bj = 0; bj < 2; ++bj) { const size_t off = (size_t)(u.pm * 256 + ai * 128 + wr * 64 + m * 16 + fr) * DM + u.pn * 256 + bj * 128 + wc * 32 + 8 * fq; const u32x4 gm = gmv[m * 2 + bj];
                    const f32x4 v0 = acc[ai][bj][m][0] * esc, v1 = acc[ai][bj][m][1] * esc;
                    *(u32x2*)(O8 + off) = (u32x2){pk4_f8(v0.x * fmaxf(bflo(gm.x), 1e-12f), v0.y * fmaxf(bfhi(gm.x), 1e-12f), v0.z * fmaxf(bflo(gm.y), 1e-12f), v0.w * fmaxf(bfhi(gm.y), 1e-12f)),
                                                  pk4_f8(v1.x * fmaxf(bflo(gm.z), 1e-12f), v1.y * fmaxf(bfhi(gm.z), 1e-12f), v1.z * fmaxf(bflo(gm.w), 1e-12f), v1.w * fmaxf(bfhi(gm.w), 1e-12f))}; }
            __builtin_amdgcn_sched_barrier(0);
        }
    }
};
struct EpiRes1 {
    static constexpr bool HAS_MID = false;
    static constexpr bool PERM = true; const float* X; const float* mod; bf16* R; float esc;
    __device__ __forceinline__ void operator()(const AccT& acc, const pg8::Unit& u, int wr, int wc, int fr, int fq) const {
        f32x4 g[2][2];
#pragma unroll
        for (int bj = 0; bj < 2; ++bj) { const float* gt = mod + ((u.pm * 256) >> 13) * 12288 + 4096 + u.pn * 256 + bj * 128 + wc * 32 + 8 * fq; g[bj][0] = 1.f + *(const f32x4*)gt; g[bj][1] = 1.f + *(const f32x4*)(gt + 4); }
#pragma unroll
        for (int ai = 0; ai < 2; ++ai) {
            f32x4 xv[8][2];
#pragma unroll
            for (int m = 0; m < 4; ++m)
#pragma unroll
                for (int bj = 0; bj < 2; ++bj) { const float* xp = X + (size_t)(u.pm * 256 + ai * 128 + wr * 64 + m * 16 + fr) * DM + u.pn * 256 + bj * 128 + wc * 32 + 8 * fq; xv[m * 2 + bj][0] = *(const f32x4*)xp; xv[m * 2 + bj][1] = *(const f32x4*)(xp + 4); }
            __builtin_amdgcn_sched_barrier(0);
#pragma unroll
            for (int m = 0; m < 4; ++m)
#pragma unroll
                for (int bj = 0; bj < 2; ++bj) { const size_t off = (size_t)(u.pm * 256 + ai * 128 + wr * 64 + m * 16 + fr) * DM + u.pn * 256 + bj * 128 + wc * 32 + 8 * fq;
                    *(u32x4*)(R + off) = pack8(DN_ALPHA * xv[m * 2 + bj][0] + g[bj][0] * (acc[ai][bj][m][0] * esc), DN_ALPHA * xv[m * 2 + bj][1] + g[bj][1] * (acc[ai][bj][m][1] * esc)); }
            __builtin_amdgcn_sched_barrier(0);
        }
    }
};
struct EpiQuery {
    static constexpr bool HAS_MID = false;
    static constexpr bool PERM = true; bf16* O; const float* HS; const float* WS;
    __device__ __forceinline__ void operator()(const AccT& acc, const pg8::Unit& u, int wr, int wc, int fr, int fq) const {
        float hsv[2][4]; f32x4 wsv[2][2];
#pragma unroll
        for (int ai = 0; ai < 2; ++ai)
#pragma unroll
            for (int m = 0; m < 4; ++m) hsv[ai][m] = HS[u.pm * 256 + ai * 128 + wr * 64 + m * 16 + fr];
#pragma unroll
        for (int bj = 0; bj < 2; ++bj) { const int col = u.pn * 256 + bj * 128 + wc * 32 + 8 * fq; wsv[bj][0] = *(const f32x4*)(WS + col); wsv[bj][1] = *(const f32x4*)(WS + col + 4); }
        __builtin_amdgcn_sched_barrier(0);
#pragma unroll
        for (int ai = 0; ai < 2; ++ai)
#pragma unroll
            for (int m = 0; m < 4; ++m) { const int row = u.pm * 256 + ai * 128 + wr * 64 + m * 16 + fr; const float hs = hsv[ai][m];
#pragma unroll
                for (int bj = 0; bj < 2; ++bj) { const int col = u.pn * 256 + bj * 128 + wc * 32 + 8 * fq; const f32x4 w0 = wsv[bj][0] * hs, w1 = wsv[bj][1] * hs;
                    const i32x4 a0 = __builtin_bit_cast(i32x4, acc[ai][bj][m][0]), a1 = __builtin_bit_cast(i32x4, acc[ai][bj][m][1]);
                    const f32x4 v0 = {(float)a0.x * w0.x, (float)a0.y * w0.y, (float)a0.z * w0.z, (float)a0.w * w0.w}, v1 = {(float)a1.x * w1.x, (float)a1.y * w1.y, (float)a1.z * w1.z, (float)a1.w * w1.w};
                    *(u32x4*)(O + (size_t)row * DM + col) = pack8(v0, v1); } }
    }
};
#ifdef PROBE_GEMM
struct EpiNull {
    static constexpr bool HAS_MID = false;
    static constexpr bool PERM = true; float* O;
    __device__ __forceinline__ void operator()(const AccT& acc, const pg8::Unit& u, int wr, int wc, int fr, int fq) const {
        f32x4 s = {0.f, 0.f, 0.f, 0.f};
#pragma unroll
        for (int ai = 0; ai < 2; ++ai)
#pragma unroll
            for (int bj = 0; bj < 2; ++bj)
#pragma unroll
                for (int m = 0; m < 4; ++m) s += acc[ai][bj][m][0] + acc[ai][bj][m][1];
        *(f32x4*)(O + ((size_t)(u.pm * 8 + u.pn) * 512 + (wr * 4 + wc) * 64 + fq * 16 + fr) * 4) = s;
    }
};
#endif
struct EpiPlain {
    static constexpr bool HAS_MID = false;
    static constexpr bool PERM = true; bf16* O; float esc;
    __device__ __forceinline__ void operator()(const AccT& acc, const pg8::Unit& u, int wr, int wc, int fr, int fq) const {
        EPI_ROWS( *(u32x4*)(O + (size_t)row * DM + u.pn * 256 + cl) = pack8(v0, v1); )
    }
};
struct EpiQ {
    static constexpr bool HAS_MID = false;
    static constexpr bool PERM = true; unsigned char* Q; const float* SS; const f32x2* rope; float esc;
    __device__ __forceinline__ void operator()(const AccT& acc, const pg8::Unit& u, int wr, int wc, int fr, int fq) const {
        const bool is_rope = u.pn >= 8;
        float rsv[2][4];
#pragma unroll
        for (int ai = 0; ai < 2; ++ai)
#pragma unroll
            for (int m = 0; m < 4; ++m) rsv[ai][m] = SS[(size_t)(u.pm * 256 + ai * 128 + wr * 64 + m * 16 + fr) * 2];
        __builtin_amdgcn_sched_barrier(0);
        EPI_ROWS( const float rs = rsv[ai][m] * (QSCALE * SC_Q); const int b = row >> 13, s = row & 8191;
            if (!is_rope) { const int cg = u.pn * 256 + cl, h = cg >> 7, d = cg & 127;
                *(u32x2*)(Q + (unsigned)(((b * NH + h) * SEQ + s) * DQK + d)) = (u32x2){pk4_f8(v0.x * rs, v0.y * rs, v0.z * rs, v0.w * rs), pk4_f8(v1.x * rs, v1.y * rs, v1.z * rs, v1.w * rs)};
            } else { const int cg = (u.pn - 8) * 256 + cl, h = cg >> 6, jj = cg & 63; const f32x4* cs = (const f32x4*)(rope + (size_t)row * 32 + (jj >> 1));
                const f32x4 c0 = cs[0], c1 = cs[1];
                *(u32x2*)(Q + (unsigned)(((b * NH + h) * SEQ + s) * DQK + 128 + jj)) = (u32x2){
                    pk4_f8((v0.x * c0.x - v0.y * c0.y) * rs, (v0.y * c0.x + v0.x * c0.y) * rs, (v0.z * c0.z - v0.w * c0.w) * rs, (v0.w * c0.z + v0.z * c0.w) * rs),
                    pk4_f8((v1.x * c1.x - v1.y * c1.y) * rs, (v1.y * c1.x + v1.x * c1.y) * rs, (v1.z * c1.z - v1.w * c1.w) * rs, (v1.w * c1.z + v1.z * c1.w) * rs)}; } )
    }
};
struct EpiK {
    static constexpr bool HAS_MID = false;
    static constexpr bool PERM = true; unsigned char* K; const float* SS; float esc;
    __device__ __forceinline__ void operator()(const AccT& acc, const pg8::Unit& u, int wr, int wc, int fr, int fq) const {
        float rsv[2][4];
#pragma unroll
        for (int ai = 0; ai < 2; ++ai)
#pragma unroll
            for (int m = 0; m < 4; ++m) rsv[ai][m] = SS[(size_t)(u.pm * 256 + ai * 128 + wr * 64 + m * 16 + fr) * 2 + 1];
        __builtin_amdgcn_sched_barrier(0);
        EPI_ROWS( const float rs = rsv[ai][m] * SC_K; const int b = row >> 13, s = row & 8191;
            const int cg = u.pn * 256 + cl, h = cg >> 7, d = cg & 127;
            *(u32x2*)(K + (unsigned)(((b * NH + h) * SEQ + s) * DQK + d)) = (u32x2){pk4_f8(v0.x * rs, v0.y * rs, v0.z * rs, v0.w * rs), pk4_f8(v1.x * rs, v1.y * rs, v1.z * rs, v1.w * rs)}; )
    }
};
struct EpiVT {
    static constexpr bool HAS_MID = false;
    static constexpr bool PERM = true; unsigned char* VT; const float* SS; float esc;
    __device__ __forceinline__ void operator()(const AccT& acc, const pg8::Unit& u, int wr, int wc, int fr, int fq) const {
#pragma unroll
        for (int bj = 0; bj < 2; ++bj) {
            const int cl = bj * 128 + wc * 32 + 8 * fq; const int t0 = u.pn * 256 + cl, b = t0 >> 13, s = t0 & 8191; const f32x4* sp = (const f32x4*)(SS + (size_t)t0 * 2);
            const f32x4 s0 = sp[0] * SC_V, s1 = sp[1] * SC_V, s2 = sp[2] * SC_V, s3 = sp[3] * SC_V;
            __builtin_amdgcn_sched_barrier(0);
#pragma unroll
            for (int ai = 0; ai < 2; ++ai)
#pragma unroll
                for (int m = 0; m < 4; ++m) { const int row = u.pm * 256 + ai * 128 + wr * 64 + m * 16 + fr, h = row >> 7, d = row & 127; const f32x4 v0 = acc[ai][bj][m][0] * esc, v1 = acc[ai][bj][m][1] * esc;
                    *(u32x2*)(VT + (unsigned)(((((b * NH + h) * 128 + (s >> 6)) * 128 + d) * 64 + (s & 63)))) = (u32x2){pk4_f8(v0.x * s0.y, v0.y * s0.w, v0.z * s1.y, v0.w * s1.w), pk4_f8(v1.x * s2.y, v1.y * s2.w, v1.z * s3.y, v1.w * s3.w)}; }
            __builtin_amdgcn_sched_barrier(0);
        }
    }
};

constexpr int RG_W = 288;
constexpr int RG_SUB = 64;
constexpr int RG_XC = 0, RG_GGT = 36864, RG_OUT = 69632;
__device__ __forceinline__ unsigned char* rg_ab(unsigned char* ws, int tile) { return tile < 1536 ? ws + WS_TMP + (size_t)tile * 131072 : ws + WS_AO8 + (size_t)(tile - 1536) * 131072; }
__device__ __forceinline__ float rg_h_lo(unsigned w) { return (float)__builtin_bit_cast(_Float16, (unsigned short)(w & 0xffffu)); }
__device__ __forceinline__ float rg_h_hi(unsigned w) { return (float)__builtin_bit_cast(_Float16, (unsigned short)(w >> 16)); }
struct RgMap { float A, H; };
__device__ __forceinline__ RgMap rg_then(const RgMap f, const RgMap g) { return RgMap{f.A * g.A, g.A * f.H + g.H}; }
__device__ __forceinline__ void rglru_passA(Frame& F) {
    const int tid = F.tid, lane = F.lane, wave = F.wave;
    {
        const float* ssp = WSP(float, WS_SSP); float* rs = WSP(float, WS_RS);
        for (int i = F.blk * NTHREADS + tid; i < NT * 2; i += F.G * NTHREADS) { const f32x4* p = (const f32x4*)(ssp + (size_t)i * 32); float s = 0.f;
#pragma unroll
            for (int k = 0; k < 8; ++k) { const f32x4 a = p[k]; s += (a.x + a.y) + (a.z + a.w); }
            rs[i] = __builtin_amdgcn_rsqf(s * (1.f / 512.f) + RMS_EPS); } }
    LAS unsigned char* L = F.lds;
    const bf16* XR = WSP(bf16, WS_XR); float* SUMM = WSP(float, WS_SUMM);
    const int q = lane >> 4;
    for (int tile = F.blk; tile < NB * 32 * NH; tile += F.G) {
        const int hh = tile & 15, c = (tile >> 4) & 31, b = tile >> 9;
        const int ech = 16 * wave + (lane & 15), egch = hh * 128 + ech;
        bf16x8 bA[4], bX[4];
        { const bf16* ga = WSP(bf16, WS_WGA) + hh * 16384 + ech * 128 + 8 * (lane >> 4); const bf16* gx = WSP(bf16, WS_WGX) + hh * 16384 + ech * 128 + 8 * (lane >> 4);
#pragma unroll
            for (int ks = 0; ks < 4; ++ks) { bA[ks] = *(const bf16x8*)(ga + 32 * ks); bX[ks] = *(const bf16x8*)(gx + 32 * ks); } }
        const float e_ba = F.b_rg_a[egch], e_bx = F.b_rg_x[egch];
        const float lam = F.rg_lambda[egch]; const float e_sp8 = -8.0f * 1.4426950408889634f * ((lam > 15.f) ? expf(-lam) : (lam < -15.f ? -lam : log1pf(expf(-lam))));
        const int crow = tid >> 4, c8 = (tid & 15) * 8, cg = hh * 128 + c8;
        float cw[4][8], cb[8];
#pragma unroll
        for (int w = 0; w < 4; ++w) { const f32x4 p = *(const f32x4*)(F.conv_w + w * DM + cg), qq = *(const f32x4*)(F.conv_w + w * DM + cg + 4);
            cw[w][0] = p.x; cw[w][1] = p.y; cw[w][2] = p.z; cw[w][3] = p.w; cw[w][4] = qq.x; cw[w][5] = qq.y; cw[w][6] = qq.z; cw[w][7] = qq.w; }
        { const f32x4 p = *(const f32x4*)(F.conv_b + cg), qq = *(const f32x4*)(F.conv_b + cg + 4); cb[0] = p.x; cb[1] = p.y; cb[2] = p.z; cb[3] = p.w; cb[4] = qq.x; cb[5] = qq.y; cb[6] = qq.z; cb[7] = qq.w; }
        float S = 0.f, atot = 1.f;
        u32x4* abw = (u32x4*)rg_ab(F.ws, tile) + (wave * 64 + lane) * 4;
        const size_t tbase = (size_t)b * SEQ + c * 256;
        u32x4 xn[2][4];
#pragma unroll
        for (int hf = 0; hf < 2; ++hf)
#pragma unroll
            for (int w = 0; w < 4; ++w) { const int rr = crow + 32 * hf - 3 + w; xn[hf][w] = (u32x4){0u, 0u, 0u, 0u}; if (c * 256 + rr >= 0) xn[hf][w] = *(const u32x4*)(XR + (tbase + rr) * DM + cg); }
#pragma unroll 1
        for (int sub = 0; sub < 256 / RG_SUB; ++sub) {
            const size_t t0 = tbase + sub * RG_SUB;
            LAS unsigned char* XC = L + RG_XC + (sub & 1) * 18432;
#pragma unroll
            for (int hf = 0; hf < 2; ++hf) { float a[8];
#pragma unroll
                for (int e = 0; e < 8; ++e) a[e] = cb[e];
#pragma unroll
                for (int w = 0; w < 4; ++w) { const u32x4 xv = xn[hf][w];
                    a[0] += cw[w][0] * bflo(xv.x); a[1] += cw[w][1] * bfhi(xv.x); a[2] += cw[w][2] * bflo(xv.y); a[3] += cw[w][3] * bfhi(xv.y);
                    a[4] += cw[w][4] * bflo(xv.z); a[5] += cw[w][5] * bfhi(xv.z); a[6] += cw[w][6] * bflo(xv.w); a[7] += cw[w][7] * bfhi(xv.w); }
                *(LAS u32x4*)(XC + (crow + 32 * hf) * RG_W + c8 * 2) = (u32x4){pk2(a[0], a[1]), pk2(a[2], a[3]), pk2(a[4], a[5]), pk2(a[6], a[7])}; }
            __syncthreads();
            if (sub + 1 < 256 / RG_SUB) {
#pragma unroll
                for (int hf = 0; hf < 2; ++hf)
#pragma unroll
                    for (int w = 0; w < 4; ++w) xn[hf][w] = *(const u32x4*)(XR + (t0 + RG_SUB + crow + 32 * hf - 3 + w) * DM + cg); }
            f32x4 accA[4], accX[4];
#pragma unroll
            for (int rb = 0; rb < 4; ++rb) { accA[rb] = (f32x4){0, 0, 0, 0}; accX[rb] = (f32x4){0, 0, 0, 0}; }
#pragma unroll
            for (int ks = 0; ks < 4; ++ks) { const int ko = (ks * 32 + 8 * (lane >> 4)) * 2;
#pragma unroll
                for (int rb = 0; rb < 4; ++rb) { const bf16x8 af = *(const LAS bf16x8*)(XC + (rb * 16 + (lane & 15)) * RG_W + ko);
                    accA[rb] = __builtin_amdgcn_mfma_f32_16x16x32_bf16(af, bA[ks], accA[rb], 0, 0, 0);
                    accX[rb] = __builtin_amdgcn_mfma_f32_16x16x32_bf16(af, bX[ks], accX[rb], 0, 0, 0); } }
#pragma unroll
            for (int rb = 0; rb < 4; ++rb) {
                RgMap G{1.f, 0.f}; u32x4 pw = {0u, 0u, 0u, 0u};
#pragma unroll
                for (int r = 0; r < 4; ++r) { const int trow = rb * 16 + 4 * q + r;
                    const float xcv = bf1(*(const LAS bf16*)(XC + trow * RG_W + ech * 2));
                    const float rr = sigmoidf_(accA[rb][r] + e_ba), ii = sigmoidf_(accX[rb][r] + e_bx);
                    const float l2 = rr * e_sp8;
                    const float a_ = __builtin_amdgcn_exp2f(l2);
                    const float x2 = l2 * (2.0f * 0.6931471805599453f);
                    const float ser = -x2 * (1.0f + x2 * (0.5f + x2 * (0.16666667f + x2 * (0.041666668f + x2 * 0.008333334f))));
                    const float om = (x2 > -0.25f) ? ser : (1.0f - a_ * a_);
                    const float b_ = __builtin_amdgcn_sqrtf(om) * ii * xcv;
                    pw[r] = __builtin_bit_cast(unsigned, __builtin_amdgcn_cvt_pkrtz(l2, b_));
                    G.H = a_ * G.H + b_; G.A *= a_; }
                abw[sub * 2048 + rb] = pw;
                const RgMap P{__shfl_xor(G.A, 16), __shfl_xor(G.H, 16)};
                const RgMap pr = (q & 1) ? rg_then(P, G) : rg_then(G, P);
                const RgMap Q{__shfl_xor(pr.A, 32), __shfl_xor(pr.H, 32)};
                const RgMap T = (q & 2) ? rg_then(Q, pr) : rg_then(pr, Q);
                S = T.A * S + T.H; atot *= T.A;
            }
        }
        if (q == 0) *(f32x2*)(SUMM + ((size_t)(b * 32 + c) * DM + egch) * 2) = (f32x2){atot, S};
    }
    __syncthreads();
}
__device__ __forceinline__ void rglru_passB(Frame& F) {
    const int tid = F.tid, lane = F.lane, wave = F.wave;
    LAS unsigned char* L = F.lds;
    const bf16* GG = WSP(bf16, WS_GG); unsigned char* RA = WSP(unsigned char, WS_S0); const float* SUMM = WSP(float, WS_SUMM);
    const int q = lane >> 4;
    for (int tile = F.blk; tile < NB * 32 * NH; tile += F.G) {
        const int hh = tile & 15, c = (tile >> 4) & 31, b = tile >> 9;
        const int ech = 16 * wave + (lane & 15), egch = hh * 128 + ech;
        const int crow = tid >> 4, c8 = (tid & 15) * 8, cg = hh * 128 + c8;
        const size_t tbase = (size_t)b * SEQ + c * 256;
        const u32x4* abr = (const u32x4*)rg_ab(F.ws, tile) + (wave * 64 + lane) * 4;
        u32x4 gn[2], ab[4];
        gn[0] = *(const u32x4*)(GG + (tbase + crow) * DM + cg); gn[1] = *(const u32x4*)(GG + (tbase + crow + 32) * DM + cg);
#pragma unroll
        for (int rb = 0; rb < 4; ++rb) ab[rb] = abr[rb];
        float S;
        { f32x2 sv[8];
#pragma unroll
            for (int k = 0; k < 8; ++k) { const int cc = 8 * q + k; sv[k] = (f32x2){1.f, 0.f}; if (cc < c) sv[k] = *(const f32x2*)(SUMM + ((size_t)(b * 32 + cc) * DM + egch) * 2); }
            RgMap M{1.f, 0.f};
#pragma unroll
            for (int k = 0; k < 8; ++k) M = rg_then(M, RgMap{sv[k].x, sv[k].y});
            const RgMap P{__shfl_xor(M.A, 16), __shfl_xor(M.H, 16)}; const RgMap pr = (q & 1) ? rg_then(P, M) : rg_then(M, P);
            const RgMap Q{__shfl_xor(pr.A, 32), __shfl_xor(pr.H, 32)}; const RgMap T = (q & 2) ? rg_then(Q, pr) : rg_then(pr, Q);
            S = T.H; }
#pragma unroll 1
        for (int sub = 0; sub < 256 / RG_SUB; ++sub) {
            const size_t t0 = tbase + sub * RG_SUB;
            LAS unsigned char* GT = L + RG_GGT + (sub & 1) * 16384; LAS unsigned char* OT = L + RG_OUT + (sub & 1) * 8192;
            *(LAS u32x4*)(GT + crow * 256 + c8 * 2) = gn[0]; *(LAS u32x4*)(GT + (crow + 32) * 256 + c8 * 2) = gn[1];
            u32x4 abc[4];
#pragma unroll
            for (int rb = 0; rb < 4; ++rb) abc[rb] = ab[rb];
            __syncthreads();
            if (sub + 1 < 256 / RG_SUB) {
                gn[0] = *(const u32x4*)(GG + (t0 + RG_SUB + crow) * DM + cg); gn[1] = *(const u32x4*)(GG + (t0 + RG_SUB + crow + 32) * DM + cg);
#pragma unroll
                for (int rb = 0; rb < 4; ++rb) ab[rb] = abr[(sub + 1) * 2048 + rb]; }
#pragma unroll
            for (int rb = 0; rb < 4; ++rb) {
                float av[4], bv[4];
#pragma unroll
                for (int r = 0; r < 4; ++r) { const unsigned pk = abc[rb][r]; av[r] = __builtin_amdgcn_exp2f(rg_h_lo(pk)); bv[r] = rg_h_hi(pk); }
                RgMap G{1.f, 0.f};
#pragma unroll
                for (int r = 0; r < 4; ++r) { G.H = av[r] * G.H + bv[r]; G.A *= av[r]; }
                const RgMap P{__shfl_xor(G.A, 16), __shfl_xor(G.H, 16)};
                const RgMap pr = (q & 1) ? rg_then(P, G) : rg_then(G, P);
                const RgMap Q{__shfl_xor(pr.A, 32), __shfl_xor(pr.H, 32)};
                const RgMap T = (q & 2) ? rg_then(Q, pr) : rg_then(pr, Q);
                RgMap E{1.f, 0.f}; if (q & 2) E = Q; if (q & 1) E = rg_then(E, P);
                float h = E.A * S + E.H; float y[4];
#pragma unroll
                for (int r = 0; r < 4; ++r) { const int trow = rb * 16 + 4 * q + r; h = av[r] * h + bv[r]; y[r] = h * bf1(*(const LAS bf16*)(GT + trow * 256 + ech * 2)) * SC_RA; }
                const unsigned w = pk4_f8(y[0], y[1], y[2], y[3]); const int tr0 = rb * 16 + 4 * q;
                OT[tr0 * 128 + ech] = (unsigned char)w; OT[(tr0 + 1) * 128 + ech] = (unsigned char)(w >> 8); OT[(tr0 + 2) * 128 + ech] = (unsigned char)(w >> 16); OT[(tr0 + 3) * 128 + ech] = (unsigned char)(w >> 24);
                S = T.A * S + T.H;
            }
            __syncthreads();
            { const int r = tid >> 3, cq = (tid & 7) * 16; *(u32x4*)(RA + (t0 + r) * DM + hh * 128 + cq) = *(const LAS u32x4*)(OT + r * 128 + cq); }
        }
    }
    __syncthreads();
}

__device__ __forceinline__ void krope_fill(Frame& F) {
    const int fl = fresh_lane(); const int gw = F.blk * NWAVES + F.wave, NGW = F.G * NWAVES, j4 = (fl & 7) * 4, tsub = fl >> 3;
    const float* KR = WSP(float, WS_KR); const f32x2* rope = WSP(f32x2, WS_ROPE); unsigned char* K = (unsigned char*)F.out + OUT_K;
    for (int tp = gw; tp < NT / 8; tp += NGW) { const int t = 8 * tp + tsub, b = t >> 13, s = t & 8191;
        const f32x4 x1 = *(const f32x4*)(KR + (size_t)t * 64 + j4), x2 = *(const f32x4*)(KR + (size_t)t * 64 + 32 + j4);
        const f32x4 c01 = *(const f32x4*)(rope + (size_t)t * 32 + j4), c23 = *(const f32x4*)(rope + (size_t)t * 32 + j4 + 2);
        const u32x2 w = {pk4_f8((x1.x * c01.x - x2.x * c01.y) * SC_K, (x2.x * c01.x + x1.x * c01.y) * SC_K, (x1.y * c01.z - x2.y * c01.w) * SC_K, (x2.y * c01.z + x1.y * c01.w) * SC_K),
                         pk4_f8((x1.z * c23.x - x2.z * c23.y) * SC_K, (x2.z * c23.x + x1.z * c23.y) * SC_K, (x1.w * c23.z - x2.w * c23.w) * SC_K, (x2.w * c23.z + x1.w * c23.w) * SC_K)};
#pragma unroll
        for (int h = 0; h < NH; ++h) *(u32x2*)(K + ((size_t)(b * NH + h) * SEQ + s) * DQK + 128 + 2 * j4) = w; }
}

constexpr int AT_KB = 12288, AT_VB = 8192, AT_BUF = AT_KB + AT_VB;
#define AT_LD8(p0_, p1_) __builtin_shufflevector(*(const LAS i32x4*)(p0_), *(const LAS i32x4*)(p1_), 0, 1, 2, 3, 4, 5, 6, 7)
constexpr int AT_SLOT = AT_KB + AT_VB, AT_NSLOT = 5;
struct AttnState { f32x16 o[4], p0, p1; f32x4 osum; i32x8 pb; float m_run; };
#define AT_MFMA(A_, B_, C_) __builtin_amdgcn_mfma_scale_f32_32x32x64_f8f6f4(A_, B_, C_, 0, 0, 0, 0x7F7F7F7F, 0, 0x7F7F7F7F)
#define AT_PIN() __builtin_amdgcn_sched_barrier(0)
template <bool FAST>
__device__ __forceinline__ void attn_iter(AttnState& S, const i32x8 (&qf)[3], const LAS unsigned char* Vprev, const LAS unsigned char* Knext, int xo0, int xo1, int r32, int hi,
                                          bool act_prev, bool act_cur, bool act_next, bool need_mask, int dq) {
    constexpr float CS = 1.0f / (SC_Q * SC_K), LSP = 6.0f;
    const f32x16 z16 = {0.f, 0.f, 0.f, 0.f, 0.f, 0.f, 0.f, 0.f, 0.f, 0.f, 0.f, 0.f, 0.f, 0.f, 0.f, 0.f};
    const int sel = (((r32 & 15) >> 2) & 1) == ((hi * 2 + (r32 >> 4)) & 1) ? 0x38383838 : 0;
    const i32x8 ones8 = {sel, sel, sel, sel, sel, sel, sel, sel};
#define AT_ROWSUM(PB_, ACC_) __builtin_amdgcn_mfma_scale_f32_16x16x128_f8f6f4(ones8, PB_, ACC_, 0, 0, 0, 0x7F7F7F7F, 0, 0x7F7F7F7F)
    float pmax = -__builtin_inff();
    if (FAST) {
        const LAS unsigned char* vb = Vprev + r32 * 64;
        const i32x8 v0 = AT_LD8(vb + xo0, vb + xo1), v1 = AT_LD8(vb + 2048 + xo0, vb + 2048 + xo1);
        S.osum = AT_ROWSUM(S.pb, S.osum);
        AT_PIN(); pmax = fmaxf(fmaxf(S.p0[0], S.p0[1]), fmaxf(S.p0[2], S.p0[3])); pmax = fmaxf(pmax, fmaxf(fmaxf(S.p0[4], S.p0[5]), fmaxf(S.p0[6], S.p0[7]))); AT_PIN();
        S.o[0] = AT_MFMA(v0, S.pb, S.o[0]);
        const i32x8 v2 = AT_LD8(vb + 4096 + xo0, vb + 4096 + xo1);
        AT_PIN(); pmax = fmaxf(pmax, fmaxf(fmaxf(S.p0[8], S.p0[9]), fmaxf(S.p0[10], S.p0[11]))); pmax = fmaxf(pmax, fmaxf(fmaxf(S.p0[12], S.p0[13]), fmaxf(S.p0[14], S.p0[15]))); AT_PIN();
        S.o[1] = AT_MFMA(v1, S.pb, S.o[1]);
        const i32x8 v3 = AT_LD8(vb + 6144 + xo0, vb + 6144 + xo1);
        AT_PIN(); pmax = fmaxf(pmax, fmaxf(fmaxf(S.p1[0], S.p1[1]), fmaxf(S.p1[2], S.p1[3]))); pmax = fmaxf(pmax, fmaxf(fmaxf(S.p1[4], S.p1[5]), fmaxf(S.p1[6], S.p1[7]))); AT_PIN();
        S.o[2] = AT_MFMA(v2, S.pb, S.o[2]);
        AT_PIN(); pmax = fmaxf(pmax, fmaxf(fmaxf(S.p1[8], S.p1[9]), fmaxf(S.p1[10], S.p1[11]))); pmax = fmaxf(pmax, fmaxf(fmaxf(S.p1[12], S.p1[13]), fmaxf(S.p1[14], S.p1[15]))); AT_PIN();
        S.o[3] = AT_MFMA(v3, S.pb, S.o[3]);
    } else if (act_prev) {
        const LAS unsigned char* vb = Vprev + r32 * 64;
        S.osum = AT_ROWSUM(S.pb, S.osum);
#pragma unroll
        for (int d = 0; d < 4; ++d) { const i32x8 vf = AT_LD8(vb + d * 2048 + xo0, vb + d * 2048 + xo1); S.o[d] = AT_MFMA(vf, S.pb, S.o[d]); AT_PIN(); }
    }
    if (!FAST) {
        if (act_cur) {
            if (need_mask) { const float NEG = -__builtin_inff();
#pragma unroll
                for (int r = 0; r < 16; ++r) { const int cr = (r & 3) + 8 * (r >> 2); if (cr > dq) S.p0[r] = NEG; if (cr + 32 > dq) S.p1[r] = NEG; } }
#pragma unroll
            for (int r = 0; r < 16; ++r) pmax = fmaxf(pmax, fmaxf(S.p0[r], S.p1[r]));
        }
    }
    float alpha = 1.f; bool resc = false; f32x16 n0 = z16, n1 = z16;
    if (FAST || act_cur) {
        { auto rr = __builtin_amdgcn_permlane32_swap(__float_as_uint(pmax), __float_as_uint(pmax), false, false); pmax = fmaxf(__uint_as_float(rr[0]), __uint_as_float(rr[1])) * CS; }
        resc = !__all(pmax - S.m_run <= 2.0f);
        const float mn = resc ? fmaxf(S.m_run, pmax) : S.m_run; alpha = __builtin_amdgcn_exp2f(S.m_run - mn); S.m_run = mn;
    }
    const float moff = LSP - S.m_run;
    const LAS unsigned char* kb = Knext + r32 * 192;
    if (FAST) {
        i32x8 ka = AT_LD8(kb + xo0, kb + xo1), kc = AT_LD8(kb + 32 * 192 + xo0, kb + 32 * 192 + xo1);
#pragma unroll
        for (int ks = 0; ks < 3; ++ks) {
            n0 = AT_MFMA(ka, qf[ks], ks == 0 ? z16 : n0); n1 = AT_MFMA(kc, qf[ks], ks == 0 ? z16 : n1);
            if (ks < 2) { ka = AT_LD8(kb + (ks + 1) * 64 + xo0, kb + (ks + 1) * 64 + xo1); kc = AT_LD8(kb + 32 * 192 + (ks + 1) * 64 + xo0, kb + 32 * 192 + (ks + 1) * 64 + xo1); }
            AT_PIN();
#pragma unroll
            for (int r = (ks * 16) / 3; r < ((ks + 1) * 16) / 3; ++r) { S.p0[r] = __builtin_amdgcn_exp2f(__builtin_fmaf(S.p0[r], CS, moff)); S.p1[r] = __builtin_amdgcn_exp2f(__builtin_fmaf(S.p1[r], CS, moff)); }
            AT_PIN();
        }
    } else {
        if (act_next) {
#pragma unroll
            for (int ks = 0; ks < 3; ++ks) { const i32x8 ka = AT_LD8(kb + ks * 64 + xo0, kb + ks * 64 + xo1), kc = AT_LD8(kb + 32 * 192 + ks * 64 + xo0, kb + 32 * 192 + ks * 64 + xo1);
                n0 = AT_MFMA(ka, qf[ks], ks == 0 ? z16 : n0); n1 = AT_MFMA(kc, qf[ks], ks == 0 ? z16 : n1); } }
        if (act_cur) {
#pragma unroll
            for (int r = 0; r < 16; ++r) { S.p0[r] = __builtin_amdgcn_exp2f(__builtin_fmaf(S.p0[r], CS, moff)); S.p1[r] = __builtin_amdgcn_exp2f(__builtin_fmaf(S.p1[r], CS, moff)); } }
    }
    if (FAST || act_cur) {
#pragma unroll
        for (int jj = 0; jj < 4; ++jj) { int a = __builtin_amdgcn_cvt_pk_fp8_f32(S.p0[4 * jj], S.p0[4 * jj + 1], 0, false); a = __builtin_amdgcn_cvt_pk_fp8_f32(S.p0[4 * jj + 2], S.p0[4 * jj + 3], a, true);
            int bq = __builtin_amdgcn_cvt_pk_fp8_f32(S.p1[4 * jj], S.p1[4 * jj + 1], 0, false); bq = __builtin_amdgcn_cvt_pk_fp8_f32(S.p1[4 * jj + 2], S.p1[4 * jj + 3], bq, true);
            auto rr = __builtin_amdgcn_permlane32_swap((unsigned)a, (unsigned)bq, false, false); S.pb[2 * jj] = (int)rr[0]; S.pb[2 * jj + 1] = (int)rr[1]; }
        if (resc) {
#pragma unroll
            for (int d = 0; d < 4; ++d)
#pragma unroll
                for (int r = 0; r < 16; ++r) S.o[d][r] *= alpha;
            S.osum = S.osum * alpha;
        }
    }
    S.p0 = n0; S.p1 = n1;
#undef AT_ROWSUM
}
__device__ __forceinline__ void attn_block(Frame& F, int bh, int qb, const unsigned char* Q, const unsigned char* Kg, const unsigned char* VTg, unsigned char* AO) {
    const int lane = F.lane, wave = F.wave, r32 = lane & 31, hi = lane >> 5;
    LAS unsigned char* L = F.lds; const unsigned ldsbase = (unsigned)(size_t)L;
    const int q0 = qb * 256, qrow = q0 + 32 * wave + r32, ntiles = 4 * (qb + 1);
    unsigned kv0, kv1, vv;
    { const int q = wave * 64 + lane, row = q / 12, pos = q % 12, c = (pos & ~3) | ((pos ^ (row >> 2)) & 3); kv0 = (unsigned)((row * 12 + c) * 16); }
    { const int q = (wave + 8) * 64 + lane, row = q / 12, pos = q % 12, c = (pos & ~3) | ((pos ^ (row >> 2)) & 3); kv1 = (unsigned)((row * 12 + c) * 16); }
    { const int q = wave * 64 + lane, row = q >> 2, pos = q & 3, c = pos ^ ((row >> 2) & 3); vv = (unsigned)((row * 4 + c) * 16); }
    const bool k2 = wave < 4;
    const char* kgb = (const char*)Kg + (size_t)bh * SEQ * DQK; const char* vgb = (const char*)VTg + (size_t)bh * SEQ * DV;
#define AT_ISSUE(tile, slot) do { const int _t = (tile) < ntiles ? (tile) : ntiles - 1; const unsigned _s = ldsbase + (slot) * AT_SLOT; \
        glds16(kgb + (size_t)_t * AT_KB, kv0, _s + wave * 1024); if (k2) glds16(kgb + (size_t)_t * AT_KB, kv1, _s + (wave + 8) * 1024); \
        glds16(vgb + (size_t)_t * AT_VB, vv, _s + AT_KB + wave * 1024); } while (0)
    AT_ISSUE(0, 0); AT_ISSUE(1, 1); AT_ISSUE(2, 2);
    i32x8 qf[3];
    { const unsigned char* qp = Q + ((size_t)bh * SEQ + qrow) * DQK + 32 * hi;
#pragma unroll
        for (int ks = 0; ks < 3; ++ks) { const i32x4 lo = *(const i32x4*)(qp + 64 * ks), hh = *(const i32x4*)(qp + 64 * ks + 16); qf[ks] = __builtin_shufflevector(lo, hh, 0, 1, 2, 3, 4, 5, 6, 7); } }
    asm volatile("s_waitcnt vmcnt(0)" ::: "memory");
    const f32x16 z16 = {0.f, 0.f, 0.f, 0.f, 0.f, 0.f, 0.f, 0.f, 0.f, 0.f, 0.f, 0.f, 0.f, 0.f, 0.f, 0.f};
    AttnState S; S.o[0] = z16; S.o[1] = z16; S.o[2] = z16; S.o[3] = z16; S.osum = (f32x4){0.f, 0.f, 0.f, 0.f}; S.p0 = z16; S.p1 = z16; S.m_run = -1e30f;
    S.pb = (i32x8){0, 0, 0, 0, 0, 0, 0, 0};
    const int swz = (r32 >> 2) & 3; const int xo0 = (((2 * hi) ^ swz) << 4), xo1 = (((2 * hi + 1) ^ swz) << 4);
    const int wfirst = q0 + 32 * wave, wlast = wfirst + 31;
    __syncthreads();
    { const LAS unsigned char* kb = L + r32 * 192;
#pragma unroll
        for (int ks = 0; ks < 3; ++ks) { const i32x8 ka = AT_LD8(kb + ks * 64 + xo0, kb + ks * 64 + xo1), kc = AT_LD8(kb + 32 * 192 + ks * 64 + xo0, kb + 32 * 192 + ks * 64 + xo1);
            S.p0 = AT_MFMA(ka, qf[ks], ks == 0 ? z16 : S.p0); S.p1 = AT_MFMA(kc, qf[ks], ks == 0 ? z16 : S.p1); } }
    const int nfast = 4 * qb;
#define AT_HEAD(j) if (k2) asm volatile("s_waitcnt vmcnt(3)" ::: "memory"); else asm volatile("s_waitcnt vmcnt(2)" ::: "memory"); \
        __syncthreads(); AT_ISSUE((j) + 3, ((j) + 3) % 5); \
        const LAS unsigned char* Vprev = L + (((j) + 4) % 5) * AT_SLOT + AT_KB; const LAS unsigned char* Knext = L + (((j) + 1) % 5) * AT_SLOT;
#define AT_SLOW(j) { const bool ap = (j) >= 1 && 64 * ((j) - 1) <= wlast, ac = (j) < ntiles && 64 * (j) <= wlast, an = (j) + 1 < ntiles && 64 * ((j) + 1) <= wlast; \
        attn_iter<false>(S, qf, Vprev, Knext, xo0, xo1, r32, hi, ap, ac, an, 64 * (j) + 63 > wfirst, qrow - 64 * (j) - 4 * hi); }
    int j = 0;
    { AT_HEAD(0); AT_SLOW(0); j = 1; }
#pragma unroll 1
    for (; j + 1 < nfast; ++j) { AT_HEAD(j); attn_iter<true>(S, qf, Vprev, Knext, xo0, xo1, r32, hi, true, true, true, false, 0); }
#pragma unroll 1
    for (; j <= ntiles; ++j) { AT_HEAD(j); AT_SLOW(j); }
#undef AT_HEAD
#undef AT_SLOW
#undef AT_ISSUE
    { int l2; asm volatile("v_mbcnt_lo_u32_b32 %0, -1, 0\n\tv_mbcnt_hi_u32_b32 %0, -1, %0" : "=v"(l2));
      const float inv = SC_AO / (SC_V * S.osum[0]); unsigned char* op = AO + ((size_t)(bh >> 4) * SEQ + qb * 256 + 32 * wave + (l2 & 31)) * DM + (bh & 15) * 128 + 4 * (l2 >> 5);
#pragma unroll
        for (int d = 0; d < 4; ++d)
#pragma unroll
            for (int g = 0; g < 4; ++g) *(unsigned*)(op + 32 * d + 8 * g) = pk4_f8(S.o[d][4 * g] * inv, S.o[d][4 * g + 1] * inv, S.o[d][4 * g + 2] * inv, S.o[d][4 * g + 3] * inv); }
    asm volatile("s_waitcnt vmcnt(0)" ::: "memory");
    __syncthreads();
}
#undef AT_MFMA
#undef AT_PIN
__device__ __forceinline__ void attn_phase(Frame& F) {
    const unsigned char* Q = (const unsigned char*)F.out + OUT_Q; const unsigned char* Kg = (const unsigned char*)F.out + OUT_K; const unsigned char* VTg = (const unsigned char*)F.out + OUT_VT; unsigned char* AO = WSP(unsigned char, WS_AO8);
    for (int it = F.blk; it < 1024; it += F.G) {
        const int r = it / F.G;
        int bh, y;
        if (F.G == 256) { const int x = F.blk & 7, loc = F.blk >> 3; bh = x * 8 + r * 2 + (loc >> 4); y = loc & 15; }
        else { bh = it >> 4; y = it & 15; }
        attn_block(F, bh, 31 - y, Q, Kg, VTg, AO);
        attn_block(F, bh, y, Q, Kg, VTg, AO);
    }
}

__device__ __forceinline__ void ln1_phase(Frame& F) {
    const int gw = F.blk * NWAVES + F.wave, NGW = F.G * NWAVES, lane = fresh_lane();
    bf16* R1 = WSP(bf16, WS_R1); unsigned char* H2I = WSP(unsigned char, WS_H2I); float* HSC = WSP(float, WS_HSC); const float* mod = WSP(float, WS_MOD);
    for (int m = gw; m < NT; m += NGW) {
        u32x4* rp = (u32x4*)(R1 + (size_t)m * DM) + lane; f32x4 v[8]; float s = 0.f;
#pragma unroll
        for (int j = 0; j < 4; ++j) { const u32x4 w = rp[64 * j]; v[2 * j] = (f32x4){bflo(w.x), bfhi(w.x), bflo(w.y), bfhi(w.y)}; v[2 * j + 1] = (f32x4){bflo(w.z), bfhi(w.z), bflo(w.w), bfhi(w.w)};
            s += ((v[2 * j].x + v[2 * j].y) + (v[2 * j].z + v[2 * j].w)) + ((v[2 * j + 1].x + v[2 * j + 1].y) + (v[2 * j + 1].z + v[2 * j + 1].w)); }
        const float mean = wave_sum(s) * (1.f / DM); float s2 = 0.f;
#pragma unroll
        for (int j = 0; j < 8; ++j) { v[j] = v[j] - mean; s2 += (v[j].x * v[j].x + v[j].y * v[j].y) + (v[j].z * v[j].z + v[j].w * v[j].w); }
        const float rstd = __builtin_amdgcn_rsqf(wave_sum(s2) * (1.f / DM) + LN_EPS);
        const int b = m >> 13; const float* sh2 = mod + b * 12288 + 6144; const float* sc2 = mod + b * 12288 + 8192;
        float amax = 0.f;
#pragma unroll
        for (int j = 0; j < 4; ++j) { const int col = 512 * j + 8 * lane; f32x4 y[2];
#pragma unroll
            for (int q = 0; q < 2; ++q) { const f32x4 g = *(const f32x4*)(F.ln1_g + col + 4 * q), bb = *(const f32x4*)(F.ln1_b + col + 4 * q);
                y[q] = v[2 * j + q] * rstd * g + bb; v[2 * j + q] = y[q] * (1.f + *(const f32x4*)(sc2 + col + 4 * q)) + *(const f32x4*)(sh2 + col + 4 * q);
                const f32x4 hh = v[2 * j + q]; amax = fmaxf(amax, fmaxf(fmaxf(fabsf(hh.x), fabsf(hh.y)), fmaxf(fabsf(hh.z), fabsf(hh.w)))); }
            rp[64 * j] = pack8(y[0], y[1]); }
        amax = fmaxf(wave_max(amax), 1e-20f); const float qs = 127.0f / amax;
        if (lane == 0) HSC[m] = amax * (1.0f / 127.0f);
#pragma unroll
        for (int j = 0; j < 4; ++j) { const f32x4 a = v[2 * j] * qs, c = v[2 * j + 1] * qs;
            *(u32x2*)(H2I + (size_t)m * DM + 512 * j + 8 * lane) = (u32x2){pk4_i8(a.x, a.y, a.z, a.w), pk4_i8(c.x, c.y, c.z, c.w)}; }
    }
    { unsigned char* pu = WSP(unsigned char, WS_PU); float* usc = WSP(float, WS_USC);
        for (int e = gw; e < 16384; e += NGW) { f32x4 r[8]; float amax = 0.f;
#pragma unroll
            for (int j = 0; j < 4; ++j) { r[2 * j] = *(const f32x4*)(F.peer_u + (size_t)e * DM + 512 * j + 8 * lane); r[2 * j + 1] = *(const f32x4*)(F.peer_u + (size_t)e * DM + 512 * j + 8 * lane + 4); }
#pragma unroll
            for (int j = 0; j < 8; ++j) amax = fmaxf(amax, fmaxf(fmaxf(fabsf(r[j].x), fabsf(r[j].y)), fmaxf(fabsf(r[j].z), fabsf(r[j].w))));
            amax = fmaxf(wave_max(amax), 1e-30f); const float qs = 127.0f / amax;
            if (lane == 0) usc[e] = amax * (1.0f / 127.0f);
#pragma unroll
            for (int j = 0; j < 4; ++j) { const f32x4 a = r[2 * j] * qs, c = r[2 * j + 1] * qs;
                *(u32x2*)(pu + (size_t)(4 * j + (lane >> 4)) * 2097152 + (size_t)e * 128 + 8 * (lane & 15)) = (u32x2){pk4_i8(a.x, a.y, a.z, a.w), pk4_i8(c.x, c.y, c.z, c.w)}; } } }
    { unsigned char* pv = WSP(unsigned char, WS_PV); float* vsc = WSP(float, WS_VSC);
        for (int e = gw; e < 16384; e += NGW) { f32x4 r[8]; float amax = 0.f;
#pragma unroll
            for (int j = 0; j < 4; ++j) { r[2 * j] = *(const f32x4*)(F.peer_v + (size_t)e * DM + 512 * j + 8 * lane); r[2 * j + 1] = *(const f32x4*)(F.peer_v + (size_t)e * DM + 512 * j + 8 * lane + 4); }
#pragma unroll
            for (int j = 0; j < 8; ++j) amax = fmaxf(amax, fmaxf(fmaxf(fabsf(r[j].x), fabsf(r[j].y)), fmaxf(fabsf(r[j].z), fabsf(r[j].w))));
            amax = fmaxf(wave_max(amax), 1e-30f); const float qs = 127.0f / amax;
            if (lane == 0) vsc[e] = amax * (1.0f / 127.0f);
#pragma unroll
            for (int j = 0; j < 4; ++j) { const f32x4 a = r[2 * j] * qs, c = r[2 * j + 1] * qs;
                *(u32x2*)(pv + (size_t)(4 * j + (lane >> 4)) * 2097152 + (size_t)e * 128 + 8 * (lane & 15)) = (u32x2){pk4_i8(a.x, a.y, a.z, a.w), pk4_i8(c.x, c.y, c.z, c.w)}; } } }
}

constexpr int PK_KW = 288, PK_KEYS = 0, PK_SF = 2 * 128 * PK_KW  , PK_SI = PK_SF + 64 * 2 * 16 * 4, PK_TAB = PK_SI + 64 * 2 * 16 * 4;
__device__ __forceinline__ unsigned ord_key(float s) { unsigned u = __float_as_uint(s); return u ^ ((u >> 31) ? 0xffffffffu : 0x80000000u); }
__device__ __forceinline__ float ord_inv(unsigned k) { return __uint_as_float((k >> 31) ? (k ^ 0x80000000u) : ~k); }
#define PK_CE(a_, b_) do { const unsigned _h = (a_) > (b_) ? (a_) : (b_), _l = (a_) > (b_) ? (b_) : (a_); (a_) = _h; (b_) = _l; } while (0)
__device__ __forceinline__ void sort16_desc(unsigned (&v)[16]) {
#pragma unroll
    for (int k = 2; k <= 16; k <<= 1)
#pragma unroll
        for (int j = k >> 1; j > 0; j >>= 1)
#pragma unroll
            for (int i = 0; i < 16; ++i) { const int l = i ^ j; if (l > i) { if ((i & k) == 0) PK_CE(v[i], v[l]); else PK_CE(v[l], v[i]); } }
}
__device__ __forceinline__ void merge16_desc(unsigned (&v)[16]) {
#pragma unroll
    for (int j = 8; j > 0; j >>= 1)
#pragma unroll
        for (int i = 0; i < 16; ++i) { const int l = i ^ j; if (l > i) PK_CE(v[i], v[l]); }
}
__device__ __forceinline__ void top16_with_partner(unsigned (&v)[16], int mask) {
    unsigned o[16];
#pragma unroll
    for (int i = 0; i < 16; ++i) o[i] = (unsigned)__shfl_xor((int)v[i], mask);
#pragma unroll
    for (int i = 0; i < 16; ++i) v[i] = v[i] > o[15 - i] ? v[i] : o[15 - i];
    merge16_desc(v);
}
__device__ __forceinline__ void peer_score_phase(Frame& F) {
    const int tid = F.tid, lane = F.lane, wave = F.wave;
    LAS unsigned char* L = F.lds;
    const bf16* PQ = WSP(bf16, WS_PQ); int* IDX = WSP(int, WS_IDX); float* GATE = WSP(float, WS_GATE);
    { const u32x4* kg = WSP(u32x4, WS_PKEYS);
#pragma unroll
        for (int i = 0; i < 8; ++i) { const int id = tid + NTHREADS * i, r = id >> 4, ch = id & 15; *(LAS u32x4*)(L + PK_KEYS + r * PK_KW + ch * 16) = kg[id]; } }
    if (tid == 0) { int n = 0; for (int i = 0; i < 16; ++i) for (int j = 0; j < 16; ++j) if ((i + 1) * (j + 1) <= 16) L[PK_TAB + n++] = (unsigned char)(i * 16 + j); for (; n < 64; ++n) L[PK_TAB + n] = 0xff; }
    __syncthreads();
    LAS float* SF = (LAS float*)(L + PK_SF); LAS int* SI = (LAS int*)(L + PK_SI);
    for (int tile = F.blk; tile < NT * PEER_H / 64; tile += F.G) {
        const int R0 = tile * 64;
        { const int p = wave >> 2, rb = (wave & 3) * 16, c = lane & 15, fq = lane >> 4; const bf16* qp = PQ + (size_t)(R0 + rb + c) * 256 + p * 128 + 8 * fq;
            bf16x8 qfr[4];
#pragma unroll
            for (int ks = 0; ks < 4; ++ks) qfr[ks] = *(const bf16x8*)(qp + 32 * ks);
            unsigned lo[16], hi[16];
#pragma unroll
            for (int nb = 0; nb < 8; ++nb) { f32x4 acc = {0, 0, 0, 0};
#pragma unroll
                for (int ks = 0; ks < 4; ++ks) { const bf16x8 kfr = *(const LAS bf16x8*)(L + PK_KEYS + (p * 128 + nb * 16 + c) * PK_KW + (ks * 32 + 8 * fq) * 2);
                    acc = __builtin_amdgcn_mfma_f32_16x16x32_bf16(kfr, qfr[ks], acc, 0, 0, 0); }
#pragma unroll
                for (int r = 0; r < 4; ++r) { const unsigned key = (ord_key(acc[r]) & ~127u) | (unsigned)(127 - (16 * nb + 4 * fq + r));
                    if (nb < 4) lo[nb * 4 + r] = key; else hi[(nb - 4) * 4 + r] = key; } }
            sort16_desc(lo); sort16_desc(hi);
#pragma unroll
            for (int i = 0; i < 16; ++i) lo[i] = lo[i] > hi[15 - i] ? lo[i] : hi[15 - i];
            merge16_desc(lo);
            top16_with_partner(lo, 16); top16_with_partner(lo, 32);
            if (fq == 0) { LAS float* sf = SF + ((rb + c) * 2 + p) * 16; LAS int* si = SI + ((rb + c) * 2 + p) * 16;
#pragma unroll
                for (int i = 0; i < 16; ++i) { sf[i] = ord_inv(lo[i] & ~127u); si[i] = 127 - (int)(lo[i] & 127u); } } }
        __syncthreads();
        if (tid < 256) { const int R = tid >> 2, c = tid & 3; const LAS float* a = SF + (R * 2) * 16; const LAS float* bq = a + 16;
            unsigned v[16];
#pragma unroll
            for (int m = 0; m < 16; ++m) { v[m] = 0u; if (m < 13) { const unsigned pr = L[PK_TAB + c + 4 * m]; if (pr != 0xffu) v[m] = (ord_key(a[pr >> 4] + bq[pr & 15]) & ~255u) | (255u - pr); } }
            sort16_desc(v); top16_with_partner(v, 1); top16_with_partner(v, 2);
            unsigned w0 = c == 0 ? v[0] : (c == 1 ? v[4] : (c == 2 ? v[8] : v[12])), w1 = c == 0 ? v[1] : (c == 1 ? v[5] : (c == 2 ? v[9] : v[13]));
            unsigned w2 = c == 0 ? v[2] : (c == 1 ? v[6] : (c == 2 ? v[10] : v[14])), w3 = c == 0 ? v[3] : (c == 1 ? v[7] : (c == 2 ? v[11] : v[15]));
            const unsigned pm = 255u - (v[0] & 255u); const float smax = a[pm >> 4] + bq[pm & 15];
            const LAS int* ia = SI + (R * 2) * 16; const LAS int* ib = ia + 16;
            const unsigned p0 = 255u - (w0 & 255u), p1 = 255u - (w1 & 255u), p2 = 255u - (w2 & 255u), p3 = 255u - (w3 & 255u);
            f32x4 e = {__expf(a[p0 >> 4] + bq[p0 & 15] - smax), __expf(a[p1 >> 4] + bq[p1 & 15] - smax), __expf(a[p2 >> 4] + bq[p2 & 15] - smax), __expf(a[p3 >> 4] + bq[p3 & 15] - smax)};
            float sum = (e.x + e.y) + (e.z + e.w); sum += __shfl_xor(sum, 1); sum += __shfl_xor(sum, 2);
            const float inv = 1.0f / sum; const size_t ob = (size_t)(R0 + R) * 16 + 4 * c;
            *(f32x4*)(GATE + ob) = e * inv;
            *(int4*)(IDX + ob) = make_int4(ia[p0 >> 4] * NKEYS + ib[p0 & 15], ia[p1 >> 4] * NKEYS + ib[p1 & 15], ia[p2 >> 4] * NKEYS + ib[p2 & 15], ia[p3 >> 4] * NKEYS + ib[p3 & 15]); }
        __syncthreads();
    }
}
#undef PK_CE

__device__ __forceinline__ void ln2_rows(Frame& F, int m0, int nrows) {
    int lane; asm volatile("v_mbcnt_lo_u32_b32 %0, -1, 0\n\tv_mbcnt_hi_u32_b32 %0, -1, %0" : "=v"(lane));
    const bf16* X1 = WSP(bf16, WS_R1); const float* mod = WSP(float, WS_MOD); const bf16* Y = WSP(bf16, WS_TMP);
    f32x4 g1[8];
    { const f32x4* gt2 = (const f32x4*)(mod + (m0 >> 13) * 12288 + 10240) + lane;
#pragma unroll
        for (int j = 0; j < 8; ++j) g1[j] = 1.f + gt2[64 * j]; }
    u32x2 yn[8], xn[8];
    { const u32x2* yb = (const u32x2*)(Y + (size_t)m0 * DM) + lane; const u32x2* xb = (const u32x2*)(X1 + (size_t)m0 * DM) + lane;
#pragma unroll
        for (int j = 0; j < 8; ++j) { yn[j] = yb[64 * j]; xn[j] = xb[64 * j]; } }
#pragma unroll 1
    for (int m = m0; m < m0 + nrows; ++m) {
        f32x4* yp = (f32x4*)(F.out + (size_t)m * DM) + lane;
        f32x4 v[8]; float s = 0.f;
#pragma unroll
        for (int j = 0; j < 8; ++j) { const u32x2 yw = yn[j], xw = xn[j]; const f32x4 y = {bflo(yw.x), bfhi(yw.x), bflo(yw.y), bfhi(yw.y)}, x = {bflo(xw.x), bfhi(xw.x), bflo(xw.y), bfhi(xw.y)};
            v[j] = DN_ALPHA * x + g1[j] * y; s += (v[j].x + v[j].y) + (v[j].z + v[j].w); }
        { const int mn = m + 1 < m0 + nrows ? m + 1 : m; const u32x2* yb = (const u32x2*)(Y + (size_t)mn * DM) + lane; const u32x2* xb = (const u32x2*)(X1 + (size_t)mn * DM) + lane;
#pragma unroll
            for (int j = 0; j < 8; ++j) { yn[j] = yb[64 * j]; xn[j] = xb[64 * j]; } }
        const float mean = wave_sum(s) * (1.f / DM); float s2 = 0.f;
#pragma unroll
        for (int j = 0; j < 8; ++j) { v[j] = v[j] - mean; s2 += (v[j].x * v[j].x + v[j].y * v[j].y) + (v[j].z * v[j].z + v[j].w * v[j].w); }
        const float rstd = __builtin_amdgcn_rsqf(wave_sum(s2) * (1.f / DM) + LN_EPS);
#pragma unroll
        for (int j = 0; j < 8; ++j) yp[64 * j] = v[j] * rstd * *((const f32x4*)F.ln2_g + 64 * j + lane) + *((const f32x4*)F.ln2_b + 64 * j + lane);
    }
}
constexpr int PE_WAVE_LDS = 16384;
template <int N, int M> __device__ __forceinline__ void xreduce_step(float (&v)[M], bool bit, int mask) {
#pragma unroll
    for (int i = 0; i < N / 2; ++i) { const float keep = bit ? v[i + N / 2] : v[i], send = bit ? v[i] : v[i + N / 2]; v[i] = keep + __shfl_xor(send, mask); }
}
template <int N, int M> __device__ __forceinline__ void xreduce_step_i(int (&v)[M], bool bit, int mask) {
#pragma unroll
    for (int i = 0; i < N / 2; ++i) { const int keep = bit ? v[i + N / 2] : v[i], send = bit ? v[i] : v[i + N / 2]; v[i] = keep + __shfl_xor(send, mask); }
}
__device__ __forceinline__ void peer_eval_phase(Frame& F) {
    const int lane = F.lane, g = lane >> 3, c16 = lane & 7;
    const unsigned char* H2I = WSP(unsigned char, WS_H2I); const float* HSC = WSP(float, WS_HSC); const float* USC = WSP(float, WS_USC); const float* VSC = WSP(float, WS_VSC); const int* IDX = WSP(int, WS_IDX); const float* GATE = WSP(float, WS_GATE);
    const unsigned char* PU = WSP(unsigned char, WS_PU); const unsigned char* PV = WSP(unsigned char, WS_PV); bf16* Y = WSP(bf16, WS_TMP);
    LAS int* idxL = (LAS int*)(F.lds + F.wave * PE_WAVE_LDS); LAS float* DL = (LAS float*)(F.lds + F.wave * PE_WAVE_LDS + 8192);
    for (int tb = F.blk; tb < NT / 128; tb += F.G) {
        const int tok0 = tb * 128 + F.wave * 16;
#pragma unroll 4
        for (int tk = 0; tk < 16; ++tk) { const int e0 = lane, e1 = lane + 64; const int i0 = IDX[(size_t)(tok0 + tk) * 128 + e0], i1 = IDX[(size_t)(tok0 + tk) * 128 + e1];
            idxL[(tk * 8 + (e0 & 7)) * 16 + (e0 >> 3)] = i0 << 7; idxL[(tk * 8 + (e1 & 7)) * 16 + (e1 >> 3)] = i1 << 7; DL[tk * 128 + e0] = 0.f; DL[tk * 128 + e1] = 0.f; }
        LDS_WAIT();
        {
            auto issueU = [&](int st, u32x4 (&w)[16], i32x4& hq) { const int sl = st >> 4, tk = st & 15; const unsigned char* pu = PU + (size_t)sl * 2097152; const unsigned lo16 = 16u * c16;
                int ids[16];
#pragma unroll
                for (int q = 0; q < 4; ++q) { const i32x4 v = *(const LAS i32x4*)(idxL + (tk * 8 + g) * 16 + 4 * q); ids[4 * q] = v.x; ids[4 * q + 1] = v.y; ids[4 * q + 2] = v.z; ids[4 * q + 3] = v.w; }
                hq = *(const i32x4*)(H2I + (size_t)(tok0 + tk) * DM + 128 * sl + 16 * c16);
#pragma unroll
                for (int k = 0; k < 16; ++k) w[k] = *(const u32x4*)(pu + ((unsigned)ids[k] + lo16)); };
            auto computeU = [&](int st, const u32x4 (&w)[16], const i32x4 hq) { const int tk = st & 15;
                int pd[16];
#pragma unroll
                for (int k = 0; k < 16; ++k) { int di = __builtin_amdgcn_sdot4((int)w[k][0], hq.x, 0, false); di = __builtin_amdgcn_sdot4((int)w[k][1], hq.y, di, false);
                    di = __builtin_amdgcn_sdot4((int)w[k][2], hq.z, di, false); di = __builtin_amdgcn_sdot4((int)w[k][3], hq.w, di, false); pd[k] = di; }
                xreduce_step_i<16>(pd, c16 & 1, 1); xreduce_step_i<8>(pd, c16 & 2, 2); xreduce_step_i<4>(pd, c16 & 4, 4);
                const int k0 = 8 * (c16 & 1) + 4 * ((c16 >> 1) & 1) + 2 * (c16 >> 2);
                LAS int* dp = (LAS int*)DL + tk * 128 + g; dp[8 * k0] += pd[0]; dp[8 * (k0 + 1)] += pd[1]; };
            u32x4 wa[16], wb[16]; i32x4 ha, hb;
            issueU(0, wa, ha);
#pragma unroll 1
            for (int st = 0; st < 256; st += 2) {
                issueU(st + 1, wb, hb); computeU(st, wa, ha);
                issueU(st + 2 < 256 ? st + 2 : 255, wa, ha); computeU(st + 1, wb, hb);
            }
        }
        LDS_WAIT();
        { float a0[16], a1[16]; const int e0 = lane, e1 = lane + 64;
#pragma unroll
            for (int tk = 0; tk < 16; ++tk) { const float g0 = GATE[(size_t)(tok0 + tk) * 128 + e0], g1 = GATE[(size_t)(tok0 + tk) * 128 + e1]; const float hs = HSC[tok0 + tk];
                const int x0 = idxL[(tk * 8 + (e0 & 7)) * 16 + (e0 >> 3)], x1 = idxL[(tk * 8 + (e1 & 7)) * 16 + (e1 >> 3)];
                a0[tk] = gelu_tanh((float)((LAS int*)DL)[tk * 128 + e0] * (hs * USC[x0 >> 7])) * g0 * VSC[x0 >> 7]; a1[tk] = gelu_tanh((float)((LAS int*)DL)[tk * 128 + e1] * (hs * USC[x1 >> 7])) * g1 * VSC[x1 >> 7]; }
            LDS_WAIT();
            LAS unsigned char* AB = (LAS unsigned char*)DL; LAS float* AS = DL + 512;
#pragma unroll
            for (int tk = 0; tk < 16; ++tk) { const float amax = fmaxf(wave_max(fmaxf(fabsf(a0[tk]), fabsf(a1[tk]))), 1e-30f); const float qs = 127.0f / amax;
                const int q0 = (int)__builtin_rintf(a0[tk] * qs), q1 = (int)__builtin_rintf(a1[tk] * qs);
                AB[(tk * 8 + (e0 & 7)) * 16 + (e0 >> 3)] = (unsigned char)q0; AB[(tk * 8 + (e1 & 7)) * 16 + (e1 >> 3)] = (unsigned char)q1;
                if (lane == 0) AS[tk] = amax * (1.0f / 127.0f); } }
        LDS_WAIT();
        {
            auto issueV = [&](int st, u32x4 (&w)[16]) { const int sl = st >> 4, tk = st & 15; const unsigned char* pv = PV + (size_t)sl * 2097152; const unsigned lo16 = 16u * c16;
                int ids[16];
#pragma unroll
                for (int q = 0; q < 4; ++q) { const i32x4 v = *(const LAS i32x4*)(idxL + (tk * 8 + g) * 16 + 4 * q); ids[4 * q] = v.x; ids[4 * q + 1] = v.y; ids[4 * q + 2] = v.z; ids[4 * q + 3] = v.w; }
#pragma unroll
                for (int k = 0; k < 16; ++k) w[k] = *(const u32x4*)(pv + ((unsigned)ids[k] + lo16)); };
            auto computeV = [&](int st, const u32x4 (&w)[16]) { const int sl = st >> 4, tk = st & 15;
                const i32x4 a4 = *(const LAS i32x4*)((const LAS unsigned char*)DL + (tk * 8 + g) * 16);
                const float ascale = (DL + 512)[tk];
                int yi[16];
#pragma unroll
                for (int c = 0; c < 16; ++c) yi[c] = 0;
#pragma unroll
                for (int m = 0; m < 4; ++m) { const int am = m == 0 ? a4.x : (m == 1 ? a4.y : (m == 2 ? a4.z : a4.w));
#pragma unroll
                    for (int q = 0; q < 4; ++q) {
                        const unsigned w0 = w[4 * m][q], w1 = w[4 * m + 1][q], w2 = w[4 * m + 2][q], w3 = w[4 * m + 3][q];
                        const unsigned t0 = __builtin_amdgcn_perm(w1, w0, 0x05010400u), t1 = __builtin_amdgcn_perm(w1, w0, 0x07030602u), t2 = __builtin_amdgcn_perm(w3, w2, 0x05010400u), t3 = __builtin_amdgcn_perm(w3, w2, 0x07030602u);
                        yi[4 * q + 0] = __builtin_amdgcn_sdot4((int)__builtin_amdgcn_perm(t2, t0, 0x05040100u), am, yi[4 * q + 0], false);
                        yi[4 * q + 1] = __builtin_amdgcn_sdot4((int)__builtin_amdgcn_perm(t2, t0, 0x07060302u), am, yi[4 * q + 1], false);
                        yi[4 * q + 2] = __builtin_amdgcn_sdot4((int)__builtin_amdgcn_perm(t3, t1, 0x05040100u), am, yi[4 * q + 2], false);
                        yi[4 * q + 3] = __builtin_amdgcn_sdot4((int)__builtin_amdgcn_perm(t3, t1, 0x07060302u), am, yi[4 * q + 3], false); } }
                float cv[16];
#pragma unroll
                for (int c = 0; c < 16; ++c) cv[c] = (float)yi[c] * ascale;
                xreduce_step<16>(cv, g & 1, 8); xreduce_step<8>(cv, g & 2, 16); xreduce_step<4>(cv, g & 4, 32);
                const int c0 = 8 * (g & 1) + 4 * ((g >> 1) & 1) + 2 * (g >> 2);
                *(unsigned*)(Y + (size_t)(tok0 + tk) * DM + 128 * sl + 16 * c16 + c0) = pk2(cv[0], cv[1]); };
            u32x4 wa[16], wb[16];
            issueV(0, wa);
#pragma unroll 1
            for (int st = 0; st < 256; st += 2) {
                issueV(st + 1, wb); computeV(st, wa);
                issueV(st + 2 < 256 ? st + 2 : 255, wa); computeV(st + 1, wb);
            }
        }
        LDS_WAIT();
        VM_WAIT();
        ln2_rows(F, tok0, 16);
    }
}

constexpr int NPHASE = 12;
__global__ void __launch_bounds__(NTHREADS, 2) fwd_kernel(Args args) {
    extern __shared__ __attribute__((aligned(16))) unsigned char lds_raw[];
    Frame F;
    F.lds = (LAS unsigned char*)lds_raw; F.tid = threadIdx.x; F.lane = F.tid & 63; F.wave = __builtin_amdgcn_readfirstlane(F.tid >> 6); F.G = gridDim.x; F.blk = blockIdx.x;
    F.x = args.in[0]; F.c = args.in[1]; F.positions = (const int*)args.in[2]; F.w_ada = args.in[3]; F.b_ada = args.in[4]; F.w_in = args.in[5]; F.conv_w = args.in[6]; F.conv_b = args.in[7];
    F.w_rg_a = args.in[8]; F.b_rg_a = args.in[9]; F.w_rg_x = args.in[10]; F.b_rg_x = args.in[11]; F.rg_lambda = args.in[12]; F.w_rnn_out = args.in[13]; F.q_norm_g = args.in[14]; F.w_uq = args.in[15];
    F.kv_norm_g = args.in[16]; F.w_ukv = args.in[17]; F.w_mla_out = args.in[18]; F.w_o = args.in[19]; F.ln1_g = args.in[20]; F.ln1_b = args.in[21]; F.peer_wq = args.in[22]; F.peer_keys = args.in[23];
    F.peer_u = args.in[24]; F.peer_v = args.in[25]; F.ln2_g = args.in[26]; F.ln2_b = args.in[27]; F.out = args.out; F.ws = args.ws;
    volatile LAS unsigned* ctlw = (volatile LAS unsigned*)(F.lds + LDSCTL_OFF);
    if (F.tid < 128) ctlw[F.tid] = 0u;
    __syncthreads();
    const int lo = args.ph_lo, hi = args.ph_hi;
    const bool multi = (hi - lo) > 1;
#ifdef PROBE_RELAUNCH
    const int bslot = args.bslot;
#else
    constexpr int bslot = 0;
#endif
    XcdBarrier bar; bar.bar = (unsigned*)(F.ws + WS_CTL) + 4096 + 16384 * (bslot & 1); bar.x = 0; bar.st = nullptr;
    if (multi) bar = xcd_barrier_post((unsigned*)(F.ws + WS_CTL) + 4096 + 16384 * (bslot & 1), ctlw + 8);
#ifndef PHASE_MASK
#define PHASE_MASK 0xfff
#endif
#define IN(k) (((PHASE_MASK >> (k)) & 1) && lo <= (k) && (k) < hi)
#define SEAM(k) do { if (IN(k) && IN((k) + 1)) xcd_barrier(bar); } while (0)
#ifndef DBL_MASK
#define DBL_MASK 0
#endif
#define DBL(k, ...) do { if ((DBL_MASK >> (k)) & 1) { __VA_ARGS__; xcd_barrier(bar); } } while (0)
    const pg8::StaticOrder S0{};
    if (IN(0)) { DBL(0, p0_prologue(F, 1)); p0_prologue(F, bslot); SEAM(0); }
    if (IN(1)) { DBL(1, p1_modulate(F)); p1_modulate(F); SEAM(1); }
    if (IN(2)) {
        const pg8::Gemm g = pg8::gemm_f8(WSP(unsigned char, WS_S0), WSP(unsigned char, WS_WIN), NT, NPROJ, DM, DM, DM); pg8::StaticOrder S; S.init(NT, NPROJ, F.G, F.blk);
        EpiProj E{WSP(bf16, WS_XR), WSP(bf16, WS_GG), WSP(unsigned char, WS_QKVC), WSP(unsigned char, WS_KVC8), WSP(bf16, WS_SGR), WSP(bf16, WS_SGM), WSP(float, WS_KR), WSP(float, WS_SSP), 1.0f / (SC_H * SC_WIN)};
        DBL(2, pg8::gemm_phase<EpiProj, pg8::StaticOrder, true, false>(F.lds, g, S, E, F.wave)); pg8::gemm_phase<EpiProj, pg8::StaticOrder, true, false>(F.lds, g, S, E, F.wave); SEAM(2); }
    if (IN(3)) { DBL(3, rglru_passA(F)); rglru_passA(F); SEAM(3); }
    if (IN(4)) {
        rglru_passB(F);
        constexpr float ESC6 = 1.0f / (SC_H * SC_WIN);
        { const pg8::Gemm g = pg8::gemm_f8(WSP(unsigned char, WS_QKVC), WSP(unsigned char, WS_WUQ), NT, 3072, 512, 512, 512); pg8::StaticOrder S; S.init(NT, 3072, F.G, F.blk);
          EpiQ E{(unsigned char*)F.out + OUT_Q, WSP(float, WS_RS), WSP(f32x2, WS_ROPE), ESC6}; pg8::gemm_phase<EpiQ, pg8::StaticOrder, true>(F.lds, g, S, E, F.wave); }
        { const pg8::Gemm g = pg8::gemm_f8(WSP(unsigned char, WS_KVC8), WSP(unsigned char, WS_WUK), NT, 2048, 512, 512, 512); pg8::StaticOrder S; S.init(NT, 2048, F.G, F.blk);
          EpiK E{(unsigned char*)F.out + OUT_K, WSP(float, WS_RS), ESC6}; pg8::gemm_phase<EpiK, pg8::StaticOrder, true>(F.lds, g, S, E, F.wave); }
        { const pg8::Gemm g = pg8::gemm_f8(WSP(unsigned char, WS_WUV), WSP(unsigned char, WS_KVC8), 2048, NT, 512, 512, 512); pg8::StaticOrder S; S.init(2048, NT, F.G, F.blk);
          EpiVT E{(unsigned char*)F.out + OUT_VT, WSP(float, WS_RS), ESC6}; pg8::gemm_phase<EpiVT, pg8::StaticOrder, true>(F.lds, g, S, E, F.wave); }
        krope_fill(F); SEAM(4); }
    if (IN(5)) {
#ifdef PROBE_ATTN
#pragma unroll 1
        for (int rep = 0; rep < PROBE_ATTN; ++rep) { attn_phase(F); xcd_barrier(bar); }
#else
        attn_phase(F);
#endif
        SEAM(5); }
    if (IN(6)) {
        pg8::Gemm g = pg8::gemm_f8(WSP(unsigned char, WS_S0), WSP(unsigned char, WS_WRNN), NT, DM, 2 * DM, DM, DM); g.A2 = WSP(unsigned char, WS_AO8); g.Bt2 = WSP(unsigned char, WS_WMLA); g.nt1 = DM / 128;
        pg8::StaticOrder S; S.init(NT, DM, F.G, F.blk);
        EpiMix E{WSP(bf16, WS_SGR), WSP(bf16, WS_SGM), WSP(unsigned char, WS_TMP8), SC_AO / SC_RA, 1.0f / (SC_AO * SC_WSQ)};
        pg8::gemm_phase<EpiMix, pg8::StaticOrder, true>(F.lds, g, S, E, F.wave); SEAM(6); }
    if (IN(7)) {
#ifdef PROBE_GEMM
#if PROBE_GEMM == 1
#define PROBE_ONE { pg8::Gemm gp = pg8::gemm_f8(WSP(unsigned char, WS_TMP8), WSP(unsigned char, WS_WO), NT, DM, DM, DM, DM); gp.nt = PROBE_NT; pg8::StaticOrder Sp; Sp.init(NT, DM, F.G, F.blk); \
            EpiRes1 Ep{F.x, WSP(float, WS_MOD), WSP(bf16, WS_PQ), 1.0f}; pg8::gemm_phase<EpiRes1, pg8::StaticOrder, true>(F.lds, gp, Sp, Ep, F.wave); xcd_barrier(bar); }
#elif PROBE_GEMM == 3
#define PROBE_ONE { pg8::Gemm gp = pg8::gemm_f8(WSP(unsigned char, WS_TMP8), WSP(unsigned char, WS_WO), NT, DM, DM, DM, DM); gp.nt = PROBE_NT; pg8::StaticOrder Sp; Sp.init(NT, DM, F.G, F.blk); \
            EpiPlain Ep{WSP(bf16, WS_PQ), 1.0f}; pg8::gemm_phase<EpiPlain, pg8::StaticOrder, true, true>(F.lds, gp, Sp, Ep, F.wave); xcd_barrier(bar); }
#elif PROBE_GEMM == 5
#define PROBE_ONE { pg8::Gemm gp = pg8::gemm_f8(WSP(unsigned char, WS_TMP8), WSP(unsigned char, WS_WO), NT, DM, DM, DM, DM); gp.nt = PROBE_NT; pg8::StaticOrder Sp; Sp.init(NT, DM, F.G, F.blk); \
            EpiNull Ep{WSP(float, WS_PQ)}; pg8::gemm_phase<EpiNull, pg8::StaticOrder, true, true>(F.lds, gp, Sp, Ep, F.wave); xcd_barrier(bar); }
#elif PROBE_GEMM == 4
#define PROBE_ONE { pg8::Gemm gp = pg8::gemm_bf16(WSP(bf16, WS_TMP), WSP(bf16, WS_WPQ), NT, DM, DM, DM, DM); gp.nt = PROBE_NT; pg8::StaticOrder Sp; Sp.init(NT, DM, F.G, F.blk); \
            EpiPlain Ep{WSP(bf16, WS_PQ), 1.0f}; pg8::gemm_phase<EpiPlain, pg8::StaticOrder>(F.lds, gp, Sp, Ep, F.wave); xcd_barrier(bar); }
#endif
#ifndef PROBE_PRB
#define PROBE_PRB 0
#endif
#ifndef PROBE_REP
#define PROBE_REP 1
#endif
        PROBE_ONE
#if PROBE_REP >= 2
        PROBE_ONE
#endif
#if PROBE_REP >= 3
        PROBE_ONE
#endif
#if PROBE_REP >= 4
        PROBE_ONE
#endif
#endif
        const pg8::Gemm g = pg8::gemm_f8(WSP(unsigned char, WS_TMP8), WSP(unsigned char, WS_WO), NT, DM, DM, DM, DM); pg8::StaticOrder S; S.init(NT, DM, F.G, F.blk);
        EpiRes1 E{F.x, WSP(float, WS_MOD), WSP(bf16, WS_R1), 1.0f / (SC_TMP * SC_WSQ)};
        pg8::gemm_phase<EpiRes1, pg8::StaticOrder, true>(F.lds, g, S, E, F.wave); SEAM(7); }
    if (IN(8)) { ln1_phase(F); SEAM(8); }
    if (IN(9)) {
        const pg8::Gemm g = pg8::gemm_f8(WSP(unsigned char, WS_H2I), WSP(unsigned char, WS_WPQ), NT, DM, DM, DM, DM); pg8::StaticOrder S; S.init(NT, DM, F.G, F.blk);
        EpiQuery E{WSP(bf16, WS_PQ), WSP(float, WS_HSC), WSP(float, WS_WQS)};
        pg8::gemm_phase<EpiQuery, pg8::StaticOrder, 2>(F.lds, g, S, E, F.wave); SEAM(9); }
#ifdef PROBE_BARS
#pragma unroll 1
    for (int r = 0; r < PROBE_BARS; ++r) xcd_barrier(bar);
#endif
    if (IN(10)) { DBL(10, peer_score_phase(F)); peer_score_phase(F); SEAM(10); }
    if (IN(11)) { DBL(11, peer_eval_phase(F)); peer_eval_phase(F); }
#undef IN
#undef SEAM
}

#ifdef PROBE_ATTN_PRB
__global__ void __launch_bounds__(NTHREADS, 2) attn_probe_kernel(Args args) {
    extern __shared__ __attribute__((aligned(16))) unsigned char lds_raw[];
    Frame F;
    F.lds = (LAS unsigned char*)lds_raw; F.tid = threadIdx.x; F.lane = F.tid & 63; F.wave = __builtin_amdgcn_readfirstlane(F.tid >> 6); F.G = gridDim.x; F.blk = blockIdx.x; F.out = args.out; F.ws = args.ws;
    attn_phase<32 | PROBE_ATTN_PRB>(F);
}
#endif
#ifdef DBG_STOP
__global__ void dbg_dump(const unsigned char* ws, size_t off, int is_f32, float* out) {
    const size_t n = (size_t)NT * DM; const size_t i0 = (size_t)blockIdx.x * blockDim.x + threadIdx.x, st = (size_t)gridDim.x * blockDim.x;
    if (is_f32) { const float* s = (const float*)(ws + off); for (size_t i = i0; i < n; i += st) out[i] = s[i]; }
    else { const bf16* s = (const bf16*)(ws + off); for (size_t i = i0; i < n; i += st) out[i] = i < (size_t)DBG_N ? bf1(s[i]) : 0.f; }
}
__global__ void dbg_count(const unsigned char* ws, size_t off, float lo, float hi, unsigned* cnt) {
    if (blockIdx.x != 0) return;
    const int pm = 3, ct = 2; const bf16* s = (const bf16*)(ws + off); __shared__ unsigned rowbad[256], colbad[256];
    rowbad[threadIdx.x] = 0; colbad[threadIdx.x] = 0; __syncthreads();
    for (int i = threadIdx.x; i < 65536; i += blockDim.x) { const int r = i >> 8, cc = i & 255; const float v = bf1(s[(size_t)(pm * 256 + r) * DM + ct * 256 + cc]); if (!(v >= lo && v <= hi)) { rowbad[r] = 1; colbad[cc] = 1; } }
    __syncthreads();
    if (threadIdx.x == 0) { unsigned nr = 0, nc = 0, fr = 999, fc = 999; for (int i = 0; i < 256; ++i) { if (rowbad[i]) { ++nr; if (fr == 999) fr = i; } if (colbad[i]) { ++nc; if (fc == 999) fc = i; } }
        cnt[0] = nr + 10; cnt[1] = nc + 10; cnt[2] = fr + 10; cnt[3] = fc + 10; }
}
__global__ void dbg_report(const unsigned* cnt, float* out) {
    const size_t n = (size_t)NT * DM; const size_t i0 = (size_t)blockIdx.x * blockDim.x + threadIdx.x, st = (size_t)gridDim.x * blockDim.x;
    const float v = (float)cnt[DBG_WHICH];
    for (size_t i = i0; i < n; i += st) out[i] = (i == 0) ? v : 0.f;
}
#endif
#ifdef PROBE_MB
template <int NM, int NV, int VT>
__global__ void __launch_bounds__(NTHREADS, 2) mb_kernel(float* sink, int iters) {
    const int lane = threadIdx.x & 63; unsigned h = (unsigned)(threadIdx.x + 512 * blockIdx.x) * 0x9E3779B9u + 0x7F4A7C15u;
    i32x8 a, b; for (int e = 0; e < 8; ++e) { h = h * 1664525u + 1013904223u; a[e] = (int)(h & 0x3F3F3F3Fu); h = h * 1664525u + 1013904223u; b[e] = (int)(h & 0x3F3F3F3Fu) ^ 0x00800080; }
    f32x16 acc[4]; for (int q = 0; q < 4; ++q) for (int e = 0; e < 16; ++e) acc[q][e] = 0.f;
    float v[12]; for (int e = 0; e < 12; ++e) v[e] = 0.001f * (float)(lane + e);
    const float c1 = 0.999f, c2 = 0.0007f;
#pragma unroll 1
    for (int it = 0; it < iters; ++it) {
#pragma unroll
        for (int q = 0; q < 4; ++q) {
            if (NM) acc[q] = __builtin_amdgcn_mfma_scale_f32_32x32x64_f8f6f4(a, b, acc[q], 0, 0, 0, 0x7F7F7F7F, 0, 0x7F7F7F7F);
            __builtin_amdgcn_sched_barrier(0);
#pragma unroll
            for (int e = 0; e < NV; ++e) v[e] = VT ? __builtin_amdgcn_exp2f(v[e]) : __builtin_fmaf(v[e], c1, c2);
            __builtin_amdgcn_sched_barrier(0);
        }
    }
    float sacc = 0.f; for (int q = 0; q < 4; ++q) for (int e = 0; e < 16; ++e) sacc += acc[q][e]; for (int e = 0; e < 12; ++e) sacc += v[e];
    sink[(size_t)blockIdx.x * 512 + threadIdx.x] = sacc;
}
#endif
extern "C" void kernel_launch(void* const* d_in, const int* in_sizes, int n_in, void* d_out, int out_size, void* d_ws, size_t ws_size, hipStream_t stream) {
    static int grid = 0;
    if (grid == 0) {
        if (n_in != 28 || out_size != NT * DM || ws_size < WS_END) { fprintf(stderr, "kernel_launch: unexpected shapes (n_in %d, out %d, ws %zu)\n", n_in, out_size, ws_size); grid = -1; return; }
        int dev = 0, cus = 0, per_cu = 0;
        if (hipGetDevice(&dev) != hipSuccess || hipDeviceGetAttribute(&cus, hipDeviceAttributeMultiprocessorCount, dev) != hipSuccess) { grid = -1; return; }
        if (hipFuncSetAttribute((const void*)fwd_kernel, hipFuncAttributeMaxDynamicSharedMemorySize, LDS_BYTES) != hipSuccess) { fprintf(stderr, "kernel_launch: hipFuncSetAttribute failed\n"); grid = -1; return; }
        if (hipOccupancyMaxActiveBlocksPerMultiprocessor(&per_cu, (const void*)fwd_kernel, NTHREADS, LDS_BYTES) != hipSuccess || per_cu < 1)
            fprintf(stderr, "kernel_launch: occupancy query reports %d workgroups per CU\n", per_cu);
        (void)hipGetLastError();
        grid = cus;
    }
    if (grid < 0) return;
    if (hipMemsetAsync((char*)d_ws + WS_CTL, 0, CTL_ZERO_BYTES, stream) != hipSuccess) return;
#ifdef PROBE_MB
    hipLaunchKernelGGL((mb_kernel<PROBE_MB_NM, PROBE_MB_NV, PROBE_MB_VT>), dim3(grid), dim3(NTHREADS), 0, stream, (float*)((char*)d_ws + WS_XR), 4000);
#endif
    Args a{};
    for (int i = 0; i < 28; ++i) a.in[i] = (const float*)d_in[i];
    a.out = (float*)d_out; a.ws = (unsigned char*)d_ws;
#ifdef PROBE_RELAUNCH
    a.ph_lo = 0; a.ph_hi = PROBE_RELAUNCH + 1; a.bslot = 0;
    hipLaunchKernelGGL(fwd_kernel, dim3(grid), dim3(NTHREADS), LDS_BYTES, stream, a);
#ifdef PROBE_ATTN_PRB
    { static bool once = false; if (!once) { once = true; (void)hipFuncSetAttribute((const void*)attn_probe_kernel, hipFuncAttributeMaxDynamicSharedMemorySize, LDS_BYTES); } }
    for (int r = 0; r < PROBE_RELAUNCH_N; ++r) hipLaunchKernelGGL(attn_probe_kernel, dim3(grid), dim3(NTHREADS), LDS_BYTES, stream, a);
#else
    for (int r = 0; r < PROBE_RELAUNCH_N; ++r) { a.ph_lo = PROBE_RELAUNCH; a.ph_hi = PROBE_RELAUNCH + 1; a.bslot = 2 + r; hipLaunchKernelGGL(fwd_kernel, dim3(grid), dim3(NTHREADS), LDS_BYTES, stream, a); }
#endif
    if (PROBE_RELAUNCH + 1 < NPHASE) { a.ph_lo = PROBE_RELAUNCH + 1; a.ph_hi = NPHASE; a.bslot = 1; hipLaunchKernelGGL(fwd_kernel, dim3(grid), dim3(NTHREADS), LDS_BYTES, stream, a); }
#elif MK_N_LAUNCHES == 1
    a.ph_lo = 0; a.ph_hi = NPHASE;
    hipLaunchKernelGGL(fwd_kernel, dim3(grid), dim3(NTHREADS), LDS_BYTES, stream, a);
#else
#ifdef DBG_STOP
    for (int p = 0; p <= DBG_STOP; ++p) { a.ph_lo = p; a.ph_hi = p + 1; hipLaunchKernelGGL(fwd_kernel, dim3(grid), dim3(NTHREADS), LDS_BYTES, stream, a); }
#ifdef DBG_COUNT
        hipLaunchKernelGGL(dbg_count, dim3(1024), dim3(256), 0, stream, (const unsigned char*)d_ws, (size_t)DBG_OFF, DBG_LO, DBG_HI, (unsigned*)d_ws + 1024);
    hipLaunchKernelGGL(dbg_report, dim3(2048), dim3(256), 0, stream, (const unsigned*)d_ws + 1024, (float*)d_out);
#else
    hipLaunchKernelGGL(dbg_dump, dim3(2048), dim3(256), 0, stream, (const unsigned char*)d_ws, (size_t)DBG_OFF, DBG_F32, (float*)d_out);
#endif
#else
    for (int p = 0; p < NPHASE; ++p) { a.ph_lo = p; a.ph_hi = p + 1; hipLaunchKernelGGL(fwd_kernel, dim3(grid), dim3(NTHREADS), LDS_BYTES, stream, a); }
#endif
#endif
    const hipError_t le = hipPeekAtLastError();
    if (le != hipSuccess) fprintf(stderr, "kernel_launch: launch failed: %s\n", hipGetErrorName(le));
}
```

```cpp
#include <hip/hip_runtime.h>
#include <cstdio>
#include <cstdint>

#ifndef MK_N_LAUNCHES
#define MK_N_LAUNCHES 1
#endif

#define LAS __attribute__((address_space(3)))
#define GAS __attribute__((address_space(1)))
typedef unsigned short bf16;
typedef short bf16x8 __attribute__((ext_vector_type(8)));
typedef float f32x2 __attribute__((ext_vector_type(2)));
typedef _Float16 f16x2 __attribute__((ext_vector_type(2)));
typedef float f32x4 __attribute__((ext_vector_type(4)));
typedef float f32x16 __attribute__((ext_vector_type(16)));
typedef unsigned u32x2 __attribute__((ext_vector_type(2)));
typedef unsigned u32x4 __attribute__((ext_vector_type(4)));
typedef int i32x4 __attribute__((ext_vector_type(4)));
typedef int i32x8 __attribute__((ext_vector_type(8)));

constexpr int NB = 4, SEQ = 8192, DM = 2048, NT = NB * SEQ;
constexpr int NH = 16, QLORA = 512, KVLORA = 512, DNOPE = 128, DROPE = 64, DV = 128, DQK = 192;
constexpr int IN_COLS = 9280, NPROJ = 9472;
constexpr int PEER_H = 8, NKEYS = 128, TOPK = 16;
constexpr float DN_ALPHA = 1.189207115002721f;
constexpr float LN_EPS = 1e-5f, RMS_EPS = 1e-6f;
constexpr float QSCALE = 0.07216878364870322f * 1.4426950408889634f;
constexpr int NWAVES = 8, NTHREADS = 512;
constexpr float PU_SCALE = 1024.0f, PV_SCALE = 64.0f;
constexpr float SC_H = 16.0f, SC_WIN = 1024.0f, SC_RA = 4.0f, SC_AO = 32.0f, SC_TMP = 32.0f, SC_WSQ = 2048.0f;
constexpr float SC_Q = 64.0f, SC_K = 16.0f, SC_V = 16.0f, SC_P = 64.0f;

constexpr size_t MiB = 1u << 20;
constexpr size_t WS_CTL = 0, CTL_ZERO_BYTES = 1 * MiB;
constexpr size_t WS_MOD = 1 * MiB;
constexpr size_t WS_RS = 1 * MiB + 512 * 1024;
constexpr size_t WS_SSP = 100 * MiB;
constexpr size_t WS_ROPE = 2 * MiB;
constexpr size_t WS_WIN = 10 * MiB;
constexpr size_t WS_WRNN = 47 * MiB, WS_WMLA = 55 * MiB, WS_WO = 63 * MiB, WS_WPQ = 71 * MiB;
constexpr size_t WS_WUQ = 79 * MiB;
constexpr size_t WS_WUK = 82 * MiB, WS_WUV = 84 * MiB;
constexpr size_t WS_WGA = 86 * MiB;
constexpr size_t WS_WGX = 86 * MiB + 512 * 1024;
constexpr size_t WS_PKEYS = 87 * MiB;
constexpr size_t WS_SUMM = 88 * MiB;
constexpr size_t WS_KR = 90 * MiB;
constexpr size_t WS_S0 = 128 * MiB;
constexpr size_t WS_XR = 256 * MiB, WS_GG = 384 * MiB, WS_SGR = 512 * MiB, WS_SGM = 640 * MiB;
constexpr size_t WS_QKVC = 768 * MiB;
constexpr size_t WS_KVC8 = 800 * MiB;
constexpr size_t WS_TMP = 832 * MiB;
constexpr size_t WS_IDX = 960 * MiB, WS_GATE = 976 * MiB;
constexpr size_t WS_TMP8 = 768 * MiB;
constexpr size_t WS_K = 256 * MiB;
constexpr size_t WS_VT = 448 * MiB;
constexpr size_t WS_R1 = 256 * MiB;
constexpr size_t WS_PQ = 512 * MiB;
constexpr size_t WS_PU = 640 * MiB, WS_PV = 704 * MiB;
constexpr size_t WS_END = 1024 * MiB;
constexpr size_t WS_WQS = WS_WPQ + 4 * MiB;
constexpr size_t CTL_WQAMAX = 32768 * 4;
constexpr size_t WS_H2I = 768 * MiB;
constexpr size_t WS_HSC = 100 * MiB, WS_USC = 101 * MiB, WS_VSC = 102 * MiB;
constexpr size_t WS_AO8 = WS_S0 + 64 * MiB;
constexpr size_t OUT_Q = 0, OUT_K = 96 * MiB, OUT_VT = 192 * MiB;

constexpr int LDS_BYTES = 147456, LDSCTL_OFF = 146944;

typedef __bf16 bf16v2 __attribute__((ext_vector_type(2)));
__device__ __forceinline__ unsigned pk2(float lo, float hi) { const bf16v2 v = __builtin_convertvector((f32x2){lo, hi}, bf16v2); return __builtin_bit_cast(unsigned, v); }
__device__ __forceinline__ float bflo(unsigned w) { return __uint_as_float(w << 16); }
__device__ __forceinline__ float bfhi(unsigned w) { return __uint_as_float(w & 0xffff0000u); }
__device__ __forceinline__ float bf1(bf16 b) { return __uint_as_float(((unsigned)b) << 16); }
__device__ __forceinline__ float sigmoidf_(float y) { return __builtin_amdgcn_rcpf(1.0f + __builtin_amdgcn_exp2f(-1.4426950408889634f * y)); }
__device__ __forceinline__ float gelu_tanh(float x) { const float z = 0.7978845608028654f * (x + 0.044715f * x * x * x); return x * sigmoidf_(2.0f * z); }
__device__ __forceinline__ float wave_sum(float v) {
#pragma unroll
    for (int o = 1; o < 64; o <<= 1) v += __shfl_xor(v, o);
    return v;
}
__device__ __forceinline__ float clamp448(float v) { return __builtin_amdgcn_fmed3f(v, -448.0f, 448.0f); }
__device__ __forceinline__ unsigned pk4_f8(float a, float b, float c, float d) { int w = __builtin_amdgcn_cvt_pk_fp8_f32(clamp448(a), clamp448(b), 0, false); w = __builtin_amdgcn_cvt_pk_fp8_f32(clamp448(c), clamp448(d), w, true); return (unsigned)w; }
__device__ __forceinline__ int fresh_lane() { int l; asm volatile("v_mbcnt_lo_u32_b32 %0, -1, 0\n\tv_mbcnt_hi_u32_b32 %0, -1, %0" : "=v"(l)); return l; }
__device__ __forceinline__ float wave_max(float v) {
#pragma unroll
    for (int o = 1; o < 64; o <<= 1) v = fmaxf(v, __shfl_xor(v, o));
    return v;
}
__device__ __forceinline__ unsigned pk4_i8(float a, float b, float c, float d) {
    const int ia = (int)__builtin_rintf(__builtin_amdgcn_fmed3f(a, -127.f, 127.f)), ib = (int)__builtin_rintf(__builtin_amdgcn_fmed3f(b, -127.f, 127.f)), ic = (int)__builtin_rintf(__builtin_amdgcn_fmed3f(c, -127.f, 127.f)), id = (int)__builtin_rintf(__builtin_amdgcn_fmed3f(d, -127.f, 127.f));
    return (unsigned)(ia & 0xff) | ((unsigned)(ib & 0xff) << 8) | ((unsigned)(ic & 0xff) << 16) | ((unsigned)id << 24); }
#define LDS_WAIT() asm volatile("s_waitcnt lgkmcnt(0)" ::: "memory")
#define VM_WAIT() asm volatile("s_waitcnt vmcnt(0)" ::: "memory")

#define XB_TMO      128
#define XB_XCNT(j)  (256  + 64 * (j))
#define XB_XSUB(j)  (1280 + 64 * (j))
#define XB_XGEN(j)  (2304 + 64 * (j))
#define XB_TOP      3328
#define XB_TOPGEN   3392
#define XCD_BAR_WORDS 3456
#define XB_SPIN_CAP (1u << 20)
__device__ __forceinline__ unsigned xb_ld(unsigned* p)              { return __hip_atomic_load(p, __ATOMIC_RELAXED, __HIP_MEMORY_SCOPE_AGENT); }
__device__ __forceinline__ unsigned xb_add(unsigned* p, unsigned v) { return __hip_atomic_fetch_add(p, v, __ATOMIC_RELAXED, __HIP_MEMORY_SCOPE_AGENT); }
__device__ __forceinline__ unsigned xb_xcc_id() { return (unsigned)__builtin_amdgcn_s_getreg((3 << 11) | 20) & 0xFu; }
#define XB_SPIN(cond, bar) do { unsigned _sp = 0; while (cond) { __builtin_amdgcn_s_sleep(1); \
    if ((++_sp & 255u) == 0u) { if (xb_ld(&(bar)[XB_TMO])) break; if (_sp > XB_SPIN_CAP) { atomicAdd(&(bar)[XB_TMO], 1u); break; } } } } while (0)
struct XcdBarrier { unsigned* bar; unsigned x; volatile LAS unsigned* st; };
__device__ __forceinline__ XcdBarrier xcd_barrier_post(unsigned* bar, volatile LAS unsigned* st) {
    XcdBarrier b; b.bar = bar; b.x = xb_xcc_id(); b.st = st;
    if (threadIdx.x == 0) (void)xb_add(&bar[XB_XCNT(b.x)], 1u);
    return b;
}
__device__ __forceinline__ void xcd_barrier_complete(unsigned* bar, unsigned x, unsigned& nloc, unsigned& nx) {
    const unsigned G = gridDim.x * gridDim.y * gridDim.z;
    unsigned sum, cnt, mine, sp = 0u;
    for (;;) {
        sum = 0u; cnt = 0u; mine = 0u;
#pragma unroll
        for (unsigned j = 0; j < 16; ++j) { const unsigned c = xb_ld(&bar[XB_XCNT(j)]); sum += c; cnt += (c > 0u) ? 1u : 0u; mine = (j == x) ? c : mine; }
        if (sum == G) break;
        __builtin_amdgcn_s_sleep(1);
        if ((++sp & 255u) == 0u) { if (xb_ld(&bar[XB_TMO])) break; if (sp > XB_SPIN_CAP) { atomicAdd(&bar[XB_TMO], 1u); break; } }
    }
    nloc = mine > 0u ? mine : 1u; nx = cnt > 0u ? cnt : 1u;
}
__device__ __forceinline__ void xcd_barrier(const XcdBarrier& b) {
    asm volatile("s_waitcnt vmcnt(0)" ::: "memory");
    __syncthreads();
    if (threadIdx.x == 0) {
        unsigned* bar = b.bar;
        __builtin_amdgcn_s_waitcnt(0);
        unsigned nloc = b.st[0], nx = b.st[1];
        if (nloc == 0u) { xcd_barrier_complete(bar, b.x, nloc, nx); b.st[0] = nloc; b.st[1] = nx; }
        const unsigned old = xb_add(&bar[XB_XSUB(b.x)], 1u);
        const unsigned gen = old / nloc;
        if (old + 1u == (gen + 1u) * nloc) {
            __builtin_amdgcn_fence(__ATOMIC_RELEASE, "agent");
            asm volatile("s_waitcnt vmcnt(0)" ::: "memory");
            const unsigned og = xb_add(&bar[XB_TOP], 1u);
            const unsigned tg = og / nx;
            if (og + 1u == (tg + 1u) * nx) xb_add(&bar[XB_TOPGEN], 1u);
            else XB_SPIN(xb_ld(&bar[XB_TOPGEN]) == tg, bar);
            __builtin_amdgcn_fence(__ATOMIC_ACQUIRE, "agent");
            asm volatile("s_waitcnt vmcnt(0)" ::: "memory");
        } else {
            XB_SPIN(xb_ld(&bar[XB_TOPGEN]) == gen, bar);
            __builtin_amdgcn_fence(__ATOMIC_ACQUIRE, "agent");
            asm volatile("s_waitcnt vmcnt(0)" ::: "memory");
        }
    }
    __syncthreads();
}

__device__ __forceinline__ void glds16(const char* sbase, unsigned voff, unsigned lds_dst) {
    unsigned keep;
    asm volatile("s_mov_b32 %0, m0\n\ts_mov_b32 m0, %3\n\ts_nop 0\n\tglobal_load_lds_dwordx4 %1, %2\n\ts_mov_b32 m0, %0" : "=&s"(keep) : "v"(voff), "s"(sbase), "s"(lds_dst) : "memory");
}
namespace pg8 {
constexpr int BM = 256, BK = 64, HALF = 128, HTB = HALF * BK * 2, STAGE_BYTES = 8 * HTB, NXCD = 8, WGM = 4;
__host__ __device__ __forceinline__ int lds_byte(int r, int c) { const int st = (r >> 4) * 2 + (c >> 5), rr = r & 15, cc = c & 31, ob = rr * 64 + cc * 2; return st * 1024 + (ob ^ (((ob >> 9) & 1) << 5)); }
__host__ __device__ __forceinline__ void stage_rc(int b, int& R, int& C) { const int st = b / 1024, sb = b % 1024, swz = sb ^ (((sb >> 9) & 1) << 5); R = (st >> 1) * 16 + swz / 64; C = (st & 1) * 32 + (swz % 64) / 2; }
__host__ __device__ __forceinline__ int perm32(int rho) { const int n = rho >> 4, i = rho & 15; return 8 * (i >> 2) + 4 * n + (i & 3); }
struct Unit { int pm, pn; };
struct Gemm { const void* A; const void* Bt; int M, N, nt, lda_b, ldb_b; const void* A2 = nullptr; const void* Bt2 = nullptr; int nt1 = 0; };
__host__ __device__ __forceinline__ Gemm gemm_bf16(const bf16* A, const bf16* Bt, int M, int N, int K, int lda, int ldb) { return Gemm{A, Bt, M, N, K / 64, lda * 2, ldb * 2}; }
__host__ __device__ __forceinline__ Gemm gemm_f8(const unsigned char* A, const unsigned char* Bt, int M, int N, int K, int lda, int ldb) { return Gemm{A, Bt, M, N, K / 128, lda, ldb}; }
struct StaticOrder {
    int nM, nN, nwg, G, c;
    __host__ __device__ void init(int M, int N, int G_, int c_) { nM = M / BM; nN = N / BM; nwg = nM * nN; G = G_; c = c_; }
    __host__ __device__ bool next(int i, Unit& u) const {
        const long L = (long)i * G + c; if (L >= nwg) return false;
        int wgid = (int)L; { const int q = nwg / NXCD, r = nwg % NXCD, xcd = wgid % NXCD, off = wgid / NXCD; wgid = (xcd < r ? xcd * (q + 1) : r * (q + 1) + (xcd - r) * q) + off; }
        const int nig = WGM * nN, gid = wgid / nig, fm = gid * WGM, gsz = (nM - fm) < WGM ? (nM - fm) : WGM;
        u.pm = fm + ((wgid % nig) % gsz); u.pn = (wgid % nig) / gsz; return true;
    }
    __device__ __forceinline__ void a_ready(const Unit&) const {}
    __device__ __forceinline__ void done(const Unit&) const {}
};
template <class Epi, class Sched, int F8 = 0, bool ALIGN_EPI = true>
__device__ __forceinline__ void gemm_phase(LAS unsigned char* lds, const Gemm g, const Sched& S, const Epi& E, int wid) {
    const int lane = fresh_lane(), tid = wid * 64 + lane, wr = wid >> 2, wc = wid & 3, fr = lane & 15, fq = lane >> 4;
    const int nt = g.nt;
    unsigned voffA, voffB;
    { int R, C; stage_rc(tid * 16, R, C); const int Rb = Epi::PERM ? ((R & ~31) + perm32(R & 31)) : R; voffA = (unsigned)(R * g.lda_b + C * 2); voffB = (unsigned)(Rb * g.ldb_b + C * 2); }
    const size_t qstepA = (size_t)64 * g.lda_b, qstepB = (size_t)64 * g.ldb_b;
    const unsigned ldsbase = (unsigned)(size_t)lds;
    const size_t kstep = (size_t)(BK * 2);
    const size_t hstepA = (size_t)HALF * g.lda_b, hstepB = (size_t)HALF * g.ldb_b;
    const size_t tstepA = 2 * hstepA, tstepB = 2 * hstepB;
    const unsigned ldsw = (unsigned)wid * 1024u;
    const int aoff = lds_byte(wr * 64 + fr, fq * 8), boff = lds_byte(wc * 32 + fr, fq * 8);
#define PG8_SA(b, h) (((b) * 2 + (h)) * HTB)
#define PG8_SB(b, h) ((4 + (b) * 2 + (h)) * HTB)
#define PG8_STAGE_A(bufoff, gbase) do { glds16((const char*)(gbase), voffA, ldsbase + (bufoff) + ldsw); glds16((const char*)(gbase) + qstepA, voffA, ldsbase + (bufoff) + ldsw + 8192); } while (0)
#define PG8_STAGE_B(bufoff, gbase) do { glds16((const char*)(gbase), voffB, ldsbase + (bufoff) + ldsw); glds16((const char*)(gbase) + qstepB, voffB, ldsbase + (bufoff) + ldsw + 8192); } while (0)
#define PG8_LD8(p) __builtin_shufflevector(*(const LAS i32x4*)(p), *(const LAS i32x4*)((p) + 1024), 0, 1, 2, 3, 4, 5, 6, 7)
#define PG8_LDA(dst, b, h) do { _Pragma("unroll") for (int m = 0; m < 4; ++m) dst[m] = PG8_LD8(lds + PG8_SA(b, h) + aoff + m * 2048); } while (0)
#define PG8_LDB(dst, b, h) do { _Pragma("unroll") for (int n = 0; n < 2; ++n) dst[n] = PG8_LD8(lds + PG8_SB(b, h) + boff + n * 2048); } while (0)
#define PG8_LO(v) __builtin_bit_cast(bf16x8, __builtin_shufflevector(v, v, 0, 1, 2, 3))
#define PG8_HI(v) __builtin_bit_cast(bf16x8, __builtin_shufflevector(v, v, 4, 5, 6, 7))
#define PG8_MMA(ai, bj, At, Bt) do { __builtin_amdgcn_s_setprio(1); _Pragma("unroll") for (int m = 0; m < 4; ++m) _Pragma("unroll") for (int n = 0; n < 2; ++n) { \
        if constexpr (F8 == 1) acc[ai][bj][m][n] = __builtin_amdgcn_mfma_scale_f32_16x16x128_f8f6f4(Bt[n], At[m], acc[ai][bj][m][n], 0, 0, 0, 0x7F7F7F7F, 0, 0x7F7F7F7F); \
        else if constexpr (F8 == 2) { i32x4 ci = __builtin_bit_cast(i32x4, acc[ai][bj][m][n]); \
               ci = __builtin_amdgcn_mfma_i32_16x16x64_i8(__builtin_shufflevector(Bt[n], Bt[n], 0, 1, 2, 3), __builtin_shufflevector(At[m], At[m], 0, 1, 2, 3), ci, 0, 0, 0); \
               ci = __builtin_amdgcn_mfma_i32_16x16x64_i8(__builtin_shufflevector(Bt[n], Bt[n], 4, 5, 6, 7), __builtin_shufflevector(At[m], At[m], 4, 5, 6, 7), ci, 0, 0, 0); \
               acc[ai][bj][m][n] = __builtin_bit_cast(f32x4, ci); } \
        else { acc[ai][bj][m][n] = __builtin_amdgcn_mfma_f32_16x16x32_bf16(PG8_LO(Bt[n]), PG8_LO(At[m]), acc[ai][bj][m][n], 0, 0, 0); \
               acc[ai][bj][m][n] = __builtin_amdgcn_mfma_f32_16x16x32_bf16(PG8_HI(Bt[n]), PG8_HI(At[m]), acc[ai][bj][m][n], 0, 0, 0); } } \
        __builtin_amdgcn_s_setprio(0); } while (0)
#define PG8_WAIT_V(n) asm volatile("s_waitcnt vmcnt(" #n ")" ::: "memory")
#define PG8_WAIT_L(n) asm volatile("s_waitcnt lgkmcnt(" #n ")" ::: "memory")
#define PG8_BAR __builtin_amdgcn_s_barrier()
#define PG8_SCHED __builtin_amdgcn_sched_barrier(0)
    Unit cur, nxt; int ui = 0;
    if (!S.next(0, cur)) return;
    f32x4 acc[2][2][4][2];
#pragma unroll
    for (int a = 0; a < 2; ++a)
#pragma unroll
        for (int b = 0; b < 2; ++b)
#pragma unroll
            for (int m = 0; m < 4; ++m)
#pragma unroll
                for (int n = 0; n < 2; ++n) acc[a][b][m][n] = (f32x4){0.f, 0.f, 0.f, 0.f};
    i32x8 At[4], B0[2], B1[2];
    const char* cA = (const char*)g.A + (size_t)cur.pm * tstepA; const char* cB = (const char*)g.Bt + (size_t)cur.pn * tstepB;
    const bool two = g.A2 != nullptr; const int nt1 = two ? g.nt1 : nt;
    const char* cA2 = two ? (const char*)g.A2 + (size_t)cur.pm * tstepA : cA; const char* cB2 = two ? (const char*)g.Bt2 + (size_t)cur.pn * tstepB : cB;
    S.a_ready(cur);
    PG8_STAGE_B(PG8_SB(0, 0), cB); PG8_STAGE_B(PG8_SB(0, 1), cB + hstepB); PG8_STAGE_A(PG8_SA(0, 0), cA); PG8_STAGE_A(PG8_SA(0, 1), cA + hstepA);
    if (wr == 1) PG8_BAR;
    PG8_WAIT_V(2); PG8_BAR;
    PG8_STAGE_B(PG8_SB(1, 0), cB + kstep); PG8_STAGE_A(PG8_SA(1, 0), cA + kstep); PG8_STAGE_B(PG8_SB(1, 1), cB + hstepB + kstep);
    PG8_WAIT_V(6); PG8_BAR;
    for (;;) {
        const bool has_next = S.next(ui + 1, nxt);
        const char* nA = has_next ? (const char*)g.A + (size_t)nxt.pm * tstepA : cA; const char* nB = has_next ? (const char*)g.Bt + (size_t)nxt.pn * tstepB : cB;
#pragma unroll 1
        for (int t = 0; t < nt; t += 2) {
            const bool last = (t == nt - 2);
            const char* a1 = (t < nt1 ? cA + (size_t)t * kstep : cA2 + (size_t)(t - nt1) * kstep) + kstep;
            const char* a2 = last ? nA : (t + 2 < nt1 ? cA + (size_t)(t + 2) * kstep : cA2 + (size_t)(t + 2 - nt1) * kstep);
            const char* b2 = last ? nB : (t + 2 < nt1 ? cB + (size_t)(t + 2) * kstep : cB2 + (size_t)(t + 2 - nt1) * kstep);
            const char* a3 = a2 + kstep; const char* b3 = b2 + kstep;
            if (last && has_next) S.a_ready(nxt);
            PG8_LDB(B0, 0, 0); PG8_LDB(B1, 0, 1); PG8_SCHED; PG8_LDA(At, 0, 0); PG8_STAGE_A(PG8_SA(1, 1), a1 + hstepA);
            PG8_WAIT_V(8); PG8_WAIT_L(0); PG8_BAR; PG8_MMA(0, 0, At, B0); PG8_MMA(0, 1, At, B1); PG8_BAR; PG8_SCHED;
            PG8_LDA(At, 0, 1); PG8_STAGE_B(PG8_SB(0, 0), b2); PG8_STAGE_B(PG8_SB(0, 1), b2 + hstepB); PG8_STAGE_A(PG8_SA(0, 0), a2);
            PG8_WAIT_V(8); PG8_WAIT_L(0); PG8_BAR; PG8_MMA(1, 0, At, B0); PG8_MMA(1, 1, At, B1); PG8_BAR; PG8_SCHED;
            PG8_LDB(B0, 1, 0); PG8_LDB(B1, 1, 1); PG8_SCHED; PG8_LDA(At, 1, 0); PG8_STAGE_A(PG8_SA(0, 1), a2 + hstepA);
            PG8_WAIT_V(8); PG8_WAIT_L(0); PG8_BAR; PG8_MMA(0, 0, At, B0); PG8_MMA(0, 1, At, B1); PG8_BAR; PG8_SCHED;
            PG8_LDA(At, 1, 1); PG8_STAGE_B(PG8_SB(1, 0), b3); PG8_STAGE_B(PG8_SB(1, 1), b3 + hstepB); PG8_STAGE_A(PG8_SA(1, 0), a3);
            PG8_WAIT_V(8); PG8_WAIT_L(0); PG8_BAR; PG8_MMA(1, 0, At, B0); PG8_MMA(1, 1, At, B1); PG8_BAR; PG8_SCHED;
            if constexpr (Epi::HAS_MID) { if (t + 2 == nt1) { int fr2 = fr, fq2 = fq; asm volatile("" : "+v"(fr2), "+v"(fq2)); E.mid(acc, cur, wr, wc, fr2, fq2); } }
        }
        if constexpr (ALIGN_EPI) { if (wr == 0) PG8_BAR; }
        { int fr2 = fr, fq2 = fq; asm volatile("" : "+v"(fr2), "+v"(fq2));
          E(acc, cur, wr, wc, fr2, fq2); }
        if (!has_next) break;
#pragma unroll
        for (int a = 0; a < 2; ++a)
#pragma unroll
            for (int b = 0; b < 2; ++b)
#pragma unroll
                for (int m = 0; m < 4; ++m)
#pragma unroll
                    for (int n = 0; n < 2; ++n) acc[a][b][m][n] = (f32x4){0.f, 0.f, 0.f, 0.f};
        cur = nxt; cA = nA; cB = nB; ++ui;
        if (two) { cA2 = (const char*)g.A2 + (size_t)cur.pm * tstepA; cB2 = (const char*)g.Bt2 + (size_t)cur.pn * tstepB; } else { cA2 = cA; cB2 = cB; }
        if constexpr (ALIGN_EPI) { if (wr == 1) PG8_BAR; }
    }
    PG8_WAIT_V(0);
    if constexpr (!ALIGN_EPI) { if (wr == 0) PG8_BAR; }
    PG8_BAR;
#undef PG8_SA
#undef PG8_SB
#undef PG8_STAGE_A
#undef PG8_STAGE_B
#undef PG8_LDA
#undef PG8_LDB
#undef PG8_LD8
#undef PG8_LO
#undef PG8_HI
#undef PG8_MMA
#undef PG8_WAIT_V
#undef PG8_WAIT_L
#undef PG8_BAR
#undef PG8_SCHED
}
}
typedef f32x4 AccT[2][2][4][2];

#ifdef PROBE_RELAUNCH
struct Args { const float* in[28]; float* out; unsigned char* ws; int ph_lo, ph_hi, bslot; };
#else
struct Args { const float* in[28]; float* out; unsigned char* ws; int ph_lo, ph_hi; };
#endif
struct Frame {
    LAS unsigned char* lds; int tid, lane, wave, G, blk;
    const float *x, *c, *w_ada, *b_ada, *w_in, *conv_w, *conv_b, *w_rg_a, *b_rg_a, *w_rg_x, *b_rg_x, *rg_lambda, *w_rnn_out, *q_norm_g, *w_uq, *kv_norm_g, *w_ukv,
                *w_mla_out, *w_o, *ln1_g, *ln1_b, *peer_wq, *peer_keys, *peer_u, *peer_v, *ln2_g, *ln2_b;
    const int* positions;
    float* out; unsigned char* ws;
};
#define WSP(T, off) ((T*)(F.ws + (off)))

template <int MAP> __device__ __forceinline__ int colmap(int n) {
    if (MAP == 0) return n;
    if (MAP == 1) return n < 5120 ? n : (n < 9216 ? n + 64 : (n < 9280 ? n - 4096 : -1));
    if (MAP == 2) { if (n < 2048) return (n >> 7) * 192 + (n & 127); const int m = n - 2048, h = m >> 6, jj = m & 63; return h * 192 + 128 + (jj >> 1) + 32 * (jj & 1); }
    if (MAP == 3) return (n >> 7) * 256 + (n & 127);
    return (n >> 7) * 256 + 128 + (n & 127);
}
template <int MAP, bool F8> __device__ __forceinline__ void tr_item64(const float* W, int ldw, void* WTv, int ldt, float scale, const float* kscale, LAS float* scr, int k0, int n0, int lane) {
    const int col = colmap<MAP>(n0 + lane);
#pragma unroll
    for (int kk = 0; kk < 64; ++kk) { float v = 0.f;
        if (col >= 0) { v = W[(size_t)(k0 + kk) * ldw + col] * scale; if (kscale) v *= kscale[k0 + kk]; }
        scr[kk * 65 + lane] = v; }
    LDS_WAIT();
    const LAS float* sp = scr + lane;
    if (F8) { unsigned char* o = (unsigned char*)WTv + (size_t)(n0 + lane) * ldt + k0;
#pragma unroll
        for (int q = 0; q < 4; ++q) { u32x4 w;
#pragma unroll
            for (int d = 0; d < 4; ++d) { const int k = 16 * q + 4 * d; w[d] = pk4_f8(sp[k * 65], sp[(k + 1) * 65], sp[(k + 2) * 65], sp[(k + 3) * 65]); }
            *(u32x4*)(o + 16 * q) = w; }
    } else { bf16* o = (bf16*)WTv + (size_t)(n0 + lane) * ldt + k0;
#pragma unroll
        for (int q = 0; q < 8; ++q) { u32x4 w;
#pragma unroll
            for (int d = 0; d < 4; ++d) { const int k = 8 * q + 2 * d; w[d] = pk2(sp[k * 65], sp[(k + 1) * 65]); }
            *(u32x4*)(o + 8 * q) = w; } }
    LDS_WAIT();
}
__device__ __forceinline__ void p0_prologue(Frame& F, int qbank = 0) {
    const int tid = F.tid, lane = F.lane;
    if (F.blk < 192) {
        LAS float* ca = (LAS float*)F.lds; LAS float* red = (LAS float*)(F.lds + 32768);
        for (int i = tid; i < NB * DM; i += NTHREADS) { const float v = F.c[i]; ca[i] = v * sigmoidf_(v); }
        __syncthreads();
        const int cq = tid & 15, rg = tid >> 4, c0 = 64 * F.blk + 4 * cq;
        f32x4 a0 = {0, 0, 0, 0}, a1 = a0, a2 = a0, a3 = a0;
#pragma unroll 8
        for (int k = rg; k < DM; k += 32) { const f32x4 w = *(const f32x4*)(F.w_ada + (size_t)k * 12288 + c0);
            a0 += ca[k] * w; a1 += ca[DM + k] * w; a2 += ca[2 * DM + k] * w; a3 += ca[3 * DM + k] * w; }
        *(LAS f32x4*)(red + (rg * 4 + 0) * 64 + 4 * cq) = a0; *(LAS f32x4*)(red + (rg * 4 + 1) * 64 + 4 * cq) = a1;
        *(LAS f32x4*)(red + (rg * 4 + 2) * 64 + 4 * cq) = a2; *(LAS f32x4*)(red + (rg * 4 + 3) * 64 + 4 * cq) = a3;
        __syncthreads();
        if (tid < 256) { const int b = tid >> 6, col = tid & 63; float s = 0.f;
            for (int r = 0; r < 32; ++r) s += red[(r * 4 + b) * 64 + col];
            WSP(float, WS_MOD)[b * 12288 + 64 * F.blk + col] = s + F.b_ada[64 * F.blk + col]; }
        __syncthreads();
    }
    {
        LAS float* scr = (LAS float*)(F.lds + F.wave * 16640);
        unsigned* qhead = (unsigned*)(F.ws + WS_CTL) + 8192 + 2048 * qbank + 64 * (F.blk & 31);
        constexpr int I_IN = (NPROJ / 64) * (DM / 64), I_SQ = (DM / 64) * (DM / 64), I_UQ = (3072 / 64) * (512 / 64), I_UK = (2048 / 64) * (512 / 64), I_RG = 16 * 2 * 2;
        constexpr int NITEMS = I_IN + 4 * I_SQ + I_UQ + 2 * I_UK + 2 * I_RG;
        int nxt = 0; if (lane == 0) nxt = (int)__hip_atomic_fetch_add(qhead, 1u, __ATOMIC_RELAXED, __HIP_MEMORY_SCOPE_AGENT);
        for (;;) {
            const int it = __builtin_amdgcn_readfirstlane(nxt) * 32 + (F.blk & 31); if (it >= NITEMS) break;
            if (lane == 0) nxt = (int)__hip_atomic_fetch_add(qhead, 1u, __ATOMIC_RELAXED, __HIP_MEMORY_SCOPE_AGENT);
            int r = it;
            if (r < I_IN) { tr_item64<1, true>(F.w_in, IN_COLS, WSP(unsigned char, WS_WIN), DM, SC_WIN, nullptr, scr, 64 * (r / (NPROJ / 64)), 64 * (r % (NPROJ / 64)), lane); continue; } r -= I_IN;
            if (r < I_SQ) { tr_item64<0, true>(F.w_rnn_out, DM, WSP(unsigned char, WS_WRNN), DM, SC_WSQ, nullptr, scr, 64 * (r / 32), 64 * (r % 32), lane); continue; } r -= I_SQ;
            if (r < I_SQ) { tr_item64<0, true>(F.w_mla_out, DM, WSP(unsigned char, WS_WMLA), DM, SC_WSQ, nullptr, scr, 64 * (r / 32), 64 * (r % 32), lane); continue; } r -= I_SQ;
            if (r < I_SQ) { tr_item64<0, true>(F.w_o, DM, WSP(unsigned char, WS_WO), DM, SC_WSQ, nullptr, scr, 64 * (r / 32), 64 * (r % 32), lane); continue; } r -= I_SQ;
            if (r < I_SQ) {
                const int k0 = 64 * (r / 32), n0 = 64 * (r % 32); float am = 0.f;
#pragma unroll
                for (int kk = 0; kk < 64; ++kk) am = fmaxf(am, fabsf(F.peer_wq[(size_t)(k0 + kk) * DM + n0 + lane]));
                (void)__hip_atomic_fetch_max((unsigned*)(F.ws + WS_CTL + CTL_WQAMAX) + n0 + lane, __float_as_uint(am), __ATOMIC_RELAXED, __HIP_MEMORY_SCOPE_AGENT);
                continue; } r -= I_SQ;
            if (r < I_UQ) { tr_item64<2, true>(F.w_uq, 3072, WSP(unsigned char, WS_WUQ), 512, SC_WIN, F.q_norm_g, scr, 64 * (r / 48), 64 * (r % 48), lane); continue; } r -= I_UQ;
            if (r < I_UK) { tr_item64<3, true>(F.w_ukv, 4096, WSP(unsigned char, WS_WUK), 512, SC_WIN, F.kv_norm_g, scr, 64 * (r / 32), 64 * (r % 32), lane); continue; } r -= I_UK;
            if (r < I_UK) { tr_item64<4, true>(F.w_ukv, 4096, WSP(unsigned char, WS_WUV), 512, SC_WIN, F.kv_norm_g, scr, 64 * (r / 32), 64 * (r % 32), lane); continue; } r -= I_UK;
            if (r < I_RG) { const int h = r >> 2, q = r & 3; tr_item64<0, false>(F.w_rg_a + h * 16384, 128, WSP(bf16, WS_WGA) + h * 16384, 128, 1.0f, nullptr, scr, 64 * (q >> 1), 64 * (q & 1), lane); continue; } r -= I_RG;
            { const int h = r >> 2, q = r & 3; tr_item64<0, false>(F.w_rg_x + h * 16384, 128, WSP(bf16, WS_WGX) + h * 16384, 128, 1.0f, nullptr, scr, 64 * (q >> 1), 64 * (q & 1), lane); }
        }
    }
    {
        const int gt = F.blk * NTHREADS + tid, NGT = F.G * NTHREADS;
        f32x2* rope = WSP(f32x2, WS_ROPE);
        for (int i = gt; i < NT * 32; i += NGT) { const int t = i >> 5, j = i & 31;
            const float inv_freq = exp2f(-(float)j * (13.287712379549449f / 32.0f));
            const float ang = (float)F.positions[t] * inv_freq;
            double rev = (double)ang * 0.15915494309189535; rev -= rint(rev);
            const float rv = (float)rev;
            rope[i] = (f32x2){__builtin_amdgcn_cosf(rv), __builtin_amdgcn_sinf(rv)}; }
        bf16* pk = WSP(bf16, WS_PKEYS);
        for (int i = gt; i < 2 * 128 * 128 / 2; i += NGT) { const f32x2 v = *(const f32x2*)(F.peer_keys + 2 * i); ((unsigned*)pk)[i] = pk2(v.x, v.y); }
    }
}

__device__ __forceinline__ void p1_modulate(Frame& F) {
    const int gw = F.blk * NWAVES + F.wave, NGW = F.G * NWAVES;
    const float* mod = WSP(float, WS_MOD); unsigned char* hb = WSP(unsigned char, WS_S0);
    for (int m = gw; m < NT; m += NGW) {
        const int b = m >> 13; const float* sh = mod + b * 12288; const float* sc = sh + 2048;
#pragma unroll
        for (int j = 0; j < 2; ++j) { const int col = 1024 * j + 16 * F.lane; u32x4 o;
#pragma unroll
            for (int q = 0; q < 4; ++q) { const f32x4 v = *(const f32x4*)(F.x + (size_t)m * DM + col + 4 * q), s = *(const f32x4*)(sc + col + 4 * q), h = *(const f32x4*)(sh + col + 4 * q);
                o[q] = pk4_f8((v.x * (1.f + s.x) + h.x) * SC_H, (v.y * (1.f + s.y) + h.y) * SC_H, (v.z * (1.f + s.z) + h.z) * SC_H, (v.w * (1.f + s.w) + h.w) * SC_H); }
            *(u32x4*)(hb + (size_t)m * DM + col) = o; }
    }
    if (F.wave < 4) {
        const int lane = F.lane, it = F.blk * 4 + F.wave;
        LAS float* scr = (LAS float*)(F.lds + F.wave * 16640);
        for (int r = it; r < 1024; r += 4 * F.G) {
            const int k0 = 64 * (r / 32), n0 = 64 * (r % 32);
            const float am = fmaxf(__uint_as_float(((const unsigned*)(F.ws + WS_CTL + CTL_WQAMAX))[n0 + lane]), 1e-30f), qs = 127.0f / am;
#pragma unroll
            for (int kk = 0; kk < 64; ++kk) scr[kk * 65 + lane] = F.peer_wq[(size_t)(k0 + kk) * DM + n0 + lane];
            LDS_WAIT();
            if (k0 == 0) WSP(float, WS_WQS)[n0 + lane] = am * (1.0f / 127.0f);
            const LAS float* sp = scr + lane;
            unsigned char* o = WSP(unsigned char, WS_WPQ) + (size_t)(n0 + lane) * DM + k0;
#pragma unroll
            for (int q = 0; q < 4; ++q) { u32x4 w;
#pragma unroll
                for (int d = 0; d < 4; ++d) { const int k = 16 * q + 4 * d; w[d] = pk4_i8(sp[k * 65] * qs, sp[(k + 1) * 65] * qs, sp[(k + 2) * 65] * qs, sp[(k + 3) * 65] * qs); }
                *(u32x4*)(o + 16 * q) = w; }
            LDS_WAIT();
        }
    }
}

#define EPI_ROWS(...) _Pragma("unroll") for (int ai = 0; ai < 2; ++ai) _Pragma("unroll") for (int m = 0; m < 4; ++m) { const int row = u.pm * 256 + ai * 128 + wr * 64 + m * 16 + fr; \
    _Pragma("unroll") for (int bj = 0; bj < 2; ++bj) { const int cl = bj * 128 + wc * 32 + 8 * fq; const f32x4 v0 = acc[ai][bj][m][0] * esc, v1 = acc[ai][bj][m][1] * esc; __VA_ARGS__ } }
__device__ __forceinline__ u32x4 pack8(const f32x4 a, const f32x4 b) { return (u32x4){pk2(a.x, a.y), pk2(a.z, a.w), pk2(b.x, b.y), pk2(b.z, b.w)}; }

struct EpiProj {
    static constexpr bool HAS_MID = false;
    static constexpr bool PERM = true;
    bf16 *XR, *GG; unsigned char *QC8, *KVC8; bf16 *SGR, *SGM; float *KR, *SS; float esc;
    __device__ __forceinline__ void operator()(const AccT& acc, const pg8::Unit& u, int wr, int wc, int fr, int fq) const {
        const int pn = u.pn;
        if (pn < 8) { bf16* O = XR + pn * 256;
            EPI_ROWS( *(u32x4*)(O + (size_t)row * DM + cl) = pack8(v0, v1); )
        } else if (pn < 16) { bf16* O = GG + (pn - 8) * 256;
            EPI_ROWS( f32x4 a, b; for (int e = 0; e < 4; ++e) { a[e] = gelu_tanh(v0[e]); b[e] = gelu_tanh(v1[e]); } *(u32x4*)(O + (size_t)row * DM + cl) = pack8(a, b); )
        } else if (pn < 20) { const int which = (pn >= 18); const int c0 = (pn & 1) * 256;
#pragma unroll
            for (int ai = 0; ai < 2; ++ai)
#pragma unroll
                for (int m = 0; m < 4; ++m) { const int row = u.pm * 256 + ai * 128 + wr * 64 + m * 16 + fr; float s = 0.f;
#pragma unroll
                    for (int bj = 0; bj < 2; ++bj) { const int cl = bj * 128 + wc * 32 + 8 * fq; const f32x4 v0 = acc[ai][bj][m][0] * esc, v1 = acc[ai][bj][m][1] * esc;
                        *(u32x2*)((which ? KVC8 : QC8) + (size_t)row * 512 + c0 + cl) = (u32x2){pk4_f8(v0.x * SC_H, v0.y * SC_H, v0.z * SC_H, v0.w * SC_H), pk4_f8(v1.x * SC_H, v1.y * SC_H, v1.z * SC_H, v1.w * SC_H)};
                        s += (v0.x * v0.x + v0.y * v0.y) + (v0.z * v0.z + v0.w * v0.w) + (v1.x * v1.x + v1.y * v1.y) + (v1.z * v1.z + v1.w * v1.w); }
                    SS[(size_t)row * 64 + which * 32 + (pn & 1) * 16 + wc * 4 + fq] = s; }
        } else if (pn < 36) { bf16* O = (pn < 28 ? SGR + (pn - 20) * 256 : SGM + (pn - 28) * 256);
            EPI_ROWS( f32x4 a, b; for (int e = 0; e < 4; ++e) { a[e] = sigmoidf_(v0[e]); b[e] = sigmoidf_(v1[e]); } *(u32x4*)(O + (size_t)row * DM + cl) = pack8(a, b); )
        } else {
            EPI_ROWS( if (cl < 64) { *(f32x4*)(KR + (size_t)row * 64 + cl) = v0; *(f32x4*)(KR + (size_t)row * 64 + cl + 4) = v1; } )
        }
    }
};
struct EpiGate1 {
    static constexpr bool HAS_MID = false;
    static constexpr bool PERM = true; const bf16* SG; bf16* O; float esc;
    __device__ __forceinline__ void operator()(const AccT& acc, const pg8::Unit& u, int wr, int wc, int fr, int fq) const {
        EPI_ROWS( const size_t off = (size_t)row * DM + u.pn * 256 + cl; const u32x4 g = *(const u32x4*)(SG + off);
            f32x4 a = {v0.x * bflo(g.x), v0.y * bfhi(g.x), v0.z * bflo(g.y), v0.w * bfhi(g.y)}, b = {v1.x * bflo(g.z), v1.y * bfhi(g.z), v1.z * bflo(g.w), v1.w * bfhi(g.w)};
            *(u32x4*)(O + off) = pack8(a, b); )
    }
};
struct EpiGate2 {
    static constexpr bool HAS_MID = false;
    static constexpr bool PERM = true; const bf16* SG; const bf16* T; unsigned char* O8; float esc;
    __device__ __forceinline__ void operator()(const AccT& acc, const pg8::Unit& u, int wr, int wc, int fr, int fq) const {
        EPI_ROWS( const size_t off = (size_t)row * DM + u.pn * 256 + cl; const u32x4 g = *(const u32x4*)(SG + off); const u32x4 p = *(const u32x4*)(T + off);
            *(u32x2*)(O8 + off) = (u32x2){pk4_f8((bflo(p.x) + v0.x * bflo(g.x)) * SC_TMP, (bfhi(p.x) + v0.y * bfhi(g.x)) * SC_TMP, (bflo(p.y) + v0.z * bflo(g.y)) * SC_TMP, (bfhi(p.y) + v0.w * bfhi(g.y)) * SC_TMP),
                                          pk4_f8((bflo(p.z) + v1.x * bflo(g.z)) * SC_TMP, (bfhi(p.z) + v1.y * bfhi(g.z)) * SC_TMP, (bflo(p.w) + v1.z * bflo(g.w)) * SC_TMP, (bfhi(p.w) + v1.w * bfhi(g.w)) * SC_TMP)}; )
    }
};
struct EpiMix {
    static constexpr bool HAS_MID = true;
    static constexpr bool PERM = true; const bf16* SGR; const bf16* SGM; unsigned char* O8; float r12, e2;
    __device__ __forceinline__ void mid(AccT& acc, const pg8::Unit& u, int wr, int wc, int fr, int fq) const {
#pragma unroll
        for (int ai = 0; ai < 2; ++ai) {
            u32x4 gr[8], gm[8];
#pragma unroll
            for (int m = 0; m < 4; ++m)
#pragma unroll
                for (int bj = 0; bj < 2; ++bj) { const size_t off = (size_t)(u.pm * 256 + ai * 128 + wr * 64 + m * 16 + fr) * DM + u.pn * 256 + bj * 128 + wc * 32 + 8 * fq;
                    gr[m * 2 + bj] = *(const u32x4*)(SGR + off); gm[m * 2 + bj] = *(const u32x4*)(SGM + off); }
            __builtin_amdgcn_sched_barrier(0);
#pragma unroll
            for (int m = 0; m < 4; ++m)
#pragma unroll
                for (int bj = 0; bj < 2; ++bj) { const u32x4 r = gr[m * 2 + bj], d = gm[m * 2 + bj];
                    const f32x4 n0 = {bflo(r.x), bfhi(r.x), bflo(r.y), bfhi(r.y)}, n1 = {bflo(r.z), bfhi(r.z), bflo(r.w), bfhi(r.w)};
                    const f32x4 d0 = {bflo(d.x), bfhi(d.x), bflo(d.y), bfhi(d.y)}, d1 = {bflo(d.z), bfhi(d.z), bflo(d.w), bfhi(d.w)};
#pragma unroll
                    for (int e = 0; e < 4; ++e) { acc[ai][bj][m][0][e] *= r12 * n0[e] * __builtin_amdgcn_rcpf(fmaxf(d0[e], 1e-12f)); acc[ai][bj][m][1][e] *= r12 * n1[e] * __builtin_amdgcn_rcpf(fmaxf(d1[e], 1e-12f)); } }
            __builtin_amdgcn_sched_barrier(0);
        }
    }
    __device__ __forceinline__ void operator()(const AccT& acc, const pg8::Unit& u, int wr, int wc, int fr, int fq) const {
        const float esc = e2 * SC_TMP;
#pragma unroll
        for (int ai = 0; ai < 2; ++ai) {
            u32x4 gmv[8];
#pragma unroll
            for (int m = 0; m < 4; ++m)
#pragma unroll
                for (int bj = 0; bj < 2; ++bj) gmv[m * 2 + bj] = *(const u32x4*)(SGM + (size_t)(u.pm * 256 + ai * 128 + wr * 64 + m * 16 + fr) * DM + u.pn * 256 + bj * 128 + wc * 32 + 8 * fq);
            __builtin_amdgcn_sched_barrier(0);
#pragma unroll
            for (int m = 0; m < 4; ++m)
#pragma unroll
                for (int bj = 0; bj < 2; ++bj) { const size_t off = (size_t)(u.pm * 256 + ai * 128 + wr * 64 + m * 16 + fr) * DM + u.pn * 256 + bj * 128 + wc * 32 + 8 * fq; const u32x4 gm = gmv[m * 2 + bj];
                    const f32x4 v0 = acc[ai][bj][m][0] * esc, v1 = acc[ai][bj][m][1] * esc;
                    *(u32x2*)(O8 + off) = (u32x2){pk4_f8(v0.x * fmaxf(bflo(gm.x), 1e-12f), v0.y * fmaxf(bfhi(gm.x), 1e-12f), v0.z * fmaxf(bflo(gm.y), 1e-12f), v0.w * fmaxf(bfhi(gm.y), 1e-12f)),
                                                  pk4_f8(v1.x * fmaxf(bflo(gm.z), 1e-12f), v1.y * fmaxf(bfhi(gm.z), 1e-12f), v1.z * fmaxf(bflo(gm.w), 1e-12f), v1.w * fmaxf(bfhi(gm.w), 1e-12f))}; }
            __builtin_amdgcn_sched_barrier(0);
        }
    }
};
struct EpiRes1 {
    static constexpr bool HAS_MID = false;
    static constexpr bool PERM = true; const float* X; const float* mod; bf16* R; float esc;
    __device__ __forceinline__ void operator()(const AccT& acc, const pg8::Unit& u, int wr, int wc, int fr, int fq) const {
        f32x4 g[2][2];
#pragma unroll
        for (int bj = 0; bj < 2; ++bj) { const float* gt = mod + ((u.pm * 256) >> 13) * 12288 + 4096 + u.pn * 256 + bj * 128 + wc * 32 + 8 * fq; g[bj][0] = 1.f + *(const f32x4*)gt; g[bj][1] = 1.f + *(const f32x4*)(gt + 4); }
#pragma unroll
        for (int ai = 0; ai < 2; ++ai) {
            f32x4 xv[8][2];
#pragma unroll
            for (int m = 0; m < 4; ++m)
#pragma unroll
                for (int bj = 0; bj < 2; ++bj) { const float* xp = X + (size_t)(u.pm * 256 + ai * 128 + wr * 64 + m * 16 + fr) * DM + u.pn * 256 + bj * 128 + wc * 32 + 8 * fq; xv[m * 2 + bj][0] = *(const f32x4*)xp; xv[m * 2 + bj][1] = *(const f32x4*)(xp + 4); }
            __builtin_amdgcn_sched_barrier(0);
#pragma unroll
            for (int m = 0; m < 4; ++m)
#pragma unroll
                for (int bj = 0; bj < 2; ++bj) { const size_t off = (size_t)(u.pm * 256 + ai * 128 + wr * 64 + m * 16 + fr) * DM + u.pn * 256 + bj * 128 + wc * 32 + 8 * fq;
                    *(u32x4*)(R + off) = pack8(DN_ALPHA * xv[m * 2 + bj][0] + g[bj][0] * (acc[ai][bj][m][0] * esc), DN_ALPHA * xv[m * 2 + bj][1] + g[bj][1] * (acc[ai][bj][m][1] * esc)); }
            __builtin_amdgcn_sched_barrier(0);
        }
    }
};
struct EpiQuery {
    static constexpr bool HAS_MID = false;
    static constexpr bool PERM = true; bf16* O; const float* HS; const float* WS;
    __device__ __forceinline__ void operator()(const AccT& acc, const pg8::Unit& u, int wr, int wc, int fr, int fq) const {
        float hsv[2][4]; f32x4 wsv[2][2];
#pragma unroll
        for (int ai = 0; ai < 2; ++ai)
#pragma unroll
            for (int m = 0; m < 4; ++m) hsv[ai][m] = HS[u.pm * 256 + ai * 128 + wr * 64 + m * 16 + fr];
#pragma unroll
        for (int bj = 0; bj < 2; ++bj) { const int col = u.pn * 256 + bj * 128 + wc * 32 + 8 * fq; wsv[bj][0] = *(const f32x4*)(WS + col); wsv[bj][1] = *(const f32x4*)(WS + col + 4); }
        __builtin_amdgcn_sched_barrier(0);
#pragma unroll
        for (int ai = 0; ai < 2; ++ai)
#pragma unroll
            for (int m = 0; m < 4; ++m) { const int row = u.pm * 256 + ai * 128 + wr * 64 + m * 16 + fr; const float hs = hsv[ai][m];
#pragma unroll
                for (int bj = 0; bj < 2; ++bj) { const int col = u.pn * 256 + bj * 128 + wc * 32 + 8 * fq; const f32x4 w0 = wsv[bj][0] * hs, w1 = wsv[bj][1] * hs;
                    const i32x4 a0 = __builtin_bit_cast(i32x4, acc[ai][bj][m][0]), a1 = __builtin_bit_cast(i32x4, acc[ai][bj][m][1]);
                    const f32x4 v0 = {(float)a0.x * w0.x, (float)a0.y * w0.y, (float)a0.z * w0.z, (float)a0.w * w0.w}, v1 = {(float)a1.x * w1.x, (float)a1.y * w1.y, (float)a1.z * w1.z, (float)a1.w * w1.w};
                    *(u32x4*)(O + (size_t)row * DM + col) = pack8(v0, v1); } }
    }
};
#ifdef PROBE_GEMM
struct EpiNull {
    static constexpr bool HAS_MID = false;
    static constexpr bool PERM = true; float* O;
    __device__ __forceinline__ void operator()(const AccT& acc, const pg8::Unit& u, int wr, int wc, int fr, int fq) const {
        f32x4 s = {0.f, 0.f, 0.f, 0.f};
#pragma unroll
        for (int ai = 0; ai < 2; ++ai)
#pragma unroll
            for (int bj = 0; bj < 2; ++bj)
#pragma unroll
                for (int m = 0; m < 4; ++m) s += acc[ai][bj][m][0] + acc[ai][bj][m][1];
        *(f32x4*)(O + ((size_t)(u.pm * 8 + u.pn) * 512 + (wr * 4 + wc) * 64 + fq * 16 + fr) * 4) = s;
    }
};
#endif
struct EpiPlain {
    static constexpr bool HAS_MID = false;
    static constexpr bool PERM = true; bf16* O; float esc;
    __device__ __forceinline__ void operator()(const AccT& acc, const pg8::Unit& u, int wr, int wc, int fr, int fq) const {
        EPI_ROWS( *(u32x4*)(O + (size_t)row * DM + u.pn * 256 + cl) = pack8(v0, v1); )
    }
};
struct EpiQ {
    static constexpr bool HAS_MID = false;
    static constexpr bool PERM = true; unsigned char* Q; const float* SS; const f32x2* rope; float esc;
    __device__ __forceinline__ void operator()(const AccT& acc, const pg8::Unit& u, int wr, int wc, int fr, int fq) const {
        const bool is_rope = u.pn >= 8;
        float rsv[2][4];
#pragma unroll
        for (int ai = 0; ai < 2; ++ai)
#pragma unroll
            for (int m = 0; m < 4; ++m) rsv[ai][m] = SS[(size_t)(u.pm * 256 + ai * 128 + wr * 64 + m * 16 + fr) * 2];
        __builtin_amdgcn_sched_barrier(0);
#pragma unroll
        for (int ai = 0; ai < 2; ++ai) {
            f32x4 cv[8][2];
            if (is_rope) {
#pragma unroll
                for (int m = 0; m < 4; ++m)
#pragma unroll
                    for (int bj = 0; bj < 2; ++bj) { const int row = u.pm * 256 + ai * 128 + wr * 64 + m * 16 + fr, jj = ((u.pn - 8) * 256 + bj * 128 + wc * 32 + 8 * fq) & 63;
                        const f32x4* cs = (const f32x4*)(rope + (size_t)row * 32 + (jj >> 1)); cv[m * 2 + bj][0] = cs[0]; cv[m * 2 + bj][1] = cs[1]; } }
            __builtin_amdgcn_sched_barrier(0);
#pragma unroll
            for (int m = 0; m < 4; ++m)
#pragma unroll
                for (int bj = 0; bj < 2; ++bj) { const int row = u.pm * 256 + ai * 128 + wr * 64 + m * 16 + fr, cl = bj * 128 + wc * 32 + 8 * fq; const int b = row >> 13, s = row & 8191;
                    const float rs = rsv[ai][m] * (QSCALE * SC_Q); const f32x4 v0 = acc[ai][bj][m][0] * esc, v1 = acc[ai][bj][m][1] * esc;
                    if (!is_rope) { const int cg = u.pn * 256 + cl, h = cg >> 7, d = cg & 127;
                        *(u32x2*)(Q + (unsigned)(((b * NH + h) * SEQ + s) * DQK + d)) = (u32x2){pk4_f8(v0.x * rs, v0.y * rs, v0.z * rs, v0.w * rs), pk4_f8(v1.x * rs, v1.y * rs, v1.z * rs, v1.w * rs)};
                    } else { const int cg = (u.pn - 8) * 256 + cl, h = cg >> 6, jj = cg & 63; const f32x4 c0 = cv[m * 2 + bj][0], c1 = cv[m * 2 + bj][1];
                        *(u32x2*)(Q + (unsigned)(((b * NH + h) * SEQ + s) * DQK + 128 + jj)) = (u32x2){
                            pk4_f8((v0.x * c0.x - v0.y * c0.y) * rs, (v0.y * c0.x + v0.x * c0.y) * rs, (v0.z * c0.z - v0.w * c0.w) * rs, (v0.w * c0.z + v0.z * c0.w) * rs),
                            pk4_f8((v1.x * c1.x - v1.y * c1.y) * rs, (v1.y * c1.x + v1.x * c1.y) * rs, (v1.z * c1.z - v1.w * c1.w) * rs, (v1.w * c1.z + v1.z * c1.w) * rs)}; } }
            __builtin_amdgcn_sched_barrier(0);
        }
    }
};
struct EpiK {
    static constexpr bool HAS_MID = false;
    static constexpr bool PERM = true; unsigned char* K; const float* SS; float esc;
    __device__ __forceinline__ void operator()(const AccT& acc, const pg8::Unit& u, int wr, int wc, int fr, int fq) const {
        float rsv[2][4];
#pragma unroll
        for (int ai = 0; ai < 2; ++ai)
#pragma unroll
            for (int m = 0; m < 4; ++m) rsv[ai][m] = SS[(size_t)(u.pm * 256 + ai * 128 + wr * 64 + m * 16 + fr) * 2 + 1];
        __builtin_amdgcn_sched_barrier(0);
        EPI_ROWS( const float rs = rsv[ai][m] * SC_K; const int b = row >> 13, s = row & 8191;
            const int cg = u.pn * 256 + cl, h = cg >> 7, d = cg & 127;
            *(u32x2*)(K + (unsigned)(((b * NH + h) * SEQ + s) * DQK + d)) = (u32x2){pk4_f8(v0.x * rs, v0.y * rs, v0.z * rs, v0.w * rs), pk4_f8(v1.x * rs, v1.y * rs, v1.z * rs, v1.w * rs)}; )
    }
};
struct EpiVT {
    static constexpr bool HAS_MID = false;
    static constexpr bool PERM = true; unsigned char* VT; const float* SS; float esc;
    __device__ __forceinline__ void operator()(const AccT& acc, const pg8::Unit& u, int wr, int wc, int fr, int fq) const {
#pragma unroll
        for (int bj = 0; bj < 2; ++bj) {
            const int cl = bj * 128 + wc * 32 + 8 * fq; const int t0 = u.pn * 256 + cl, b = t0 >> 13, s = t0 & 8191; const f32x4* sp = (const f32x4*)(SS + (size_t)t0 * 2);
            const f32x4 s0 = sp[0] * SC_V, s1 = sp[1] * SC_V, s2 = sp[2] * SC_V, s3 = sp[3] * SC_V;
            __builtin_amdgcn_sched_barrier(0);
#pragma unroll
            for (int ai = 0; ai < 2; ++ai)
#pragma unroll
                for (int m = 0; m < 4; ++m) { const int row = u.pm * 256 + ai * 128 + wr * 64 + m * 16 + fr, h = row >> 7, d = row & 127; const f32x4 v0 = acc[ai][bj][m][0] * esc, v1 = acc[ai][bj][m][1] * esc;
                    *(u32x2*)(VT + (unsigned)(((((b * NH + h) * 128 + (s >> 6)) * 128 + d) * 64 + (s & 63)))) = (u32x2){pk4_f8(v0.x * s0.y, v0.y * s0.w, v0.z * s1.y, v0.w * s1.w), pk4_f8(v1.x * s2.y, v1.y * s2.w, v1.z * s3.y, v1.w * s3.w)}; }
            __builtin_amdgcn_sched_barrier(0);
        }
    }
};

constexpr int RG_W = 288;
constexpr int RG_SUB = 64;
constexpr int RG_XC = 0, RG_GGT = 36864, RG_OUT = 69632;
__device__ __forceinline__ unsigned char* rg_ab(unsigned char* ws, int tile) { return tile < 1536 ? ws + WS_TMP + (size_t)tile * 131072 : ws + WS_AO8 + (size_t)(tile - 1536) * 131072; }
__device__ __forceinline__ float rg_h_lo(unsigned w) { return (float)__builtin_bit_cast(_Float16, (unsigned short)(w & 0xffffu)); }
__device__ __forceinline__ float rg_h_hi(unsigned w) { return (float)__builtin_bit_cast(_Float16, (unsigned short)(w >> 16)); }
struct RgMap { float A, H; };
__device__ __forceinline__ RgMap rg_then(const RgMap f, const RgMap g) { return RgMap{f.A * g.A, g.A * f.H + g.H}; }
__device__ __forceinline__ void rglru_passA(Frame& F) {
    const int tid = F.tid, lane = F.lane, wave = F.wave;
    {
        const float* ssp = WSP(float, WS_SSP); float* rs = WSP(float, WS_RS);
        for (int i = F.blk * NTHREADS + tid; i < NT * 2; i += F.G * NTHREADS) { const f32x4* p = (const f32x4*)(ssp + (size_t)i * 32); float s = 0.f;
#pragma unroll
            for (int k = 0; k < 8; ++k) { const f32x4 a = p[k]; s += (a.x + a.y) + (a.z + a.w); }
            rs[i] = __builtin_amdgcn_rsqf(s * (1.f / 512.f) + RMS_EPS); } }
    LAS unsigned char* L = F.lds;
    const bf16* XR = WSP(bf16, WS_XR); float* SUMM = WSP(float, WS_SUMM);
    const int q = lane >> 4;
    for (int tile = F.blk; tile < NB * 32 * NH; tile += F.G) {
        const int hh = tile & 15, c = (tile >> 4) & 31, b = tile >> 9;
        const int ech = 16 * wave + (lane & 15), egch = hh * 128 + ech;
        bf16x8 bA[4], bX[4];
        { const bf16* ga = WSP(bf16, WS_WGA) + hh * 16384 + ech * 128 + 8 * (lane >> 4); const bf16* gx = WSP(bf16, WS_WGX) + hh * 16384 + ech * 128 + 8 * (lane >> 4);
#pragma unroll
            for (int ks = 0; ks < 4; ++ks) { bA[ks] = *(const bf16x8*)(ga + 32 * ks); bX[ks] = *(const bf16x8*)(gx + 32 * ks); } }
        const float e_ba = F.b_rg_a[egch], e_bx = F.b_rg_x[egch];
        const float lam = F.rg_lambda[egch]; const float e_sp8 = -8.0f * 1.4426950408889634f * ((lam > 15.f) ? expf(-lam) : (lam < -15.f ? -lam : log1pf(expf(-lam))));
        const int crow = tid >> 4, c8 = (tid & 15) * 8, cg = hh * 128 + c8;
        float cw[4][8], cb[8];
#pragma unroll
        for (int w = 0; w < 4; ++w) { const f32x4 p = *(const f32x4*)(F.conv_w + w * DM + cg), qq = *(const f32x4*)(F.conv_w + w * DM + cg + 4);
            cw[w][0] = p.x; cw[w][1] = p.y; cw[w][2] = p.z; cw[w][3] = p.w; cw[w][4] = qq.x; cw[w][5] = qq.y; cw[w][6] = qq.z; cw[w][7] = qq.w; }
        { const f32x4 p = *(const f32x4*)(F.conv_b + cg), qq = *(const f32x4*)(F.conv_b + cg + 4); cb[0] = p.x; cb[1] = p.y; cb[2] = p.z; cb[3] = p.w; cb[4] = qq.x; cb[5] = qq.y; cb[6] = qq.z; cb[7] = qq.w; }
        float S = 0.f, atot = 1.f;
        u32x4* abw = (u32x4*)rg_ab(F.ws, tile) + (wave * 64 + lane) * 4;
        const size_t tbase = (size_t)b * SEQ + c * 256;
        u32x4 xn[2][4];
#pragma unroll
        for (int hf = 0; hf < 2; ++hf)
#pragma unroll
            for (int w = 0; w < 4; ++w) { const int rr = crow + 32 * hf - 3 + w; xn[hf][w] = (u32x4){0u, 0u, 0u, 0u}; if (c * 256 + rr >= 0) xn[hf][w] = *(const u32x4*)(XR + (tbase + rr) * DM + cg); }
#pragma unroll 1
        for (int sub = 0; sub < 256 / RG_SUB; ++sub) {
            const size_t t0 = tbase + sub * RG_SUB;
            LAS unsigned char* XC = L + RG_XC + (sub & 1) * 18432;
#pragma unroll
            for (int hf = 0; hf < 2; ++hf) { float a[8];
#pragma unroll
                for (int e = 0; e < 8; ++e) a[e] = cb[e];
#pragma unroll
                for (int w = 0; w < 4; ++w) { const u32x4 xv = xn[hf][w];
                    a[0] += cw[w][0] * bflo(xv.x); a[1] += cw[w][1] * bfhi(xv.x); a[2] += cw[w][2] * bflo(xv.y); a[3] += cw[w][3] * bfhi(xv.y);
                    a[4] += cw[w][4] * bflo(xv.z); a[5] += cw[w][5] * bfhi(xv.z); a[6] += cw[w][6] * bflo(xv.w); a[7] += cw[w][7] * bfhi(xv.w); }
                *(LAS u32x4*)(XC + (crow + 32 * hf) * RG_W + c8 * 2) = (u32x4){pk2(a[0], a[1]), pk2(a[2], a[3]), pk2(a[4], a[5]), pk2(a[6], a[7])}; }
            __syncthreads();
            if (sub + 1 < 256 / RG_SUB) {
#pragma unroll
                for (int hf = 0; hf < 2; ++hf)
#pragma unroll
                    for (int w = 0; w < 4; ++w) xn[hf][w] = *(const u32x4*)(XR + (t0 + RG_SUB + crow + 32 * hf - 3 + w) * DM + cg); }
            f32x4 accA[4], accX[4];
#pragma unroll
            for (int rb = 0; rb < 4; ++rb) { accA[rb] = (f32x4){0, 0, 0, 0}; accX[rb] = (f32x4){0, 0, 0, 0}; }
#pragma unroll
            for (int ks = 0; ks < 4; ++ks) { const int ko = (ks * 32 + 8 * (lane >> 4)) * 2;
#pragma unroll
                for (int rb = 0; rb < 4; ++rb) { const bf16x8 af = *(const LAS bf16x8*)(XC + (rb * 16 + (lane & 15)) * RG_W + ko);
                    accA[rb] = __builtin_amdgcn_mfma_f32_16x16x32_bf16(af, bA[ks], accA[rb], 0, 0, 0);
                    accX[rb] = __builtin_amdgcn_mfma_f32_16x16x32_bf16(af, bX[ks], accX[rb], 0, 0, 0); } }
#pragma unroll
            for (int rb = 0; rb < 4; ++rb) {
                RgMap G{1.f, 0.f}; u32x4 pw = {0u, 0u, 0u, 0u};
#pragma unroll
                for (int r = 0; r < 4; ++r) { const int trow = rb * 16 + 4 * q + r;
                    const float xcv = bf1(*(const LAS bf16*)(XC + trow * RG_W + ech * 2));
                    const float rr = sigmoidf_(accA[rb][r] + e_ba), ii = sigmoidf_(accX[rb][r] + e_bx);
                    const float l2 = rr * e_sp8;
                    const float a_ = __builtin_amdgcn_exp2f(l2);
                    const float x2 = l2 * (2.0f * 0.6931471805599453f);
                    const float ser = -x2 * (1.0f + x2 * (0.5f + x2 * (0.16666667f + x2 * (0.041666668f + x2 * 0.008333334f))));
                    const float om = (x2 > -0.25f) ? ser : (1.0f - a_ * a_);
                    const float b_ = __builtin_amdgcn_sqrtf(om) * ii * xcv;
                    pw[r] = __builtin_bit_cast(unsigned, __builtin_amdgcn_cvt_pkrtz(l2, b_));
                    G.H = a_ * G.H + b_; G.A *= a_; }
                abw[sub * 2048 + rb] = pw;
                const RgMap P{__shfl_xor(G.A, 16), __shfl_xor(G.H, 16)};
                const RgMap pr = (q & 1) ? rg_then(P, G) : rg_then(G, P);
                const RgMap Q{__shfl_xor(pr.A, 32), __shfl_xor(pr.H, 32)};
                const RgMap T = (q & 2) ? rg_then(Q, pr) : rg_then(pr, Q);
                S = T.A * S + T.H; atot *= T.A;
            }
        }
        if (q == 0) *(f32x2*)(SUMM + ((size_t)(b * 32 + c) * DM + egch) * 2) = (f32x2){atot, S};
    }
    __syncthreads();
}
__device__ __forceinline__ void rglru_passB(Frame& F) {
    const int tid = F.tid, lane = F.lane, wave = F.wave;
    LAS unsigned char* L = F.lds;
    const bf16* GG = WSP(bf16, WS_GG); unsigned char* RA = WSP(unsigned char, WS_S0); const float* SUMM = WSP(float, WS_SUMM);
    const int q = lane >> 4;
    for (int tile = F.blk; tile < NB * 32 * NH; tile += F.G) {
        const int hh = tile & 15, c = (tile >> 4) & 31, b = tile >> 9;
        const int ech = 16 * wave + (lane & 15), egch = hh * 128 + ech;
        const int crow = tid >> 4, c8 = (tid & 15) * 8, cg = hh * 128 + c8;
        const size_t tbase = (size_t)b * SEQ + c * 256;
        const u32x4* abr = (const u32x4*)rg_ab(F.ws, tile) + (wave * 64 + lane) * 4;
        u32x4 gn[2], ab[4];
        gn[0] = *(const u32x4*)(GG + (tbase + crow) * DM + cg); gn[1] = *(const u32x4*)(GG + (tbase + crow + 32) * DM + cg);
#pragma unroll
        for (int rb = 0; rb < 4; ++rb) ab[rb] = abr[rb];
        float S;
        { f32x2 sv[8];
#pragma unroll
            for (int k = 0; k < 8; ++k) { const int cc = 8 * q + k; sv[k] = (f32x2){1.f, 0.f}; if (cc < c) sv[k] = *(const f32x2*)(SUMM + ((size_t)(b * 32 + cc) * DM + egch) * 2); }
            RgMap M{1.f, 0.f};
#pragma unroll
            for (int k = 0; k < 8; ++k) M = rg_then(M, RgMap{sv[k].x, sv[k].y});
            const RgMap P{__shfl_xor(M.A, 16), __shfl_xor(M.H, 16)}; const RgMap pr = (q & 1) ? rg_then(P, M) : rg_then(M, P);
            const RgMap Q{__shfl_xor(pr.A, 32), __shfl_xor(pr.H, 32)}; const RgMap T = (q & 2) ? rg_then(Q, pr) : rg_then(pr, Q);
            S = T.H; }
#pragma unroll 1
        for (int sub = 0; sub < 256 / RG_SUB; ++sub) {
            const size_t t0 = tbase + sub * RG_SUB;
            LAS unsigned char* GT = L + RG_GGT + (sub & 1) * 16384; LAS unsigned char* OT = L + RG_OUT + (sub & 1) * 8192;
            *(LAS u32x4*)(GT + crow * 256 + c8 * 2) = gn[0]; *(LAS u32x4*)(GT + (crow + 32) * 256 + c8 * 2) = gn[1];
            u32x4 abc[4];
#pragma unroll
            for (int rb = 0; rb < 4; ++rb) abc[rb] = ab[rb];
            __syncthreads();
            if (sub + 1 < 256 / RG_SUB) {
                gn[0] = *(const u32x4*)(GG + (t0 + RG_SUB + crow) * DM + cg); gn[1] = *(const u32x4*)(GG + (t0 + RG_SUB + crow + 32) * DM + cg);
#pragma unroll
                for (int rb = 0; rb < 4; ++rb) ab[rb] = abr[(sub + 1) * 2048 + rb]; }
#pragma unroll
            for (int rb = 0; rb < 4; ++rb) {
                float av[4], bv[4];
#pragma unroll
                for (int r = 0; r < 4; ++r) { const unsigned pk = abc[rb][r]; av[r] = __builtin_amdgcn_exp2f(rg_h_lo(pk)); bv[r] = rg_h_hi(pk); }
                RgMap G{1.f, 0.f};
#pragma unroll
                for (int r = 0; r < 4; ++r) { G.H = av[r] * G.H + bv[r]; G.A *= av[r]; }
                const RgMap P{__shfl_xor(G.A, 16), __shfl_xor(G.H, 16)};
                const RgMap pr = (q & 1) ? rg_then(P, G) : rg_then(G, P);
                const RgMap Q{__shfl_xor(pr.A, 32), __shfl_xor(pr.H, 32)};
                const RgMap T = (q & 2) ? rg_then(Q, pr) : rg_then(pr, Q);
                RgMap E{1.f, 0.f}; if (q & 2) E = Q; if (q & 1) E = rg_then(E, P);
                float h = E.A * S + E.H; float y[4];
#pragma unroll
                for (int r = 0; r < 4; ++r) { const int trow = rb * 16 + 4 * q + r; h = av[r] * h + bv[r]; y[r] = h * bf1(*(const LAS bf16*)(GT + trow * 256 + ech * 2)) * SC_RA; }
                const unsigned w = pk4_f8(y[0], y[1], y[2], y[3]); const int tr0 = rb * 16 + 4 * q;
                OT[tr0 * 128 + ech] = (unsigned char)w; OT[(tr0 + 1) * 128 + ech] = (unsigned char)(w >> 8); OT[(tr0 + 2) * 128 + ech] = (unsigned char)(w >> 16); OT[(tr0 + 3) * 128 + ech] = (unsigned char)(w >> 24);
                S = T.A * S + T.H;
            }
            __syncthreads();
            { const int r = tid >> 3, cq = (tid & 7) * 16; *(u32x4*)(RA + (t0 + r) * DM + hh * 128 + cq) = *(const LAS u32x4*)(OT + r * 128 + cq); }
        }
    }
    __syncthreads();
}

__device__ __forceinline__ void krope_fill(Frame& F) {
    const int fl = fresh_lane(); const int gw = F.blk * NWAVES + F.wave, NGW = F.G * NWAVES, j4 = (fl & 7) * 4, tsub = fl >> 3;
    const float* KR = WSP(float, WS_KR); const f32x2* rope = WSP(f32x2, WS_ROPE); unsigned char* K = (unsigned char*)F.out + OUT_K;
    for (int tp = gw; tp < NT / 8; tp += NGW) { const int t = 8 * tp + tsub, b = t >> 13, s = t & 8191;
        const f32x4 x1 = *(const f32x4*)(KR + (size_t)t * 64 + j4), x2 = *(const f32x4*)(KR + (size_t)t * 64 + 32 + j4);
        const f32x4 c01 = *(const f32x4*)(rope + (size_t)t * 32 + j4), c23 = *(const f32x4*)(rope + (size_t)t * 32 + j4 + 2);
        const u32x2 w = {pk4_f8((x1.x * c01.x - x2.x * c01.y) * SC_K, (x2.x * c01.x + x1.x * c01.y) * SC_K, (x1.y * c01.z - x2.y * c01.w) * SC_K, (x2.y * c01.z + x1.y * c01.w) * SC_K),
                         pk4_f8((x1.z * c23.x - x2.z * c23.y) * SC_K, (x2.z * c23.x + x1.z * c23.y) * SC_K, (x1.w * c23.z - x2.w * c23.w) * SC_K, (x2.w * c23.z + x1.w * c23.w) * SC_K)};
#pragma unroll
        for (int h = 0; h < NH; ++h) *(u32x2*)(K + ((size_t)(b * NH + h) * SEQ + s) * DQK + 128 + 2 * j4) = w; }
}

constexpr int AT_KB = 12288, AT_VB = 8192, AT_BUF = AT_KB + AT_VB;
#define AT_LD8(p0_, p1_) __builtin_shufflevector(*(const LAS i32x4*)(p0_), *(const LAS i32x4*)(p1_), 0, 1, 2, 3, 4, 5, 6, 7)
constexpr int AT_SLOT = AT_KB + AT_VB, AT_NSLOT = 5;
struct AttnState { f32x16 o[4], p0, p1; f32x4 osum; i32x8 pb; float m_run; };
#define AT_MFMA(A_, B_, C_) __builtin_amdgcn_mfma_scale_f32_32x32x64_f8f6f4(A_, B_, C_, 0, 0, 0, 0x7F7F7F7F, 0, 0x7F7F7F7F)
#define AT_PIN() __builtin_amdgcn_sched_barrier(0)
template <bool FAST>
__device__ __forceinline__ void attn_iter(AttnState& S, const i32x8 (&qf)[3], const LAS unsigned char* Vprev, const LAS unsigned char* Knext, int xo0, int xo1, int r32, int hi,
                                          bool act_prev, bool act_cur, bool act_next, bool need_mask, int dq) {
    constexpr float CS = 1.0f / (SC_Q * SC_K), LSP = 6.0f;
    const f32x16 z16 = {0.f, 0.f, 0.f, 0.f, 0.f, 0.f, 0.f, 0.f, 0.f, 0.f, 0.f, 0.f, 0.f, 0.f, 0.f, 0.f};
    const int sel = (((r32 & 15) >> 2) & 1) == ((hi * 2 + (r32 >> 4)) & 1) ? 0x38383838 : 0;
    const i32x8 ones8 = {sel, sel, sel, sel, sel, sel, sel, sel};
#define AT_ROWSUM(PB_, ACC_) __builtin_amdgcn_mfma_scale_f32_16x16x128_f8f6f4(ones8, PB_, ACC_, 0, 0, 0, 0x7F7F7F7F, 0, 0x7F7F7F7F)
    float pmax = -__builtin_inff();
    if (FAST) {
        const LAS unsigned char* vb = Vprev + r32 * 64;
        const i32x8 v0 = AT_LD8(vb + xo0, vb + xo1), v1 = AT_LD8(vb + 2048 + xo0, vb + 2048 + xo1);
        S.osum = AT_ROWSUM(S.pb, S.osum);
        AT_PIN(); pmax = fmaxf(fmaxf(S.p0[0], S.p0[1]), fmaxf(S.p0[2], S.p0[3])); pmax = fmaxf(pmax, fmaxf(fmaxf(S.p0[4], S.p0[5]), fmaxf(S.p0[6], S.p0[7]))); AT_PIN();
        S.o[0] = AT_MFMA(v0, S.pb, S.o[0]);
        const i32x8 v2 = AT_LD8(vb + 4096 + xo0, vb + 4096 + xo1);
        AT_PIN(); pmax = fmaxf(pmax, fmaxf(fmaxf(S.p0[8], S.p0[9]), fmaxf(S.p0[10], S.p0[11]))); pmax = fmaxf(pmax, fmaxf(fmaxf(S.p0[12], S.p0[13]), fmaxf(S.p0[14], S.p0[15]))); AT_PIN();
        S.o[1] = AT_MFMA(v1, S.pb, S.o[1]);
        const i32x8 v3 = AT_LD8(vb + 6144 + xo0, vb + 6144 + xo1);
        AT_PIN(); pmax = fmaxf(pmax, fmaxf(fmaxf(S.p1[0], S.p1[1]), fmaxf(S.p1[2], S.p1[3]))); pmax = fmaxf(pmax, fmaxf(fmaxf(S.p1[4], S.p1[5]), fmaxf(S.p1[6], S.p1[7]))); AT_PIN();
        S.o[2] = AT_MFMA(v2, S.pb, S.o[2]);
        AT_PIN(); pmax = fmaxf(pmax, fmaxf(fmaxf(S.p1[8], S.p1[9]), fmaxf(S.p1[10], S.p1[11]))); pmax = fmaxf(pmax, fmaxf(fmaxf(S.p1[12], S.p1[13]), fmaxf(S.p1[14], S.p1[15]))); AT_PIN();
        S.o[3] = AT_MFMA(v3, S.pb, S.o[3]);
    } else if (act_prev) {
        const LAS unsigned char* vb = Vprev + r32 * 64;
        S.osum = AT_ROWSUM(S.pb, S.osum);
#pragma unroll
        for (int d = 0; d < 4; ++d) { const i32x8 vf = AT_LD8(vb + d * 2048 + xo0, vb + d * 2048 + xo1); S.o[d] = AT_MFMA(vf, S.pb, S.o[d]); AT_PIN(); }
    }
    if (!FAST) {
        if (act_cur) {
            if (need_mask) { const float NEG = -__builtin_inff();
#pragma unroll
                for (int r = 0; r < 16; ++r) { const int cr = (r & 3) + 8 * (r >> 2); if (cr > dq) S.p0[r] = NEG; if (cr + 32 > dq) S.p1[r] = NEG; } }
#pragma unroll
            for (int r = 0; r < 16; ++r) pmax = fmaxf(pmax, fmaxf(S.p0[r], S.p1[r]));
        }
    }
    float alpha = 1.f; bool resc = false; f32x16 n0 = z16, n1 = z16;
    if (FAST || act_cur) {
        { auto rr = __builtin_amdgcn_permlane32_swap(__float_as_uint(pmax), __float_as_uint(pmax), false, false); pmax = fmaxf(__uint_as_float(rr[0]), __uint_as_float(rr[1])) * CS; }
        resc = !__all(pmax - S.m_run <= 2.0f);
        const float mn = resc ? fmaxf(S.m_run, pmax) : S.m_run; alpha = __builtin_amdgcn_exp2f(S.m_run - mn); S.m_run = mn;
    }
    const float moff = LSP - S.m_run;
    const LAS unsigned char* kb = Knext + r32 * 192;
    if (FAST) {
        i32x8 ka = AT_LD8(kb + xo0, kb + xo1), kc = AT_LD8(kb + 32 * 192 + xo0, kb + 32 * 192 + xo1);
#pragma unroll
        for (int ks = 0; ks < 3; ++ks) {
            n0 = AT_MFMA(ka, qf[ks], ks == 0 ? z16 : n0); n1 = AT_MFMA(kc, qf[ks], ks == 0 ? z16 : n1);
            if (ks < 2) { ka = AT_LD8(kb + (ks + 1) * 64 + xo0, kb + (ks + 1) * 64 + xo1); kc = AT_LD8(kb + 32 * 192 + (ks + 1) * 64 + xo0, kb + 32 * 192 + (ks + 1) * 64 + xo1); }
            AT_PIN();
#pragma unroll
            for (int r = (ks * 16) / 3; r < ((ks + 1) * 16) / 3; ++r) { S.p0[r] = __builtin_amdgcn_exp2f(__builtin_fmaf(S.p0[r], CS, moff)); S.p1[r] = __builtin_amdgcn_exp2f(__builtin_fmaf(S.p1[r], CS, moff)); }
            AT_PIN();
        }
    } else {
        if (act_next) {
#pragma unroll
            for (int ks = 0; ks < 3; ++ks) { const i32x8 ka = AT_LD8(kb + ks * 64 + xo0, kb + ks * 64 + xo1), kc = AT_LD8(kb + 32 * 192 + ks * 64 + xo0, kb + 32 * 192 + ks * 64 + xo1);
                n0 = AT_MFMA(ka, qf[ks], ks == 0 ? z16 : n0); n1 = AT_MFMA(kc, qf[ks], ks == 0 ? z16 : n1); } }
        if (act_cur) {
#pragma unroll
            for (int r = 0; r < 16; ++r) { S.p0[r] = __builtin_amdgcn_exp2f(__builtin_fmaf(S.p0[r], CS, moff)); S.p1[r] = __builtin_amdgcn_exp2f(__builtin_fmaf(S.p1[r], CS, moff)); } }
    }
    if (FAST || act_cur) {
#pragma unroll
        for (int jj = 0; jj < 4; ++jj) { int a = __builtin_amdgcn_cvt_pk_fp8_f32(S.p0[4 * jj], S.p0[4 * jj + 1], 0, false); a = __builtin_amdgcn_cvt_pk_fp8_f32(S.p0[4 * jj + 2], S.p0[4 * jj + 3], a, true);
            int bq = __builtin_amdgcn_cvt_pk_fp8_f32(S.p1[4 * jj], S.p1[4 * jj + 1], 0, false); bq = __builtin_amdgcn_cvt_pk_fp8_f32(S.p1[4 * jj + 2], S.p1[4 * jj + 3], bq, true);
            auto rr = __builtin_amdgcn_permlane32_swap((unsigned)a, (unsigned)bq, false, false); S.pb[2 * jj] = (int)rr[0]; S.pb[2 * jj + 1] = (int)rr[1]; }
        if (resc) {
#pragma unroll
            for (int d = 0; d < 4; ++d)
#pragma unroll
                for (int r = 0; r < 16; ++r) S.o[d][r] *= alpha;
            S.osum = S.osum * alpha;
        }
    }
    S.p0 = n0; S.p1 = n1;
#undef AT_ROWSUM
}
__device__ __forceinline__ void attn_block(Frame& F, int bh, int qb, const unsigned char* Q, const unsigned char* Kg, const unsigned char* VTg, unsigned char* AO) {
    const int lane = F.lane, wave = F.wave, r32 = lane & 31, hi = lane >> 5;
    LAS unsigned char* L = F.lds; const unsigned ldsbase = (unsigned)(size_t)L;
    const int q0 = qb * 256, qrow = q0 + 32 * wave + r32, ntiles = 4 * (qb + 1);
    unsigned kv0, kv1, vv;
    { const int q = wave * 64 + lane, row = q / 12, pos = q % 12, c = (pos & ~3) | ((pos ^ (row >> 2)) & 3); kv0 = (unsigned)((row * 12 + c) * 16); }
    { const int q = (wave + 8) * 64 + lane, row = q / 12, pos = q % 12, c = (pos & ~3) | ((pos ^ (row >> 2)) & 3); kv1 = (unsigned)((row * 12 + c) * 16); }
    { const int q = wave * 64 + lane, row = q >> 2, pos = q & 3, c = pos ^ ((row >> 2) & 3); vv = (unsigned)((row * 4 + c) * 16); }
    const bool k2 = wave < 4;
    const char* kgb = (const char*)Kg + (size_t)bh * SEQ * DQK; const char* vgb = (const char*)VTg + (size_t)bh * SEQ * DV;
#define AT_ISSUE(tile, slot) do { const int _t = (tile) < ntiles ? (tile) : ntiles - 1; const unsigned _s = ldsbase + (slot) * AT_SLOT; \
        glds16(kgb + (size_t)_t * AT_KB, kv0, _s + wave * 1024); if (k2) glds16(kgb + (size_t)_t * AT_KB, kv1, _s + (wave + 8) * 1024); \
        glds16(vgb + (size_t)_t * AT_VB, vv, _s + AT_KB + wave * 1024); } while (0)
    AT_ISSUE(0, 0); AT_ISSUE(1, 1); AT_ISSUE(2, 2);
    i32x8 qf[3];
    { const unsigned char* qp = Q + ((size_t)bh * SEQ + qrow) * DQK + 32 * hi;
#pragma unroll
        for (int ks = 0; ks < 3; ++ks) { const i32x4 lo = *(const i32x4*)(qp + 64 * ks), hh = *(const i32x4*)(qp + 64 * ks + 16); qf[ks] = __builtin_shufflevector(lo, hh, 0, 1, 2, 3, 4, 5, 6, 7); } }
    asm volatile("s_waitcnt vmcnt(0)" ::: "memory");
    const f32x16 z16 = {0.f, 0.f, 0.f, 0.f, 0.f, 0.f, 0.f, 0.f, 0.f, 0.f, 0.f, 0.f, 0.f, 0.f, 0.f, 0.f};
    AttnState S; S.o[0] = z16; S.o[1] = z16; S.o[2] = z16; S.o[3] = z16; S.osum = (f32x4){0.f, 0.f, 0.f, 0.f}; S.p0 = z16; S.p1 = z16; S.m_run = -1e30f;
    S.pb = (i32x8){0, 0, 0, 0, 0, 0, 0, 0};
    const int swz = (r32 >> 2) & 3; const int xo0 = (((2 * hi) ^ swz) << 4), xo1 = (((2 * hi + 1) ^ swz) << 4);
    const int wfirst = q0 + 32 * wave, wlast = wfirst + 31;
    __syncthreads();
    { const LAS unsigned char* kb = L + r32 * 192;
#pragma unroll
        for (int ks = 0; ks < 3; ++ks) { const i32x8 ka = AT_LD8(kb + ks * 64 + xo0, kb + ks * 64 + xo1), kc = AT_LD8(kb + 32 * 192 + ks * 64 + xo0, kb + 32 * 192 + ks * 64 + xo1);
            S.p0 = AT_MFMA(ka, qf[ks], ks == 0 ? z16 : S.p0); S.p1 = AT_MFMA(kc, qf[ks], ks == 0 ? z16 : S.p1); } }
    const int nfast = 4 * qb;
#define AT_HEAD(j) if (k2) asm volatile("s_waitcnt vmcnt(3)" ::: "memory"); else asm volatile("s_waitcnt vmcnt(2)" ::: "memory"); \
        __syncthreads(); AT_ISSUE((j) + 3, ((j) + 3) % 5); \
        const LAS unsigned char* Vprev = L + (((j) + 4) % 5) * AT_SLOT + AT_KB; const LAS unsigned char* Knext = L + (((j) + 1) % 5) * AT_SLOT;
#define AT_SLOW(j) { const bool ap = (j) >= 1 && 64 * ((j) - 1) <= wlast, ac = (j) < ntiles && 64 * (j) <= wlast, an = (j) + 1 < ntiles && 64 * ((j) + 1) <= wlast; \
        attn_iter<false>(S, qf, Vprev, Knext, xo0, xo1, r32, hi, ap, ac, an, 64 * (j) + 63 > wfirst, qrow - 64 * (j) - 4 * hi); }
    int j = 0;
    { AT_HEAD(0); AT_SLOW(0); j = 1; }
#pragma unroll 1
    for (; j + 1 < nfast; ++j) { AT_HEAD(j); attn_iter<true>(S, qf, Vprev, Knext, xo0, xo1, r32, hi, true, true, true, false, 0); }
#pragma unroll 1
    for (; j <= ntiles; ++j) { AT_HEAD(j); AT_SLOW(j); }
#undef AT_HEAD
#undef AT_SLOW
#undef AT_ISSUE
    { int l2; asm volatile("v_mbcnt_lo_u32_b32 %0, -1, 0\n\tv_mbcnt_hi_u32_b32 %0, -1, %0" : "=v"(l2));
      const float inv = SC_AO / (SC_V * S.osum[0]); unsigned char* op = AO + ((size_t)(bh >> 4) * SEQ + qb * 256 + 32 * wave + (l2 & 31)) * DM + (bh & 15) * 128 + 4 * (l2 >> 5);
#pragma unroll
        for (int d = 0; d < 4; ++d)
#pragma unroll
            for (int g = 0; g < 4; ++g) *(unsigned*)(op + 32 * d + 8 * g) = pk4_f8(S.o[d][4 * g] * inv, S.o[d][4 * g + 1] * inv, S.o[d][4 * g + 2] * inv, S.o[d][4 * g + 3] * inv); }
    asm volatile("s_waitcnt vmcnt(0)" ::: "memory");
    __syncthreads();
}
#undef AT_MFMA
#undef AT_PIN
__device__ __forceinline__ void attn_phase(Frame& F) {
    const unsigned char* Q = (const unsigned char*)F.out + OUT_Q; const unsigned char* Kg = (const unsigned char*)F.out + OUT_K; const unsigned char* VTg = (const unsigned char*)F.out + OUT_VT; unsigned char* AO = WSP(unsigned char, WS_AO8);
    for (int it = F.blk; it < 1024; it += F.G) {
        const int r = it / F.G;
        int bh, y;
        if (F.G == 256) { const int x = F.blk & 7, loc = F.blk >> 3; bh = x * 8 + r * 2 + (loc >> 4); y = loc & 15; }
        else { bh = it >> 4; y = it & 15; }
        attn_block(F, bh, 31 - y, Q, Kg, VTg, AO);
        attn_block(F, bh, y, Q, Kg, VTg, AO);
    }
}

__device__ __forceinline__ void ln1_phase(Frame& F) {
    const int gw = F.blk * NWAVES + F.wave, NGW = F.G * NWAVES, lane = fresh_lane();
    bf16* R1 = WSP(bf16, WS_R1); unsigned char* H2I = WSP(unsigned char, WS_H2I); float* HSC = WSP(float, WS_HSC); const float* mod = WSP(float, WS_MOD);
    for (int m = gw; m < NT; m += NGW) {
        u32x4* rp = (u32x4*)(R1 + (size_t)m * DM) + lane; f32x4 v[8]; float s = 0.f;
#pragma unroll
        for (int j = 0; j < 4; ++j) { const u32x4 w = rp[64 * j]; v[2 * j] = (f32x4){bflo(w.x), bfhi(w.x), bflo(w.y), bfhi(w.y)}; v[2 * j + 1] = (f32x4){bflo(w.z), bfhi(w.z), bflo(w.w), bfhi(w.w)};
            s += ((v[2 * j].x + v[2 * j].y) + (v[2 * j].z + v[2 * j].w)) + ((v[2 * j + 1].x + v[2 * j + 1].y) + (v[2 * j + 1].z + v[2 * j + 1].w)); }
        const float mean = wave_sum(s) * (1.f / DM); float s2 = 0.f;
#pragma unroll
        for (int j = 0; j < 8; ++j) { v[j] = v[j] - mean; s2 += (v[j].x * v[j].x + v[j].y * v[j].y) + (v[j].z * v[j].z + v[j].w * v[j].w); }
        const float rstd = __builtin_amdgcn_rsqf(wave_sum(s2) * (1.f / DM) + LN_EPS);
        const int b = m >> 13; const float* sh2 = mod + b * 12288 + 6144; const float* sc2 = mod + b * 12288 + 8192;
        float amax = 0.f;
#pragma unroll
        for (int j = 0; j < 4; ++j) { const int col = 512 * j + 8 * lane; f32x4 y[2];
#pragma unroll
            for (int q = 0; q < 2; ++q) { const f32x4 g = *(const f32x4*)(F.ln1_g + col + 4 * q), bb = *(const f32x4*)(F.ln1_b + col + 4 * q);
                y[q] = v[2 * j + q] * rstd * g + bb; v[2 * j + q] = y[q] * (1.f + *(const f32x4*)(sc2 + col + 4 * q)) + *(const f32x4*)(sh2 + col + 4 * q);
                const f32x4 hh = v[2 * j + q]; amax = fmaxf(amax, fmaxf(fmaxf(fabsf(hh.x), fabsf(hh.y)), fmaxf(fabsf(hh.z), fabsf(hh.w)))); }
            rp[64 * j] = pack8(y[0], y[1]); }
        amax = fmaxf(wave_max(amax), 1e-20f); const float qs = 127.0f / amax;
        if (lane == 0) HSC[m] = amax * (1.0f / 127.0f);
#pragma unroll
        for (int j = 0; j < 4; ++j) { const f32x4 a = v[2 * j] * qs, c = v[2 * j + 1] * qs;
            *(u32x2*)(H2I + (size_t)m * DM + 512 * j + 8 * lane) = (u32x2){pk4_i8(a.x, a.y, a.z, a.w), pk4_i8(c.x, c.y, c.z, c.w)}; }
    }
    { unsigned char* pu = WSP(unsigned char, WS_PU); float* usc = WSP(float, WS_USC);
        for (int e = gw; e < 16384; e += NGW) { f32x4 r[8]; float amax = 0.f;
#pragma unroll
            for (int j = 0; j < 4; ++j) { r[2 * j] = *(const f32x4*)(F.peer_u + (size_t)e * DM + 512 * j + 8 * lane); r[2 * j + 1] = *(const f32x4*)(F.peer_u + (size_t)e * DM + 512 * j + 8 * lane + 4); }
#pragma unroll
            for (int j = 0; j < 8; ++j) amax = fmaxf(amax, fmaxf(fmaxf(fabsf(r[j].x), fabsf(r[j].y)), fmaxf(fabsf(r[j].z), fabsf(r[j].w))));
            amax = fmaxf(wave_max(amax), 1e-30f); const float qs = 127.0f / amax;
            if (lane == 0) usc[e] = amax * (1.0f / 127.0f);
#pragma unroll
            for (int j = 0; j < 4; ++j) { const f32x4 a = r[2 * j] * qs, c = r[2 * j + 1] * qs;
                *(u32x2*)(pu + (size_t)(4 * j + (lane >> 4)) * 2097152 + (size_t)e * 128 + 8 * (lane & 15)) = (u32x2){pk4_i8(a.x, a.y, a.z, a.w), pk4_i8(c.x, c.y, c.z, c.w)}; } } }
    { unsigned char* pv = WSP(unsigned char, WS_PV); float* vsc = WSP(float, WS_VSC);
        for (int e = gw; e < 16384; e += NGW) { f32x4 r[8]; float amax = 0.f;
#pragma unroll
            for (int j = 0; j < 4; ++j) { r[2 * j] = *(const f32x4*)(F.peer_v + (size_t)e * DM + 512 * j + 8 * lane); r[2 * j + 1] = *(const f32x4*)(F.peer_v + (size_t)e * DM + 512 * j + 8 * lane + 4); }
#pragma unroll
            for (int j = 0; j < 8; ++j) amax = fmaxf(amax, fmaxf(fmaxf(fabsf(r[j].x), fabsf(r[j].y)), fmaxf(fabsf(r[j].z), fabsf(r[j].w))));
            amax = fmaxf(wave_max(amax), 1e-30f); const float qs = 127.0f / amax;
            if (lane == 0) vsc[e] = amax * (1.0f / 127.0f);
#pragma unroll
            for (int j = 0; j < 4; ++j) { const f32x4 a = r[2 * j] * qs, c = r[2 * j + 1] * qs;
                *(u32x2*)(pv + (size_t)(4 * j + (lane >> 4)) * 2097152 + (size_t)e * 128 + 8 * (lane & 15)) = (u32x2){pk4_i8(a.x, a.y, a.z, a.w), pk4_i8(c.x, c.y, c.z, c.w)}; } } }
}

constexpr int PK_KW = 288, PK_KEYS = 0, PK_SF = 2 * 128 * PK_KW  , PK_SI = PK_SF + 64 * 2 * 16 * 4, PK_TAB = PK_SI + 64 * 2 * 16 * 4;
__device__ __forceinline__ unsigned ord_key(float s) { unsigned u = __float_as_uint(s); return u ^ ((u >> 31) ? 0xffffffffu : 0x80000000u); }
__device__ __forceinline__ float ord_inv(unsigned k) { return __uint_as_float((k >> 31) ? (k ^ 0x80000000u) : ~k); }
#define PK_CE(a_, b_) do { const unsigned _h = (a_) > (b_) ? (a_) : (b_), _l = (a_) > (b_) ? (b_) : (a_); (a_) = _h; (b_) = _l; } while (0)
__device__ __forceinline__ void sort16_desc(unsigned (&v)[16]) {
#pragma unroll
    for (int k = 2; k <= 16; k <<= 1)
#pragma unroll
        for (int j = k >> 1; j > 0; j >>= 1)
#pragma unroll
            for (int i = 0; i < 16; ++i) { const int l = i ^ j; if (l > i) { if ((i & k) == 0) PK_CE(v[i], v[l]); else PK_CE(v[l], v[i]); } }
}
__device__ __forceinline__ void merge16_desc(unsigned (&v)[16]) {
#pragma unroll
    for (int j = 8; j > 0; j >>= 1)
#pragma unroll
        for (int i = 0; i < 16; ++i) { const int l = i ^ j; if (l > i) PK_CE(v[i], v[l]); }
}
__device__ __forceinline__ void top16_with_partner(unsigned (&v)[16], int mask) {
    unsigned o[16];
#pragma unroll
    for (int i = 0; i < 16; ++i) o[i] = (unsigned)__shfl_xor((int)v[i], mask);
#pragma unroll
    for (int i = 0; i < 16; ++i) v[i] = v[i] > o[15 - i] ? v[i] : o[15 - i];
    merge16_desc(v);
}
__device__ __forceinline__ void peer_score_phase(Frame& F) {
    const int tid = F.tid, lane = F.lane, wave = F.wave;
    LAS unsigned char* L = F.lds;
    const bf16* PQ = WSP(bf16, WS_PQ); int* IDX = WSP(int, WS_IDX); float* GATE = WSP(float, WS_GATE);
    { const u32x4* kg = WSP(u32x4, WS_PKEYS);
#pragma unroll
        for (int i = 0; i < 8; ++i) { const int id = tid + NTHREADS * i, r = id >> 4, ch = id & 15; *(LAS u32x4*)(L + PK_KEYS + r * PK_KW + ch * 16) = kg[id]; } }
    if (tid == 0) { int n = 0; for (int i = 0; i < 16; ++i) for (int j = 0; j < 16; ++j) if ((i + 1) * (j + 1) <= 16) L[PK_TAB + n++] = (unsigned char)(i * 16 + j); for (; n < 64; ++n) L[PK_TAB + n] = 0xff; }
    __syncthreads();
    LAS float* SF = (LAS float*)(L + PK_SF); LAS int* SI = (LAS int*)(L + PK_SI);
    for (int tile = F.blk; tile < NT * PEER_H / 64; tile += F.G) {
        const int R0 = tile * 64;
        { const int p = wave >> 2, rb = (wave & 3) * 16, c = lane & 15, fq = lane >> 4; const bf16* qp = PQ + (size_t)(R0 + rb + c) * 256 + p * 128 + 8 * fq;
            bf16x8 qfr[4];
#pragma unroll
            for (int ks = 0; ks < 4; ++ks) qfr[ks] = *(const bf16x8*)(qp + 32 * ks);
            unsigned lo[16], hi[16];
#pragma unroll
            for (int nb = 0; nb < 8; ++nb) { f32x4 acc = {0, 0, 0, 0};
#pragma unroll
                for (int ks = 0; ks < 4; ++ks) { const bf16x8 kfr = *(const LAS bf16x8*)(L + PK_KEYS + (p * 128 + nb * 16 + c) * PK_KW + (ks * 32 + 8 * fq) * 2);
                    acc = __builtin_amdgcn_mfma_f32_16x16x32_bf16(kfr, qfr[ks], acc, 0, 0, 0); }
#pragma unroll
                for (int r = 0; r < 4; ++r) { const unsigned key = (ord_key(acc[r]) & ~127u) | (unsigned)(127 - (16 * nb + 4 * fq + r));
                    if (nb < 4) lo[nb * 4 + r] = key; else hi[(nb - 4) * 4 + r] = key; } }
            sort16_desc(lo); sort16_desc(hi);
#pragma unroll
            for (int i = 0; i < 16; ++i) lo[i] = lo[i] > hi[15 - i] ? lo[i] : hi[15 - i];
            merge16_desc(lo);
            top16_with_partner(lo, 16); top16_with_partner(lo, 32);
            if (fq == 0) { LAS float* sf = SF + ((rb + c) * 2 + p) * 16; LAS int* si = SI + ((rb + c) * 2 + p) * 16;
#pragma unroll
                for (int i = 0; i < 16; ++i) { sf[i] = ord_inv(lo[i] & ~127u); si[i] = 127 - (int)(lo[i] & 127u); } } }
        __syncthreads();
        if (tid < 256) { const int R = tid >> 2, c = tid & 3; const LAS float* a = SF + (R * 2) * 16; const LAS float* bq = a + 16;
            unsigned v[16];
#pragma unroll
            for (int m = 0; m < 16; ++m) { v[m] = 0u; if (m < 13) { const unsigned pr = L[PK_TAB + c + 4 * m]; if (pr != 0xffu) v[m] = (ord_key(a[pr >> 4] + bq[pr & 15]) & ~255u) | (255u - pr); } }
            sort16_desc(v); top16_with_partner(v, 1); top16_with_partner(v, 2);
            unsigned w0 = c == 0 ? v[0] : (c == 1 ? v[4] : (c == 2 ? v[8] : v[12])), w1 = c == 0 ? v[1] : (c == 1 ? v[5] : (c == 2 ? v[9] : v[13]));
            unsigned w2 = c == 0 ? v[2] : (c == 1 ? v[6] : (c == 2 ? v[10] : v[14])), w3 = c == 0 ? v[3] : (c == 1 ? v[7] : (c == 2 ? v[11] : v[15]));
            const unsigned pm = 255u - (v[0] & 255u); const float smax = a[pm >> 4] + bq[pm & 15];
            const LAS int* ia = SI + (R * 2) * 16; const LAS int* ib = ia + 16;
            const unsigned p0 = 255u - (w0 & 255u), p1 = 255u - (w1 & 255u), p2 = 255u - (w2 & 255u), p3 = 255u - (w3 & 255u);
            f32x4 e = {__expf(a[p0 >> 4] + bq[p0 & 15] - smax), __expf(a[p1 >> 4] + bq[p1 & 15] - smax), __expf(a[p2 >> 4] + bq[p2 & 15] - smax), __expf(a[p3 >> 4] + bq[p3 & 15] - smax)};
            float sum = (e.x + e.y) + (e.z + e.w); sum += __shfl_xor(sum, 1); sum += __shfl_xor(sum, 2);
            const float inv = 1.0f / sum; const size_t ob = (size_t)(R0 + R) * 16 + 4 * c;
            *(f32x4*)(GATE + ob) = e * inv;
            *(int4*)(IDX + ob) = make_int4(ia[p0 >> 4] * NKEYS + ib[p0 & 15], ia[p1 >> 4] * NKEYS + ib[p1 & 15], ia[p2 >> 4] * NKEYS + ib[p2 & 15], ia[p3 >> 4] * NKEYS + ib[p3 & 15]); }
        __syncthreads();
    }
}
#undef PK_CE

__device__ __forceinline__ void ln2_rows(Frame& F, int m0, int nrows) {
    int lane; asm volatile("v_mbcnt_lo_u32_b32 %0, -1, 0\n\tv_mbcnt_hi_u32_b32 %0, -1, %0" : "=v"(lane));
    const bf16* X1 = WSP(bf16, WS_R1); const float* mod = WSP(float, WS_MOD); const bf16* Y = WSP(bf16, WS_TMP);
    f32x4 g1[8];
    { const f32x4* gt2 = (const f32x4*)(mod + (m0 >> 13) * 12288 + 10240) + lane;
#pragma unroll
        for (int j = 0; j < 8; ++j) g1[j] = 1.f + gt2[64 * j]; }
    u32x2 yn[8], xn[8];
    { const u32x2* yb = (const u32x2*)(Y + (size_t)m0 * DM) + lane; const u32x2* xb = (const u32x2*)(X1 + (size_t)m0 * DM) + lane;
#pragma unroll
        for (int j = 0; j < 8; ++j) { yn[j] = yb[64 * j]; xn[j] = xb[64 * j]; } }
#pragma unroll 1
    for (int m = m0; m < m0 + nrows; ++m) {
        f32x4* yp = (f32x4*)(F.out + (size_t)m * DM) + lane;
        f32x4 v[8]; float s = 0.f;
#pragma unroll
        for (int j = 0; j < 8; ++j) { const u32x2 yw = yn[j], xw = xn[j]; const f32x4 y = {bflo(yw.x), bfhi(yw.x), bflo(yw.y), bfhi(yw.y)}, x = {bflo(xw.x), bfhi(xw.x), bflo(xw.y), bfhi(xw.y)};
            v[j] = DN_ALPHA * x + g1[j] * y; s += (v[j].x + v[j].y) + (v[j].z + v[j].w); }
        { const int mn = m + 1 < m0 + nrows ? m + 1 : m; const u32x2* yb = (const u32x2*)(Y + (size_t)mn * DM) + lane; const u32x2* xb = (const u32x2*)(X1 + (size_t)mn * DM) + lane;
#pragma unroll
            for (int j = 0; j < 8; ++j) { yn[j] = yb[64 * j]; xn[j] = xb[64 * j]; } }
        const float mean = wave_sum(s) * (1.f / DM); float s2 = 0.f;
#pragma unroll
        for (int j = 0; j < 8; ++j) { v[j] = v[j] - mean; s2 += (v[j].x * v[j].x + v[j].y * v[j].y) + (v[j].z * v[j].z + v[j].w * v[j].w); }
        const float rstd = __builtin_amdgcn_rsqf(wave_sum(s2) * (1.f / DM) + LN_EPS);
#pragma unroll
        for (int j = 0; j < 8; ++j) yp[64 * j] = v[j] * rstd * *((const f32x4*)F.ln2_g + 64 * j + lane) + *((const f32x4*)F.ln2_b + 64 * j + lane);
    }
}
constexpr int PE_WAVE_LDS = 16384;
template <int N, int M> __device__ __forceinline__ void xreduce_step(float (&v)[M], bool bit, int mask) {
#pragma unroll
    for (int i = 0; i < N / 2; ++i) { const float keep = bit ? v[i + N / 2] : v[i], send = bit ? v[i] : v[i + N / 2]; v[i] = keep + __shfl_xor(send, mask); }
}
template <int N, int M> __device__ __forceinline__ void xreduce_step_i(int (&v)[M], bool bit, int mask) {
#pragma unroll
    for (int i = 0; i < N / 2; ++i) { const int keep = bit ? v[i + N / 2] : v[i], send = bit ? v[i] : v[i + N / 2]; v[i] = keep + __shfl_xor(send, mask); }
}
__device__ __forceinline__ void peer_eval_phase(Frame& F) {
    const int lane = F.lane, g = lane >> 3, c16 = lane & 7;
    const unsigned char* H2I = WSP(unsigned char, WS_H2I); const float* HSC = WSP(float, WS_HSC); const float* USC = WSP(float, WS_USC); const float* VSC = WSP(float, WS_VSC); const int* IDX = WSP(int, WS_IDX); const float* GATE = WSP(float, WS_GATE);
    const unsigned char* PU = WSP(unsigned char, WS_PU); const unsigned char* PV = WSP(unsigned char, WS_PV); bf16* Y = WSP(bf16, WS_TMP);
    LAS int* idxL = (LAS int*)(F.lds + F.wave * PE_WAVE_LDS); LAS float* DL = (LAS float*)(F.lds + F.wave * PE_WAVE_LDS + 8192);
    for (int tb = F.blk; tb < NT / 128; tb += F.G) {
        const int tok0 = tb * 128 + F.wave * 16;
#pragma unroll 4
        for (int tk = 0; tk < 16; ++tk) { const int e0 = lane, e1 = lane + 64; const int i0 = IDX[(size_t)(tok0 + tk) * 128 + e0], i1 = IDX[(size_t)(tok0 + tk) * 128 + e1];
            idxL[(tk * 8 + (e0 & 7)) * 16 + (e0 >> 3)] = i0 << 7; idxL[(tk * 8 + (e1 & 7)) * 16 + (e1 >> 3)] = i1 << 7; DL[tk * 128 + e0] = 0.f; DL[tk * 128 + e1] = 0.f; }
        LDS_WAIT();
        {
            auto issueU = [&](int st, u32x4 (&w)[16], i32x4& hq) { const int sl = st >> 4, tk = st & 15; const unsigned char* pu = PU + (size_t)sl * 2097152; const unsigned lo16 = 16u * c16;
                int ids[16];
#pragma unroll
                for (int q = 0; q < 4; ++q) { const i32x4 v = *(const LAS i32x4*)(idxL + (tk * 8 + g) * 16 + 4 * q); ids[4 * q] = v.x; ids[4 * q + 1] = v.y; ids[4 * q + 2] = v.z; ids[4 * q + 3] = v.w; }
                hq = *(const i32x4*)(H2I + (size_t)(tok0 + tk) * DM + 128 * sl + 16 * c16);
#pragma unroll
                for (int k = 0; k < 16; ++k) w[k] = *(const u32x4*)(pu + ((unsigned)ids[k] + lo16)); };
            auto computeU = [&](int st, const u32x4 (&w)[16], const i32x4 hq) { const int tk = st & 15;
                int pd[16];
#pragma unroll
                for (int k = 0; k < 16; ++k) { int di = __builtin_amdgcn_sdot4((int)w[k][0], hq.x, 0, false); di = __builtin_amdgcn_sdot4((int)w[k][1], hq.y, di, false);
                    di = __builtin_amdgcn_sdot4((int)w[k][2], hq.z, di, false); di = __builtin_amdgcn_sdot4((int)w[k][3], hq.w, di, false); pd[k] = di; }
                xreduce_step_i<16>(pd, c16 & 1, 1); xreduce_step_i<8>(pd, c16 & 2, 2); xreduce_step_i<4>(pd, c16 & 4, 4);
                const int k0 = 8 * (c16 & 1) + 4 * ((c16 >> 1) & 1) + 2 * (c16 >> 2);
                LAS int* dp = (LAS int*)DL + tk * 128 + g; dp[8 * k0] += pd[0]; dp[8 * (k0 + 1)] += pd[1]; };
            u32x4 wa[16], wb[16]; i32x4 ha, hb;
            issueU(0, wa, ha);
#pragma unroll 1
            for (int st = 0; st < 256; st += 2) {
                issueU(st + 1, wb, hb); computeU(st, wa, ha);
                issueU(st + 2 < 256 ? st + 2 : 255, wa, ha); computeU(st + 1, wb, hb);
            }
        }
        LDS_WAIT();
        { float a0[16], a1[16]; const int e0 = lane, e1 = lane + 64;
#pragma unroll
            for (int tk = 0; tk < 16; ++tk) { const float g0 = GATE[(size_t)(tok0 + tk) * 128 + e0], g1 = GATE[(size_t)(tok0 + tk) * 128 + e1]; const float hs = HSC[tok0 + tk];
                const int x0 = idxL[(tk * 8 + (e0 & 7)) * 16 + (e0 >> 3)], x1 = idxL[(tk * 8 + (e1 & 7)) * 16 + (e1 >> 3)];
                a0[tk] = gelu_tanh((float)((LAS int*)DL)[tk * 128 + e0] * (hs * USC[x0 >> 7])) * g0 * VSC[x0 >> 7]; a1[tk] = gelu_tanh((float)((LAS int*)DL)[tk * 128 + e1] * (hs * USC[x1 >> 7])) * g1 * VSC[x1 >> 7]; }
            LDS_WAIT();
            LAS unsigned char* AB = (LAS unsigned char*)DL; LAS float* AS = DL + 512;
#pragma unroll
            for (int tk = 0; tk < 16; ++tk) { const float amax = fmaxf(wave_max(fmaxf(fabsf(a0[tk]), fabsf(a1[tk]))), 1e-30f); const float qs = 127.0f / amax;
                const int q0 = (int)__builtin_rintf(a0[tk] * qs), q1 = (int)__builtin_rintf(a1[tk] * qs);
                AB[(tk * 8 + (e0 & 7)) * 16 + (e0 >> 3)] = (unsigned char)q0; AB[(tk * 8 + (e1 & 7)) * 16 + (e1 >> 3)] = (unsigned char)q1;
                if (lane == 0) AS[tk] = amax * (1.0f / 127.0f); } }
        LDS_WAIT();
        {
            auto issueV = [&](int st, u32x4 (&w)[16]) { const int sl = st >> 4, tk = st & 15; const unsigned char* pv = PV + (size_t)sl * 2097152; const unsigned lo16 = 16u * c16;
                int ids[16];
#pragma unroll
                for (int q = 0; q < 4; ++q) { const i32x4 v = *(const LAS i32x4*)(idxL + (tk * 8 + g) * 16 + 4 * q); ids[4 * q] = v.x; ids[4 * q + 1] = v.y; ids[4 * q + 2] = v.z; ids[4 * q + 3] = v.w; }
#pragma unroll
                for (int k = 0; k < 16; ++k) w[k] = *(const u32x4*)(pv + ((unsigned)ids[k] + lo16)); };
            auto computeV = [&](int st, const u32x4 (&w)[16]) { const int sl = st >> 4, tk = st & 15;
                const i32x4 a4 = *(const LAS i32x4*)((const LAS unsigned char*)DL + (tk * 8 + g) * 16);
                const float ascale = (DL + 512)[tk];
                int yi[16];
#pragma unroll
                for (int c = 0; c < 16; ++c) yi[c] = 0;
#pragma unroll
                for (int m = 0; m < 4; ++m) { const int am = m == 0 ? a4.x : (m == 1 ? a4.y : (m == 2 ? a4.z : a4.w));
#pragma unroll
                    for (int q = 0; q < 4; ++q) {
                        const unsigned w0 = w[4 * m][q], w1 = w[4 * m + 1][q], w2 = w[4 * m + 2][q], w3 = w[4 * m + 3][q];
                        const unsigned t0 = __builtin_amdgcn_perm(w1, w0, 0x05010400u), t1 = __builtin_amdgcn_perm(w1, w0, 0x07030602u), t2 = __builtin_amdgcn_perm(w3, w2, 0x05010400u), t3 = __builtin_amdgcn_perm(w3, w2, 0x07030602u);
                        yi[4 * q + 0] = __builtin_amdgcn_sdot4((int)__builtin_amdgcn_perm(t2, t0, 0x05040100u), am, yi[4 * q + 0], false);
                        yi[4 * q + 1] = __builtin_amdgcn_sdot4((int)__builtin_amdgcn_perm(t2, t0, 0x07060302u), am, yi[4 * q + 1], false);
                        yi[4 * q + 2] = __builtin_amdgcn_sdot4((int)__builtin_amdgcn_perm(t3, t1, 0x05040100u), am, yi[4 * q + 2], false);
                        yi[4 * q + 3] = __builtin_amdgcn_sdot4((int)__builtin_amdgcn_perm(t3, t1, 0x07060302u), am, yi[4 * q + 3], false); } }
                float cv[16];
#pragma unroll
                for (int c = 0; c < 16; ++c) cv[c] = (float)yi[c] * ascale;
                xreduce_step<16>(cv, g & 1, 8); xreduce_step<8>(cv, g & 2, 16); xreduce_step<4>(cv, g & 4, 32);
                const int c0 = 8 * (g & 1) + 4 * ((g >> 1) & 1) + 2 * (g >> 2);
                *(unsigned*)(Y + (size_t)(tok0 + tk) * DM + 128 * sl + 16 * c16 + c0) = pk2(cv[0], cv[1]); };
            u32x4 wa[16], wb[16];
            issueV(0, wa);
#pragma unroll 1
            for (int st = 0; st < 256; st += 2) {
                issueV(st + 1, wb); computeV(st, wa);
                issueV(st + 2 < 256 ? st + 2 : 255, wa); computeV(st + 1, wb);
            }
        }
        LDS_WAIT();
        VM_WAIT();
        ln2_rows(F, tok0, 16);
    }
}

constexpr int NPHASE = 12;
__global__ void __launch_bounds__(NTHREADS, 2) fwd_kernel(Args args) {
    extern __shared__ __attribute__((aligned(16))) unsigned char lds_raw[];
    Frame F;
    F.lds = (LAS unsigned char*)lds_raw; F.tid = threadIdx.x; F.lane = F.tid & 63; F.wave = __builtin_amdgcn_readfirstlane(F.tid >> 6); F.G = gridDim.x; F.blk = blockIdx.x;
    F.x = args.in[0]; F.c = args.in[1]; F.positions = (const int*)args.in[2]; F.w_ada = args.in[3]; F.b_ada = args.in[4]; F.w_in = args.in[5]; F.conv_w = args.in[6]; F.conv_b = args.in[7];
    F.w_rg_a = args.in[8]; F.b_rg_a = args.in[9]; F.w_rg_x = args.in[10]; F.b_rg_x = args.in[11]; F.rg_lambda = args.in[12]; F.w_rnn_out = args.in[13]; F.q_norm_g = args.in[14]; F.w_uq = args.in[15];
    F.kv_norm_g = args.in[16]; F.w_ukv = args.in[17]; F.w_mla_out = args.in[18]; F.w_o = args.in[19]; F.ln1_g = args.in[20]; F.ln1_b = args.in[21]; F.peer_wq = args.in[22]; F.peer_keys = args.in[23];
    F.peer_u = args.in[24]; F.peer_v = args.in[25]; F.ln2_g = args.in[26]; F.ln2_b = args.in[27]; F.out = args.out; F.ws = args.ws;
    volatile LAS unsigned* ctlw = (volatile LAS unsigned*)(F.lds + LDSCTL_OFF);
    if (F.tid < 128) ctlw[F.tid] = 0u;
    __syncthreads();
    const int lo = args.ph_lo, hi = args.ph_hi;
    const bool multi = (hi - lo) > 1;
#ifdef PROBE_RELAUNCH
    const int bslot = args.bslot;
#else
    constexpr int bslot = 0;
#endif
    XcdBarrier bar; bar.bar = (unsigned*)(F.ws + WS_CTL) + 4096 + 16384 * (bslot & 1); bar.x = 0; bar.st = nullptr;
    if (multi) bar = xcd_barrier_post((unsigned*)(F.ws + WS_CTL) + 4096 + 16384 * (bslot & 1), ctlw + 8);
#ifndef PHASE_MASK
#define PHASE_MASK 0xfff
#endif
#define IN(k) (((PHASE_MASK >> (k)) & 1) && lo <= (k) && (k) < hi)
#define SEAM(k) do { if (IN(k) && IN((k) + 1)) xcd_barrier(bar); } while (0)
#ifndef DBL_MASK
#define DBL_MASK 0
#endif
#define DBL(k, ...) do { if ((DBL_MASK >> (k)) & 1) { __VA_ARGS__; xcd_barrier(bar); } } while (0)
    const pg8::StaticOrder S0{};
    if (IN(0)) { DBL(0, p0_prologue(F, 1)); p0_prologue(F, bslot); SEAM(0); }
    if (IN(1)) { DBL(1, p1_modulate(F)); p1_modulate(F); SEAM(1); }
    if (IN(2)) {
        const pg8::Gemm g = pg8::gemm_f8(WSP(unsigned char, WS_S0), WSP(unsigned char, WS_WIN), NT, NPROJ, DM, DM, DM); pg8::StaticOrder S; S.init(NT, NPROJ, F.G, F.blk);
        EpiProj E{WSP(bf16, WS_XR), WSP(bf16, WS_GG), WSP(unsigned char, WS_QKVC), WSP(unsigned char, WS_KVC8), WSP(bf16, WS_SGR), WSP(bf16, WS_SGM), WSP(float, WS_KR), WSP(float, WS_SSP), 1.0f / (SC_H * SC_WIN)};
        DBL(2, pg8::gemm_phase<EpiProj, pg8::StaticOrder, true, false>(F.lds, g, S, E, F.wave)); pg8::gemm_phase<EpiProj, pg8::StaticOrder, true, false>(F.lds, g, S, E, F.wave); SEAM(2); }
    if (IN(3)) { DBL(3, rglru_passA(F)); rglru_passA(F); SEAM(3); }
    if (IN(4)) {
        rglru_passB(F);
        constexpr float ESC6 = 1.0f / (SC_H * SC_WIN);
        { const pg8::Gemm g = pg8::gemm_f8(WSP(unsigned char, WS_QKVC), WSP(unsigned char, WS_WUQ), NT, 3072, 512, 512, 512); pg8::StaticOrder S; S.init(NT, 3072, F.G, F.blk);
          EpiQ E{(unsigned char*)F.out + OUT_Q, WSP(float, WS_RS), WSP(f32x2, WS_ROPE), ESC6}; pg8::gemm_phase<EpiQ, pg8::StaticOrder, true>(F.lds, g, S, E, F.wave); }
        { const pg8::Gemm g = pg8::gemm_f8(WSP(unsigned char, WS_KVC8), WSP(unsigned char, WS_WUK), NT, 2048, 512, 512, 512); pg8::StaticOrder S; S.init(NT, 2048, F.G, F.blk);
          EpiK E{(unsigned char*)F.out + OUT_K, WSP(float, WS_RS), ESC6}; pg8::gemm_phase<EpiK, pg8::StaticOrder, true>(F.lds, g, S, E, F.wave); }
        { const pg8::Gemm g = pg8::gemm_f8(WSP(unsigned char, WS_WUV), WSP(unsigned char, WS_KVC8), 2048, NT, 512, 512, 512); pg8::StaticOrder S; S.init(2048, NT, F.G, F.blk);
          EpiVT E{(unsigned char*)F.out + OUT_VT, WSP(float, WS_RS), ESC6}; pg8::gemm_phase<EpiVT, pg8::StaticOrder, true>(F.lds, g, S, E, F.wave); }
        krope_fill(F); SEAM(4); }
    if (IN(5)) {
#ifdef PROBE_ATTN
#pragma unroll 1
        for (int rep = 0; rep < PROBE_ATTN; ++rep) { attn_phase(F); xcd_barrier(bar); }
#else
        attn_phase(F);
#endif
        SEAM(5); }
    if (IN(6)) {
        pg8::Gemm g = pg8::gemm_f8(WSP(unsigned char, WS_S0), WSP(unsigned char, WS_WRNN), NT, DM, 2 * DM, DM, DM); g.A2 = WSP(unsigned char, WS_AO8); g.Bt2 = WSP(unsigned char, WS_WMLA); g.nt1 = DM / 128;
        pg8::StaticOrder S; S.init(NT, DM, F.G, F.blk);
        EpiMix E{WSP(bf16, WS_SGR), WSP(bf16, WS_SGM), WSP(unsigned char, WS_TMP8), SC_AO / SC_RA, 1.0f / (SC_AO * SC_WSQ)};
        pg8::gemm_phase<EpiMix, pg8::StaticOrder, true>(F.lds, g, S, E, F.wave); SEAM(6); }
    if (IN(7)) {
#ifdef PROBE_GEMM
#if PROBE_GEMM == 1
#define PROBE_ONE { pg8::Gemm gp = pg8::gemm_f8(WSP(unsigned char, WS_TMP8), WSP(unsigned char, WS_WO), NT, DM, DM, DM, DM); gp.nt = PROBE_NT; pg8::StaticOrder Sp; Sp.init(NT, DM, F.G, F.blk); \
            EpiRes1 Ep{F.x, WSP(float, WS_MOD), WSP(bf16, WS_PQ), 1.0f}; pg8::gemm_phase<EpiRes1, pg8::StaticOrder, true>(F.lds, gp, Sp, Ep, F.wave); xcd_barrier(bar); }
#elif PROBE_GEMM == 3
#define PROBE_ONE { pg8::Gemm gp = pg8::gemm_f8(WSP(unsigned char, WS_TMP8), WSP(unsigned char, WS_WO), NT, DM, DM, DM, DM); gp.nt = PROBE_NT; pg8::StaticOrder Sp; Sp.init(NT, DM, F.G, F.blk); \
            EpiPlain Ep{WSP(bf16, WS_PQ), 1.0f}; pg8::gemm_phase<EpiPlain, pg8::StaticOrder, true, true>(F.lds, gp, Sp, Ep, F.wave); xcd_barrier(bar); }
#elif PROBE_GEMM == 5
#define PROBE_ONE { pg8::Gemm gp = pg8::gemm_f8(WSP(unsigned char, WS_TMP8), WSP(unsigned char, WS_WO), NT, DM, DM, DM, DM); gp.nt = PROBE_NT; pg8::StaticOrder Sp; Sp.init(NT, DM, F.G, F.blk); \
            EpiNull Ep{WSP(float, WS_PQ)}; pg8::gemm_phase<EpiNull, pg8::StaticOrder, true, true>(F.lds, gp, Sp, Ep, F.wave); xcd_barrier(bar); }
#elif PROBE_GEMM == 4
#define PROBE_ONE { pg8::Gemm gp = pg8::gemm_bf16(WSP(bf16, WS_TMP), WSP(bf16, WS_WPQ), NT, DM, DM, DM, DM); gp.nt = PROBE_NT; pg8::StaticOrder Sp; Sp.init(NT, DM, F.G, F.blk); \
            EpiPlain Ep{WSP(bf16, WS_PQ), 1.0f}; pg8::gemm_phase<EpiPlain, pg8::StaticOrder>(F.lds, gp, Sp, Ep, F.wave); xcd_barrier(bar); }
#endif
#ifndef PROBE_PRB
#define PROBE_PRB 0
#endif
#ifndef PROBE_REP
#define PROBE_REP 1
#endif
        PROBE_ONE
#if PROBE_REP >= 2
        PROBE_ONE
#endif
#if PROBE_REP >= 3
        PROBE_ONE
#endif
#if PROBE_REP >= 4
        PROBE_ONE
#endif
#endif
        const pg8::Gemm g = pg8::gemm_f8(WSP(unsigned char, WS_TMP8), WSP(unsigned char, WS_WO), NT, DM, DM, DM, DM); pg8::StaticOrder S; S.init(NT, DM, F.G, F.blk);
        EpiRes1 E{F.x, WSP(float, WS_MOD), WSP(bf16, WS_R1), 1.0f / (SC_TMP * SC_WSQ)};
        pg8::gemm_phase<EpiRes1, pg8::StaticOrder, true>(F.lds, g, S, E, F.wave); SEAM(7); }
    if (IN(8)) { ln1_phase(F); SEAM(8); }
    if (IN(9)) {
        const pg8::Gemm g = pg8::gemm_f8(WSP(unsigned char, WS_H2I), WSP(unsigned char, WS_WPQ), NT, DM, DM, DM, DM); pg8::StaticOrder S; S.init(NT, DM, F.G, F.blk);
        EpiQuery E{WSP(bf16, WS_PQ), WSP(float, WS_HSC), WSP(float, WS_WQS)};
        pg8::gemm_phase<EpiQuery, pg8::StaticOrder, 2>(F.lds, g, S, E, F.wave); SEAM(9); }
#ifdef PROBE_BARS
#pragma unroll 1
    for (int r = 0; r < PROBE_BARS; ++r) xcd_barrier(bar);
#endif
    if (IN(10)) { DBL(10, peer_score_phase(F)); peer_score_phase(F); SEAM(10); }
    if (IN(11)) { DBL(11, peer_eval_phase(F)); peer_eval_phase(F); }
#undef IN
#undef SEAM
}

#ifdef PROBE_ATTN_PRB
__global__ void __launch_bounds__(NTHREADS, 2) attn_probe_kernel(Args args) {
    extern __shared__ __attribute__((aligned(16))) unsigned char lds_raw[];
    Frame F;
    F.lds = (LAS unsigned char*)lds_raw; F.tid = threadIdx.x; F.lane = F.tid & 63; F.wave = __builtin_amdgcn_readfirstlane(F.tid >> 6); F.G = gridDim.x; F.blk = blockIdx.x; F.out = args.out; F.ws = args.ws;
    attn_phase<32 | PROBE_ATTN_PRB>(F);
}
#endif
#ifdef DBG_STOP
__global__ void dbg_dump(const unsigned char* ws, size_t off, int is_f32, float* out) {
    const size_t n = (size_t)NT * DM; const size_t i0 = (size_t)blockIdx.x * blockDim.x + threadIdx.x, st = (size_t)gridDim.x * blockDim.x;
    if (is_f32) { const float* s = (const float*)(ws + off); for (size_t i = i0; i < n; i += st) out[i] = s[i]; }
    else { const bf16* s = (const bf16*)(ws + off); for (size_t i = i0; i < n; i += st) out[i] = i < (size_t)DBG_N ? bf1(s[i]) : 0.f; }
}
__global__ void dbg_count(const unsigned char* ws, size_t off, float lo, float hi, unsigned* cnt) {
    if (blockIdx.x != 0) return;
    const int pm = 3, ct = 2; const bf16* s = (const bf16*)(ws + off); __shared__ unsigned rowbad[256], colbad[256];
    rowbad[threadIdx.x] = 0; colbad[threadIdx.x] = 0; __syncthreads();
    for (int i = threadIdx.x; i < 65536; i += blockDim.x) { const int r = i >> 8, cc = i & 255; const float v = bf1(s[(size_t)(pm * 256 + r) * DM + ct * 256 + cc]); if (!(v >= lo && v <= hi)) { rowbad[r] = 1; colbad[cc] = 1; } }
    __syncthreads();
    if (threadIdx.x == 0) { unsigned nr = 0, nc = 0, fr = 999, fc = 999; for (int i = 0; i < 256; ++i) { if (rowbad[i]) { ++nr; if (fr == 999) fr = i; } if (colbad[i]) { ++nc; if (fc == 999) fc = i; } }
        cnt[0] = nr + 10; cnt[1] = nc + 10; cnt[2] = fr + 10; cnt[3] = fc + 10; }
}
__global__ void dbg_report(const unsigned* cnt, float* out) {
    const size_t n = (size_t)NT * DM; const size_t i0 = (size_t)blockIdx.x * blockDim.x + threadIdx.x, st = (size_t)gridDim.x * blockDim.x;
    const float v = (float)cnt[DBG_WHICH];
    for (size_t i = i0; i < n; i += st) out[i] = (i == 0) ? v : 0.f;
}
#endif
#ifdef PROBE_MB
template <int NM, int NV, int VT>
__global__ void __launch_bounds__(NTHREADS, 2) mb_kernel(float* sink, int iters) {
    const int lane = threadIdx.x & 63; unsigned h = (unsigned)(threadIdx.x + 512 * blockIdx.x) * 0x9E3779B9u + 0x7F4A7C15u;
    i32x8 a, b; for (int e = 0; e < 8; ++e) { h = h * 1664525u + 1013904223u; a[e] = (int)(h & 0x3F3F3F3Fu); h = h * 1664525u + 1013904223u; b[e] = (int)(h & 0x3F3F3F3Fu) ^ 0x00800080; }
    f32x16 acc[4]; for (int q = 0; q < 4; ++q) for (int e = 0; e < 16; ++e) acc[q][e] = 0.f;
    float v[12]; for (int e = 0; e < 12; ++e) v[e] = 0.001f * (float)(lane + e);
    const float c1 = 0.999f, c2 = 0.0007f;
#pragma unroll 1
    for (int it = 0; it < iters; ++it) {
#pragma unroll
        for (int q = 0; q < 4; ++q) {
            if (NM) acc[q] = __builtin_amdgcn_mfma_scale_f32_32x32x64_f8f6f4(a, b, acc[q], 0, 0, 0, 0x7F7F7F7F, 0, 0x7F7F7F7F);
            __builtin_amdgcn_sched_barrier(0);
#pragma unroll
            for (int e = 0; e < NV; ++e) v[e] = VT ? __builtin_amdgcn_exp2f(v[e]) : __builtin_fmaf(v[e], c1, c2);
            __builtin_amdgcn_sched_barrier(0);
        }
    }
    float sacc = 0.f; for (int q = 0; q < 4; ++q) for (int e = 0; e < 16; ++e) sacc += acc[q][e]; for (int e = 0; e < 12; ++e) sacc += v[e];
    sink[(size_t)blockIdx.x * 512 + threadIdx.x] = sacc;
}
#endif
extern "C" void kernel_launch(void* const* d_in, const int* in_sizes, int n_in, void* d_out, int out_size, void* d_ws, size_t ws_size, hipStream_t stream) {
    static int grid = 0;
    if (grid == 0) {
        if (n_in != 28 || out_size != NT * DM || ws_size < WS_END) { fprintf(stderr, "kernel_launch: unexpected shapes (n_in %d, out %d, ws %zu)\n", n_in, out_size, ws_size); grid = -1; return; }
        int dev = 0, cus = 0, per_cu = 0;
        if (hipGetDevice(&dev) != hipSuccess || hipDeviceGetAttribute(&cus, hipDeviceAttributeMultiprocessorCount, dev) != hipSuccess) { grid = -1; return; }
        if (hipFuncSetAttribute((const void*)fwd_kernel, hipFuncAttributeMaxDynamicSharedMemorySize, LDS_BYTES) != hipSuccess) { fprintf(stderr, "kernel_launch: hipFuncSetAttribute failed\n"); grid = -1; return; }
        if (hipOccupancyMaxActiveBlocksPerMultiprocessor(&per_cu, (const void*)fwd_kernel, NTHREADS, LDS_BYTES) != hipSuccess || per_cu < 1)
            fprintf(stderr, "kernel_launch: occupancy query reports %d workgroups per CU\n", per_cu);
        (void)hipGetLastError();
        grid = cus;
    }
    if (grid < 0) return;
    if (hipMemsetAsync((char*)d_ws + WS_CTL, 0, CTL_ZERO_BYTES, stream) != hipSuccess) return;
#ifdef PROBE_MB
    hipLaunchKernelGGL((mb_kernel<PROBE_MB_NM, PROBE_MB_NV, PROBE_MB_VT>), dim3(grid), dim3(NTHREADS), 0, stream, (float*)((char*)d_ws + WS_XR), 4000);
#endif
    Args a{};
    for (int i = 0; i < 28; ++i) a.in[i] = (const float*)d_in[i];
    a.out = (float*)d_out; a.ws = (unsigned char*)d_ws;
#ifdef PROBE_RELAUNCH
    a.ph_lo = 0; a.ph_hi = PROBE_RELAUNCH + 1; a.bslot = 0;
    hipLaunchKernelGGL(fwd_kernel, dim3(grid), dim3(NTHREADS), LDS_BYTES, stream, a);
#ifdef PROBE_ATTN_PRB
    { static bool once = false; if (!once) { once = true; (void)hipFuncSetAttribute((const void*)attn_probe_kernel, hipFuncAttributeMaxDynamicSharedMemorySize, LDS_BYTES); } }
    for (int r = 0; r < PROBE_RELAUNCH_N; ++r) hipLaunchKernelGGL(attn_probe_kernel, dim3(grid), dim3(NTHREADS), LDS_BYTES, stream, a);
#else
    for (int r = 0; r < PROBE_RELAUNCH_N; ++r) { a.ph_lo = PROBE_RELAUNCH; a.ph_hi = PROBE_RELAUNCH + 1; a.bslot = 2 + r; hipLaunchKernelGGL(fwd_kernel, dim3(grid), dim3(NTHREADS), LDS_BYTES, stream, a); }
#endif
    if (PROBE_RELAUNCH + 1 < NPHASE) { a.ph_lo = PROBE_RELAUNCH + 1; a.ph_hi = NPHASE; a.bslot = 1; hipLaunchKernelGGL(fwd_kernel, dim3(grid), dim3(NTHREADS), LDS_BYTES, stream, a); }
#elif MK_N_LAUNCHES == 1
    a.ph_lo = 0; a.ph_hi = NPHASE;
    hipLaunchKernelGGL(fwd_kernel, dim3(grid), dim3(NTHREADS), LDS_BYTES, stream, a);
#else
#ifdef DBG_STOP
    for (int p = 0; p <= DBG_STOP; ++p) { a.ph_lo = p; a.ph_hi = p + 1; hipLaunchKernelGGL(fwd_kernel, dim3(grid), dim3(NTHREADS), LDS_BYTES, stream, a); }
#ifdef DBG_COUNT
        hipLaunchKernelGGL(dbg_count, dim3(1024), dim3(256), 0, stream, (const unsigned char*)d_ws, (size_t)DBG_OFF, DBG_LO, DBG_HI, (unsigned*)d_ws + 1024);
    hipLaunchKernelGGL(dbg_report, dim3(2048), dim3(256), 0, stream, (const unsigned*)d_ws + 1024, (float*)d_out);
#else
    hipLaunchKernelGGL(dbg_dump, dim3(2048), dim3(256), 0, stream, (const unsigned char*)d_ws, (size_t)DBG_OFF, DBG_F32, (float*)d_out);
#endif
#else
    for (int p = 0; p < NPHASE; ++p) { a.ph_lo = p; a.ph_hi = p + 1; hipLaunchKernelGGL(fwd_kernel, dim3(grid), dim3(NTHREADS), LDS_BYTES, stream, a); }
#endif
#endif
    const hipError_t le = hipPeekAtLastError();
    if (le != hipSuccess) fprintf(stderr, "kernel_launch: launch failed: %s\n", hipGetErrorName(le));
}
```

```cpp
#include <hip/hip_runtime.h>
#include <cstdio>
#include <cstdint>

#ifndef MK_N_LAUNCHES
#define MK_N_LAUNCHES 1
#endif

#define LAS __attribute__((address_space(3)))
#define GAS __attribute__((address_space(1)))
typedef unsigned short bf16;
typedef short bf16x8 __attribute__((ext_vector_type(8)));
typedef float f32x2 __attribute__((ext_vector_type(2)));
typedef _Float16 f16x2 __attribute__((ext_vector_type(2)));
typedef float f32x4 __attribute__((ext_vector_type(4)));
typedef float f32x16 __attribute__((ext_vector_type(16)));
typedef unsigned u32x2 __attribute__((ext_vector_type(2)));
typedef unsigned u32x4 __attribute__((ext_vector_type(4)));
typedef int i32x4 __attribute__((ext_vector_type(4)));
typedef int i32x8 __attribute__((ext_vector_type(8)));

constexpr int NB = 4, SEQ = 8192, DM = 2048, NT = NB * SEQ;
constexpr int NH = 16, QLORA = 512, KVLORA = 512, DNOPE = 128, DROPE = 64, DV = 128, DQK = 192;
constexpr int IN_COLS = 9280, NPROJ = 9472;
constexpr int PEER_H = 8, NKEYS = 128, TOPK = 16;
constexpr float DN_ALPHA = 1.189207115002721f;
constexpr float LN_EPS = 1e-5f, RMS_EPS = 1e-6f;
constexpr float QSCALE = 0.07216878364870322f * 1.4426950408889634f;
constexpr int NWAVES = 8, NTHREADS = 512;
constexpr float PU_SCALE = 1024.0f, PV_SCALE = 64.0f;
constexpr float SC_H = 16.0f, SC_WIN = 1024.0f, SC_RA = 4.0f, SC_AO = 32.0f, SC_TMP = 32.0f, SC_WSQ = 2048.0f;
constexpr float SC_Q = 64.0f, SC_K = 16.0f, SC_V = 16.0f, SC_P = 64.0f;

constexpr size_t MiB = 1u << 20;
constexpr size_t WS_CTL = 0, CTL_ZERO_BYTES = 1 * MiB;
constexpr size_t WS_MOD = 1 * MiB;
constexpr size_t WS_RS = 1 * MiB + 512 * 1024;
constexpr size_t WS_SSP = 100 * MiB;
constexpr size_t WS_ROPE = 2 * MiB;
constexpr size_t WS_WIN = 10 * MiB;
constexpr size_t WS_WRNN = 47 * MiB, WS_WMLA = 55 * MiB, WS_WO = 63 * MiB, WS_WPQ = 71 * MiB;
constexpr size_t WS_WUQ = 79 * MiB;
constexpr size_t WS_WUK = 82 * MiB, WS_WUV = 84 * MiB;
constexpr size_t WS_WGA = 86 * MiB;
constexpr size_t WS_WGX = 86 * MiB + 512 * 1024;
constexpr size_t WS_PKEYS = 87 * MiB;
constexpr size_t WS_SUMM = 88 * MiB;
constexpr size_t WS_KR = 90 * MiB;
constexpr size_t WS_S0 = 128 * MiB;
constexpr size_t WS_XR = 256 * MiB, WS_GG = 384 * MiB, WS_SGR = 512 * MiB, WS_SGM = 640 * MiB;
constexpr size_t WS_QKVC = 768 * MiB;
constexpr size_t WS_KVC8 = 800 * MiB;
constexpr size_t WS_TMP = 832 * MiB;
constexpr size_t WS_IDX = 960 * MiB, WS_GATE = 976 * MiB;
constexpr size_t WS_TMP8 = 768 * MiB;
constexpr size_t WS_K = 256 * MiB;
constexpr size_t WS_VT = 448 * MiB;
constexpr size_t WS_R1 = 256 * MiB;
constexpr size_t WS_PQ = 512 * MiB;
constexpr size_t WS_PU = 640 * MiB, WS_PV = 704 * MiB;
constexpr size_t WS_END = 1024 * MiB;
constexpr size_t WS_WQS = WS_WPQ + 4 * MiB;
constexpr size_t CTL_WQAMAX = 32768 * 4;
constexpr size_t WS_H2I = 768 * MiB;
constexpr size_t WS_HSC = 100 * MiB, WS_USC = 101 * MiB, WS_VSC = 102 * MiB;
constexpr size_t WS_AO8 = WS_S0 + 64 * MiB;
constexpr size_t OUT_Q = 0, OUT_K = 96 * MiB, OUT_VT = 192 * MiB;

constexpr int LDS_BYTES = 147456, LDSCTL_OFF = 146944;

typedef __bf16 bf16v2 __attribute__((ext_vector_type(2)));
__device__ __forceinline__ unsigned pk2(float lo, float hi) { const bf16v2 v = __builtin_convertvector((f32x2){lo, hi}, bf16v2); return __builtin_bit_cast(unsigned, v); }
__device__ __forceinline__ float bflo(unsigned w) { return __uint_as_float(w << 16); }
__device__ __forceinline__ float bfhi(unsigned w) { return __uint_as_float(w & 0xffff0000u); }
__device__ __forceinline__ float bf1(bf16 b) { return __uint_as_float(((unsigned)b) << 16); }
__device__ __forceinline__ float sigmoidf_(float y) { return __builtin_amdgcn_rcpf(1.0f + __builtin_amdgcn_exp2f(-1.4426950408889634f * y)); }
__device__ __forceinline__ float gelu_tanh(float x) { const float z = 0.7978845608028654f * (x + 0.044715f * x * x * x); return x * sigmoidf_(2.0f * z); }
__device__ __forceinline__ float wave_sum(float v) {
#pragma unroll
    for (int o = 1; o < 64; o <<= 1) v += __shfl_xor(v, o);
    return v;
}
__device__ __forceinline__ float clamp448(float v) { return __builtin_amdgcn_fmed3f(v, -448.0f, 448.0f); }
__device__ __forceinline__ unsigned pk4_f8(float a, float b, float c, float d) { int w = __builtin_amdgcn_cvt_pk_fp8_f32(clamp448(a), clamp448(b), 0, false); w = __builtin_amdgcn_cvt_pk_fp8_f32(clamp448(c), clamp448(d), w, true); return (unsigned)w; }
__device__ __forceinline__ int fresh_lane() { int l; asm volatile("v_mbcnt_lo_u32_b32 %0, -1, 0\n\tv_mbcnt_hi_u32_b32 %0, -1, %0" : "=v"(l)); return l; }
__device__ __forceinline__ float wave_max(float v) {
#pragma unroll
    for (int o = 1; o < 64; o <<= 1) v = fmaxf(v, __shfl_xor(v, o));
    return v;
}
__device__ __forceinline__ unsigned pk4_i8(float a, float b, float c, float d) {
    const int ia = (int)__builtin_rintf(__builtin_amdgcn_fmed3f(a, -127.f, 127.f)), ib = (int)__builtin_rintf(__builtin_amdgcn_fmed3f(b, -127.f, 127.f)), ic = (int)__builtin_rintf(__builtin_amdgcn_fmed3f(c, -127.f, 127.f)), id = (int)__builtin_rintf(__builtin_amdgcn_fmed3f(d, -127.f, 127.f));
    return (unsigned)(ia & 0xff) | ((unsigned)(ib & 0xff) << 8) | ((unsigned)(ic & 0xff) << 16) | ((unsigned)id << 24); }
#define LDS_WAIT() asm volatile("s_waitcnt lgkmcnt(0)" ::: "memory")
#define VM_WAIT() asm volatile("s_waitcnt vmcnt(0)" ::: "memory")

#define XB_TMO      128
#define XB_XCNT(j)  (256  + 64 * (j))
#define XB_XSUB(j)  (1280 + 64 * (j))
#define XB_XGEN(j)  (2304 + 64 * (j))
#define XB_TOP      3328
#define XB_TOPGEN   3392
#define XCD_BAR_WORDS 3456
#define XB_SPIN_CAP (1u << 20)
__device__ __forceinline__ unsigned xb_ld(unsigned* p)              { return __hip_atomic_load(p, __ATOMIC_RELAXED, __HIP_MEMORY_SCOPE_AGENT); }
__device__ __forceinline__ unsigned xb_add(unsigned* p, unsigned v) { return __hip_atomic_fetch_add(p, v, __ATOMIC_RELAXED, __HIP_MEMORY_SCOPE_AGENT); }
__device__ __forceinline__ unsigned xb_xcc_id() { return (unsigned)__builtin_amdgcn_s_getreg((3 << 11) | 20) & 0xFu; }
#define XB_SPIN(cond, bar) do { unsigned _sp = 0; while (cond) { __builtin_amdgcn_s_sleep(1); \
    if ((++_sp & 255u) == 0u) { if (xb_ld(&(bar)[XB_TMO])) break; if (_sp > XB_SPIN_CAP) { atomicAdd(&(bar)[XB_TMO], 1u); break; } } } } while (0)
struct XcdBarrier { unsigned* bar; unsigned x; volatile LAS unsigned* st; };
__device__ __forceinline__ XcdBarrier xcd_barrier_post(unsigned* bar, volatile LAS unsigned* st) {
    XcdBarrier b; b.bar = bar; b.x = xb_xcc_id(); b.st = st;
    if (threadIdx.x == 0) (void)xb_add(&bar[XB_XCNT(b.x)], 1u);
    return b;
}
__device__ __forceinline__ void xcd_barrier_complete(unsigned* bar, unsigned x, unsigned& nloc, unsigned& nx) {
    const unsigned G = gridDim.x * gridDim.y * gridDim.z;
    unsigned sum, cnt, mine, sp = 0u;
    for (;;) {
        sum = 0u; cnt = 0u; mine = 0u;
#pragma unroll
        for (unsigned j = 0; j < 16; ++j) { const unsigned c = xb_ld(&bar[XB_XCNT(j)]); sum += c; cnt += (c > 0u) ? 1u : 0u; mine = (j == x) ? c : mine; }
        if (sum == G) break;
        __builtin_amdgcn_s_sleep(1);
        if ((++sp & 255u) == 0u) { if (xb_ld(&bar[XB_TMO])) break; if (sp > XB_SPIN_CAP) { atomicAdd(&bar[XB_TMO], 1u); break; } }
    }
    nloc = mine > 0u ? mine : 1u; nx = cnt > 0u ? cnt : 1u;
}
__device__ __forceinline__ void xcd_barrier(const XcdBarrier& b) {
    asm volatile("s_waitcnt vmcnt(0)" ::: "memory");
    __syncthreads();
    if (threadIdx.x == 0) {
        unsigned* bar = b.bar;
        __builtin_amdgcn_s_waitcnt(0);
        unsigned nloc = b.st[0], nx = b.st[1];
        if (nloc == 0u) { xcd_barrier_complete(bar, b.x, nloc, nx); b.st[0] = nloc; b.st[1] = nx; }
        const unsigned old = xb_add(&bar[XB_XSUB(b.x)], 1u);
        const unsigned gen = old / nloc;
        if (old + 1u == (gen + 1u) * nloc) {
            __builtin_amdgcn_fence(__ATOMIC_RELEASE, "agent");
            asm volatile("s_waitcnt vmcnt(0)" ::: "memory");
            const unsigned og = xb_add(&bar[XB_TOP], 1u);
            const unsigned tg = og / nx;
            if (og + 1u == (tg + 1u) * nx) xb_add(&bar[XB_TOPGEN], 1u);
            else XB_SPIN(xb_ld(&bar[XB_TOPGEN]) == tg, bar);
            __builtin_amdgcn_fence(__ATOMIC_ACQUIRE, "agent");
            asm volatile("s_waitcnt vmcnt(0)" ::: "memory");
        } else {
            XB_SPIN(xb_ld(&bar[XB_TOPGEN]) == gen, bar);
            __builtin_amdgcn_fence(__ATOMIC_ACQUIRE, "agent");
            asm volatile("s_waitcnt vmcnt(0)" ::: "memory");
        }
    }
    __syncthreads();
}

__device__ __forceinline__ void glds16(const char* sbase, unsigned voff, unsigned lds_dst) {
    unsigned keep;
    asm volatile("s_mov_b32 %0, m0\n\ts_mov_b32 m0, %3\n\ts_nop 0\n\tglobal_load_lds_dwordx4 %1, %2\n\ts_mov_b32 m0, %0" : "=&s"(keep) : "v"(voff), "s"(sbase), "s"(lds_dst) : "memory");
}
namespace pg8 {
constexpr int BM = 256, BK = 64, HALF = 128, HTB = HALF * BK * 2, STAGE_BYTES = 8 * HTB, NXCD = 8, WGM = 4;
__host__ __device__ __forceinline__ int lds_byte(int r, int c) { const int st = (r >> 4) * 2 + (c >> 5), rr = r & 15, cc = c & 31, ob = rr * 64 + cc * 2; return st * 1024 + (ob ^ (((ob >> 9) & 1) << 5)); }
__host__ __device__ __forceinline__ void stage_rc(int b, int& R, int& C) { const int st = b / 1024, sb = b % 1024, swz = sb ^ (((sb >> 9) & 1) << 5); R = (st >> 1) * 16 + swz / 64; C = (st & 1) * 32 + (swz % 64) / 2; }
__host__ __device__ __forceinline__ int perm32(int rho) { const int n = rho >> 4, i = rho & 15; return 8 * (i >> 2) + 4 * n + (i & 3); }
struct Unit { int pm, pn; };
struct Gemm { const void* A; const void* Bt; int M, N, nt, lda_b, ldb_b; const void* A2 = nullptr; const void* Bt2 = nullptr; int nt1 = 0; };
__host__ __device__ __forceinline__ Gemm gemm_bf16(const bf16* A, const bf16* Bt, int M, int N, int K, int lda, int ldb) { return Gemm{A, Bt, M, N, K / 64, lda * 2, ldb * 2}; }
__host__ __device__ __forceinline__ Gemm gemm_f8(const unsigned char* A, const unsigned char* Bt, int M, int N, int K, int lda, int ldb) { return Gemm{A, Bt, M, N, K / 128, lda, ldb}; }
struct StaticOrder {
    int nM, nN, nwg, G, c;
    __host__ __device__ void init(int M, int N, int G_, int c_) { nM = M / BM; nN = N / BM; nwg = nM * nN; G = G_; c = c_; }
    __host__ __device__ bool next(int i, Unit& u) const {
        const long L = (long)i * G + c; if (L >= nwg) return false;
        int wgid = (int)L; { const int q = nwg / NXCD, r = nwg % NXCD, xcd = wgid % NXCD, off = wgid / NXCD; wgid = (xcd < r ? xcd * (q + 1) : r * (q + 1) + (xcd - r) * q) + off; }
        const int nig = WGM * nN, gid = wgid / nig, fm = gid * WGM, gsz = (nM - fm) < WGM ? (nM - fm) : WGM;
        u.pm = fm + ((wgid % nig) % gsz); u.pn = (wgid % nig) / gsz; return true;
    }
    __device__ __forceinline__ void a_ready(const Unit&) const {}
    __device__ __forceinline__ void done(const Unit&) const {}
};
template <class Epi, class Sched, int F8 = 0, bool ALIGN_EPI = true>
__device__ __forceinline__ void gemm_phase(LAS unsigned char* lds, const Gemm g, const Sched& S, const Epi& E, int wid) {
    const int lane = fresh_lane(), tid = wid * 64 + lane, wr = wid >> 2, wc = wid & 3, fr = lane & 15, fq = lane >> 4;
    const int nt = g.nt;
    unsigned voffA, voffB;
    { int R, C; stage_rc(tid * 16, R, C); const int Rb = Epi::PERM ? ((R & ~31) + perm32(R & 31)) : R; voffA = (unsigned)(R * g.lda_b + C * 2); voffB = (unsigned)(Rb * g.ldb_b + C * 2); }
    const size_t qstepA = (size_t)64 * g.lda_b, qstepB = (size_t)64 * g.ldb_b;
    const unsigned ldsbase = (unsigned)(size_t)lds;
    const size_t kstep = (size_t)(BK * 2);
    const size_t hstepA = (size_t)HALF * g.lda_b, hstepB = (size_t)HALF * g.ldb_b;
    const size_t tstepA = 2 * hstepA, tstepB = 2 * hstepB;
    const unsigned ldsw = (unsigned)wid * 1024u;
    const int aoff = lds_byte(wr * 64 + fr, fq * 8), boff = lds_byte(wc * 32 + fr, fq * 8);
#define PG8_SA(b, h) (((b) * 2 + (h)) * HTB)
#define PG8_SB(b, h) ((4 + (b) * 2 + (h)) * HTB)
#define PG8_STAGE_A(bufoff, gbase) do { glds16((const char*)(gbase), voffA, ldsbase + (bufoff) + ldsw); glds16((const char*)(gbase) + qstepA, voffA, ldsbase + (bufoff) + ldsw + 8192); } while (0)
#define PG8_STAGE_B(bufoff, gbase) do { glds16((const char*)(gbase), voffB, ldsbase + (bufoff) + ldsw); glds16((const char*)(gbase) + qstepB, voffB, ldsbase + (bufoff) + ldsw + 8192); } while (0)
#define PG8_LD8(p) __builtin_shufflevector(*(const LAS i32x4*)(p), *(const LAS i32x4*)((p) + 1024), 0, 1, 2, 3, 4, 5, 6, 7)
#define PG8_LDA(dst, b, h) do { _Pragma("unroll") for (int m = 0; m < 4; ++m) dst[m] = PG8_LD8(lds + PG8_SA(b, h) + aoff + m * 2048); } while (0)
#define PG8_LDB(dst, b, h) do { _Pragma("unroll") for (int n = 0; n < 2; ++n) dst[n] = PG8_LD8(lds + PG8_SB(b, h) + boff + n * 2048); } while (0)
#define PG8_LO(v) __builtin_bit_cast(bf16x8, __builtin_shufflevector(v, v, 0, 1, 2, 3))
#define PG8_HI(v) __builtin_bit_cast(bf16x8, __builtin_shufflevector(v, v, 4, 5, 6, 7))
#define PG8_MMA(ai, bj, At, Bt) do { __builtin_amdgcn_s_setprio(1); _Pragma("unroll") for (int m = 0; m < 4; ++m) _Pragma("unroll") for (int n = 0; n < 2; ++n) { \
        if constexpr (F8 == 1) acc[ai][bj][m][n] = __builtin_amdgcn_mfma_scale_f32_16x16x128_f8f6f4(Bt[n], At[m], acc[ai][bj][m][n], 0, 0, 0, 0x7F7F7F7F, 0, 0x7F7F7F7F); \
        else if constexpr (F8 == 2) { i32x4 ci = __builtin_bit_cast(i32x4, acc[ai][bj][m][n]); \
               ci = __builtin_amdgcn_mfma_i32_16x16x64_i8(__builtin_shufflevector(Bt[n], Bt[n], 0, 1, 2, 3), __builtin_shufflevector(At[m], At[m], 0, 1, 2, 3), ci, 0, 0, 0); \
               ci = __builtin_amdgcn_mfma_i32_16x16x64_i8(__builtin_shufflevector(Bt[n], Bt[n], 4, 5, 6, 7), __builtin_shufflevector(At[m], At[m], 4, 5, 6, 7), ci, 0, 0, 0); \
               acc[ai][bj][m][n] = __builtin_bit_cast(f32x4, ci); } \
        else { acc[ai][bj][m][n] = __builtin_amdgcn_mfma_f32_16x16x32_bf16(PG8_LO(Bt[n]), PG8_LO(At[m]), acc[ai][bj][m][n], 0, 0, 0); \
               acc[ai][bj][m][n] = __builtin_amdgcn_mfma_f32_16x16x32_bf16(PG8_HI(Bt[n]), PG8_HI(At[m]), acc[ai][bj][m][n], 0, 0, 0); } } \
        __builtin_amdgcn_s_setprio(0); } while (0)
#define PG8_WAIT_V(n) asm volatile("s_waitcnt vmcnt(" #n ")" ::: "memory")
#define PG8_WAIT_L(n) asm volatile("s_waitcnt lgkmcnt(" #n ")" ::: "memory")
#define PG8_BAR __builtin_amdgcn_s_barrier()
#define PG8_SCHED __builtin_amdgcn_sched_barrier(0)
    Unit cur, nxt; int ui = 0;
    if (!S.next(0, cur)) return;
    f32x4 acc[2][2][4][2];
#pragma unroll
    for (int a = 0; a < 2; ++a)
#pragma unroll
        for (int b = 0; b < 2; ++b)
#pragma unroll
            for (int m = 0; m < 4; ++m)
#pragma unroll
                for (int n = 0; n < 2; ++n) acc[a][b][m][n] = (f32x4){0.f, 0.f, 0.f, 0.f};
    i32x8 At[4], B0[2], B1[2];
    const char* cA = (const char*)g.A + (size_t)cur.pm * tstepA; const char* cB = (const char*)g.Bt + (size_t)cur.pn * tstepB;
    const bool two = g.A2 != nullptr; const int nt1 = two ? g.nt1 : nt;
    const char* cA2 = two ? (const char*)g.A2 + (size_t)cur.pm * tstepA : cA; const char* cB2 = two ? (const char*)g.Bt2 + (size_t)cur.pn * tstepB : cB;
    S.a_ready(cur);
    PG8_STAGE_B(PG8_SB(0, 0), cB); PG8_STAGE_B(PG8_SB(0, 1), cB + hstepB); PG8_STAGE_A(PG8_SA(0, 0), cA); PG8_STAGE_A(PG8_SA(0, 1), cA + hstepA);
    if (wr == 1) PG8_BAR;
    PG8_WAIT_V(2); PG8_BAR;
    PG8_STAGE_B(PG8_SB(1, 0), cB + kstep); PG8_STAGE_A(PG8_SA(1, 0), cA + kstep); PG8_STAGE_B(PG8_SB(1, 1), cB + hstepB + kstep);
    PG8_WAIT_V(6); PG8_BAR;
    for (;;) {
        const bool has_next = S.next(ui + 1, nxt);
        const char* nA = has_next ? (const char*)g.A + (size_t)nxt.pm * tstepA : cA; const char* nB = has_next ? (const char*)g.Bt + (size_t)nxt.pn * tstepB : cB;
#pragma unroll 1
        for (int t = 0; t < nt; t += 2) {
            const bool last = (t == nt - 2);
            const char* a1 = (t < nt1 ? cA + (size_t)t * kstep : cA2 + (size_t)(t - nt1) * kstep) + kstep;
            const char* a2 = last ? nA : (t + 2 < nt1 ? cA + (size_t)(t + 2) * kstep : cA2 + (size_t)(t + 2 - nt1) * kstep);
            const char* b2 = last ? nB : (t + 2 < nt1 ? cB + (size_t)(t + 2) * kstep : cB2 + (size_t)(t + 2 - nt1) * kstep);
            const char* a3 = a2 + kstep; const char* b3 = b2 + kstep;
            if (last && has_next) S.a_ready(nxt);
            PG8_LDB(B0, 0, 0); PG8_LDB(B1, 0, 1); PG8_SCHED; PG8_LDA(At, 0, 0); PG8_STAGE_A(PG8_SA(1, 1), a1 + hstepA);
            PG8_WAIT_V(8); PG8_WAIT_L(0); PG8_BAR; PG8_MMA(0, 0, At, B0); PG8_MMA(0, 1, At, B1); PG8_BAR; PG8_SCHED;
            PG8_LDA(At, 0, 1); PG8_STAGE_B(PG8_SB(0, 0), b2); PG8_STAGE_B(PG8_SB(0, 1), b2 + hstepB); PG8_STAGE_A(PG8_SA(0, 0), a2);
            PG8_WAIT_V(8); PG8_WAIT_L(0); PG8_BAR; PG8_MMA(1, 0, At, B0); PG8_MMA(1, 1, At, B1); PG8_BAR; PG8_SCHED;
            PG8_LDB(B0, 1, 0); PG8_LDB(B1, 1, 1); PG8_SCHED; PG8_LDA(At, 1, 0); PG8_STAGE_A(PG8_SA(0, 1), a2 + hstepA);
            PG8_WAIT_V(8); PG8_WAIT_L(0); PG8_BAR; PG8_MMA(0, 0, At, B0); PG8_MMA(0, 1, At, B1); PG8_BAR; PG8_SCHED;
            PG8_LDA(At, 1, 1); PG8_STAGE_B(PG8_SB(1, 0), b3); PG8_STAGE_B(PG8_SB(1, 1), b3 + hstepB); PG8_STAGE_A(PG8_SA(1, 0), a3);
            PG8_WAIT_V(8); PG8_WAIT_L(0); PG8_BAR; PG8_MMA(1, 0, At, B0); PG8_MMA(1, 1, At, B1); PG8_BAR; PG8_SCHED;
            if constexpr (Epi::HAS_MID) { if (t + 2 == nt1) { int fr2 = fr, fq2 = fq; asm volatile("" : "+v"(fr2), "+v"(fq2)); E.mid(acc, cur, wr, wc, fr2, fq2); } }
        }
        if constexpr (ALIGN_EPI) { if (wr == 0) PG8_BAR; }
        { int fr2 = fr, fq2 = fq; asm volatile("" : "+v"(fr2), "+v"(fq2));
          E(acc, cur, wr, wc, fr2, fq2); }
        if (!has_next) break;
#pragma unroll
        for (int a = 0; a < 2; ++a)
#pragma unroll
            for (int b = 0; b < 2; ++b)
#pragma unroll
                for (int m = 0; m < 4; ++m)
#pragma unroll
                    for (int n = 0; n < 2; ++n) acc[a][b][m][n] = (f32x4){0.f, 0.f, 0.f, 0.f};
        cur = nxt; cA = nA; cB = nB; ++ui;
        if (two) { cA2 = (const char*)g.A2 + (size_t)cur.pm * tstepA; cB2 = (const char*)g.Bt2 + (size_t)cur.pn * tstepB; } else { cA2 = cA; cB2 = cB; }
        if constexpr (ALIGN_EPI) { if (wr == 1) PG8_BAR; }
    }
    PG8_WAIT_V(0);
    if constexpr (!ALIGN_EPI) { if (wr == 0) PG8_BAR; }
    PG8_BAR;
#undef PG8_SA
#undef PG8_SB
#undef PG8_STAGE_A
#undef PG8_STAGE_B
#undef PG8_LDA
#undef PG8_LDB
#undef PG8_LD8
#undef PG8_LO
#undef PG8_HI
#undef PG8_MMA
#undef PG8_WAIT_V
#undef PG8_WAIT_L
#undef PG8_BAR
#undef PG8_SCHED
}
}
typedef f32x4 AccT[2][2][4][2];

#ifdef PROBE_RELAUNCH
struct Args { const float* in[28]; float* out; unsigned char* ws; int ph_lo, ph_hi, bslot; };
#else
struct Args { const float* in[28]; float* out; unsigned char* ws; int ph_lo, ph_hi; };
#endif
struct Frame {
    LAS unsigned char* lds; int tid, lane, wave, G, blk;
    const float *x, *c, *w_ada, *b_ada, *w_in, *conv_w, *conv_b, *w_rg_a, *b_rg_a, *w_rg_x, *b_rg_x, *rg_lambda, *w_rnn_out, *q_norm_g, *w_uq, *kv_norm_g, *w_ukv,
                *w_mla_out, *w_o, *ln1_g, *ln1_b, *peer_wq, *peer_keys, *peer_u, *peer_v, *ln2_g, *ln2_b;
    const int* positions;
    float* out; unsigned char* ws;
};
#define WSP(T, off) ((T*)(F.ws + (off)))

template <int MAP> __device__ __forceinline__ int colmap(int n) {
    if (MAP == 0) return n;
    if (MAP == 1) return n < 5120 ? n : (n < 9216 ? n + 64 : (n < 9280 ? n - 4096 : -1));
    if (MAP == 2) { if (n < 2048) return (n >> 7) * 192 + (n & 127); const int m = n - 2048, h = m >> 6, jj = m & 63; return h * 192 + 128 + (jj >> 1) + 32 * (jj & 1); }
    if (MAP == 3) return (n >> 7) * 256 + (n & 127);
    return (n >> 7) * 256 + 128 + (n & 127);
}
template <int MAP, bool F8> __device__ __forceinline__ void tr_item64(const float* W, int ldw, void* WTv, int ldt, float scale, const float* kscale, LAS float* scr, int k0, int n0, int lane) {
    const int col = colmap<MAP>(n0 + lane);
    const int cc = col >= 0 ? col : 0; const float cs = col >= 0 ? scale : 0.f;
    const float ksl = kscale ? kscale[k0 + lane] : 1.f;
    float wv[64];
#pragma unroll
    for (int kk = 0; kk < 64; ++kk) wv[kk] = W[(size_t)(k0 + kk) * ldw + cc];
#pragma unroll
    for (int kk = 0; kk < 64; ++kk) scr[kk * 65 + lane] = wv[kk] * cs * __builtin_bit_cast(float, __builtin_amdgcn_readlane(__builtin_bit_cast(int, ksl), kk));
    LDS_WAIT();
    const LAS float* sp = scr + lane;
    if (F8) { unsigned char* o = (unsigned char*)WTv + (size_t)(n0 + lane) * ldt + k0;
#pragma unroll
        for (int q = 0; q < 4; ++q) { u32x4 w;
#pragma unroll
            for (int d = 0; d < 4; ++d) { const int k = 16 * q + 4 * d; w[d] = pk4_f8(sp[k * 65], sp[(k + 1) * 65], sp[(k + 2) * 65], sp[(k + 3) * 65]); }
            *(u32x4*)(o + 16 * q) = w; }
    } else { bf16* o = (bf16*)WTv + (size_t)(n0 + lane) * ldt + k0;
#pragma unroll
        for (int q = 0; q < 8; ++q) { u32x4 w;
#pragma unroll
            for (int d = 0; d < 4; ++d) { const int k = 8 * q + 2 * d; w[d] = pk2(sp[k * 65], sp[(k + 1) * 65]); }
            *(u32x4*)(o + 8 * q) = w; } }
    LDS_WAIT();
}
__device__ __forceinline__ void p0_prologue(Frame& F, int qbank = 0) {
    const int tid = F.tid, lane = F.lane;
    if (F.blk < 192) {
        LAS float* ca = (LAS float*)F.lds; LAS float* red = (LAS float*)(F.lds + 32768);
        for (int i = tid; i < NB * DM; i += NTHREADS) { const float v = F.c[i]; ca[i] = v * sigmoidf_(v); }
        __syncthreads();
        const int cq = tid & 15, rg = tid >> 4, c0 = 64 * F.blk + 4 * cq;
        f32x4 a0 = {0, 0, 0, 0}, a1 = a0, a2 = a0, a3 = a0;
#pragma unroll 8
        for (int k = rg; k < DM; k += 32) { const f32x4 w = *(const f32x4*)(F.w_ada + (size_t)k * 12288 + c0);
            a0 += ca[k] * w; a1 += ca[DM + k] * w; a2 += ca[2 * DM + k] * w; a3 += ca[3 * DM + k] * w; }
        *(LAS f32x4*)(red + (rg * 4 + 0) * 64 + 4 * cq) = a0; *(LAS f32x4*)(red + (rg * 4 + 1) * 64 + 4 * cq) = a1;
        *(LAS f32x4*)(red + (rg * 4 + 2) * 64 + 4 * cq) = a2; *(LAS f32x4*)(red + (rg * 4 + 3) * 64 + 4 * cq) = a3;
        __syncthreads();
        if (tid < 256) { const int b = tid >> 6, col = tid & 63; float s = 0.f;
            for (int r = 0; r < 32; ++r) s += red[(r * 4 + b) * 64 + col];
            WSP(float, WS_MOD)[b * 12288 + 64 * F.blk + col] = s + F.b_ada[64 * F.blk + col]; }
        __syncthreads();
    }
    {
        LAS float* scr = (LAS float*)(F.lds + F.wave * 16640);
        unsigned* qhead = (unsigned*)(F.ws + WS_CTL) + 8192 + 2048 * qbank + 64 * (F.blk & 31);
        constexpr int I_IN = (NPROJ / 64) * (DM / 64), I_SQ = (DM / 64) * (DM / 64), I_UQ = (3072 / 64) * (512 / 64), I_UK = (2048 / 64) * (512 / 64), I_RG = 16 * 2 * 2;
        constexpr int NITEMS = I_IN + 4 * I_SQ + I_UQ + 2 * I_UK + 2 * I_RG;
        int nxt = 0; if (lane == 0) nxt = (int)__hip_atomic_fetch_add(qhead, 1u, __ATOMIC_RELAXED, __HIP_MEMORY_SCOPE_AGENT);
        for (;;) {
            const int it = __builtin_amdgcn_readfirstlane(nxt) * 32 + (F.blk & 31); if (it >= NITEMS) break;
            if (lane == 0) nxt = (int)__hip_atomic_fetch_add(qhead, 1u, __ATOMIC_RELAXED, __HIP_MEMORY_SCOPE_AGENT);
            int r = it;
            if (r < I_IN) { tr_item64<1, true>(F.w_in, IN_COLS, WSP(unsigned char, WS_WIN), DM, SC_WIN, nullptr, scr, 64 * (r / (NPROJ / 64)), 64 * (r % (NPROJ / 64)), lane); continue; } r -= I_IN;
            if (r < I_SQ) { tr_item64<0, true>(F.w_rnn_out, DM, WSP(unsigned char, WS_WRNN), DM, SC_WSQ, nullptr, scr, 64 * (r / 32), 64 * (r % 32), lane); continue; } r -= I_SQ;
            if (r < I_SQ) { tr_item64<0, true>(F.w_mla_out, DM, WSP(unsigned char, WS_WMLA), DM, SC_WSQ, nullptr, scr, 64 * (r / 32), 64 * (r % 32), lane); continue; } r -= I_SQ;
            if (r < I_SQ) { tr_item64<0, true>(F.w_o, DM, WSP(unsigned char, WS_WO), DM, SC_WSQ, nullptr, scr, 64 * (r / 32), 64 * (r % 32), lane); continue; } r -= I_SQ;
            if (r < I_SQ) {
                const int k0 = 64 * (r / 32), n0 = 64 * (r % 32); float am = 0.f;
#pragma unroll
                for (int kk = 0; kk < 64; ++kk) am = fmaxf(am, fabsf(F.peer_wq[(size_t)(k0 + kk) * DM + n0 + lane]));
                (void)__hip_atomic_fetch_max((unsigned*)(F.ws + WS_CTL + CTL_WQAMAX) + n0 + lane, __float_as_uint(am), __ATOMIC_RELAXED, __HIP_MEMORY_SCOPE_AGENT);
                continue; } r -= I_SQ;
            if (r < I_UQ) { tr_item64<2, true>(F.w_uq, 3072, WSP(unsigned char, WS_WUQ), 512, SC_WIN, F.q_norm_g, scr, 64 * (r / 48), 64 * (r % 48), lane); continue; } r -= I_UQ;
            if (r < I_UK) { tr_item64<3, true>(F.w_ukv, 4096, WSP(unsigned char, WS_WUK), 512, SC_WIN, F.kv_norm_g, scr, 64 * (r / 32), 64 * (r % 32), lane); continue; } r -= I_UK;
            if (r < I_UK) { tr_item64<4, true>(F.w_ukv, 4096, WSP(unsigned char, WS_WUV), 512, SC_WIN, F.kv_norm_g, scr, 64 * (r / 32), 64 * (r % 32), lane); continue; } r -= I_UK;
            if (r < I_RG) { const int h = r >> 2, q = r & 3; tr_item64<0, false>(F.w_rg_a + h * 16384, 128, WSP(bf16, WS_WGA) + h * 16384, 128, 1.0f, nullptr, scr, 64 * (q >> 1), 64 * (q & 1), lane); continue; } r -= I_RG;
            { const int h = r >> 2, q = r & 3; tr_item64<0, false>(F.w_rg_x + h * 16384, 128, WSP(bf16, WS_WGX) + h * 16384, 128, 1.0f, nullptr, scr, 64 * (q >> 1), 64 * (q & 1), lane); }
        }
    }
    {
        const int gt = F.blk * NTHREADS + tid, NGT = F.G * NTHREADS;
        f32x2* rope = WSP(f32x2, WS_ROPE);
        for (int i = gt; i < NT * 32; i += NGT) { const int t = i >> 5, j = i & 31;
            const float inv_freq = exp2f(-(float)j * (13.287712379549449f / 32.0f));
            const float ang = (float)F.positions[t] * inv_freq;
            double rev = (double)ang * 0.15915494309189535; rev -= rint(rev);
            const float rv = (float)rev;
            rope[i] = (f32x2){__builtin_amdgcn_cosf(rv), __builtin_amdgcn_sinf(rv)}; }
        bf16* pk = WSP(bf16, WS_PKEYS);
        for (int i = gt; i < 2 * 128 * 128 / 2; i += NGT) { const f32x2 v = *(const f32x2*)(F.peer_keys + 2 * i); ((unsigned*)pk)[i] = pk2(v.x, v.y); }
    }
}

__device__ __forceinline__ void p1_modulate(Frame& F) {
    const int gw = F.blk * NWAVES + F.wave, NGW = F.G * NWAVES;
    const float* mod = WSP(float, WS_MOD); unsigned char* hb = WSP(unsigned char, WS_S0);
    for (int m = gw; m < NT; m += NGW) {
        const int b = m >> 13; const float* sh = mod + b * 12288; const float* sc = sh + 2048;
#pragma unroll
        for (int j = 0; j < 2; ++j) { const int col = 1024 * j + 16 * F.lane; u32x4 o;
#pragma unroll
            for (int q = 0; q < 4; ++q) { const f32x4 v = *(const f32x4*)(F.x + (size_t)m * DM + col + 4 * q), s = *(const f32x4*)(sc + col + 4 * q), h = *(const f32x4*)(sh + col + 4 * q);
                o[q] = pk4_f8((v.x * (1.f + s.x) + h.x) * SC_H, (v.y * (1.f + s.y) + h.y) * SC_H, (v.z * (1.f + s.z) + h.z) * SC_H, (v.w * (1.f + s.w) + h.w) * SC_H); }
            *(u32x4*)(hb + (size_t)m * DM + col) = o; }
    }
    if (F.wave < 4) {
        const int lane = F.lane, it = F.blk * 4 + F.wave;
        LAS float* scr = (LAS float*)(F.lds + F.wave * 16640);
        for (int r = it; r < 1024; r += 4 * F.G) {
            const int k0 = 64 * (r / 32), n0 = 64 * (r % 32);
            const float am = fmaxf(__uint_as_float(((const unsigned*)(F.ws + WS_CTL + CTL_WQAMAX))[n0 + lane]), 1e-30f), qs = 127.0f / am;
#pragma unroll
            for (int kk = 0; kk < 64; ++kk) scr[kk * 65 + lane] = F.peer_wq[(size_t)(k0 + kk) * DM + n0 + lane];
            LDS_WAIT();
            if (k0 == 0) WSP(float, WS_WQS)[n0 + lane] = am * (1.0f / 127.0f);
            const LAS float* sp = scr + lane;
            unsigned char* o = WSP(unsigned char, WS_WPQ) + (size_t)(n0 + lane) * DM + k0;
#pragma unroll
            for (int q = 0; q < 4; ++q) { u32x4 w;
#pragma unroll
                for (int d = 0; d < 4; ++d) { const int k = 16 * q + 4 * d; w[d] = pk4_i8(sp[k * 65] * qs, sp[(k + 1) * 65] * qs, sp[(k + 2) * 65] * qs, sp[(k + 3) * 65] * qs); }
                *(u32x4*)(o + 16 * q) = w; }
            LDS_WAIT();
        }
    }
}

#define EPI_ROWS(...) _Pragma("unroll") for (int ai = 0; ai < 2; ++ai) _Pragma("unroll") for (int m = 0; m < 4; ++m) { const int row = u.pm * 256 + ai * 128 + wr * 64 + m * 16 + fr; \
    _Pragma("unroll") for (int bj = 0; bj < 2; ++bj) { const int cl = bj * 128 + wc * 32 + 8 * fq; const f32x4 v0 = acc[ai][bj][m][0] * esc, v1 = acc[ai][bj][m][1] * esc; __VA_ARGS__ } }
__device__ __forceinline__ u32x4 pack8(const f32x4 a, const f32x4 b) { return (u32x4){pk2(a.x, a.y), pk2(a.z, a.w), pk2(b.x, b.y), pk2(b.z, b.w)}; }

struct EpiProj {
    static constexpr bool HAS_MID = false;
    static constexpr bool PERM = true;
    bf16 *XR, *GG; unsigned char *QC8, *KVC8; bf16 *SGR, *SGM; float *KR, *SS; float esc;
    __device__ __forceinline__ void operator()(const AccT& acc, const pg8::Unit& u, int wr, int wc, int fr, int fq) const {
        const int pn = u.pn;
        if (pn < 8) { bf16* O = XR + pn * 256;
            EPI_ROWS( *(u32x4*)(O + (size_t)row * DM + cl) = pack8(v0, v1); )
        } else if (pn < 16) { bf16* O = GG + (pn - 8) * 256;
            EPI_ROWS( f32x4 a, b; for (int e = 0; e < 4; ++e) { a[e] = gelu_tanh(v0[e]); b[e] = gelu_tanh(v1[e]); } *(u32x4*)(O + (size_t)row * DM + cl) = pack8(a, b); )
        } else if (pn < 20) { const int which = (pn >= 18); const int c0 = (pn & 1) * 256;
#pragma unroll
            for (int ai = 0; ai < 2; ++ai)
#pragma unroll
                for (int m = 0; m < 4; ++m) { const int row = u.pm * 256 + ai * 128 + wr * 64 + m * 16 + fr; float s = 0.f;
#pragma unroll
                    for (int bj = 0; bj < 2; ++bj) { const int cl = bj * 128 + wc * 32 + 8 * fq; const f32x4 v0 = acc[ai][bj][m][0] * esc, v1 = acc[ai][bj][m][1] * esc;
                        *(u32x2*)((which ? KVC8 : QC8) + (size_t)row * 512 + c0 + cl) = (u32x2){pk4_f8(v0.x * SC_H, v0.y * SC_H, v0.z * SC_H, v0.w * SC_H), pk4_f8(v1.x * SC_H, v1.y * SC_H, v1.z * SC_H, v1.w * SC_H)};
                        s += (v0.x * v0.x + v0.y * v0.y) + (v0.z * v0.z + v0.w * v0.w) + (v1.x * v1.x + v1.y * v1.y) + (v1.z * v1.z + v1.w * v1.w); }
                    SS[(size_t)row * 64 + which * 32 + (pn & 1) * 16 + wc * 4 + fq] = s; }
        } else if (pn < 36) { bf16* O = (pn < 28 ? SGR + (pn - 20) * 256 : SGM + (pn - 28) * 256);
            EPI_ROWS( f32x4 a, b; for (int e = 0; e < 4; ++e) { a[e] = sigmoidf_(v0[e]); b[e] = sigmoidf_(v1[e]); } *(u32x4*)(O + (size_t)row * DM + cl) = pack8(a, b); )
        } else {
            EPI_ROWS( if (cl < 64) { *(f32x4*)(KR + (size_t)row * 64 + cl) = v0; *(f32x4*)(KR + (size_t)row * 64 + cl + 4) = v1; } )
        }
    }
};
struct EpiGate1 {
    static constexpr bool HAS_MID = false;
    static constexpr bool PERM = true; const bf16* SG; bf16* O; float esc;
    __device__ __forceinline__ void operator()(const AccT& acc, const pg8::Unit& u, int wr, int wc, int fr, int fq) const {
        EPI_ROWS( const size_t off = (size_t)row * DM + u.pn * 256 + cl; const u32x4 g = *(const u32x4*)(SG + off);
            f32x4 a = {v0.x * bflo(g.x), v0.y * bfhi(g.x), v0.z * bflo(g.y), v0.w * bfhi(g.y)}, b = {v1.x * bflo(g.z), v1.y * bfhi(g.z), v1.z * bflo(g.w), v1.w * bfhi(g.w)};
            *(u32x4*)(O + off) = pack8(a, b); )
    }
};
struct EpiGate2 {
    static constexpr bool HAS_MID = false;
    static constexpr bool PERM = true; const bf16* SG; const bf16* T; unsigned char* O8; float esc;
    __device__ __forceinline__ void operator()(const AccT& acc, const pg8::Unit& u, int wr, int wc, int fr, int fq) const {
        EPI_ROWS( const size_t off = (size_t)row * DM + u.pn * 256 + cl; const u32x4 g = *(const u32x4*)(SG + off); const u32x4 p = *(const u32x4*)(T + off);
            *(u32x2*)(O8 + off) = (u32x2){pk4_f8((bflo(p.x) + v0.x * bflo(g.x)) * SC_TMP, (bfhi(p.x) + v0.y * bfhi(g.x)) * SC_TMP, (bflo(p.y) + v0.z * bflo(g.y)) * SC_TMP, (bfhi(p.y) + v0.w * bfhi(g.y)) * SC_TMP),
                                          pk4_f8((bflo(p.z) + v1.x * bflo(g.z)) * SC_TMP, (bfhi(p.z) + v1.y * bfhi(g.z)) * SC_TMP, (bflo(p.w) + v1.z * bflo(g.w)) * SC_TMP, (bfhi(p.w) + v1.w * bfhi(g.w)) * SC_TMP)}; )
    }
};
struct EpiMix {
    static constexpr bool HAS_MID = true;
    static constexpr bool PERM = true; const bf16* SGR; const bf16* SGM; unsigned char* O8; float r12, e2;
    __device__ __forceinline__ void mid(AccT& acc, const pg8::Unit& u, int wr, int wc, int fr, int fq) const {
#pragma unroll
        for (int ai = 0; ai < 2; ++ai) {
            u32x4 gr[8], gm[8];
#pragma unroll
            for (int m = 0; m < 4; ++m)
#pragma unroll
                for (int bj = 0; bj < 2; ++bj) { const size_t off = (size_t)(u.pm * 256 + ai * 128 + wr * 64 + m * 16 + fr) * DM + u.pn * 256 + bj * 128 + wc * 32 + 8 * fq;
                    gr[m * 2 + bj] = *(const u32x4*)(SGR + off); gm[m * 2 + bj] = *(const u32x4*)(SGM + off); }
            __builtin_amdgcn_sched_barrier(0);
#pragma unroll
            for (int m = 0; m < 4; ++m)
#pragma unroll
                for (int bj = 0; bj < 2; ++bj) { const u32x4 r = gr[m * 2 + bj], d = gm[m * 2 + bj];
                    const f32x4 n0 = {bflo(r.x), bfhi(r.x), bflo(r.y), bfhi(r.y)}, n1 = {bflo(r.z), bfhi(r.z), bflo(r.w), bfhi(r.w)};
                    const f32x4 d0 = {bflo(d.x), bfhi(d.x), bflo(d.y), bfhi(d.y)}, d1 = {bflo(d.z), bfhi(d.z), bflo(d.w), bfhi(d.w)};
#pragma unroll
                    for (int e = 0; e < 4; ++e) { acc[ai][bj][m][0][e] *= r12 * n0[e] * __builtin_amdgcn_rcpf(fmaxf(d0[e], 1e-12f)); acc[ai][bj][m][1][e] *= r12 * n1[e] * __builtin_amdgcn_rcpf(fmaxf(d1[e], 1e-12f)); } }
            __builtin_amdgcn_sched_barrier(0);
        }
    }
    __device__ __forceinline__ void operator()(const AccT& acc, const pg8::Unit& u, int wr, int wc, int fr, int fq) const {
        const float esc = e2 * SC_TMP;
#pragma unroll
        for (int ai = 0; ai < 2; ++ai) {
            u32x4 gmv[8];
#pragma unroll
            for (int m = 0; m < 4; ++m)
#pragma unroll
                for (int bj = 0; bj < 2; ++bj) gmv[m * 2 + bj] = *(const u32x4*)(SGM + (size_t)(u.pm * 256 + ai * 128 + wr * 64 + m * 16 + fr) * DM + u.pn * 256 + bj * 128 + wc * 32 + 8 * fq);
            __builtin_amdgcn_sched_barrier(0);
#pragma unroll
            for (int m = 0; m < 4; ++m)
#pragma unroll
                for (int bj = 0; bj < 2; ++bj) { const size_t off = (size_t)(u.pm * 256 + ai * 128 + wr * 64 + m * 16 + fr) * DM + u.pn * 256 + bj * 128 + wc * 32 + 8 * fq; const u32x4 gm = gmv[m * 2 + bj];
                    const f32x4 v0 = acc[ai][bj][m][0] * esc, v1 = acc[ai][bj][m][1] * esc;
                    *(u32x2*)(O8 + off) = (u32x2){pk4_f8(v0.x * fmaxf(bflo(gm.x), 1e-12f), v0.y * fmaxf(bfhi(gm.x), 1e-12f), v0.z * fmaxf(bflo(gm.y), 1e-12f), v0.w * fmaxf(bfhi(gm.y), 1e-12f)),
                                                  pk4_f8(v1.x * fmaxf(bflo(gm.z), 1e-12f), v1.y * fmaxf(bfhi(gm.z), 1e-12f), v1.z * fmaxf(bflo(gm.w), 1e-12f), v1.w * fmaxf(bfhi(gm.w), 1e-12f))}; }
            __builtin_amdgcn_sched_barrier(0);
        }
    }
};
struct EpiRes1 {
    static constexpr bool HAS_MID = false;
    static constexpr bool PERM = true; const float* X; const float* mod; bf16* R; float esc;
    __device__ __forceinline__ void operator()(const AccT& acc, const pg8::Unit& u, int wr, int wc, int fr, int fq) const {
        f32x4 g[2][2];
#pragma unroll
        for (int bj = 0; bj < 2; ++bj) { const float* gt = mod + ((u.pm * 256) >> 13) * 12288 + 4096 + u.pn * 256 + bj * 128 + wc * 32 + 8 * fq; g[bj][0] = 1.f + *(const f32x4*)gt; g[bj][1] = 1.f + *(const f32x4*)(gt + 4); }
#pragma unroll
        for (int ai = 0; ai < 2; ++ai) {
            f32x4 xv[8][2];
#pragma unroll
            for (int m = 0; m < 4; ++m)
#pragma unroll
                for (int bj = 0; bj < 2; ++bj) { const float* xp = X + (size_t)(u.pm * 256 + ai * 128 + wr * 64 + m * 16 + fr) * DM + u.pn * 256 + bj * 128 + wc * 32 + 8 * fq; xv[m * 2 + bj][0] = *(const f32x4*)xp; xv[m * 2 + bj][1] = *(const f32x4*)(xp + 4); }
            __builtin_amdgcn_sched_barrier(0);
#pragma unroll
            for (int m = 0; m < 4; ++m)
#pragma unroll
                for (int bj = 0; bj < 2; ++bj) { const size_t off = (size_t)(u.pm * 256 + ai * 128 + wr * 64 + m * 16 + fr) * DM + u.pn * 256 + bj * 128 + wc * 32 + 8 * fq;
                    *(u32x4*)(R + off) = pack8(DN_ALPHA * xv[m * 2 + bj][0] + g[bj][0] * (acc[ai][bj][m][0] * esc), DN_ALPHA * xv[m * 2 + bj][1] + g[bj][1] * (acc[ai][bj][m][1] * esc)); }
            __builtin_amdgcn_sched_barrier(0);
        }
    }
};
struct EpiQuery {
    static constexpr bool HAS_MID = false;
    static constexpr bool PERM = true; bf16* O; const float* HS; const float* WS;
    __device__ __forceinline__ void operator()(const AccT& acc, const pg8::Unit& u, int wr, int wc, int fr, int fq) const {
        float hsv[2][4]; f32x4 wsv[2][2];
#pragma unroll
        for (int ai = 0; ai < 2; ++ai)
#pragma unroll
            for (int m = 0; m < 4; ++m) hsv[ai][m] = HS[u.pm * 256 + ai * 128 + wr * 64 + m * 16 + fr];
#pragma unroll
        for (int bj = 0; bj < 2; ++bj) { const int col = u.pn * 256 + bj * 128 + wc * 32 + 8 * fq; wsv[bj][0] = *(const f32x4*)(WS + col); wsv[bj][1] = *(const f32x4*)(WS + col + 4); }
        __builtin_amdgcn_sched_barrier(0);
#pragma unroll
        for (int ai = 0; ai < 2; ++ai)
#pragma unroll
            for (int m = 0; m < 4; ++m) { const int row = u.pm * 256 + ai * 128 + wr * 64 + m * 16 + fr; const float hs = hsv[ai][m];
#pragma unroll
                for (int bj = 0; bj < 2; ++bj) { const int col = u.pn * 256 + bj * 128 + wc * 32 + 8 * fq; const f32x4 w0 = wsv[bj][0] * hs, w1 = wsv[bj][1] * hs;
                    const i32x4 a0 = __builtin_bit_cast(i32x4, acc[ai][bj][m][0]), a1 = __builtin_bit_cast(i32x4, acc[ai][bj][m][1]);
                    const f32x4 v0 = {(float)a0.x * w0.x, (float)a0.y * w0.y, (float)a0.z * w0.z, (float)a0.w * w0.w}, v1 = {(float)a1.x * w1.x, (float)a1.y * w1.y, (float)a1.z * w1.z, (float)a1.w * w1.w};
                    *(u32x4*)(O + (size_t)row * DM + col) = pack8(v0, v1); } }
    }
};
#ifdef PROBE_GEMM
struct EpiNull {
    static constexpr bool HAS_MID = false;
    static constexpr bool PERM = true; float* O;
    __device__ __forceinline__ void operator()(const AccT& acc, const pg8::Unit& u, int wr, int wc, int fr, int fq) const {
        f32x4 s = {0.f, 0.f, 0.f, 0.f};
#pragma unroll
        for (int ai = 0; ai < 2; ++ai)
#pragma unroll
            for (int bj = 0; bj < 2; ++bj)
#pragma unroll
                for (int m = 0; m < 4; ++m) s += acc[ai][bj][m][0] + acc[ai][bj][m][1];
        *(f32x4*)(O + ((size_t)(u.pm * 8 + u.pn) * 512 + (wr * 4 + wc) * 64 + fq * 16 + fr) * 4) = s;
    }
};
#endif
struct EpiPlain {
    static constexpr bool HAS_MID = false;
    static constexpr bool PERM = true; bf16* O; float esc;
    __device__ __forceinline__ void operator()(const AccT& acc, const pg8::Unit& u, int wr, int wc, int fr, int fq) const {
        EPI_ROWS( *(u32x4*)(O + (size_t)row * DM + u.pn * 256 + cl) = pack8(v0, v1); )
    }
};
struct EpiQ {
    static constexpr bool HAS_MID = false;
    static constexpr bool PERM = true; unsigned char* Q; const float* SS; const f32x2* rope; float esc;
    __device__ __forceinline__ void operator()(const AccT& acc, const pg8::Unit& u, int wr, int wc, int fr, int fq) const {
        const bool is_rope = u.pn >= 8;
        float rsv[2][4];
#pragma unroll
        for (int ai = 0; ai < 2; ++ai)
#pragma unroll
            for (int m = 0; m < 4; ++m) rsv[ai][m] = SS[(size_t)(u.pm * 256 + ai * 128 + wr * 64 + m * 16 + fr) * 2];
        __builtin_amdgcn_sched_barrier(0);
#pragma unroll
        for (int ai = 0; ai < 2; ++ai) {
            f32x4 cv[8][2];
            if (is_rope) {
#pragma unroll
                for (int m = 0; m < 4; ++m)
#pragma unroll
                    for (int bj = 0; bj < 2; ++bj) { const int row = u.pm * 256 + ai * 128 + wr * 64 + m * 16 + fr, jj = ((u.pn - 8) * 256 + bj * 128 + wc * 32 + 8 * fq) & 63;
                        const f32x4* cs = (const f32x4*)(rope + (size_t)row * 32 + (jj >> 1)); cv[m * 2 + bj][0] = cs[0]; cv[m * 2 + bj][1] = cs[1]; } }
            __builtin_amdgcn_sched_barrier(0);
#pragma unroll
            for (int m = 0; m < 4; ++m)
#pragma unroll
                for (int bj = 0; bj < 2; ++bj) { const int row = u.pm * 256 + ai * 128 + wr * 64 + m * 16 + fr, cl = bj * 128 + wc * 32 + 8 * fq; const int b = row >> 13, s = row & 8191;
                    const float rs = rsv[ai][m] * (QSCALE * SC_Q); const f32x4 v0 = acc[ai][bj][m][0] * esc, v1 = acc[ai][bj][m][1] * esc;
                    if (!is_rope) { const int cg = u.pn * 256 + cl, h = cg >> 7, d = cg & 127;
                        *(u32x2*)(Q + (unsigned)(((b * NH + h) * SEQ + s) * DQK + d)) = (u32x2){pk4_f8(v0.x * rs, v0.y * rs, v0.z * rs, v0.w * rs), pk4_f8(v1.x * rs, v1.y * rs, v1.z * rs, v1.w * rs)};
                    } else { const int cg = (u.pn - 8) * 256 + cl, h = cg >> 6, jj = cg & 63; const f32x4 c0 = cv[m * 2 + bj][0], c1 = cv[m * 2 + bj][1];
                        *(u32x2*)(Q + (unsigned)(((b * NH + h) * SEQ + s) * DQK + 128 + jj)) = (u32x2){
                            pk4_f8((v0.x * c0.x - v0.y * c0.y) * rs, (v0.y * c0.x + v0.x * c0.y) * rs, (v0.z * c0.z - v0.w * c0.w) * rs, (v0.w * c0.z + v0.z * c0.w) * rs),
                            pk4_f8((v1.x * c1.x - v1.y * c1.y) * rs, (v1.y * c1.x + v1.x * c1.y) * rs, (v1.z * c1.z - v1.w * c1.w) * rs, (v1.w * c1.z + v1.z * c1.w) * rs)}; } }
            __builtin_amdgcn_sched_barrier(0);
        }
    }
};
struct EpiK {
    static constexpr bool HAS_MID = false;
    static constexpr bool PERM = true; unsigned char* K; const float* SS; float esc;
    __device__ __forceinline__ void operator()(const AccT& acc, const pg8::Unit& u, int wr, int wc, int fr, int fq) const {
        float rsv[2][4];
#pragma unroll
        for (int ai = 0; ai < 2; ++ai)
#pragma unroll
            for (int m = 0; m < 4; ++m) rsv[ai][m] = SS[(size_t)(u.pm * 256 + ai * 128 + wr * 64 + m * 16 + fr) * 2 + 1];
        __builtin_amdgcn_sched_barrier(0);
        EPI_ROWS( const float rs = rsv[ai][m] * SC_K; const int b = row >> 13, s = row & 8191;
            const int cg = u.pn * 256 + cl, h = cg >> 7, d = cg & 127;
            *(u32x2*)(K + (unsigned)(((b * NH + h) * SEQ + s) * DQK + d)) = (u32x2){pk4_f8(v0.x * rs, v0.y * rs, v0.z * rs, v0.w * rs), pk4_f8(v1.x * rs, v1.y * rs, v1.z * rs, v1.w * rs)}; )
    }
};
struct EpiVT {
    static constexpr bool HAS_MID = false;
    static constexpr bool PERM = true; unsigned char* VT; const float* SS; float esc;
    __device__ __forceinline__ void operator()(const AccT& acc, const pg8::Unit& u, int wr, int wc, int fr, int fq) const {
#pragma unroll
        for (int bj = 0; bj < 2; ++bj) {
            const int cl = bj * 128 + wc * 32 + 8 * fq; const int t0 = u.pn * 256 + cl, b = t0 >> 13, s = t0 & 8191; const f32x4* sp = (const f32x4*)(SS + (size_t)t0 * 2);
            const f32x4 s0 = sp[0] * SC_V, s1 = sp[1] * SC_V, s2 = sp[2] * SC_V, s3 = sp[3] * SC_V;
            __builtin_amdgcn_sched_barrier(0);
#pragma unroll
            for (int ai = 0; ai < 2; ++ai)
#pragma unroll
                for (int m = 0; m < 4; ++m) { const int row = u.pm * 256 + ai * 128 + wr * 64 + m * 16 + fr, h = row >> 7, d = row & 127; const f32x4 v0 = acc[ai][bj][m][0] * esc, v1 = acc[ai][bj][m][1] * esc;
                    *(u32x2*)(VT + (unsigned)(((((b * NH + h) * 128 + (s >> 6)) * 128 + d) * 64 + (s & 63)))) = (u32x2){pk4_f8(v0.x * s0.y, v0.y * s0.w, v0.z * s1.y, v0.w * s1.w), pk4_f8(v1.x * s2.y, v1.y * s2.w, v1.z * s3.y, v1.w * s3.w)}; }
            __builtin_amdgcn_sched_barrier(0);
        }
    }
};

constexpr int RG_W = 288;
constexpr int RG_SUB = 64;
constexpr int RG_XC = 0, RG_GGT = 36864, RG_OUT = 69632;
__device__ __forceinline__ unsigned char* rg_ab(unsigned char* ws, int tile) { return tile < 1536 ? ws + WS_TMP + (size_t)tile * 131072 : ws + WS_AO8 + (size_t)(tile - 1536) * 131072; }
__device__ __forceinline__ float rg_h_lo(unsigned w) { return (float)__builtin_bit_cast(_Float16, (unsigned short)(w & 0xffffu)); }
__device__ __forceinline__ float rg_h_hi(unsigned w) { return (float)__builtin_bit_cast(_Float16, (unsigned short)(w >> 16)); }
struct RgMap { float A, H; };
__device__ __forceinline__ RgMap rg_then(const RgMap f, const RgMap g) { return RgMap{f.A * g.A, g.A * f.H + g.H}; }
__device__ __forceinline__ void rglru_passA(Frame& F) {
    const int tid = F.tid, lane = F.lane, wave = F.wave;
    {
        const float* ssp = WSP(float, WS_SSP); float* rs = WSP(float, WS_RS);
        for (int i = F.blk * NTHREADS + tid; i < NT * 2; i += F.G * NTHREADS) { const f32x4* p = (const f32x4*)(ssp + (size_t)i * 32); float s = 0.f;
#pragma unroll
            for (int k = 0; k < 8; ++k) { const f32x4 a = p[k]; s += (a.x + a.y) + (a.z + a.w); }
            rs[i] = __builtin_amdgcn_rsqf(s * (1.f / 512.f) + RMS_EPS); } }
    LAS unsigned char* L = F.lds;
    const bf16* XR = WSP(bf16, WS_XR); float* SUMM = WSP(float, WS_SUMM);
    const int q = lane >> 4;
    for (int tile = F.blk; tile < NB * 32 * NH; tile += F.G) {
        const int hh = tile & 15, c = (tile >> 4) & 31, b = tile >> 9;
        const int ech = 16 * wave + (lane & 15), egch = hh * 128 + ech;
        bf16x8 bA[4], bX[4];
        { const bf16* ga = WSP(bf16, WS_WGA) + hh * 16384 + ech * 128 + 8 * (lane >> 4); const bf16* gx = WSP(bf16, WS_WGX) + hh * 16384 + ech * 128 + 8 * (lane >> 4);
#pragma unroll
            for (int ks = 0; ks < 4; ++ks) { bA[ks] = *(const bf16x8*)(ga + 32 * ks); bX[ks] = *(const bf16x8*)(gx + 32 * ks); } }
        const float e_ba = F.b_rg_a[egch], e_bx = F.b_rg_x[egch];
        const float lam = F.rg_lambda[egch]; const float e_sp8 = -8.0f * 1.4426950408889634f * ((lam > 15.f) ? expf(-lam) : (lam < -15.f ? -lam : log1pf(expf(-lam))));
        const int crow = tid >> 4, c8 = (tid & 15) * 8, cg = hh * 128 + c8;
        float cw[4][8], cb[8];
#pragma unroll
        for (int w = 0; w < 4; ++w) { const f32x4 p = *(const f32x4*)(F.conv_w + w * DM + cg), qq = *(const f32x4*)(F.conv_w + w * DM + cg + 4);
            cw[w][0] = p.x; cw[w][1] = p.y; cw[w][2] = p.z; cw[w][3] = p.w; cw[w][4] = qq.x; cw[w][5] = qq.y; cw[w][6] = qq.z; cw[w][7] = qq.w; }
        { const f32x4 p = *(const f32x4*)(F.conv_b + cg), qq = *(const f32x4*)(F.conv_b + cg + 4); cb[0] = p.x; cb[1] = p.y; cb[2] = p.z; cb[3] = p.w; cb[4] = qq.x; cb[5] = qq.y; cb[6] = qq.z; cb[7] = qq.w; }
        float S = 0.f, atot = 1.f;
        u32x4* abw = (u32x4*)rg_ab(F.ws, tile) + (wave * 64 + lane) * 4;
        const size_t tbase = (size_t)b * SEQ + c * 256;
        u32x4 xn[2][4];
#pragma unroll
        for (int hf = 0; hf < 2; ++hf)
#pragma unroll
            for (int w = 0; w < 4; ++w) { const int rr = crow + 32 * hf - 3 + w; xn[hf][w] = (u32x4){0u, 0u, 0u, 0u}; if (c * 256 + rr >= 0) xn[hf][w] = *(const u32x4*)(XR + (tbase + rr) * DM + cg); }
#pragma unroll 1
        for (int sub = 0; sub < 256 / RG_SUB; ++sub) {
            const size_t t0 = tbase + sub * RG_SUB;
            LAS unsigned char* XC = L + RG_XC + (sub & 1) * 18432;
#pragma unroll
            for (int hf = 0; hf < 2; ++hf) { float a[8];
#pragma unroll
                for (int e = 0; e < 8; ++e) a[e] = cb[e];
#pragma unroll
                for (int w = 0; w < 4; ++w) { const u32x4 xv = xn[hf][w];
                    a[0] += cw[w][0] * bflo(xv.x); a[1] += cw[w][1] * bfhi(xv.x); a[2] += cw[w][2] * bflo(xv.y); a[3] += cw[w][3] * bfhi(xv.y);
                    a[4] += cw[w][4] * bflo(xv.z); a[5] += cw[w][5] * bfhi(xv.z); a[6] += cw[w][6] * bflo(xv.w); a[7] += cw[w][7] * bfhi(xv.w); }
                *(LAS u32x4*)(XC + (crow + 32 * hf) * RG_W + c8 * 2) = (u32x4){pk2(a[0], a[1]), pk2(a[2], a[3]), pk2(a[4], a[5]), pk2(a[6], a[7])}; }
            __syncthreads();
            if (sub + 1 < 256 / RG_SUB) {
#pragma unroll
                for (int hf = 0; hf < 2; ++hf)
#pragma unroll
                    for (int w = 0; w < 4; ++w) xn[hf][w] = *(const u32x4*)(XR + (t0 + RG_SUB + crow + 32 * hf - 3 + w) * DM + cg); }
            f32x4 accA[4], accX[4];
#pragma unroll
            for (int rb = 0; rb < 4; ++rb) { accA[rb] = (f32x4){0, 0, 0, 0}; accX[rb] = (f32x4){0, 0, 0, 0}; }
#pragma unroll
            for (int ks = 0; ks < 4; ++ks) { const int ko = (ks * 32 + 8 * (lane >> 4)) * 2;
#pragma unroll
                for (int rb = 0; rb < 4; ++rb) { const bf16x8 af = *(const LAS bf16x8*)(XC + (rb * 16 + (lane & 15)) * RG_W + ko);
                    accA[rb] = __builtin_amdgcn_mfma_f32_16x16x32_bf16(af, bA[ks], accA[rb], 0, 0, 0);
                    accX[rb] = __builtin_amdgcn_mfma_f32_16x16x32_bf16(af, bX[ks], accX[rb], 0, 0, 0); } }
#pragma unroll
            for (int rb = 0; rb < 4; ++rb) {
                RgMap G{1.f, 0.f}; u32x4 pw = {0u, 0u, 0u, 0u};
#pragma unroll
                for (int r = 0; r < 4; ++r) { const int trow = rb * 16 + 4 * q + r;
                    const float xcv = bf1(*(const LAS bf16*)(XC + trow * RG_W + ech * 2));
                    const float rr = sigmoidf_(accA[rb][r] + e_ba), ii = sigmoidf_(accX[rb][r] + e_bx);
                    const float l2 = rr * e_sp8;
                    const float a_ = __builtin_amdgcn_exp2f(l2);
                    const float x2 = l2 * (2.0f * 0.6931471805599453f);
                    const float ser = -x2 * (1.0f + x2 * (0.5f + x2 * (0.16666667f + x2 * (0.041666668f + x2 * 0.008333334f))));
                    const float om = (x2 > -0.25f) ? ser : (1.0f - a_ * a_);
                    const float b_ = __builtin_amdgcn_sqrtf(om) * ii * xcv;
                    pw[r] = __builtin_bit_cast(unsigned, __builtin_amdgcn_cvt_pkrtz(l2, b_));
                    G.H = a_ * G.H + b_; G.A *= a_; }
                abw[sub * 2048 + rb] = pw;
                const RgMap P{__shfl_xor(G.A, 16), __shfl_xor(G.H, 16)};
                const RgMap pr = (q & 1) ? rg_then(P, G) : rg_then(G, P);
                const RgMap Q{__shfl_xor(pr.A, 32), __shfl_xor(pr.H, 32)};
                const RgMap T = (q & 2) ? rg_then(Q, pr) : rg_then(pr, Q);
                S = T.A * S + T.H; atot *= T.A;
            }
        }
        if (q == 0) *(f32x2*)(SUMM + ((size_t)(b * 32 + c) * DM + egch) * 2) = (f32x2){atot, S};
    }
    __syncthreads();
}
__device__ __forceinline__ void rglru_passB(Frame& F) {
    const int tid = F.tid, lane = F.lane, wave = F.wave;
    LAS unsigned char* L = F.lds;
    const bf16* GG = WSP(bf16, WS_GG); unsigned char* RA = WSP(unsigned char, WS_S0); const float* SUMM = WSP(float, WS_SUMM);
    const int q = lane >> 4;
    for (int tile = F.blk; tile < NB * 32 * NH; tile += F.G) {
        const int hh = tile & 15, c = (tile >> 4) & 31, b = tile >> 9;
        const int ech = 16 * wave + (lane & 15), egch = hh * 128 + ech;
        const int crow = tid >> 4, c8 = (tid & 15) * 8, cg = hh * 128 + c8;
        const size_t tbase = (size_t)b * SEQ + c * 256;
        const u32x4* abr = (const u32x4*)rg_ab(F.ws, tile) + (wave * 64 + lane) * 4;
        u32x4 gn[2], ab[4];
        gn[0] = *(const u32x4*)(GG + (tbase + crow) * DM + cg); gn[1] = *(const u32x4*)(GG + (tbase + crow + 32) * DM + cg);
#pragma unroll
        for (int rb = 0; rb < 4; ++rb) ab[rb] = abr[rb];
        float S;
        { f32x2 sv[8];
#pragma unroll
            for (int k = 0; k < 8; ++k) { const int cc = 8 * q + k; sv[k] = (f32x2){1.f, 0.f}; if (cc < c) sv[k] = *(const f32x2*)(SUMM + ((size_t)(b * 32 + cc) * DM + egch) * 2); }
            RgMap M{1.f, 0.f};
#pragma unroll
            for (int k = 0; k < 8; ++k) M = rg_then(M, RgMap{sv[k].x, sv[k].y});
            const RgMap P{__shfl_xor(M.A, 16), __shfl_xor(M.H, 16)}; const RgMap pr = (q & 1) ? rg_then(P, M) : rg_then(M, P);
            const RgMap Q{__shfl_xor(pr.A, 32), __shfl_xor(pr.H, 32)}; const RgMap T = (q & 2) ? rg_then(Q, pr) : rg_then(pr, Q);
            S = T.H; }
#pragma unroll 1
        for (int sub = 0; sub < 256 / RG_SUB; ++sub) {
            const size_t t0 = tbase + sub * RG_SUB;
            LAS unsigned char* GT = L + RG_GGT + (sub & 1) * 16384; LAS unsigned char* OT = L + RG_OUT + (sub & 1) * 8192;
            *(LAS u32x4*)(GT + crow * 256 + c8 * 2) = gn[0]; *(LAS u32x4*)(GT + (crow + 32) * 256 + c8 * 2) = gn[1];
            u32x4 abc[4];
#pragma unroll
            for (int rb = 0; rb < 4; ++rb) abc[rb] = ab[rb];
            __syncthreads();
            if (sub + 1 < 256 / RG_SUB) {
                gn[0] = *(const u32x4*)(GG + (t0 + RG_SUB + crow) * DM + cg); gn[1] = *(const u32x4*)(GG + (t0 + RG_SUB + crow + 32) * DM + cg);
#pragma unroll
                for (int rb = 0; rb < 4; ++rb) ab[rb] = abr[(sub + 1) * 2048 + rb]; }
#pragma unroll
            for (int rb = 0; rb < 4; ++rb) {
                float av[4], bv[4];
#pragma unroll
                for (int r = 0; r < 4; ++r) { const unsigned pk = abc[rb][r]; av[r] = __builtin_amdgcn_exp2f(rg_h_lo(pk)); bv[r] = rg_h_hi(pk); }
                RgMap G{1.f, 0.f};
#pragma unroll
                for (int r = 0; r < 4; ++r) { G.H = av[r] * G.H + bv[r]; G.A *= av[r]; }
                const RgMap P{__shfl_xor(G.A, 16), __shfl_xor(G.H, 16)};
                const RgMap pr = (q & 1) ? rg_then(P, G) : rg_then(G, P);
                const RgMap Q{__shfl_xor(pr.A, 32), __shfl_xor(pr.H, 32)};
                const RgMap T = (q & 2) ? rg_then(Q, pr) : rg_then(pr, Q);
                RgMap E{1.f, 0.f}; if (q & 2) E = Q; if (q & 1) E = rg_then(E, P);
                float h = E.A * S + E.H; float y[4];
#pragma unroll
                for (int r = 0; r < 4; ++r) { const int trow = rb * 16 + 4 * q + r; h = av[r] * h + bv[r]; y[r] = h * bf1(*(const LAS bf16*)(GT + trow * 256 + ech * 2)) * SC_RA; }
                const unsigned w = pk4_f8(y[0], y[1], y[2], y[3]); const int tr0 = rb * 16 + 4 * q;
                OT[tr0 * 128 + ech] = (unsigned char)w; OT[(tr0 + 1) * 128 + ech] = (unsigned char)(w >> 8); OT[(tr0 + 2) * 128 + ech] = (unsigned char)(w >> 16); OT[(tr0 + 3) * 128 + ech] = (unsigned char)(w >> 24);
                S = T.A * S + T.H;
            }
            __syncthreads();
            { const int r = tid >> 3, cq = (tid & 7) * 16; *(u32x4*)(RA + (t0 + r) * DM + hh * 128 + cq) = *(const LAS u32x4*)(OT + r * 128 + cq); }
        }
    }
    __syncthreads();
}

__device__ __forceinline__ void krope_fill(Frame& F) {
    const int fl = fresh_lane(); const int gw = F.blk * NWAVES + F.wave, NGW = F.G * NWAVES, j4 = (fl & 7) * 4, tsub = fl >> 3;
    const float* KR = WSP(float, WS_KR); const f32x2* rope = WSP(f32x2, WS_ROPE); unsigned char* K = (unsigned char*)F.out + OUT_K;
    for (int tp = gw; tp < NT / 8; tp += NGW) { const int t = 8 * tp + tsub, b = t >> 13, s = t & 8191;
        const f32x4 x1 = *(const f32x4*)(KR + (size_t)t * 64 + j4), x2 = *(const f32x4*)(KR + (size_t)t * 64 + 32 + j4);
        const f32x4 c01 = *(const f32x4*)(rope + (size_t)t * 32 + j4), c23 = *(const f32x4*)(rope + (size_t)t * 32 + j4 + 2);
        const u32x2 w = {pk4_f8((x1.x * c01.x - x2.x * c01.y) * SC_K, (x2.x * c01.x + x1.x * c01.y) * SC_K, (x1.y * c01.z - x2.y * c01.w) * SC_K, (x2.y * c01.z + x1.y * c01.w) * SC_K),
                         pk4_f8((x1.z * c23.x - x2.z * c23.y) * SC_K, (x2.z * c23.x + x1.z * c23.y) * SC_K, (x1.w * c23.z - x2.w * c23.w) * SC_K, (x2.w * c23.z + x1.w * c23.w) * SC_K)};
#pragma unroll
        for (int h = 0; h < NH; ++h) *(u32x2*)(K + ((size_t)(b * NH + h) * SEQ + s) * DQK + 128 + 2 * j4) = w; }
}

constexpr int AT_KB = 12288, AT_VB = 8192, AT_BUF = AT_KB + AT_VB;
#define AT_LD8(p0_, p1_) __builtin_shufflevector(*(const LAS i32x4*)(p0_), *(const LAS i32x4*)(p1_), 0, 1, 2, 3, 4, 5, 6, 7)
constexpr int AT_SLOT = AT_KB + AT_VB, AT_NSLOT = 5;
struct AttnState { f32x16 o[4], p0, p1; f32x4 osum; i32x8 pb; float m_run; };
#define AT_MFMA(A_, B_, C_) __builtin_amdgcn_mfma_scale_f32_32x32x64_f8f6f4(A_, B_, C_, 0, 0, 0, 0x7F7F7F7F, 0, 0x7F7F7F7F)
#define AT_PIN() __builtin_amdgcn_sched_barrier(0)
template <bool FAST>
__device__ __forceinline__ void attn_iter(AttnState& S, const i32x8 (&qf)[3], const LAS unsigned char* Vprev, const LAS unsigned char* Knext, int xo0, int xo1, int r32, int hi,
                                          bool act_prev, bool act_cur, bool act_next, bool need_mask, int dq) {
    constexpr float CS = 1.0f / (SC_Q * SC_K), LSP = 6.0f;
    const f32x16 z16 = {0.f, 0.f, 0.f, 0.f, 0.f, 0.f, 0.f, 0.f, 0.f, 0.f, 0.f, 0.f, 0.f, 0.f, 0.f, 0.f};
    const int sel = (((r32 & 15) >> 2) & 1) == ((hi * 2 + (r32 >> 4)) & 1) ? 0x38383838 : 0;
    const i32x8 ones8 = {sel, sel, sel, sel, sel, sel, sel, sel};
#define AT_ROWSUM(PB_, ACC_) __builtin_amdgcn_mfma_scale_f32_16x16x128_f8f6f4(ones8, PB_, ACC_, 0, 0, 0, 0x7F7F7F7F, 0, 0x7F7F7F7F)
    float pmax = -__builtin_inff();
    if (FAST) {
        const LAS unsigned char* vb = Vprev + r32 * 64;
        const i32x8 v0 = AT_LD8(vb + xo0, vb + xo1), v1 = AT_LD8(vb + 2048 + xo0, vb + 2048 + xo1);
        S.osum = AT_ROWSUM(S.pb, S.osum);
        AT_PIN(); pmax = fmaxf(fmaxf(S.p0[0], S.p0[1]), fmaxf(S.p0[2], S.p0[3])); pmax = fmaxf(pmax, fmaxf(fmaxf(S.p0[4], S.p0[5]), fmaxf(S.p0[6], S.p0[7]))); AT_PIN();
        S.o[0] = AT_MFMA(v0, S.pb, S.o[0]);
        const i32x8 v2 = AT_LD8(vb + 4096 + xo0, vb + 4096 + xo1);
        AT_PIN(); pmax = fmaxf(pmax, fmaxf(fmaxf(S.p0[8], S.p0[9]), fmaxf(S.p0[10], S.p0[11]))); pmax = fmaxf(pmax, fmaxf(fmaxf(S.p0[12], S.p0[13]), fmaxf(S.p0[14], S.p0[15]))); AT_PIN();
        S.o[1] = AT_MFMA(v1, S.pb, S.o[1]);
        const i32x8 v3 = AT_LD8(vb + 6144 + xo0, vb + 6144 + xo1);
        AT_PIN(); pmax = fmaxf(pmax, fmaxf(fmaxf(S.p1[0], S.p1[1]), fmaxf(S.p1[2], S.p1[3]))); pmax = fmaxf(pmax, fmaxf(fmaxf(S.p1[4], S.p1[5]), fmaxf(S.p1[6], S.p1[7]))); AT_PIN();
        S.o[2] = AT_MFMA(v2, S.pb, S.o[2]);
        AT_PIN(); pmax = fmaxf(pmax, fmaxf(fmaxf(S.p1[8], S.p1[9]), fmaxf(S.p1[10], S.p1[11]))); pmax = fmaxf(pmax, fmaxf(fmaxf(S.p1[12], S.p1[13]), fmaxf(S.p1[14], S.p1[15]))); AT_PIN();
        S.o[3] = AT_MFMA(v3, S.pb, S.o[3]);
    } else if (act_prev) {
        const LAS unsigned char* vb = Vprev + r32 * 64;
        S.osum = AT_ROWSUM(S.pb, S.osum);
#pragma unroll
        for (int d = 0; d < 4; ++d) { const i32x8 vf = AT_LD8(vb + d * 2048 + xo0, vb + d * 2048 + xo1); S.o[d] = AT_MFMA(vf, S.pb, S.o[d]); AT_PIN(); }
    }
    if (!FAST) {
        if (act_cur) {
            if (need_mask) { const float NEG = -__builtin_inff();
#pragma unroll
                for (int r = 0; r < 16; ++r) { const int cr = (r & 3) + 8 * (r >> 2); if (cr > dq) S.p0[r] = NEG; if (cr + 32 > dq) S.p1[r] = NEG; } }
#pragma unroll
            for (int r = 0; r < 16; ++r) pmax = fmaxf(pmax, fmaxf(S.p0[r], S.p1[r]));
        }
    }
    float alpha = 1.f; bool resc = false; f32x16 n0 = z16, n1 = z16;
    if (FAST || act_cur) {
        { auto rr = __builtin_amdgcn_permlane32_swap(__float_as_uint(pmax), __float_as_uint(pmax), false, false); pmax = fmaxf(__uint_as_float(rr[0]), __uint_as_float(rr[1])) * CS; }
        resc = !__all(pmax - S.m_run <= 2.0f);
        const float mn = resc ? fmaxf(S.m_run, pmax) : S.m_run; alpha = __builtin_amdgcn_exp2f(S.m_run - mn); S.m_run = mn;
    }
    const float moff = LSP - S.m_run;
    const LAS unsigned char* kb = Knext + r32 * 192;
    if (FAST) {
        i32x8 ka = AT_LD8(kb + xo0, kb + xo1), kc = AT_LD8(kb + 32 * 192 + xo0, kb + 32 * 192 + xo1);
#pragma unroll
        for (int ks = 0; ks < 3; ++ks) {
            n0 = AT_MFMA(ka, qf[ks], ks == 0 ? z16 : n0); n1 = AT_MFMA(kc, qf[ks], ks == 0 ? z16 : n1);
            if (ks < 2) { ka = AT_LD8(kb + (ks + 1) * 64 + xo0, kb + (ks + 1) * 64 + xo1); kc = AT_LD8(kb + 32 * 192 + (ks + 1) * 64 + xo0, kb + 32 * 192 + (ks + 1) * 64 + xo1); }
            AT_PIN();
#pragma unroll
            for (int r = (ks * 16) / 3; r < ((ks + 1) * 16) / 3; ++r) { S.p0[r] = __builtin_amdgcn_exp2f(__builtin_fmaf(S.p0[r], CS, moff)); S.p1[r] = __builtin_amdgcn_exp2f(__builtin_fmaf(S.p1[r], CS, moff)); }
            AT_PIN();
        }
    } else {
        if (act_next) {
#pragma unroll
            for (int ks = 0; ks < 3; ++ks) { const i32x8 ka = AT_LD8(kb + ks * 64 + xo0, kb + ks * 64 + xo1), kc = AT_LD8(kb + 32 * 192 + ks * 64 + xo0, kb + 32 * 192 + ks * 64 + xo1);
                n0 = AT_MFMA(ka, qf[ks], ks == 0 ? z16 : n0); n1 = AT_MFMA(kc, qf[ks], ks == 0 ? z16 : n1); } }
        if (act_cur) {
#pragma unroll
            for (int r = 0; r < 16; ++r) { S.p0[r] = __builtin_amdgcn_exp2f(__builtin_fmaf(S.p0[r], CS, moff)); S.p1[r] = __builtin_amdgcn_exp2f(__builtin_fmaf(S.p1[r], CS, moff)); } }
    }
    if (FAST || act_cur) {
#pragma unroll
        for (int jj = 0; jj < 4; ++jj) { int a = __builtin_amdgcn_cvt_pk_fp8_f32(S.p0[4 * jj], S.p0[4 * jj + 1], 0, false); a = __builtin_amdgcn_cvt_pk_fp8_f32(S.p0[4 * jj + 2], S.p0[4 * jj + 3], a, true);
            int bq = __builtin_amdgcn_cvt_pk_fp8_f32(S.p1[4 * jj], S.p1[4 * jj + 1], 0, false); bq = __builtin_amdgcn_cvt_pk_fp8_f32(S.p1[4 * jj + 2], S.p1[4 * jj + 3], bq, true);
            auto rr = __builtin_amdgcn_permlane32_swap((unsigned)a, (unsigned)bq, false, false); S.pb[2 * jj] = (int)rr[0]; S.pb[2 * jj + 1] = (int)rr[1]; }
        if (resc) {
#pragma unroll
            for (int d = 0; d < 4; ++d)
#pragma unroll
                for (int r = 0; r < 16; ++r) S.o[d][r] *= alpha;
            S.osum = S.osum * alpha;
        }
    }
    S.p0 = n0; S.p1 = n1;
#undef AT_ROWSUM
}
__device__ __forceinline__ void attn_block(Frame& F, int bh, int qb, const unsigned char* Q, const unsigned char* Kg, const unsigned char* VTg, unsigned char* AO) {
    const int lane = F.lane, wave = F.wave, r32 = lane & 31, hi = lane >> 5;
    LAS unsigned char* L = F.lds; const unsigned ldsbase = (unsigned)(size_t)L;
    const int q0 = qb * 256, qrow = q0 + 32 * wave + r32, ntiles = 4 * (qb + 1);
    unsigned kv0, kv1, vv;
    { const int q = wave * 64 + lane, row = q / 12, pos = q % 12, c = (pos & ~3) | ((pos ^ (row >> 2)) & 3); kv0 = (unsigned)((row * 12 + c) * 16); }
    { const int q = (wave + 8) * 64 + lane, row = q / 12, pos = q % 12, c = (pos & ~3) | ((pos ^ (row >> 2)) & 3); kv1 = (unsigned)((row * 12 + c) * 16); }
    { const int q = wave * 64 + lane, row = q >> 2, pos = q & 3, c = pos ^ ((row >> 2) & 3); vv = (unsigned)((row * 4 + c) * 16); }
    const bool k2 = wave < 4;
    const char* kgb = (const char*)Kg + (size_t)bh * SEQ * DQK; const char* vgb = (const char*)VTg + (size_t)bh * SEQ * DV;
#define AT_ISSUE(tile, slot) do { const int _t = (tile) < ntiles ? (tile) : ntiles - 1; const unsigned _s = ldsbase + (slot) * AT_SLOT; \
        glds16(kgb + (size_t)_t * AT_KB, kv0, _s + wave * 1024); if (k2) glds16(kgb + (size_t)_t * AT_KB, kv1, _s + (wave + 8) * 1024); \
        glds16(vgb + (size_t)_t * AT_VB, vv, _s + AT_KB + wave * 1024); } while (0)
    AT_ISSUE(0, 0); AT_ISSUE(1, 1); AT_ISSUE(2, 2);
    i32x8 qf[3];
    { const unsigned char* qp = Q + ((size_t)bh * SEQ + qrow) * DQK + 32 * hi;
#pragma unroll
        for (int ks = 0; ks < 3; ++ks) { const i32x4 lo = *(const i32x4*)(qp + 64 * ks), hh = *(const i32x4*)(qp + 64 * ks + 16); qf[ks] = __builtin_shufflevector(lo, hh, 0, 1, 2, 3, 4, 5, 6, 7); } }
    asm volatile("s_waitcnt vmcnt(0)" ::: "memory");
    const f32x16 z16 = {0.f, 0.f, 0.f, 0.f, 0.f, 0.f, 0.f, 0.f, 0.f, 0.f, 0.f, 0.f, 0.f, 0.f, 0.f, 0.f};
    AttnState S; S.o[0] = z16; S.o[1] = z16; S.o[2] = z16; S.o[3] = z16; S.osum = (f32x4){0.f, 0.f, 0.f, 0.f}; S.p0 = z16; S.p1 = z16; S.m_run = -1e30f;
    S.pb = (i32x8){0, 0, 0, 0, 0, 0, 0, 0};
    const int swz = (r32 >> 2) & 3; const int xo0 = (((2 * hi) ^ swz) << 4), xo1 = (((2 * hi + 1) ^ swz) << 4);
    const int wfirst = q0 + 32 * wave, wlast = wfirst + 31;
    __syncthreads();
    { const LAS unsigned char* kb = L + r32 * 192;
#pragma unroll
        for (int ks = 0; ks < 3; ++ks) { const i32x8 ka = AT_LD8(kb + ks * 64 + xo0, kb + ks * 64 + xo1), kc = AT_LD8(kb + 32 * 192 + ks * 64 + xo0, kb + 32 * 192 + ks * 64 + xo1);
            S.p0 = AT_MFMA(ka, qf[ks], ks == 0 ? z16 : S.p0); S.p1 = AT_MFMA(kc, qf[ks], ks == 0 ? z16 : S.p1); } }
    const int nfast = 4 * qb;
#define AT_HEAD(j) if (k2) asm volatile("s_waitcnt vmcnt(3)" ::: "memory"); else asm volatile("s_waitcnt vmcnt(2)" ::: "memory"); \
        __syncthreads(); AT_ISSUE((j) + 3, ((j) + 3) % 5); \
        const LAS unsigned char* Vprev = L + (((j) + 4) % 5) * AT_SLOT + AT_KB; const LAS unsigned char* Knext = L + (((j) + 1) % 5) * AT_SLOT;
#define AT_SLOW(j) { const bool ap = (j) >= 1 && 64 * ((j) - 1) <= wlast, ac = (j) < ntiles && 64 * (j) <= wlast, an = (j) + 1 < ntiles && 64 * ((j) + 1) <= wlast; \
        attn_iter<false>(S, qf, Vprev, Knext, xo0, xo1, r32, hi, ap, ac, an, 64 * (j) + 63 > wfirst, qrow - 64 * (j) - 4 * hi); }
    int j = 0;
    { AT_HEAD(0); AT_SLOW(0); j = 1; }
#pragma unroll 1
    for (; j + 1 < nfast; ++j) { AT_HEAD(j); attn_iter<true>(S, qf, Vprev, Knext, xo0, xo1, r32, hi, true, true, true, false, 0); }
#pragma unroll 1
    for (; j <= ntiles; ++j) { AT_HEAD(j); AT_SLOW(j); }
#undef AT_HEAD
#undef AT_SLOW
#undef AT_ISSUE
    { int l2; asm volatile("v_mbcnt_lo_u32_b32 %0, -1, 0\n\tv_mbcnt_hi_u32_b32 %0, -1, %0" : "=v"(l2));
      const float inv = SC_AO / (SC_V * S.osum[0]); unsigned char* op = AO + ((size_t)(bh >> 4) * SEQ + qb * 256 + 32 * wave + (l2 & 31)) * DM + (bh & 15) * 128 + 4 * (l2 >> 5);
#pragma unroll
        for (int d = 0; d < 4; ++d)
#pragma unroll
            for (int g = 0; g < 4; ++g) *(unsigned*)(op + 32 * d + 8 * g) = pk4_f8(S.o[d][4 * g] * inv, S.o[d][4 * g + 1] * inv, S.o[d][4 * g + 2] * inv, S.o[d][4 * g + 3] * inv); }
    asm volatile("s_waitcnt vmcnt(0)" ::: "memory");
    __syncthreads();
}
#undef AT_MFMA
#undef AT_PIN
__device__ __forceinline__ void attn_phase(Frame& F) {
    const unsigned char* Q = (const unsigned char*)F.out + OUT_Q; const unsigned char* Kg = (const unsigned char*)F.out + OUT_K; const unsigned char* VTg = (const unsigned char*)F.out + OUT_VT; unsigned char* AO = WSP(unsigned char, WS_AO8);
    for (int it = F.blk; it < 1024; it += F.G) {
        const int r = it / F.G;
        int bh, y;
        if (F.G == 256) { const int x = F.blk & 7, loc = F.blk >> 3; bh = x * 8 + r * 2 + (loc >> 4); y = loc & 15; }
        else { bh = it >> 4; y = it & 15; }
        attn_block(F, bh, 31 - y, Q, Kg, VTg, AO);
        attn_block(F, bh, y, Q, Kg, VTg, AO);
    }
}

__device__ __forceinline__ void ln1_phase(Frame& F) {
    const int gw = F.blk * NWAVES + F.wave, NGW = F.G * NWAVES, lane = fresh_lane();
    bf16* R1 = WSP(bf16, WS_R1); unsigned char* H2I = WSP(unsigned char, WS_H2I); float* HSC = WSP(float, WS_HSC); const float* mod = WSP(float, WS_MOD);
    for (int m = gw; m < NT; m += NGW) {
        u32x4* rp = (u32x4*)(R1 + (size_t)m * DM) + lane; f32x4 v[8]; float s = 0.f;
#pragma unroll
        for (int j = 0; j < 4; ++j) { const u32x4 w = rp[64 * j]; v[2 * j] = (f32x4){bflo(w.x), bfhi(w.x), bflo(w.y), bfhi(w.y)}; v[2 * j + 1] = (f32x4){bflo(w.z), bfhi(w.z), bflo(w.w), bfhi(w.w)};
            s += ((v[2 * j].x + v[2 * j].y) + (v[2 * j].z + v[2 * j].w)) + ((v[2 * j + 1].x + v[2 * j + 1].y) + (v[2 * j + 1].z + v[2 * j + 1].w)); }
        const float mean = wave_sum(s) * (1.f / DM); float s2 = 0.f;
#pragma unroll
        for (int j = 0; j < 8; ++j) { v[j] = v[j] - mean; s2 += (v[j].x * v[j].x + v[j].y * v[j].y) + (v[j].z * v[j].z + v[j].w * v[j].w); }
        const float rstd = __builtin_amdgcn_rsqf(wave_sum(s2) * (1.f / DM) + LN_EPS);
        const int b = m >> 13; const float* sh2 = mod + b * 12288 + 6144; const float* sc2 = mod + b * 12288 + 8192;
        float amax = 0.f;
#pragma unroll
        for (int j = 0; j < 4; ++j) { const int col = 512 * j + 8 * lane; f32x4 y[2];
#pragma unroll
            for (int q = 0; q < 2; ++q) { const f32x4 g = *(const f32x4*)(F.ln1_g + col + 4 * q), bb = *(const f32x4*)(F.ln1_b + col + 4 * q);
                y[q] = v[2 * j + q] * rstd * g + bb; v[2 * j + q] = y[q] * (1.f + *(const f32x4*)(sc2 + col + 4 * q)) + *(const f32x4*)(sh2 + col + 4 * q);
                const f32x4 hh = v[2 * j + q]; amax = fmaxf(amax, fmaxf(fmaxf(fabsf(hh.x), fabsf(hh.y)), fmaxf(fabsf(hh.z), fabsf(hh.w)))); }
            rp[64 * j] = pack8(y[0], y[1]); }
        amax = fmaxf(wave_max(amax), 1e-20f); const float qs = 127.0f / amax;
        if (lane == 0) HSC[m] = amax * (1.0f / 127.0f);
#pragma unroll
        for (int j = 0; j < 4; ++j) { const f32x4 a = v[2 * j] * qs, c = v[2 * j + 1] * qs;
            *(u32x2*)(H2I + (size_t)m * DM + 512 * j + 8 * lane) = (u32x2){pk4_i8(a.x, a.y, a.z, a.w), pk4_i8(c.x, c.y, c.z, c.w)}; }
    }
    { unsigned char* pu = WSP(unsigned char, WS_PU); float* usc = WSP(float, WS_USC);
        for (int e = gw; e < 16384; e += NGW) { f32x4 r[8]; float amax = 0.f;
#pragma unroll
            for (int j = 0; j < 4; ++j) { r[2 * j] = *(const f32x4*)(F.peer_u + (size_t)e * DM + 512 * j + 8 * lane); r[2 * j + 1] = *(const f32x4*)(F.peer_u + (size_t)e * DM + 512 * j + 8 * lane + 4); }
#pragma unroll
            for (int j = 0; j < 8; ++j) amax = fmaxf(amax, fmaxf(fmaxf(fabsf(r[j].x), fabsf(r[j].y)), fmaxf(fabsf(r[j].z), fabsf(r[j].w))));
            amax = fmaxf(wave_max(amax), 1e-30f); const float qs = 127.0f / amax;
            if (lane == 0) usc[e] = amax * (1.0f / 127.0f);
#pragma unroll
            for (int j = 0; j < 4; ++j) { const f32x4 a = r[2 * j] * qs, c = r[2 * j + 1] * qs;
                *(u32x2*)(pu + (size_t)(4 * j + (lane >> 4)) * 2097152 + (size_t)e * 128 + 8 * (lane & 15)) = (u32x2){pk4_i8(a.x, a.y, a.z, a.w), pk4_i8(c.x, c.y, c.z, c.w)}; } } }
    { unsigned char* pv = WSP(unsigned char, WS_PV); float* vsc = WSP(float, WS_VSC);
        for (int e = gw; e < 16384; e += NGW) { f32x4 r[8]; float amax = 0.f;
#pragma unroll
            for (int j = 0; j < 4; ++j) { r[2 * j] = *(const f32x4*)(F.peer_v + (size_t)e * DM + 512 * j + 8 * lane); r[2 * j + 1] = *(const f32x4*)(F.peer_v + (size_t)e * DM + 512 * j + 8 * lane + 4); }
#pragma unroll
            for (int j = 0; j < 8; ++j) amax = fmaxf(amax, fmaxf(fmaxf(fabsf(r[j].x), fabsf(r[j].y)), fmaxf(fabsf(r[j].z), fabsf(r[j].w))));
            amax = fmaxf(wave_max(amax), 1e-30f); const float qs = 127.0f / amax;
            if (lane == 0) vsc[e] = amax * (1.0f / 127.0f);
#pragma unroll
            for (int j = 0; j < 4; ++j) { const f32x4 a = r[2 * j] * qs, c = r[2 * j + 1] * qs;
                *(u32x2*)(pv + (size_t)(4 * j + (lane >> 4)) * 2097152 + (size_t)e * 128 + 8 * (lane & 15)) = (u32x2){pk4_i8(a.x, a.y, a.z, a.w), pk4_i8(c.x, c.y, c.z, c.w)}; } } }
}

constexpr int PK_KW = 288, PK_KEYS = 0, PK_SF = 2 * 128 * PK_KW  , PK_SI = PK_SF + 64 * 2 * 16 * 4, PK_TAB = PK_SI + 64 * 2 * 16 * 4;
__device__ __forceinline__ unsigned ord_key(float s) { unsigned u = __float_as_uint(s); return u ^ ((u >> 31) ? 0xffffffffu : 0x80000000u); }
__device__ __forceinline__ float ord_inv(unsigned k) { return __uint_as_float((k >> 31) ? (k ^ 0x80000000u) : ~k); }
#define PK_CE(a_, b_) do { const unsigned _h = (a_) > (b_) ? (a_) : (b_), _l = (a_) > (b_) ? (b_) : (a_); (a_) = _h; (b_) = _l; } while (0)
__device__ __forceinline__ void sort16_desc(unsigned (&v)[16]) {
#pragma unroll
    for (int k = 2; k <= 16; k <<= 1)
#pragma unroll
        for (int j = k >> 1; j > 0; j >>= 1)
#pragma unroll
            for (int i = 0; i < 16; ++i) { const int l = i ^ j; if (l > i) { if ((i & k) == 0) PK_CE(v[i], v[l]); else PK_CE(v[l], v[i]); } }
}
__device__ __forceinline__ void merge16_desc(unsigned (&v)[16]) {
#pragma unroll
    for (int j = 8; j > 0; j >>= 1)
#pragma unroll
        for (int i = 0; i < 16; ++i) { const int l = i ^ j; if (l > i) PK_CE(v[i], v[l]); }
}
__device__ __forceinline__ void top16_with_partner(unsigned (&v)[16], int mask) {
    unsigned o[16];
#pragma unroll
    for (int i = 0; i < 16; ++i) o[i] = (unsigned)__shfl_xor((int)v[i], mask);
#pragma unroll
    for (int i = 0; i < 16; ++i) v[i] = v[i] > o[15 - i] ? v[i] : o[15 - i];
    merge16_desc(v);
}
__device__ __forceinline__ void peer_score_phase(Frame& F) {
    const int tid = F.tid, lane = F.lane, wave = F.wave;
    LAS unsigned char* L = F.lds;
    const bf16* PQ = WSP(bf16, WS_PQ); int* IDX = WSP(int, WS_IDX); float* GATE = WSP(float, WS_GATE);
    { const u32x4* kg = WSP(u32x4, WS_PKEYS);
#pragma unroll
        for (int i = 0; i < 8; ++i) { const int id = tid + NTHREADS * i, r = id >> 4, ch = id & 15; *(LAS u32x4*)(L + PK_KEYS + r * PK_KW + ch * 16) = kg[id]; } }
    if (tid == 0) { int n = 0; for (int i = 0; i < 16; ++i) for (int j = 0; j < 16; ++j) if ((i + 1) * (j + 1) <= 16) L[PK_TAB + n++] = (unsigned char)(i * 16 + j); for (; n < 64; ++n) L[PK_TAB + n] = 0xff; }
    __syncthreads();
    LAS float* SF = (LAS float*)(L + PK_SF); LAS int* SI = (LAS int*)(L + PK_SI);
    for (int tile = F.blk; tile < NT * PEER_H / 64; tile += F.G) {
        const int R0 = tile * 64;
        { const int p = wave >> 2, rb = (wave & 3) * 16, c = lane & 15, fq = lane >> 4; const bf16* qp = PQ + (size_t)(R0 + rb + c) * 256 + p * 128 + 8 * fq;
            bf16x8 qfr[4];
#pragma unroll
            for (int ks = 0; ks < 4; ++ks) qfr[ks] = *(const bf16x8*)(qp + 32 * ks);
            unsigned lo[16], hi[16];
#pragma unroll
            for (int nb = 0; nb < 8; ++nb) { f32x4 acc = {0, 0, 0, 0};
#pragma unroll
                for (int ks = 0; ks < 4; ++ks) { const bf16x8 kfr = *(const LAS bf16x8*)(L + PK_KEYS + (p * 128 + nb * 16 + c) * PK_KW + (ks * 32 + 8 * fq) * 2);
                    acc = __builtin_amdgcn_mfma_f32_16x16x32_bf16(kfr, qfr[ks], acc, 0, 0, 0); }
#pragma unroll
                for (int r = 0; r < 4; ++r) { const unsigned key = (ord_key(acc[r]) & ~127u) | (unsigned)(127 - (16 * nb + 4 * fq + r));
                    if (nb < 4) lo[nb * 4 + r] = key; else hi[(nb - 4) * 4 + r] = key; } }
            sort16_desc(lo); sort16_desc(hi);
#pragma unroll
            for (int i = 0; i < 16; ++i) lo[i] = lo[i] > hi[15 - i] ? lo[i] : hi[15 - i];
            merge16_desc(lo);
            top16_with_partner(lo, 16); top16_with_partner(lo, 32);
            if (fq == 0) { LAS float* sf = SF + ((rb + c) * 2 + p) * 16; LAS int* si = SI + ((rb + c) * 2 + p) * 16;
#pragma unroll
                for (int i = 0; i < 16; ++i) { sf[i] = ord_inv(lo[i] & ~127u); si[i] = 127 - (int)(lo[i] & 127u); } } }
        __syncthreads();
        if (tid < 256) { const int R = tid >> 2, c = tid & 3; const LAS float* a = SF + (R * 2) * 16; const LAS float* bq = a + 16;
            unsigned v[16];
#pragma unroll
            for (int m = 0; m < 16; ++m) { v[m] = 0u; if (m < 13) { const unsigned pr = L[PK_TAB + c + 4 * m]; if (pr != 0xffu) v[m] = (ord_key(a[pr >> 4] + bq[pr & 15]) & ~255u) | (255u - pr); } }
            sort16_desc(v); top16_with_partner(v, 1); top16_with_partner(v, 2);
            unsigned w0 = c == 0 ? v[0] : (c == 1 ? v[4] : (c == 2 ? v[8] : v[12])), w1 = c == 0 ? v[1] : (c == 1 ? v[5] : (c == 2 ? v[9] : v[13]));
            unsigned w2 = c == 0 ? v[2] : (c == 1 ? v[6] : (c == 2 ? v[10] : v[14])), w3 = c == 0 ? v[3] : (c == 1 ? v[7] : (c == 2 ? v[11] : v[15]));
            const unsigned pm = 255u - (v[0] & 255u); const float smax = a[pm >> 4] + bq[pm & 15];
            const LAS int* ia = SI + (R * 2) * 16; const LAS int* ib = ia + 16;
            const unsigned p0 = 255u - (w0 & 255u), p1 = 255u - (w1 & 255u), p2 = 255u - (w2 & 255u), p3 = 255u - (w3 & 255u);
            f32x4 e = {__expf(a[p0 >> 4] + bq[p0 & 15] - smax), __expf(a[p1 >> 4] + bq[p1 & 15] - smax), __expf(a[p2 >> 4] + bq[p2 & 15] - smax), __expf(a[p3 >> 4] + bq[p3 & 15] - smax)};
            float sum = (e.x + e.y) + (e.z + e.w); sum += __shfl_xor(sum, 1); sum += __shfl_xor(sum, 2);
            const float inv = 1.0f / sum; const size_t ob = (size_t)(R0 + R) * 16 + 4 * c;
            *(f32x4*)(GATE + ob) = e * inv;
            *(int4*)(IDX + ob) = make_int4(ia[p0 >> 4] * NKEYS + ib[p0 & 15], ia[p1 >> 4] * NKEYS + ib[p1 & 15], ia[p2 >> 4] * NKEYS + ib[p2 & 15], ia[p3 >> 4] * NKEYS + ib[p3 & 15]); }
        __syncthreads();
    }
}
#undef PK_CE

__device__ __forceinline__ void ln2_rows(Frame& F, int m0, int nrows) {
    int lane; asm volatile("v_mbcnt_lo_u32_b32 %0, -1, 0\n\tv_mbcnt_hi_u32_b32 %0, -1, %0" : "=v"(lane));
    const bf16* X1 = WSP(bf16, WS_R1); const float* mod = WSP(float, WS_MOD); const bf16* Y = WSP(bf16, WS_TMP);
    f32x4 g1[8];
    { const f32x4* gt2 = (const f32x4*)(mod + (m0 >> 13) * 12288 + 10240) + lane;
#pragma unroll
        for (int j = 0; j < 8; ++j) g1[j] = 1.f + gt2[64 * j]; }
    u32x2 yn[8], xn[8];
    { const u32x2* yb = (const u32x2*)(Y + (size_t)m0 * DM) + lane; const u32x2* xb = (const u32x2*)(X1 + (size_t)m0 * DM) + lane;
#pragma unroll
        for (int j = 0; j < 8; ++j) { yn[j] = yb[64 * j]; xn[j] = xb[64 * j]; } }
#pragma unroll 1
    for (int m = m0; m < m0 + nrows; ++m) {
        f32x4* yp = (f32x4*)(F.out + (size_t)m * DM) + lane;
        f32x4 v[8]; float s = 0.f;
#pragma unroll
        for (int j = 0; j < 8; ++j) { const u32x2 yw = yn[j], xw = xn[j]; const f32x4 y = {bflo(yw.x), bfhi(yw.x), bflo(yw.y), bfhi(yw.y)}, x = {bflo(xw.x), bfhi(xw.x), bflo(xw.y), bfhi(xw.y)};
            v[j] = DN_ALPHA * x + g1[j] * y; s += (v[j].x + v[j].y) + (v[j].z + v[j].w); }
        { const int mn = m + 1 < m0 + nrows ? m + 1 : m; const u32x2* yb = (const u32x2*)(Y + (size_t)mn * DM) + lane; const u32x2* xb = (const u32x2*)(X1 + (size_t)mn * DM) + lane;
#pragma unroll
            for (int j = 0; j < 8; ++j) { yn[j] = yb[64 * j]; xn[j] = xb[64 * j]; } }
        const float mean = wave_sum(s) * (1.f / DM); float s2 = 0.f;
#pragma unroll
        for (int j = 0; j < 8; ++j) { v[j] = v[j] - mean; s2 += (v[j].x * v[j].x + v[j].y * v[j].y) + (v[j].z * v[j].z + v[j].w * v[j].w); }
        const float rstd = __builtin_amdgcn_rsqf(wave_sum(s2) * (1.f / DM) + LN_EPS);
#pragma unroll
        for (int j = 0; j < 8; ++j) yp[64 * j] = v[j] * rstd * *((const f32x4*)F.ln2_g + 64 * j + lane) + *((const f32x4*)F.ln2_b + 64 * j + lane);
    }
}
constexpr int PE_WAVE_LDS = 16384;
template <int N, int M> __device__ __forceinline__ void xreduce_step(float (&v)[M], bool bit, int mask) {
#pragma unroll
    for (int i = 0; i < N / 2; ++i) { const float keep = bit ? v[i + N / 2] : v[i], send = bit ? v[i] : v[i + N / 2]; v[i] = keep + __shfl_xor(send, mask); }
}
template <int N, int M> __device__ __forceinline__ void xreduce_step_i(int (&v)[M], bool bit, int mask) {
#pragma unroll
    for (int i = 0; i < N / 2; ++i) { const int keep = bit ? v[i + N / 2] : v[i], send = bit ? v[i] : v[i + N / 2]; v[i] = keep + __shfl_xor(send, mask); }
}
__device__ __forceinline__ void peer_eval_phase(Frame& F) {
    const int lane = F.lane, g = lane >> 3, c16 = lane & 7;
    const unsigned char* H2I = WSP(unsigned char, WS_H2I); const float* HSC = WSP(float, WS_HSC); const float* USC = WSP(float, WS_USC); const float* VSC = WSP(float, WS_VSC); const int* IDX = WSP(int, WS_IDX); const float* GATE = WSP(float, WS_GATE);
    const unsigned char* PU = WSP(unsigned char, WS_PU); const unsigned char* PV = WSP(unsigned char, WS_PV); bf16* Y = WSP(bf16, WS_TMP);
    LAS int* idxL = (LAS int*)(F.lds + F.wave * PE_WAVE_LDS); LAS float* DL = (LAS float*)(F.lds + F.wave * PE_WAVE_LDS + 8192);
    for (int tb = F.blk; tb < NT / 128; tb += F.G) {
        const int tok0 = tb * 128 + F.wave * 16;
#pragma unroll 4
        for (int tk = 0; tk < 16; ++tk) { const int e0 = lane, e1 = lane + 64; const int i0 = IDX[(size_t)(tok0 + tk) * 128 + e0], i1 = IDX[(size_t)(tok0 + tk) * 128 + e1];
            idxL[(tk * 8 + (e0 & 7)) * 16 + (e0 >> 3)] = i0 << 7; idxL[(tk * 8 + (e1 & 7)) * 16 + (e1 >> 3)] = i1 << 7; DL[tk * 128 + e0] = 0.f; DL[tk * 128 + e1] = 0.f; }
        LDS_WAIT();
        {
            auto issueU = [&](int st, u32x4 (&w)[16], i32x4& hq) { const int sl = st >> 4, tk = st & 15; const unsigned char* pu = PU + (size_t)sl * 2097152; const unsigned lo16 = 16u * c16;
                int ids[16];
#pragma unroll
                for (int q = 0; q < 4; ++q) { const i32x4 v = *(const LAS i32x4*)(idxL + (tk * 8 + g) * 16 + 4 * q); ids[4 * q] = v.x; ids[4 * q + 1] = v.y; ids[4 * q + 2] = v.z; ids[4 * q + 3] = v.w; }
                hq = *(const i32x4*)(H2I + (size_t)(tok0 + tk) * DM + 128 * sl + 16 * c16);
#pragma unroll
                for (int k = 0; k < 16; ++k) w[k] = *(const u32x4*)(pu + ((unsigned)ids[k] + lo16)); };
            auto computeU = [&](int st, const u32x4 (&w)[16], const i32x4 hq) { const int tk = st & 15;
                int pd[16];
#pragma unroll
                for (int k = 0; k < 16; ++k) { int di = __builtin_amdgcn_sdot4((int)w[k][0], hq.x, 0, false); di = __builtin_amdgcn_sdot4((int)w[k][1], hq.y, di, false);
                    di = __builtin_amdgcn_sdot4((int)w[k][2], hq.z, di, false); di = __builtin_amdgcn_sdot4((int)w[k][3], hq.w, di, false); pd[k] = di; }
                xreduce_step_i<16>(pd, c16 & 1, 1); xreduce_step_i<8>(pd, c16 & 2, 2); xreduce_step_i<4>(pd, c16 & 4, 4);
                const int k0 = 8 * (c16 & 1) + 4 * ((c16 >> 1) & 1) + 2 * (c16 >> 2);
                LAS int* dp = (LAS int*)DL + tk * 128 + g; dp[8 * k0] += pd[0]; dp[8 * (k0 + 1)] += pd[1]; };
            u32x4 wa[16], wb[16]; i32x4 ha, hb;
            issueU(0, wa, ha);
#pragma unroll 1
            for (int st = 0; st < 256; st += 2) {
                issueU(st + 1, wb, hb); computeU(st, wa, ha);
                issueU(st + 2 < 256 ? st + 2 : 255, wa, ha); computeU(st + 1, wb, hb);
            }
        }
        LDS_WAIT();
        { float a0[16], a1[16]; const int e0 = lane, e1 = lane + 64;
#pragma unroll
            for (int tk = 0; tk < 16; ++tk) { const float g0 = GATE[(size_t)(tok0 + tk) * 128 + e0], g1 = GATE[(size_t)(tok0 + tk) * 128 + e1]; const float hs = HSC[tok0 + tk];
                const int x0 = idxL[(tk * 8 + (e0 & 7)) * 16 + (e0 >> 3)], x1 = idxL[(tk * 8 + (e1 & 7)) * 16 + (e1 >> 3)];
                a0[tk] = gelu_tanh((float)((LAS int*)DL)[tk * 128 + e0] * (hs * USC[x0 >> 7])) * g0 * VSC[x0 >> 7]; a1[tk] = gelu_tanh((float)((LAS int*)DL)[tk * 128 + e1] * (hs * USC[x1 >> 7])) * g1 * VSC[x1 >> 7]; }
            LDS_WAIT();
            LAS unsigned char* AB = (LAS unsigned char*)DL; LAS float* AS = DL + 512;
#pragma unroll
            for (int tk = 0; tk < 16; ++tk) { const float amax = fmaxf(wave_max(fmaxf(fabsf(a0[tk]), fabsf(a1[tk]))), 1e-30f); const float qs = 127.0f / amax;
                const int q0 = (int)__builtin_rintf(a0[tk] * qs), q1 = (int)__builtin_rintf(a1[tk] * qs);
                AB[(tk * 8 + (e0 & 7)) * 16 + (e0 >> 3)] = (unsigned char)q0; AB[(tk * 8 + (e1 & 7)) * 16 + (e1 >> 3)] = (unsigned char)q1;
                if (lane == 0) AS[tk] = amax * (1.0f / 127.0f); } }
        LDS_WAIT();
        {
            auto issueV = [&](int st, u32x4 (&w)[16]) { const int sl = st >> 4, tk = st & 15; const unsigned char* pv = PV + (size_t)sl * 2097152; const unsigned lo16 = 16u * c16;
                int ids[16];
#pragma unroll
                for (int q = 0; q < 4; ++q) { const i32x4 v = *(const LAS i32x4*)(idxL + (tk * 8 + g) * 16 + 4 * q); ids[4 * q] = v.x; ids[4 * q + 1] = v.y; ids[4 * q + 2] = v.z; ids[4 * q + 3] = v.w; }
#pragma unroll
                for (int k = 0; k < 16; ++k) w[k] = *(const u32x4*)(pv + ((unsigned)ids[k] + lo16)); };
            auto computeV = [&](int st, const u32x4 (&w)[16]) { const int sl = st >> 4, tk = st & 15;
                const i32x4 a4 = *(const LAS i32x4*)((const LAS unsigned char*)DL + (tk * 8 + g) * 16);
                const float ascale = (DL + 512)[tk];
                int yi[16];
#pragma unroll
                for (int c = 0; c < 16; ++c) yi[c] = 0;
#pragma unroll
                for (int m = 0; m < 4; ++m) { const int am = m == 0 ? a4.x : (m == 1 ? a4.y : (m == 2 ? a4.z : a4.w));
#pragma unroll
                    for (int q = 0; q < 4; ++q) {
                        const unsigned w0 = w[4 * m][q], w1 = w[4 * m + 1][q], w2 = w[4 * m + 2][q], w3 = w[4 * m + 3][q];
                        const unsigned t0 = __builtin_amdgcn_perm(w1, w0, 0x05010400u), t1 = __builtin_amdgcn_perm(w1, w0, 0x07030602u), t2 = __builtin_amdgcn_perm(w3, w2, 0x05010400u), t3 = __builtin_amdgcn_perm(w3, w2, 0x07030602u);
                        yi[4 * q + 0] = __builtin_amdgcn_sdot4((int)__builtin_amdgcn_perm(t2, t0, 0x05040100u), am, yi[4 * q + 0], false);
                        yi[4 * q + 1] = __builtin_amdgcn_sdot4((int)__builtin_amdgcn_perm(t2, t0, 0x07060302u), am, yi[4 * q + 1], false);
                        yi[4 * q + 2] = __builtin_amdgcn_sdot4((int)__builtin_amdgcn_perm(t3, t1, 0x05040100u), am, yi[4 * q + 2], false);
                        yi[4 * q + 3] = __builtin_amdgcn_sdot4((int)__builtin_amdgcn_perm(t3, t1, 0x07060302u), am, yi[4 * q + 3], false); } }
                float cv[16];
#pragma unroll
                for (int c = 0; c < 16; ++c) cv[c] = (float)yi[c] * ascale;
                xreduce_step<16>(cv, g & 1, 8); xreduce_step<8>(cv, g & 2, 16); xreduce_step<4>(cv, g & 4, 32);
                const int c0 = 8 * (g & 1) + 4 * ((g >> 1) & 1) + 2 * (g >> 2);
                *(unsigned*)(Y + (size_t)(tok0 + tk) * DM + 128 * sl + 16 * c16 + c0) = pk2(cv[0], cv[1]); };
            u32x4 wa[16], wb[16];
            issueV(0, wa);
#pragma unroll 1
            for (int st = 0; st < 256; st += 2) {
                issueV(st + 1, wb); computeV(st, wa);
                issueV(st + 2 < 256 ? st + 2 : 255, wa); computeV(st + 1, wb);
            }
        }
        LDS_WAIT();
        VM_WAIT();
        ln2_rows(F, tok0, 16);
    }
}

constexpr int NPHASE = 12;
__global__ void __launch_bounds__(NTHREADS, 2) fwd_kernel(Args args) {
    extern __shared__ __attribute__((aligned(16))) unsigned char lds_raw[];
    Frame F;
    F.lds = (LAS unsigned char*)lds_raw; F.tid = threadIdx.x; F.lane = F.tid & 63; F.wave = __builtin_amdgcn_readfirstlane(F.tid >> 6); F.G = gridDim.x; F.blk = blockIdx.x;
    F.x = args.in[0]; F.c = args.in[1]; F.positions = (const int*)args.in[2]; F.w_ada = args.in[3]; F.b_ada = args.in[4]; F.w_in = args.in[5]; F.conv_w = args.in[6]; F.conv_b = args.in[7];
    F.w_rg_a = args.in[8]; F.b_rg_a = args.in[9]; F.w_rg_x = args.in[10]; F.b_rg_x = args.in[11]; F.rg_lambda = args.in[12]; F.w_rnn_out = args.in[13]; F.q_norm_g = args.in[14]; F.w_uq = args.in[15];
    F.kv_norm_g = args.in[16]; F.w_ukv = args.in[17]; F.w_mla_out = args.in[18]; F.w_o = args.in[19]; F.ln1_g = args.in[20]; F.ln1_b = args.in[21]; F.peer_wq = args.in[22]; F.peer_keys = args.in[23];
    F.peer_u = args.in[24]; F.peer_v = args.in[25]; F.ln2_g = args.in[26]; F.ln2_b = args.in[27]; F.out = args.out; F.ws = args.ws;
    volatile LAS unsigned* ctlw = (volatile LAS unsigned*)(F.lds + LDSCTL_OFF);
    if (F.tid < 128) ctlw[F.tid] = 0u;
    __syncthreads();
    const int lo = args.ph_lo, hi = args.ph_hi;
    const bool multi = (hi - lo) > 1;
#ifdef PROBE_RELAUNCH
    const int bslot = args.bslot;
#else
    constexpr int bslot = 0;
#endif
    XcdBarrier bar; bar.bar = (unsigned*)(F.ws + WS_CTL) + 4096 + 16384 * (bslot & 1); bar.x = 0; bar.st = nullptr;
    if (multi) bar = xcd_barrier_post((unsigned*)(F.ws + WS_CTL) + 4096 + 16384 * (bslot & 1), ctlw + 8);
#ifndef PHASE_MASK
#define PHASE_MASK 0xfff
#endif
#define IN(k) (((PHASE_MASK >> (k)) & 1) && lo <= (k) && (k) < hi)
#define SEAM(k) do { if (IN(k) && IN((k) + 1)) xcd_barrier(bar); } while (0)
#ifndef DBL_MASK
#define DBL_MASK 0
#endif
#define DBL(k, ...) do { if ((DBL_MASK >> (k)) & 1) { __VA_ARGS__; xcd_barrier(bar); } } while (0)
    const pg8::StaticOrder S0{};
    if (IN(0)) { DBL(0, p0_prologue(F, 1)); p0_prologue(F, bslot); SEAM(0); }
    if (IN(1)) { DBL(1, p1_modulate(F)); p1_modulate(F); SEAM(1); }
    if (IN(2)) {
        const pg8::Gemm g = pg8::gemm_f8(WSP(unsigned char, WS_S0), WSP(unsigned char, WS_WIN), NT, NPROJ, DM, DM, DM); pg8::StaticOrder S; S.init(NT, NPROJ, F.G, F.blk);
        EpiProj E{WSP(bf16, WS_XR), WSP(bf16, WS_GG), WSP(unsigned char, WS_QKVC), WSP(unsigned char, WS_KVC8), WSP(bf16, WS_SGR), WSP(bf16, WS_SGM), WSP(float, WS_KR), WSP(float, WS_SSP), 1.0f / (SC_H * SC_WIN)};
        DBL(2, pg8::gemm_phase<EpiProj, pg8::StaticOrder, true, false>(F.lds, g, S, E, F.wave)); pg8::gemm_phase<EpiProj, pg8::StaticOrder, true, false>(F.lds, g, S, E, F.wave); SEAM(2); }
    if (IN(3)) { DBL(3, rglru_passA(F)); rglru_passA(F); SEAM(3); }
    if (IN(4)) {
        rglru_passB(F);
        constexpr float ESC6 = 1.0f / (SC_H * SC_WIN);
        { const pg8::Gemm g = pg8::gemm_f8(WSP(unsigned char, WS_QKVC), WSP(unsigned char, WS_WUQ), NT, 3072, 512, 512, 512); pg8::StaticOrder S; S.init(NT, 3072, F.G, F.blk);
          EpiQ E{(unsigned char*)F.out + OUT_Q, WSP(float, WS_RS), WSP(f32x2, WS_ROPE), ESC6}; pg8::gemm_phase<EpiQ, pg8::StaticOrder, true>(F.lds, g, S, E, F.wave); }
        { const pg8::Gemm g = pg8::gemm_f8(WSP(unsigned char, WS_KVC8), WSP(unsigned char, WS_WUK), NT, 2048, 512, 512, 512); pg8::StaticOrder S; S.init(NT, 2048, F.G, F.blk);
          EpiK E{(unsigned char*)F.out + OUT_K, WSP(float, WS_RS), ESC6}; pg8::gemm_phase<EpiK, pg8::StaticOrder, true>(F.lds, g, S, E, F.wave); }
        { const pg8::Gemm g = pg8::gemm_f8(WSP(unsigned char, WS_WUV), WSP(unsigned char, WS_KVC8), 2048, NT, 512, 512, 512); pg8::StaticOrder S; S.init(2048, NT, F.G, F.blk);
          EpiVT E{(unsigned char*)F.out + OUT_VT, WSP(float, WS_RS), ESC6}; pg8::gemm_phase<EpiVT, pg8::StaticOrder, true>(F.lds, g, S, E, F.wave); }
        krope_fill(F); SEAM(4); }
    if (IN(5)) {
#ifdef PROBE_ATTN
#pragma unroll 1
        for (int rep = 0; rep < PROBE_ATTN; ++rep) { attn_phase(F); xcd_barrier(bar); }
#else
        attn_phase(F);
#endif
        SEAM(5); }
    if (IN(6)) {
        pg8::Gemm g = pg8::gemm_f8(WSP(unsigned char, WS_S0), WSP(unsigned char, WS_WRNN), NT, DM, 2 * DM, DM, DM); g.A2 = WSP(unsigned char, WS_AO8); g.Bt2 = WSP(unsigned char, WS_WMLA); g.nt1 = DM / 128;
        pg8::StaticOrder S; S.init(NT, DM, F.G, F.blk);
        EpiMix E{WSP(bf16, WS_SGR), WSP(bf16, WS_SGM), WSP(unsigned char, WS_TMP8), SC_AO / SC_RA, 1.0f / (SC_AO * SC_WSQ)};
        pg8::gemm_phase<EpiMix, pg8::StaticOrder, true>(F.lds, g, S, E, F.wave); SEAM(6); }
    if (IN(7)) {
#ifdef PROBE_GEMM
#if PROBE_GEMM == 1
#define PROBE_ONE { pg8::Gemm gp = pg8::gemm_f8(WSP(unsigned char, WS_TMP8), WSP(unsigned char, WS_WO), NT, DM, DM, DM, DM); gp.nt = PROBE_NT; pg8::StaticOrder Sp; Sp.init(NT, DM, F.G, F.blk); \
            EpiRes1 Ep{F.x, WSP(float, WS_MOD), WSP(bf16, WS_PQ), 1.0f}; pg8::gemm_phase<EpiRes1, pg8::StaticOrder, true>(F.lds, gp, Sp, Ep, F.wave); xcd_barrier(bar); }
#elif PROBE_GEMM == 3
#define PROBE_ONE { pg8::Gemm gp = pg8::gemm_f8(WSP(unsigned char, WS_TMP8), WSP(unsigned char, WS_WO), NT, DM, DM, DM, DM); gp.nt = PROBE_NT; pg8::StaticOrder Sp; Sp.init(NT, DM, F.G, F.blk); \
            EpiPlain Ep{WSP(bf16, WS_PQ), 1.0f}; pg8::gemm_phase<EpiPlain, pg8::StaticOrder, true, true>(F.lds, gp, Sp, Ep, F.wave); xcd_barrier(bar); }
#elif PROBE_GEMM == 5
#define PROBE_ONE { pg8::Gemm gp = pg8::gemm_f8(WSP(unsigned char, WS_TMP8), WSP(unsigned char, WS_WO), NT, DM, DM, DM, DM); gp.nt = PROBE_NT; pg8::StaticOrder Sp; Sp.init(NT, DM, F.G, F.blk); \
            EpiNull Ep{WSP(float, WS_PQ)}; pg8::gemm_phase<EpiNull, pg8::StaticOrder, true, true>(F.lds, gp, Sp, Ep, F.wave); xcd_barrier(bar); }
#elif PROBE_GEMM == 4
#define PROBE_ONE { pg8::Gemm gp = pg8::gemm_bf16(WSP(bf16, WS_TMP), WSP(bf16, WS_WPQ), NT, DM, DM, DM, DM); gp.nt = PROBE_NT; pg8::StaticOrder Sp; Sp.init(NT, DM, F.G, F.blk); \
            EpiPlain Ep{WSP(bf16, WS_PQ), 1.0f}; pg8::gemm_phase<EpiPlain, pg8::StaticOrder>(F.lds, gp, Sp, Ep, F.wave); xcd_barrier(bar); }
#endif
#ifndef PROBE_PRB
#define PROBE_PRB 0
#endif
#ifndef PROBE_REP
#define PROBE_REP 1
#endif
        PROBE_ONE
#if PROBE_REP >= 2
        PROBE_ONE
#endif
#if PROBE_REP >= 3
        PROBE_ONE
#endif
#if PROBE_REP >= 4
        PROBE_ONE
#endif
#endif
        const pg8::Gemm g = pg8::gemm_f8(WSP(unsigned char, WS_TMP8), WSP(unsigned char, WS_WO), NT, DM, DM, DM, DM); pg8::StaticOrder S; S.init(NT, DM, F.G, F.blk);
        EpiRes1 E{F.x, WSP(float, WS_MOD), WSP(bf16, WS_R1), 1.0f / (SC_TMP * SC_WSQ)};
        pg8::gemm_phase<EpiRes1, pg8::StaticOrder, true>(F.lds, g, S, E, F.wave); SEAM(7); }
    if (IN(8)) { ln1_phase(F); SEAM(8); }
    if (IN(9)) {
        const pg8::Gemm g = pg8::gemm_f8(WSP(unsigned char, WS_H2I), WSP(unsigned char, WS_WPQ), NT, DM, DM, DM, DM); pg8::StaticOrder S; S.init(NT, DM, F.G, F.blk);
        EpiQuery E{WSP(bf16, WS_PQ), WSP(float, WS_HSC), WSP(float, WS_WQS)};
        pg8::gemm_phase<EpiQuery, pg8::StaticOrder, 2>(F.lds, g, S, E, F.wave); SEAM(9); }
#ifdef PROBE_BARS
#pragma unroll 1
    for (int r = 0; r < PROBE_BARS; ++r) xcd_barrier(bar);
#endif
    if (IN(10)) { DBL(10, peer_score_phase(F)); peer_score_phase(F); SEAM(10); }
    if (IN(11)) { DBL(11, peer_eval_phase(F)); peer_eval_phase(F); }
#undef IN
#undef SEAM
}

#ifdef PROBE_ATTN_PRB
__global__ void __launch_bounds__(NTHREADS, 2) attn_probe_kernel(Args args) {
    extern __shared__ __attribute__((aligned(16))) unsigned char lds_raw[];
    Frame F;
    F.lds = (LAS unsigned char*)lds_raw; F.tid = threadIdx.x; F.lane = F.tid & 63; F.wave = __builtin_amdgcn_readfirstlane(F.tid >> 6); F.G = gridDim.x; F.blk = blockIdx.x; F.out = args.out; F.ws = args.ws;
    attn_phase<32 | PROBE_ATTN_PRB>(F);
}
#endif
#ifdef DBG_STOP
__global__ void dbg_dump(const unsigned char* ws, size_t off, int is_f32, float* out) {
    const size_t n = (size_t)NT * DM; const size_t i0 = (size_t)blockIdx.x * blockDim.x + threadIdx.x, st = (size_t)gridDim.x * blockDim.x;
    if (is_f32) { const float* s = (const float*)(ws + off); for (size_t i = i0; i < n; i += st) out[i] = s[i]; }
    else { const bf16* s = (const bf16*)(ws + off); for (size_t i = i0; i < n; i += st) out[i] = i < (size_t)DBG_N ? bf1(s[i]) : 0.f; }
}
__global__ void dbg_count(const unsigned char* ws, size_t off, float lo, float hi, unsigned* cnt) {
    if (blockIdx.x != 0) return;
    const int pm = 3, ct = 2; const bf16* s = (const bf16*)(ws + off); __shared__ unsigned rowbad[256], colbad[256];
    rowbad[threadIdx.x] = 0; colbad[threadIdx.x] = 0; __syncthreads();
    for (int i = threadIdx.x; i < 65536; i += blockDim.x) { const int r = i >> 8, cc = i & 255; const float v = bf1(s[(size_t)(pm * 256 + r) * DM + ct * 256 + cc]); if (!(v >= lo && v <= hi)) { rowbad[r] = 1; colbad[cc] = 1; } }
    __syncthreads();
    if (threadIdx.x == 0) { unsigned nr = 0, nc = 0, fr = 999, fc = 999; for (int i = 0; i < 256; ++i) { if (rowbad[i]) { ++nr; if (fr == 999) fr = i; } if (colbad[i]) { ++nc; if (fc == 999) fc = i; } }
        cnt[0] = nr + 10; cnt[1] = nc + 10; cnt[2] = fr + 10; cnt[3] = fc + 10; }
}
__global__ void dbg_report(const unsigned* cnt, float* out) {
    const size_t n = (size_t)NT * DM; const size_t i0 = (size_t)blockIdx.x * blockDim.x + threadIdx.x, st = (size_t)gridDim.x * blockDim.x;
    const float v = (float)cnt[DBG_WHICH];
    for (size_t i = i0; i < n; i += st) out[i] = (i == 0) ? v : 0.f;
}
#endif
#ifdef PROBE_MB
template <int NM, int NV, int VT>
__global__ void __launch_bounds__(NTHREADS, 2) mb_kernel(float* sink, int iters) {
    const int lane = threadIdx.x & 63; unsigned h = (unsigned)(threadIdx.x + 512 * blockIdx.x) * 0x9E3779B9u + 0x7F4A7C15u;
    i32x8 a, b; for (int e = 0; e < 8; ++e) { h = h * 1664525u + 1013904223u; a[e] = (int)(h & 0x3F3F3F3Fu); h = h * 1664525u + 1013904223u; b[e] = (int)(h & 0x3F3F3F3Fu) ^ 0x00800080; }
    f32x16 acc[4]; for (int q = 0; q < 4; ++q) for (int e = 0; e < 16; ++e) acc[q][e] = 0.f;
    float v[12]; for (int e = 0; e < 12; ++e) v[e] = 0.001f * (float)(lane + e);
    const float c1 = 0.999f, c2 = 0.0007f;
#pragma unroll 1
    for (int it = 0; it < iters; ++it) {
#pragma unroll
        for (int q = 0; q < 4; ++q) {
            if (NM) acc[q] = __builtin_amdgcn_mfma_scale_f32_32x32x64_f8f6f4(a, b, acc[q], 0, 0, 0, 0x7F7F7F7F, 0, 0x7F7F7F7F);
            __builtin_amdgcn_sched_barrier(0);
#pragma unroll
            for (int e = 0; e < NV; ++e) v[e] = VT ? __builtin_amdgcn_exp2f(v[e]) : __builtin_fmaf(v[e], c1, c2);
            __builtin_amdgcn_sched_barrier(0);
        }
    }
    float sacc = 0.f; for (int q = 0; q < 4; ++q) for (int e = 0; e < 16; ++e) sacc += acc[q][e]; for (int e = 0; e < 12; ++e) sacc += v[e];
    sink[(size_t)blockIdx.x * 512 + threadIdx.x] = sacc;
}
#endif
extern "C" void kernel_launch(void* const* d_in, const int* in_sizes, int n_in, void* d_out, int out_size, void* d_ws, size_t ws_size, hipStream_t stream) {
    static int grid = 0;
    if (grid == 0) {
        if (n_in != 28 || out_size != NT * DM || ws_size < WS_END) { fprintf(stderr, "kernel_launch: unexpected shapes (n_in %d, out %d, ws %zu)\n", n_in, out_size, ws_size); grid = -1; return; }
        int dev = 0, cus = 0, per_cu = 0;
        if (hipGetDevice(&dev) != hipSuccess || hipDeviceGetAttribute(&cus, hipDeviceAttributeMultiprocessorCount, dev) != hipSuccess) { grid = -1; return; }
        if (hipFuncSetAttribute((const void*)fwd_kernel, hipFuncAttributeMaxDynamicSharedMemorySize, LDS_BYTES) != hipSuccess) { fprintf(stderr, "kernel_launch: hipFuncSetAttribute failed\n"); grid = -1; return; }
        if (hipOccupancyMaxActiveBlocksPerMultiprocessor(&per_cu, (const void*)fwd_kernel, NTHREADS, LDS_BYTES) != hipSuccess || per_cu < 1)
            fprintf(stderr, "kernel_launch: occupancy query reports %d workgroups per CU\n", per_cu);
        (void)hipGetLastError();
        grid = cus;
    }
    if (grid < 0) return;
    if (hipMemsetAsync((char*)d_ws + WS_CTL, 0, CTL_ZERO_BYTES, stream) != hipSuccess) return;
#ifdef PROBE_MB
    hipLaunchKernelGGL((mb_kernel<PROBE_MB_NM, PROBE_MB_NV, PROBE_MB_VT>), dim3(grid), dim3(NTHREADS), 0, stream, (float*)((char*)d_ws + WS_XR), 4000);
#endif
    Args a{};
    for (int i = 0; i < 28; ++i) a.in[i] = (const float*)d_in[i];
    a.out = (float*)d_out; a.ws = (unsigned char*)d_ws;
#ifdef PROBE_RELAUNCH
    a.ph_lo = 0; a.ph_hi = PROBE_RELAUNCH + 1; a.bslot = 0;
    hipLaunchKernelGGL(fwd_kernel, dim3(grid), dim3(NTHREADS), LDS_BYTES, stream, a);
#ifdef PROBE_ATTN_PRB
    { static bool once = false; if (!once) { once = true; (void)hipFuncSetAttribute((const void*)attn_probe_kernel, hipFuncAttributeMaxDynamicSharedMemorySize, LDS_BYTES); } }
    for (int r = 0; r < PROBE_RELAUNCH_N; ++r) hipLaunchKernelGGL(attn_probe_kernel, dim3(grid), dim3(NTHREADS), LDS_BYTES, stream, a);
#else
    for (int r = 0; r < PROBE_RELAUNCH_N; ++r) { a.ph_lo = PROBE_RELAUNCH; a.ph_hi = PROBE_RELAUNCH + 1; a.bslot = 2 + r; hipLaunchKernelGGL(fwd_kernel, dim3(grid), dim3(NTHREADS), LDS_BYTES, stream, a); }
#endif
    if (PROBE_RELAUNCH + 1 < NPHASE) { a.ph_lo = PROBE_RELAUNCH + 1; a.ph_hi = NPHASE; a.bslot = 1; hipLaunchKernelGGL(fwd_kernel, dim3(grid), dim3(NTHREADS), LDS_BYTES, stream, a); }
#elif MK_N_LAUNCHES == 1
    a.ph_lo = 0; a.ph_hi = NPHASE;
    hipLaunchKernelGGL(fwd_kernel, dim3(grid), dim3(NTHREADS), LDS_BYTES, stream, a);
#else
#ifdef DBG_STOP
    for (int p = 0; p <= DBG_STOP; ++p) { a.ph_lo = p; a.ph_hi = p + 1; hipLaunchKernelGGL(fwd_kernel, dim3(grid), dim3(NTHREADS), LDS_BYTES, stream, a); }
#ifdef DBG_COUNT
        hipLaunchKernelGGL(dbg_count, dim3(1024), dim3(256), 0, stream, (const unsigned char*)d_ws, (size_t)DBG_OFF, DBG_LO, DBG_HI, (unsigned*)d_ws + 1024);
    hipLaunchKernelGGL(dbg_report, dim3(2048), dim3(256), 0, stream, (const unsigned*)d_ws + 1024, (float*)d_out);
#else
    hipLaunchKernelGGL(dbg_dump, dim3(2048), dim3(256), 0, stream, (const unsigned char*)d_ws, (size_t)DBG_OFF, DBG_F32, (float*)d_out);
#endif
#else
    for (int p = 0; p < NPHASE; ++p) { a.ph_lo = p; a.ph_hi = p + 1; hipLaunchKernelGGL(fwd_kernel, dim3(grid), dim3(NTHREADS), LDS_BYTES, stream, a); }
#endif
#endif
    const hipError_t le = hipPeekAtLastError();
    if (le != hipSuccess) fprintf(stderr, "kernel_launch: launch failed: %s\n", hipGetErrorName(le));
}
```

```cpp
#include <hip/hip_runtime.h>
#include <cstdio>
#include <cstdint>

#ifndef MK_N_LAUNCHES
#define MK_N_LAUNCHES 1
#endif

#define LAS __attribute__((address_space(3)))
#define GAS __attribute__((address_space(1)))
typedef unsigned short bf16;
typedef short bf16x8 __attribute__((ext_vector_type(8)));
typedef float f32x2 __attribute__((ext_vector_type(2)));
typedef _Float16 f16x2 __attribute__((ext_vector_type(2)));
typedef float f32x4 __attribute__((ext_vector_type(4)));
typedef float f32x16 __attribute__((ext_vector_type(16)));
typedef unsigned u32x2 __attribute__((ext_vector_type(2)));
typedef unsigned u32x4 __attribute__((ext_vector_type(4)));
typedef int i32x4 __attribute__((ext_vector_type(4)));
typedef int i32x8 __attribute__((ext_vector_type(8)));

constexpr int NB = 4, SEQ = 8192, DM = 2048, NT = NB * SEQ;
constexpr int NH = 16, QLORA = 512, KVLORA = 512, DNOPE = 128, DROPE = 64, DV = 128, DQK = 192;
constexpr int IN_COLS = 9280, NPROJ = 9472;
constexpr int PEER_H = 8, NKEYS = 128, TOPK = 16;
constexpr float DN_ALPHA = 1.189207115002721f;
constexpr float LN_EPS = 1e-5f, RMS_EPS = 1e-6f;
constexpr float QSCALE = 0.07216878364870322f * 1.4426950408889634f;
constexpr int NWAVES = 8, NTHREADS = 512;
constexpr float PU_SCALE = 1024.0f, PV_SCALE = 64.0f;
constexpr float SC_H = 16.0f, SC_WIN = 1024.0f, SC_RA = 4.0f, SC_AO = 32.0f, SC_TMP = 32.0f, SC_WSQ = 2048.0f;
constexpr float SC_Q = 64.0f, SC_K = 16.0f, SC_V = 16.0f, SC_P = 64.0f;

constexpr size_t MiB = 1u << 20;
constexpr size_t WS_CTL = 0, CTL_ZERO_BYTES = 1 * MiB;
constexpr size_t WS_MOD = 1 * MiB;
constexpr size_t WS_RS = 1 * MiB + 512 * 1024;
constexpr size_t WS_SSP = 100 * MiB;
constexpr size_t WS_ROPE = 2 * MiB;
constexpr size_t WS_WIN = 10 * MiB;
constexpr size_t WS_WRNN = 47 * MiB, WS_WMLA = 55 * MiB, WS_WO = 63 * MiB, WS_WPQ = 71 * MiB;
constexpr size_t WS_WUQ = 79 * MiB;
constexpr size_t WS_WUK = 82 * MiB, WS_WUV = 84 * MiB;
constexpr size_t WS_WGA = 86 * MiB;
constexpr size_t WS_WGX = 86 * MiB + 512 * 1024;
constexpr size_t WS_PKEYS = 87 * MiB;
constexpr size_t WS_SUMM = 88 * MiB;
constexpr size_t WS_KR = 90 * MiB;
constexpr size_t WS_S0 = 128 * MiB;
constexpr size_t WS_XR = 256 * MiB, WS_GG = 384 * MiB, WS_SGR = 512 * MiB, WS_SGM = 640 * MiB;
constexpr size_t WS_QKVC = 768 * MiB;
constexpr size_t WS_KVC8 = 800 * MiB;
constexpr size_t WS_TMP = 832 * MiB;
constexpr size_t WS_IDX = 960 * MiB, WS_GATE = 976 * MiB;
constexpr size_t WS_TMP8 = 768 * MiB;
constexpr size_t WS_K = 256 * MiB;
constexpr size_t WS_VT = 448 * MiB;
constexpr size_t WS_R1 = 256 * MiB;
constexpr size_t WS_PQ = 512 * MiB;
constexpr size_t WS_PU = 640 * MiB, WS_PV = 704 * MiB;
constexpr size_t WS_END = 1024 * MiB;
constexpr size_t WS_WQS = WS_WPQ + 4 * MiB;
constexpr size_t CTL_WQAMAX = 32768 * 4;
constexpr size_t WS_H2I = 768 * MiB;
constexpr size_t WS_HSC = 100 * MiB, WS_USC = 101 * MiB, WS_VSC = 102 * MiB;
constexpr size_t WS_AO8 = WS_S0 + 64 * MiB;
constexpr size_t OUT_Q = 0, OUT_K = 96 * MiB, OUT_VT = 192 * MiB;

constexpr int LDS_BYTES = 147456, LDSCTL_OFF = 146944;

typedef __bf16 bf16v2 __attribute__((ext_vector_type(2)));
__device__ __forceinline__ unsigned pk2(float lo, float hi) { const bf16v2 v = __builtin_convertvector((f32x2){lo, hi}, bf16v2); return __builtin_bit_cast(unsigned, v); }
__device__ __forceinline__ float bflo(unsigned w) { return __uint_as_float(w << 16); }
__device__ __forceinline__ float bfhi(unsigned w) { return __uint_as_float(w & 0xffff0000u); }
__device__ __forceinline__ float bf1(bf16 b) { return __uint_as_float(((unsigned)b) << 16); }
__device__ __forceinline__ float sigmoidf_(float y) { return __builtin_amdgcn_rcpf(1.0f + __builtin_amdgcn_exp2f(-1.4426950408889634f * y)); }
__device__ __forceinline__ f32x2 sigmoid2(f32x2 y) { const f32x2 e = y * -1.4426950408889634f; const f32x2 d = (f32x2){__builtin_amdgcn_exp2f(e.x), __builtin_amdgcn_exp2f(e.y)} + 1.0f; return (f32x2){__builtin_amdgcn_rcpf(d.x), __builtin_amdgcn_rcpf(d.y)}; }
__device__ __forceinline__ f32x2 gelu_tanh2(f32x2 x) { const f32x2 p = __builtin_elementwise_fma(x * x, (f32x2){0.044715f, 0.044715f}, (f32x2){1.0f, 1.0f});
    const f32x2 e = (x * p) * (-2.0f * 0.7978845608028654f * 1.4426950408889634f); const f32x2 d = (f32x2){__builtin_amdgcn_exp2f(e.x), __builtin_amdgcn_exp2f(e.y)} + 1.0f;
    return x * (f32x2){__builtin_amdgcn_rcpf(d.x), __builtin_amdgcn_rcpf(d.y)}; }
__device__ __forceinline__ float gelu_tanh(float x) { const float z = 0.7978845608028654f * (x + 0.044715f * x * x * x); return x * sigmoidf_(2.0f * z); }
__device__ __forceinline__ float wave_sum(float v) {
#pragma unroll
    for (int o = 1; o < 64; o <<= 1) v += __shfl_xor(v, o);
    return v;
}
__device__ __forceinline__ float clamp448(float v) { return __builtin_amdgcn_fmed3f(v, -448.0f, 448.0f); }
__device__ __forceinline__ unsigned pk4_f8(float a, float b, float c, float d) { int w = __builtin_amdgcn_cvt_pk_fp8_f32(clamp448(a), clamp448(b), 0, false); w = __builtin_amdgcn_cvt_pk_fp8_f32(clamp448(c), clamp448(d), w, true); return (unsigned)w; }
__device__ __forceinline__ int fresh_lane() { int l; asm volatile("v_mbcnt_lo_u32_b32 %0, -1, 0\n\tv_mbcnt_hi_u32_b32 %0, -1, %0" : "=v"(l)); return l; }
__device__ __forceinline__ float wave_max(float v) {
#pragma unroll
    for (int o = 1; o < 64; o <<= 1) v = fmaxf(v, __shfl_xor(v, o));
    return v;
}
__device__ __forceinline__ unsigned pk4_i8(float a, float b, float c, float d) {
    const int ia = (int)__builtin_rintf(__builtin_amdgcn_fmed3f(a, -127.f, 127.f)), ib = (int)__builtin_rintf(__builtin_amdgcn_fmed3f(b, -127.f, 127.f)), ic = (int)__builtin_rintf(__builtin_amdgcn_fmed3f(c, -127.f, 127.f)), id = (int)__builtin_rintf(__builtin_amdgcn_fmed3f(d, -127.f, 127.f));
    return (unsigned)(ia & 0xff) | ((unsigned)(ib & 0xff) << 8) | ((unsigned)(ic & 0xff) << 16) | ((unsigned)id << 24); }
#define LDS_WAIT() asm volatile("s_waitcnt lgkmcnt(0)" ::: "memory")
#define VM_WAIT() asm volatile("s_waitcnt vmcnt(0)" ::: "memory")

#define XB_TMO      128
#define XB_XCNT(j)  (256  + 64 * (j))
#define XB_XSUB(j)  (1280 + 64 * (j))
#define XB_XGEN(j)  (2304 + 64 * (j))
#define XB_TOP      3328
#define XB_TOPGEN   3392
#define XCD_BAR_WORDS 3456
#define XB_SPIN_CAP (1u << 20)
__device__ __forceinline__ unsigned xb_ld(unsigned* p)              { return __hip_atomic_load(p, __ATOMIC_RELAXED, __HIP_MEMORY_SCOPE_AGENT); }
__device__ __forceinline__ unsigned xb_add(unsigned* p, unsigned v) { return __hip_atomic_fetch_add(p, v, __ATOMIC_RELAXED, __HIP_MEMORY_SCOPE_AGENT); }
__device__ __forceinline__ unsigned xb_xcc_id() { return (unsigned)__builtin_amdgcn_s_getreg((3 << 11) | 20) & 0xFu; }
#define XB_SPIN(cond, bar) do { unsigned _sp = 0; while (cond) { __builtin_amdgcn_s_sleep(1); \
    if ((++_sp & 255u) == 0u) { if (xb_ld(&(bar)[XB_TMO])) break; if (_sp > XB_SPIN_CAP) { atomicAdd(&(bar)[XB_TMO], 1u); break; } } } } while (0)
struct XcdBarrier { unsigned* bar; unsigned x; volatile LAS unsigned* st; };
__device__ __forceinline__ XcdBarrier xcd_barrier_post(unsigned* bar, volatile LAS unsigned* st) {
    XcdBarrier b; b.bar = bar; b.x = xb_xcc_id(); b.st = st;
    if (threadIdx.x == 0) (void)xb_add(&bar[XB_XCNT(b.x)], 1u);
    return b;
}
__device__ __forceinline__ void xcd_barrier_complete(unsigned* bar, unsigned x, unsigned& nloc, unsigned& nx) {
    const unsigned G = gridDim.x * gridDim.y * gridDim.z;
    unsigned sum, cnt, mine, sp = 0u;
    for (;;) {
        sum = 0u; cnt = 0u; mine = 0u;
#pragma unroll
        for (unsigned j = 0; j < 16; ++j) { const unsigned c = xb_ld(&bar[XB_XCNT(j)]); sum += c; cnt += (c > 0u) ? 1u : 0u; mine = (j == x) ? c : mine; }
        if (sum == G) break;
        __builtin_amdgcn_s_sleep(1);
        if ((++sp & 255u) == 0u) { if (xb_ld(&bar[XB_TMO])) break; if (sp > XB_SPIN_CAP) { atomicAdd(&bar[XB_TMO], 1u); break; } }
    }
    nloc = mine > 0u ? mine : 1u; nx = cnt > 0u ? cnt : 1u;
}
__device__ __forceinline__ void xcd_barrier(const XcdBarrier& b) {
    asm volatile("s_waitcnt vmcnt(0)" ::: "memory");
    __syncthreads();
    if (threadIdx.x == 0) {
        unsigned* bar = b.bar;
        __builtin_amdgcn_s_waitcnt(0);
        unsigned nloc = b.st[0], nx = b.st[1];
        if (nloc == 0u) { xcd_barrier_complete(bar, b.x, nloc, nx); b.st[0] = nloc; b.st[1] = nx; }
        const unsigned old = xb_add(&bar[XB_XSUB(b.x)], 1u);
        const unsigned gen = old / nloc;
        if (old + 1u == (gen + 1u) * nloc) {
            __builtin_amdgcn_fence(__ATOMIC_RELEASE, "agent");
            asm volatile("s_waitcnt vmcnt(0)" ::: "memory");
            const unsigned og = xb_add(&bar[XB_TOP], 1u);
            const unsigned tg = og / nx;
            if (og + 1u == (tg + 1u) * nx) xb_add(&bar[XB_TOPGEN], 1u);
            else XB_SPIN(xb_ld(&bar[XB_TOPGEN]) == tg, bar);
            __builtin_amdgcn_fence(__ATOMIC_ACQUIRE, "agent");
            asm volatile("s_waitcnt vmcnt(0)" ::: "memory");
        } else {
            XB_SPIN(xb_ld(&bar[XB_TOPGEN]) == gen, bar);
            __builtin_amdgcn_fence(__ATOMIC_ACQUIRE, "agent");
            asm volatile("s_waitcnt vmcnt(0)" ::: "memory");
        }
    }
    __syncthreads();
}

__device__ __forceinline__ void glds16(const char* sbase, unsigned voff, unsigned lds_dst) {
    unsigned keep;
    asm volatile("s_mov_b32 %0, m0\n\ts_mov_b32 m0, %3\n\ts_nop 0\n\tglobal_load_lds_dwordx4 %1, %2\n\ts_mov_b32 m0, %0" : "=&s"(keep) : "v"(voff), "s"(sbase), "s"(lds_dst) : "memory");
}
namespace pg8 {
constexpr int BM = 256, BK = 64, HALF = 128, HTB = HALF * BK * 2, STAGE_BYTES = 8 * HTB, NXCD = 8, WGM = 4;
__host__ __device__ __forceinline__ int lds_byte(int r, int c) { const int st = (r >> 4) * 2 + (c >> 5), rr = r & 15, cc = c & 31, ob = rr * 64 + cc * 2; return st * 1024 + (ob ^ (((ob >> 9) & 1) << 5)); }
__host__ __device__ __forceinline__ void stage_rc(int b, int& R, int& C) { const int st = b / 1024, sb = b % 1024, swz = sb ^ (((sb >> 9) & 1) << 5); R = (st >> 1) * 16 + swz / 64; C = (st & 1) * 32 + (swz % 64) / 2; }
__host__ __device__ __forceinline__ int perm32(int rho) { const int n = rho >> 4, i = rho & 15; return 8 * (i >> 2) + 4 * n + (i & 3); }
struct Unit { int pm, pn; };
struct Gemm { const void* A; const void* Bt; int M, N, nt, lda_b, ldb_b; const void* A2 = nullptr; const void* Bt2 = nullptr; int nt1 = 0; };
__host__ __device__ __forceinline__ Gemm gemm_bf16(const bf16* A, const bf16* Bt, int M, int N, int K, int lda, int ldb) { return Gemm{A, Bt, M, N, K / 64, lda * 2, ldb * 2}; }
__host__ __device__ __forceinline__ Gemm gemm_f8(const unsigned char* A, const unsigned char* Bt, int M, int N, int K, int lda, int ldb) { return Gemm{A, Bt, M, N, K / 128, lda, ldb}; }
struct StaticOrder {
    int nM, nN, nwg, G, c;
    __host__ __device__ void init(int M, int N, int G_, int c_) { nM = M / BM; nN = N / BM; nwg = nM * nN; G = G_; c = c_; }
    __host__ __device__ bool next(int i, Unit& u) const {
        const long L = (long)i * G + c; if (L >= nwg) return false;
        int wgid = (int)L; { const int q = nwg / NXCD, r = nwg % NXCD, xcd = wgid % NXCD, off = wgid / NXCD; wgid = (xcd < r ? xcd * (q + 1) : r * (q + 1) + (xcd - r) * q) + off; }
        const int nig = WGM * nN, gid = wgid / nig, fm = gid * WGM, gsz = (nM - fm) < WGM ? (nM - fm) : WGM;
        u.pm = fm + ((wgid % nig) % gsz); u.pn = (wgid % nig) / gsz; return true;
    }
    __device__ __forceinline__ void a_ready(const Unit&) const {}
    __device__ __forceinline__ void done(const Unit&) const {}
};
template <class Epi, class Sched, int F8 = 0, bool ALIGN_EPI = true>
__device__ __forceinline__ void gemm_phase(LAS unsigned char* lds, const Gemm g, const Sched& S, const Epi& E, int wid) {
    const int lane = fresh_lane(), tid = wid * 64 + lane, wr = wid >> 2, wc = wid & 3, fr = lane & 15, fq = lane >> 4;
    const int nt = g.nt;
    unsigned voffA, voffB;
    { int R, C; stage_rc(tid * 16, R, C); const int Rb = Epi::PERM ? ((R & ~31) + perm32(R & 31)) : R; voffA = (unsigned)(R * g.lda_b + C * 2); voffB = (unsigned)(Rb * g.ldb_b + C * 2); }
    const size_t qstepA = (size_t)64 * g.lda_b, qstepB = (size_t)64 * g.ldb_b;
    const unsigned ldsbase = (unsigned)(size_t)lds;
    const size_t kstep = (size_t)(BK * 2);
    const size_t hstepA = (size_t)HALF * g.lda_b, hstepB = (size_t)HALF * g.ldb_b;
    const size_t tstepA = 2 * hstepA, tstepB = 2 * hstepB;
    const unsigned ldsw = (unsigned)wid * 1024u;
    const int aoff = lds_byte(wr * 64 + fr, fq * 8), boff = lds_byte(wc * 32 + fr, fq * 8);
#define PG8_SA(b, h) (((b) * 2 + (h)) * HTB)
#define PG8_SB(b, h) ((4 + (b) * 2 + (h)) * HTB)
#define PG8_STAGE_A(bufoff, gbase) do { glds16((const char*)(gbase), voffA, ldsbase + (bufoff) + ldsw); glds16((const char*)(gbase) + qstepA, voffA, ldsbase + (bufoff) + ldsw + 8192); } while (0)
#define PG8_STAGE_B(bufoff, gbase) do { glds16((const char*)(gbase), voffB, ldsbase + (bufoff) + ldsw); glds16((const char*)(gbase) + qstepB, voffB, ldsbase + (bufoff) + ldsw + 8192); } while (0)
#define PG8_LD8(p) __builtin_shufflevector(*(const LAS i32x4*)(p), *(const LAS i32x4*)((p) + 1024), 0, 1, 2, 3, 4, 5, 6, 7)
#define PG8_LDA(dst, b, h) do { _Pragma("unroll") for (int m = 0; m < 4; ++m) dst[m] = PG8_LD8(lds + PG8_SA(b, h) + aoff + m * 2048); } while (0)
#define PG8_LDB(dst, b, h) do { _Pragma("unroll") for (int n = 0; n < 2; ++n) dst[n] = PG8_LD8(lds + PG8_SB(b, h) + boff + n * 2048); } while (0)
#define PG8_LO(v) __builtin_bit_cast(bf16x8, __builtin_shufflevector(v, v, 0, 1, 2, 3))
#define PG8_HI(v) __builtin_bit_cast(bf16x8, __builtin_shufflevector(v, v, 4, 5, 6, 7))
#define PG8_MMA(ai, bj, At, Bt) do { __builtin_amdgcn_s_setprio(1); _Pragma("unroll") for (int m = 0; m < 4; ++m) _Pragma("unroll") for (int n = 0; n < 2; ++n) { \
        if constexpr (F8 == 1) acc[ai][bj][m][n] = __builtin_amdgcn_mfma_scale_f32_16x16x128_f8f6f4(Bt[n], At[m], acc[ai][bj][m][n], 0, 0, 0, 0x7F7F7F7F, 0, 0x7F7F7F7F); \
        else if constexpr (F8 == 2) { i32x4 ci = __builtin_bit_cast(i32x4, acc[ai][bj][m][n]); \
               ci = __builtin_amdgcn_mfma_i32_16x16x64_i8(__builtin_shufflevector(Bt[n], Bt[n], 0, 1, 2, 3), __builtin_shufflevector(At[m], At[m], 0, 1, 2, 3), ci, 0, 0, 0); \
               ci = __builtin_amdgcn_mfma_i32_16x16x64_i8(__builtin_shufflevector(Bt[n], Bt[n], 4, 5, 6, 7), __builtin_shufflevector(At[m], At[m], 4, 5, 6, 7), ci, 0, 0, 0); \
               acc[ai][bj][m][n] = __builtin_bit_cast(f32x4, ci); } \
        else { acc[ai][bj][m][n] = __builtin_amdgcn_mfma_f32_16x16x32_bf16(PG8_LO(Bt[n]), PG8_LO(At[m]), acc[ai][bj][m][n], 0, 0, 0); \
               acc[ai][bj][m][n] = __builtin_amdgcn_mfma_f32_16x16x32_bf16(PG8_HI(Bt[n]), PG8_HI(At[m]), acc[ai][bj][m][n], 0, 0, 0); } } \
        __builtin_amdgcn_s_setprio(0); } while (0)
#define PG8_WAIT_V(n) asm volatile("s_waitcnt vmcnt(" #n ")" ::: "memory")
#define PG8_WAIT_L(n) asm volatile("s_waitcnt lgkmcnt(" #n ")" ::: "memory")
#define PG8_BAR __builtin_amdgcn_s_barrier()
#define PG8_SCHED __builtin_amdgcn_sched_barrier(0)
    Unit cur, nxt; int ui = 0;
    if (!S.next(0, cur)) return;
    f32x4 acc[2][2][4][2];
#pragma unroll
    for (int a = 0; a < 2; ++a)
#pragma unroll
        for (int b = 0; b < 2; ++b)
#pragma unroll
            for (int m = 0; m < 4; ++m)
#pragma unroll
                for (int n = 0; n < 2; ++n) acc[a][b][m][n] = (f32x4){0.f, 0.f, 0.f, 0.f};
    i32x8 At[4], B0[2], B1[2];
    const char* cA = (const char*)g.A + (size_t)cur.pm * tstepA; const char* cB = (const char*)g.Bt + (size_t)cur.pn * tstepB;
    const bool two = g.A2 != nullptr; const int nt1 = two ? g.nt1 : nt;
    const char* cA2 = two ? (const char*)g.A2 + (size_t)cur.pm * tstepA : cA; const char* cB2 = two ? (const char*)g.Bt2 + (size_t)cur.pn * tstepB : cB;
    S.a_ready(cur);
    PG8_STAGE_B(PG8_SB(0, 0), cB); PG8_STAGE_B(PG8_SB(0, 1), cB + hstepB); PG8_STAGE_A(PG8_SA(0, 0), cA); PG8_STAGE_A(PG8_SA(0, 1), cA + hstepA);
    if (wr == 1) PG8_BAR;
    PG8_WAIT_V(2); PG8_BAR;
    PG8_STAGE_B(PG8_SB(1, 0), cB + kstep); PG8_STAGE_A(PG8_SA(1, 0), cA + kstep); PG8_STAGE_B(PG8_SB(1, 1), cB + hstepB + kstep);
    PG8_WAIT_V(6); PG8_BAR;
    for (;;) {
        const bool has_next = S.next(ui + 1, nxt);
        const char* nA = has_next ? (const char*)g.A + (size_t)nxt.pm * tstepA : cA; const char* nB = has_next ? (const char*)g.Bt + (size_t)nxt.pn * tstepB : cB;
#pragma unroll 1
        for (int t = 0; t < nt; t += 2) {
            const bool last = (t == nt - 2);
            const char* a1 = (t < nt1 ? cA + (size_t)t * kstep : cA2 + (size_t)(t - nt1) * kstep) + kstep;
            const char* a2 = last ? nA : (t + 2 < nt1 ? cA + (size_t)(t + 2) * kstep : cA2 + (size_t)(t + 2 - nt1) * kstep);
            const char* b2 = last ? nB : (t + 2 < nt1 ? cB + (size_t)(t + 2) * kstep : cB2 + (size_t)(t + 2 - nt1) * kstep);
            const char* a3 = a2 + kstep; const char* b3 = b2 + kstep;
            if (last && has_next) S.a_ready(nxt);
            PG8_LDB(B0, 0, 0); PG8_LDB(B1, 0, 1); PG8_SCHED; PG8_LDA(At, 0, 0); PG8_STAGE_A(PG8_SA(1, 1), a1 + hstepA);
            PG8_WAIT_V(8); PG8_WAIT_L(0); PG8_BAR; PG8_MMA(0, 0, At, B0); PG8_MMA(0, 1, At, B1); PG8_BAR; PG8_SCHED;
            PG8_LDA(At, 0, 1); PG8_STAGE_B(PG8_SB(0, 0), b2); PG8_STAGE_B(PG8_SB(0, 1), b2 + hstepB); PG8_STAGE_A(PG8_SA(0, 0), a2);
            PG8_WAIT_V(8); PG8_WAIT_L(0); PG8_BAR; PG8_MMA(1, 0, At, B0); PG8_MMA(1, 1, At, B1); PG8_BAR; PG8_SCHED;
            PG8_LDB(B0, 1, 0); PG8_LDB(B1, 1, 1); PG8_SCHED; PG8_LDA(At, 1, 0); PG8_STAGE_A(PG8_SA(0, 1), a2 + hstepA);
            PG8_WAIT_V(8); PG8_WAIT_L(0); PG8_BAR; PG8_MMA(0, 0, At, B0); PG8_MMA(0, 1, At, B1); PG8_BAR; PG8_SCHED;
            PG8_LDA(At, 1, 1); PG8_STAGE_B(PG8_SB(1, 0), b3); PG8_STAGE_B(PG8_SB(1, 1), b3 + hstepB); PG8_STAGE_A(PG8_SA(1, 0), a3);
            PG8_WAIT_V(8); PG8_WAIT_L(0); PG8_BAR; PG8_MMA(1, 0, At, B0); PG8_MMA(1, 1, At, B1); PG8_BAR; PG8_SCHED;
            if constexpr (Epi::HAS_MID) { if (t + 2 == nt1) { int fr2 = fr, fq2 = fq; asm volatile("" : "+v"(fr2), "+v"(fq2)); E.mid(acc, cur, wr, wc, fr2, fq2); } }
        }
        if constexpr (ALIGN_EPI) { if (wr == 0) PG8_BAR; }
        { int fr2 = fr, fq2 = fq; asm volatile("" : "+v"(fr2), "+v"(fq2));
          E(acc, cur, wr, wc, fr2, fq2); }
        if (!has_next) break;
#pragma unroll
        for (int a = 0; a < 2; ++a)
#pragma unroll
            for (int b = 0; b < 2; ++b)
#pragma unroll
                for (int m = 0; m < 4; ++m)
#pragma unroll
                    for (int n = 0; n < 2; ++n) acc[a][b][m][n] = (f32x4){0.f, 0.f, 0.f, 0.f};
        cur = nxt; cA = nA; cB = nB; ++ui;
        if (two) { cA2 = (const char*)g.A2 + (size_t)cur.pm * tstepA; cB2 = (const char*)g.Bt2 + (size_t)cur.pn * tstepB; } else { cA2 = cA; cB2 = cB; }
        if constexpr (ALIGN_EPI) { if (wr == 1) PG8_BAR; }
    }
    PG8_WAIT_V(0);
    if constexpr (!ALIGN_EPI) { if (wr == 0) PG8_BAR; }
    PG8_BAR;
#undef PG8_SA
#undef PG8_SB
#undef PG8_STAGE_A
#undef PG8_STAGE_B
#undef PG8_LDA
#undef PG8_LDB
#undef PG8_LD8
#undef PG8_LO
#undef PG8_HI
#undef PG8_MMA
#undef PG8_WAIT_V
#undef PG8_WAIT_L
#undef PG8_BAR
#undef PG8_SCHED
}
}
typedef f32x4 AccT[2][2][4][2];

#ifdef PROBE_RELAUNCH
struct Args { const float* in[28]; float* out; unsigned char* ws; int ph_lo, ph_hi, bslot; };
#else
struct Args { const float* in[28]; float* out; unsigned char* ws; int ph_lo, ph_hi; };
#endif
struct Frame {
    LAS unsigned char* lds; int tid, lane, wave, G, blk;
    const float *x, *c, *w_ada, *b_ada, *w_in, *conv_w, *conv_b, *w_rg_a, *b_rg_a, *w_rg_x, *b_rg_x, *rg_lambda, *w_rnn_out, *q_norm_g, *w_uq, *kv_norm_g, *w_ukv,
                *w_mla_out, *w_o, *ln1_g, *ln1_b, *peer_wq, *peer_keys, *peer_u, *peer_v, *ln2_g, *ln2_b;
    const int* positions;
    float* out; unsigned char* ws;
};
#define WSP(T, off) ((T*)(F.ws + (off)))

template <int MAP> __device__ __forceinline__ int colmap(int n) {
    if (MAP == 0) return n;
    if (MAP == 1) return n < 5120 ? n : (n < 9216 ? n + 64 : (n < 9280 ? n - 4096 : -1));
    if (MAP == 2) { if (n < 2048) return (n >> 7) * 192 + (n & 127); const int m = n - 2048, h = m >> 6, jj = m & 63; return h * 192 + 128 + (jj >> 1) + 32 * (jj & 1); }
    if (MAP == 3) return (n >> 7) * 256 + (n & 127);
    return (n >> 7) * 256 + 128 + (n & 127);
}
template <int MAP, bool F8> __device__ __forceinline__ void tr_item64(const float* W, int ldw, void* WTv, int ldt, float scale, const float* kscale, LAS float* scr, int k0, int n0, int lane) {
    const int col = colmap<MAP>(n0 + lane);
    const int cc = col >= 0 ? col : 0; const float cs = col >= 0 ? scale : 0.f;
    const float ksl = kscale ? kscale[k0 + lane] : 1.f;
    float wv[64];
#pragma unroll
    for (int kk = 0; kk < 64; ++kk) wv[kk] = W[(size_t)(k0 + kk) * ldw + cc];
#pragma unroll
    for (int kk = 0; kk < 64; ++kk) scr[kk * 65 + lane] = wv[kk] * cs * __builtin_bit_cast(float, __builtin_amdgcn_readlane(__builtin_bit_cast(int, ksl), kk));
    LDS_WAIT();
    const LAS float* sp = scr + lane;
    if (F8) { unsigned char* o = (unsigned char*)WTv + (size_t)(n0 + lane) * ldt + k0;
#pragma unroll
        for (int q = 0; q < 4; ++q) { u32x4 w;
#pragma unroll
            for (int d = 0; d < 4; ++d) { const int k = 16 * q + 4 * d; w[d] = pk4_f8(sp[k * 65], sp[(k + 1) * 65], sp[(k + 2) * 65], sp[(k + 3) * 65]); }
            *(u32x4*)(o + 16 * q) = w; }
    } else { bf16* o = (bf16*)WTv + (size_t)(n0 + lane) * ldt + k0;
#pragma unroll
        for (int q = 0; q < 8; ++q) { u32x4 w;
#pragma unroll
            for (int d = 0; d < 4; ++d) { const int k = 8 * q + 2 * d; w[d] = pk2(sp[k * 65], sp[(k + 1) * 65]); }
            *(u32x4*)(o + 8 * q) = w; } }
    LDS_WAIT();
}
__device__ __forceinline__ void p0_prologue(Frame& F, int qbank = 0) {
    const int tid = F.tid, lane = F.lane;
    if (F.blk < 192) {
        LAS float* ca = (LAS float*)F.lds; LAS float* red = (LAS float*)(F.lds + 32768);
        for (int i = tid; i < NB * DM; i += NTHREADS) { const float v = F.c[i]; ca[i] = v * sigmoidf_(v); }
        __syncthreads();
        const int cq = tid & 15, rg = tid >> 4, c0 = 64 * F.blk + 4 * cq;
        f32x4 a0 = {0, 0, 0, 0}, a1 = a0, a2 = a0, a3 = a0;
#pragma unroll 8
        for (int k = rg; k < DM; k += 32) { const f32x4 w = *(const f32x4*)(F.w_ada + (size_t)k * 12288 + c0);
            a0 += ca[k] * w; a1 += ca[DM + k] * w; a2 += ca[2 * DM + k] * w; a3 += ca[3 * DM + k] * w; }
        *(LAS f32x4*)(red + (rg * 4 + 0) * 64 + 4 * cq) = a0; *(LAS f32x4*)(red + (rg * 4 + 1) * 64 + 4 * cq) = a1;
        *(LAS f32x4*)(red + (rg * 4 + 2) * 64 + 4 * cq) = a2; *(LAS f32x4*)(red + (rg * 4 + 3) * 64 + 4 * cq) = a3;
        __syncthreads();
        if (tid < 256) { const int b = tid >> 6, col = tid & 63; float s = 0.f;
            for (int r = 0; r < 32; ++r) s += red[(r * 4 + b) * 64 + col];
            WSP(float, WS_MOD)[b * 12288 + 64 * F.blk + col] = s + F.b_ada[64 * F.blk + col]; }
        __syncthreads();
    }
    {
        LAS float* scr = (LAS float*)(F.lds + F.wave * 16640);
        unsigned* qhead = (unsigned*)(F.ws + WS_CTL) + 8192 + 2048 * qbank + 64 * (F.blk & 31);
        constexpr int I_IN = (NPROJ / 64) * (DM / 64), I_SQ = (DM / 64) * (DM / 64), I_UQ = (3072 / 64) * (512 / 64), I_UK = (2048 / 64) * (512 / 64), I_RG = 16 * 2 * 2;
        constexpr int NITEMS = I_IN + 4 * I_SQ + I_UQ + 2 * I_UK + 2 * I_RG;
        int nxt = 0; if (lane == 0) nxt = (int)__hip_atomic_fetch_add(qhead, 1u, __ATOMIC_RELAXED, __HIP_MEMORY_SCOPE_AGENT);
        for (;;) {
            const int it = __builtin_amdgcn_readfirstlane(nxt) * 32 + (F.blk & 31); if (it >= NITEMS) break;
            if (lane == 0) nxt = (int)__hip_atomic_fetch_add(qhead, 1u, __ATOMIC_RELAXED, __HIP_MEMORY_SCOPE_AGENT);
            int r = it;
            if (r < I_IN) { tr_item64<1, true>(F.w_in, IN_COLS, WSP(unsigned char, WS_WIN), DM, SC_WIN, nullptr, scr, 64 * (r / (NPROJ / 64)), 64 * (r % (NPROJ / 64)), lane); continue; } r -= I_IN;
            if (r < I_SQ) { tr_item64<0, true>(F.w_rnn_out, DM, WSP(unsigned char, WS_WRNN), DM, SC_WSQ, nullptr, scr, 64 * (r / 32), 64 * (r % 32), lane); continue; } r -= I_SQ;
            if (r < I_SQ) { tr_item64<0, true>(F.w_mla_out, DM, WSP(unsigned char, WS_WMLA), DM, SC_WSQ, nullptr, scr, 64 * (r / 32), 64 * (r % 32), lane); continue; } r -= I_SQ;
            if (r < I_SQ) { tr_item64<0, true>(F.w_o, DM, WSP(unsigned char, WS_WO), DM, SC_WSQ, nullptr, scr, 64 * (r / 32), 64 * (r % 32), lane); continue; } r -= I_SQ;
            if (r < I_SQ) {
                const int k0 = 64 * (r / 32), n0 = 64 * (r % 32); float am = 0.f;
#pragma unroll
                for (int kk = 0; kk < 64; ++kk) am = fmaxf(am, fabsf(F.peer_wq[(size_t)(k0 + kk) * DM + n0 + lane]));
                (void)__hip_atomic_fetch_max((unsigned*)(F.ws + WS_CTL + CTL_WQAMAX) + n0 + lane, __float_as_uint(am), __ATOMIC_RELAXED, __HIP_MEMORY_SCOPE_AGENT);
                continue; } r -= I_SQ;
            if (r < I_UQ) { tr_item64<2, true>(F.w_uq, 3072, WSP(unsigned char, WS_WUQ), 512, SC_WIN, F.q_norm_g, scr, 64 * (r / 48), 64 * (r % 48), lane); continue; } r -= I_UQ;
            if (r < I_UK) { tr_item64<3, true>(F.w_ukv, 4096, WSP(unsigned char, WS_WUK), 512, SC_WIN, F.kv_norm_g, scr, 64 * (r / 32), 64 * (r % 32), lane); continue; } r -= I_UK;
            if (r < I_UK) { tr_item64<4, true>(F.w_ukv, 4096, WSP(unsigned char, WS_WUV), 512, SC_WIN, F.kv_norm_g, scr, 64 * (r / 32), 64 * (r % 32), lane); continue; } r -= I_UK;
            if (r < I_RG) { const int h = r >> 2, q = r & 3; tr_item64<0, false>(F.w_rg_a + h * 16384, 128, WSP(bf16, WS_WGA) + h * 16384, 128, 1.0f, nullptr, scr, 64 * (q >> 1), 64 * (q & 1), lane); continue; } r -= I_RG;
            { const int h = r >> 2, q = r & 3; tr_item64<0, false>(F.w_rg_x + h * 16384, 128, WSP(bf16, WS_WGX) + h * 16384, 128, 1.0f, nullptr, scr, 64 * (q >> 1), 64 * (q & 1), lane); }
        }
    }
    {
        const int gt = F.blk * NTHREADS + tid, NGT = F.G * NTHREADS;
        f32x2* rope = WSP(f32x2, WS_ROPE);
        for (int i = gt; i < NT * 32; i += NGT) { const int t = i >> 5, j = i & 31;
            const float inv_freq = exp2f(-(float)j * (13.287712379549449f / 32.0f));
            const float ang = (float)F.positions[t] * inv_freq;
            double rev = (double)ang * 0.15915494309189535; rev -= rint(rev);
            const float rv = (float)rev;
            rope[i] = (f32x2){__builtin_amdgcn_cosf(rv), __builtin_amdgcn_sinf(rv)}; }
        bf16* pk = WSP(bf16, WS_PKEYS);
        for (int i = gt; i < 2 * 128 * 128 / 2; i += NGT) { const f32x2 v = *(const f32x2*)(F.peer_keys + 2 * i); ((unsigned*)pk)[i] = pk2(v.x, v.y); }
    }
}

__device__ __forceinline__ void p1_modulate(Frame& F) {
    const int gw = F.blk * NWAVES + F.wave, NGW = F.G * NWAVES;
    const float* mod = WSP(float, WS_MOD); unsigned char* hb = WSP(unsigned char, WS_S0);
    for (int m = gw; m < NT; m += NGW) {
        const int b = m >> 13; const float* sh = mod + b * 12288; const float* sc = sh + 2048;
#pragma unroll
        for (int j = 0; j < 2; ++j) { const int col = 1024 * j + 16 * F.lane; u32x4 o;
#pragma unroll
            for (int q = 0; q < 4; ++q) { const f32x4 v = *(const f32x4*)(F.x + (size_t)m * DM + col + 4 * q), s = *(const f32x4*)(sc + col + 4 * q), h = *(const f32x4*)(sh + col + 4 * q);
                o[q] = pk4_f8((v.x * (1.f + s.x) + h.x) * SC_H, (v.y * (1.f + s.y) + h.y) * SC_H, (v.z * (1.f + s.z) + h.z) * SC_H, (v.w * (1.f + s.w) + h.w) * SC_H); }
            *(u32x4*)(hb + (size_t)m * DM + col) = o; }
    }
    if (F.wave < 4) {
        const int lane = F.lane, it = F.blk * 4 + F.wave;
        LAS float* scr = (LAS float*)(F.lds + F.wave * 16640);
        for (int r = it; r < 1024; r += 4 * F.G) {
            const int k0 = 64 * (r / 32), n0 = 64 * (r % 32);
            const float am = fmaxf(__uint_as_float(((const unsigned*)(F.ws + WS_CTL + CTL_WQAMAX))[n0 + lane]), 1e-30f), qs = 127.0f / am;
#pragma unroll
            for (int kk = 0; kk < 64; ++kk) scr[kk * 65 + lane] = F.peer_wq[(size_t)(k0 + kk) * DM + n0 + lane];
            LDS_WAIT();
            if (k0 == 0) WSP(float, WS_WQS)[n0 + lane] = am * (1.0f / 127.0f);
            const LAS float* sp = scr + lane;
            unsigned char* o = WSP(unsigned char, WS_WPQ) + (size_t)(n0 + lane) * DM + k0;
#pragma unroll
            for (int q = 0; q < 4; ++q) { u32x4 w;
#pragma unroll
                for (int d = 0; d < 4; ++d) { const int k = 16 * q + 4 * d; w[d] = pk4_i8(sp[k * 65] * qs, sp[(k + 1) * 65] * qs, sp[(k + 2) * 65] * qs, sp[(k + 3) * 65] * qs); }
                *(u32x4*)(o + 16 * q) = w; }
            LDS_WAIT();
        }
    }
}

#define EPI_ROWS(...) _Pragma("unroll") for (int ai = 0; ai < 2; ++ai) _Pragma("unroll") for (int m = 0; m < 4; ++m) { const int row = u.pm * 256 + ai * 128 + wr * 64 + m * 16 + fr; \
    _Pragma("unroll") for (int bj = 0; bj < 2; ++bj) { const int cl = bj * 128 + wc * 32 + 8 * fq; const f32x4 v0 = acc[ai][bj][m][0] * esc, v1 = acc[ai][bj][m][1] * esc; __VA_ARGS__ } }
__device__ __forceinline__ u32x4 pack8(const f32x4 a, const f32x4 b) { return (u32x4){pk2(a.x, a.y), pk2(a.z, a.w), pk2(b.x, b.y), pk2(b.z, b.w)}; }

struct EpiProj {
    static constexpr bool HAS_MID = false;
    static constexpr bool PERM = true;
    bf16 *XR, *GG; unsigned char *QC8, *KVC8; bf16 *SGR, *SGM; float *KR, *SS; float esc;
    __device__ __forceinline__ void operator()(const AccT& acc, const pg8::Unit& u, int wr, int wc, int fr, int fq) const {
        const int pn = u.pn;
        if (pn < 8) { bf16* O = XR + pn * 256;
            EPI_ROWS( *(u32x4*)(O + (size_t)row * DM + cl) = pack8(v0, v1); )
        } else if (pn < 16) { bf16* O = GG + (pn - 8) * 256;
            EPI_ROWS( const f32x2 g0 = gelu_tanh2((f32x2){v0.x, v0.y}), g1 = gelu_tanh2((f32x2){v0.z, v0.w}), g2 = gelu_tanh2((f32x2){v1.x, v1.y}), g3 = gelu_tanh2((f32x2){v1.z, v1.w});
                *(u32x4*)(O + (size_t)row * DM + cl) = (u32x4){pk2(g0.x, g0.y), pk2(g1.x, g1.y), pk2(g2.x, g2.y), pk2(g3.x, g3.y)}; )
        } else if (pn < 20) { const int which = (pn >= 18); const int c0 = (pn & 1) * 256;
#pragma unroll
            for (int ai = 0; ai < 2; ++ai)
#pragma unroll
                for (int m = 0; m < 4; ++m) { const int row = u.pm * 256 + ai * 128 + wr * 64 + m * 16 + fr; float s = 0.f;
#pragma unroll
                    for (int bj = 0; bj < 2; ++bj) { const int cl = bj * 128 + wc * 32 + 8 * fq; const f32x4 v0 = acc[ai][bj][m][0] * esc, v1 = acc[ai][bj][m][1] * esc;
                        *(u32x2*)((which ? KVC8 : QC8) + (size_t)row * 512 + c0 + cl) = (u32x2){pk4_f8(v0.x * SC_H, v0.y * SC_H, v0.z * SC_H, v0.w * SC_H), pk4_f8(v1.x * SC_H, v1.y * SC_H, v1.z * SC_H, v1.w * SC_H)};
                        s += (v0.x * v0.x + v0.y * v0.y) + (v0.z * v0.z + v0.w * v0.w) + (v1.x * v1.x + v1.y * v1.y) + (v1.z * v1.z + v1.w * v1.w); }
                    SS[(size_t)row * 64 + which * 32 + (pn & 1) * 16 + wc * 4 + fq] = s; }
        } else if (pn < 36) { bf16* O = (pn < 28 ? SGR + (pn - 20) * 256 : SGM + (pn - 28) * 256);
            EPI_ROWS( const f32x2 g0 = sigmoid2((f32x2){v0.x, v0.y}), g1 = sigmoid2((f32x2){v0.z, v0.w}), g2 = sigmoid2((f32x2){v1.x, v1.y}), g3 = sigmoid2((f32x2){v1.z, v1.w});
                *(u32x4*)(O + (size_t)row * DM + cl) = (u32x4){pk2(g0.x, g0.y), pk2(g1.x, g1.y), pk2(g2.x, g2.y), pk2(g3.x, g3.y)}; )
        } else {
            EPI_ROWS( if (cl < 64) { *(f32x4*)(KR + (size_t)row * 64 + cl) = v0; *(f32x4*)(KR + (size_t)row * 64 + cl + 4) = v1; } )
        }
    }
};
struct EpiGate1 {
    static constexpr bool HAS_MID = false;
    static constexpr bool PERM = true; const bf16* SG; bf16* O; float esc;
    __device__ __forceinline__ void operator()(const AccT& acc, const pg8::Unit& u, int wr, int wc, int fr, int fq) const {
        EPI_ROWS( const size_t off = (size_t)row * DM + u.pn * 256 + cl; const u32x4 g = *(const u32x4*)(SG + off);
            f32x4 a = {v0.x * bflo(g.x), v0.y * bfhi(g.x), v0.z * bflo(g.y), v0.w * bfhi(g.y)}, b = {v1.x * bflo(g.z), v1.y * bfhi(g.z), v1.z * bflo(g.w), v1.w * bfhi(g.w)};
            *(u32x4*)(O + off) = pack8(a, b); )
    }
};
struct EpiGate2 {
    static constexpr bool HAS_MID = false;
    static constexpr bool PERM = true; const bf16* SG; const bf16* T; unsigned char* O8; float esc;
    __device__ __forceinline__ void operator()(const AccT& acc, const pg8::Unit& u, int wr, int wc, int fr, int fq) const {
        EPI_ROWS( const size_t off = (size_t)row * DM + u.pn * 256 + cl; const u32x4 g = *(const u32x4*)(SG + off); const u32x4 p = *(const u32x4*)(T + off);
            *(u32x2*)(O8 + off) = (u32x2){pk4_f8((bflo(p.x) + v0.x * bflo(g.x)) * SC_TMP, (bfhi(p.x) + v0.y * bfhi(g.x)) * SC_TMP, (bflo(p.y) + v0.z * bflo(g.y)) * SC_TMP, (bfhi(p.y) + v0.w * bfhi(g.y)) * SC_TMP),
                                          pk4_f8((bflo(p.z) + v1.x * bflo(g.z)) * SC_TMP, (bfhi(p.z) + v1.y * bfhi(g.z)) * SC_TMP, (bflo(p.w) + v1.z * bflo(g.w)) * SC_TMP, (bfhi(p.w) + v1.w * bfhi(g.w)) * SC_TMP)}; )
    }
};
struct EpiMix {
    static constexpr bool HAS_MID = true;
    static constexpr bool PERM = true; const bf16* SGR; const bf16* SGM; unsigned char* O8; float r12, e2;
    __device__ __forceinline__ void mid(AccT& acc, const pg8::Unit& u, int wr, int wc, int fr, int fq) const {
#pragma unroll
        for (int ai = 0; ai < 2; ++ai) {
            u32x4 gr[8], gm[8];
#pragma unroll
            for (int m = 0; m < 4; ++m)
#pragma unroll
                for (int bj = 0; bj < 2; ++bj) { const size_t off = (size_t)(u.pm * 256 + ai * 128 + wr * 64 + m * 16 + fr) * DM + u.pn * 256 + bj * 128 + wc * 32 + 8 * fq;
                    gr[m * 2 + bj] = *(const u32x4*)(SGR + off); gm[m * 2 + bj] = *(const u32x4*)(SGM + off); }
            __builtin_amdgcn_sched_barrier(0);
#pragma unroll
            for (int m = 0; m < 4; ++m)
#pragma unroll
                for (int bj = 0; bj < 2; ++bj) { const u32x4 r = gr[m * 2 + bj], d = gm[m * 2 + bj];
                    const f32x4 n0 = {bflo(r.x), bfhi(r.x), bflo(r.y), bfhi(r.y)}, n1 = {bflo(r.z), bfhi(r.z), bflo(r.w), bfhi(r.w)};
                    const f32x4 d0 = {bflo(d.x), bfhi(d.x), bflo(d.y), bfhi(d.y)}, d1 = {bflo(d.z), bfhi(d.z), bflo(d.w), bfhi(d.w)};
#pragma unroll
                    for (int e = 0; e < 4; ++e) { acc[ai][bj][m][0][e] *= r12 * n0[e] * __builtin_amdgcn_rcpf(fmaxf(d0[e], 1e-12f)); acc[ai][bj][m][1][e] *= r12 * n1[e] * __builtin_amdgcn_rcpf(fmaxf(d1[e], 1e-12f)); } }
            __builtin_amdgcn_sched_barrier(0);
        }
    }
    __device__ __forceinline__ void operator()(const AccT& acc, const pg8::Unit& u, int wr, int wc, int fr, int fq) const {
        const float esc = e2 * SC_TMP;
#pragma unroll
        for (int ai = 0; ai < 2; ++ai) {
            u32x4 gmv[8];
#pragma unroll
            for (int m = 0; m < 4; ++m)
#pragma unroll
                for (int bj = 0; bj < 2; ++bj) gmv[m * 2 + bj] = *(const u32x4*)(SGM + (size_t)(u.pm * 256 + ai * 128 + wr * 64 + m * 16 + fr) * DM + u.pn * 256 + bj * 128 + wc * 32 + 8 * fq);
            __builtin_amdgcn_sched_barrier(0);
#pragma unroll
            for (int m = 0; m < 4; ++m)
#pragma unroll
                for (int bj = 0; bj < 2; ++bj) { const size_t off = (size_t)(u.pm * 256 + ai * 128 + wr * 64 + m * 16 + fr) * DM + u.pn * 256 + bj * 128 + wc * 32 + 8 * fq; const u32x4 gm = gmv[m * 2 + bj];
                    const f32x4 v0 = acc[ai][bj][m][0] * esc, v1 = acc[ai][bj][m][1] * esc;
                    *(u32x2*)(O8 + off) = (u32x2){pk4_f8(v0.x * fmaxf(bflo(gm.x), 1e-12f), v0.y * fmaxf(bfhi(gm.x), 1e-12f), v0.z * fmaxf(bflo(gm.y), 1e-12f), v0.w * fmaxf(bfhi(gm.y), 1e-12f)),
                                                  pk4_f8(v1.x * fmaxf(bflo(gm.z), 1e-12f), v1.y * fmaxf(bfhi(gm.z), 1e-12f), v1.z * fmaxf(bflo(gm.w), 1e-12f), v1.w * fmaxf(bfhi(gm.w), 1e-12f))}; }
            __builtin_amdgcn_sched_barrier(0);
        }
    }
};
struct EpiRes1 {
    static constexpr bool HAS_MID = false;
    static constexpr bool PERM = true; const float* X; const float* mod; bf16* R; float esc;
    __device__ __forceinline__ void operator()(const AccT& acc, const pg8::Unit& u, int wr, int wc, int fr, int fq) const {
        f32x4 g[2][2];
#pragma unroll
        for (int bj = 0; bj < 2; ++bj) { const float* gt = mod + ((u.pm * 256) >> 13) * 12288 + 4096 + u.pn * 256 + bj * 128 + wc * 32 + 8 * fq; g[bj][0] = 1.f + *(const f32x4*)gt; g[bj][1] = 1.f + *(const f32x4*)(gt + 4); }
#pragma unroll
        for (int ai = 0; ai < 2; ++ai) {
            f32x4 xv[8][2];
#pragma unroll
            for (int m = 0; m < 4; ++m)
#pragma unroll
                for (int bj = 0; bj < 2; ++bj) { const float* xp = X + (size_t)(u.pm * 256 + ai * 128 + wr * 64 + m * 16 + fr) * DM + u.pn * 256 + bj * 128 + wc * 32 + 8 * fq; xv[m * 2 + bj][0] = *(const f32x4*)xp; xv[m * 2 + bj][1] = *(const f32x4*)(xp + 4); }
            __builtin_amdgcn_sched_barrier(0);
#pragma unroll
            for (int m = 0; m < 4; ++m)
#pragma unroll
                for (int bj = 0; bj < 2; ++bj) { const size_t off = (size_t)(u.pm * 256 + ai * 128 + wr * 64 + m * 16 + fr) * DM + u.pn * 256 + bj * 128 + wc * 32 + 8 * fq;
                    *(u32x4*)(R + off) = pack8(DN_ALPHA * xv[m * 2 + bj][0] + g[bj][0] * (acc[ai][bj][m][0] * esc), DN_ALPHA * xv[m * 2 + bj][1] + g[bj][1] * (acc[ai][bj][m][1] * esc)); }
            __builtin_amdgcn_sched_barrier(0);
        }
    }
};
struct EpiQuery {
    static constexpr bool HAS_MID = false;
    static constexpr bool PERM = true; bf16* O; const float* HS; const float* WS;
    __device__ __forceinline__ void operator()(const AccT& acc, const pg8::Unit& u, int wr, int wc, int fr, int fq) const {
        float hsv[2][4]; f32x4 wsv[2][2];
#pragma unroll
        for (int ai = 0; ai < 2; ++ai)
#pragma unroll
            for (int m = 0; m < 4; ++m) hsv[ai][m] = HS[u.pm * 256 + ai * 128 + wr * 64 + m * 16 + fr];
#pragma unroll
        for (int bj = 0; bj < 2; ++bj) { const int col = u.pn * 256 + bj * 128 + wc * 32 + 8 * fq; wsv[bj][0] = *(const f32x4*)(WS + col); wsv[bj][1] = *(const f32x4*)(WS + col + 4); }
        __builtin_amdgcn_sched_barrier(0);
#pragma unroll
        for (int ai = 0; ai < 2; ++ai)
#pragma unroll
            for (int m = 0; m < 4; ++m) { const int row = u.pm * 256 + ai * 128 + wr * 64 + m * 16 + fr; const float hs = hsv[ai][m];
#pragma unroll
                for (int bj = 0; bj < 2; ++bj) { const int col = u.pn * 256 + bj * 128 + wc * 32 + 8 * fq; const f32x4 w0 = wsv[bj][0] * hs, w1 = wsv[bj][1] * hs;
                    const i32x4 a0 = __builtin_bit_cast(i32x4, acc[ai][bj][m][0]), a1 = __builtin_bit_cast(i32x4, acc[ai][bj][m][1]);
                    const f32x4 v0 = {(float)a0.x * w0.x, (float)a0.y * w0.y, (float)a0.z * w0.z, (float)a0.w * w0.w}, v1 = {(float)a1.x * w1.x, (float)a1.y * w1.y, (float)a1.z * w1.z, (float)a1.w * w1.w};
                    *(u32x4*)(O + (size_t)row * DM + col) = pack8(v0, v1); } }
    }
};
#ifdef PROBE_GEMM
struct EpiNull {
    static constexpr bool HAS_MID = false;
    static constexpr bool PERM = true; float* O;
    __device__ __forceinline__ void operator()(const AccT& acc, const pg8::Unit& u, int wr, int wc, int fr, int fq) const {
        f32x4 s = {0.f, 0.f, 0.f, 0.f};
#pragma unroll
        for (int ai = 0; ai < 2; ++ai)
#pragma unroll
            for (int bj = 0; bj < 2; ++bj)
#pragma unroll
                for (int m = 0; m < 4; ++m) s += acc[ai][bj][m][0] + acc[ai][bj][m][1];
        *(f32x4*)(O + ((size_t)(u.pm * 8 + u.pn) * 512 + (wr * 4 + wc) * 64 + fq * 16 + fr) * 4) = s;
    }
};
#endif
struct EpiPlain {
    static constexpr bool HAS_MID = false;
    static constexpr bool PERM = true; bf16* O; float esc;
    __device__ __forceinline__ void operator()(const AccT& acc, const pg8::Unit& u, int wr, int wc, int fr, int fq) const {
        EPI_ROWS( *(u32x4*)(O + (size_t)row * DM + u.pn * 256 + cl) = pack8(v0, v1); )
    }
};
struct EpiQ {
    static constexpr bool HAS_MID = false;
    static constexpr bool PERM = true; unsigned char* Q; const float* SS; const f32x2* rope; float esc;
    __device__ __forceinline__ void operator()(const AccT& acc, const pg8::Unit& u, int wr, int wc, int fr, int fq) const {
        const bool is_rope = u.pn >= 8;
        float rsv[2][4];
#pragma unroll
        for (int ai = 0; ai < 2; ++ai)
#pragma unroll
            for (int m = 0; m < 4; ++m) rsv[ai][m] = SS[(size_t)(u.pm * 256 + ai * 128 + wr * 64 + m * 16 + fr) * 2];
        __builtin_amdgcn_sched_barrier(0);
#pragma unroll
        for (int ai = 0; ai < 2; ++ai) {
            f32x4 cv[8][2];
            if (is_rope) {
#pragma unroll
                for (int m = 0; m < 4; ++m)
#pragma unroll
                    for (int bj = 0; bj < 2; ++bj) { const int row = u.pm * 256 + ai * 128 + wr * 64 + m * 16 + fr, jj = ((u.pn - 8) * 256 + bj * 128 + wc * 32 + 8 * fq) & 63;
                        const f32x4* cs = (const f32x4*)(rope + (size_t)row * 32 + (jj >> 1)); cv[m * 2 + bj][0] = cs[0]; cv[m * 2 + bj][1] = cs[1]; } }
            __builtin_amdgcn_sched_barrier(0);
#pragma unroll
            for (int m = 0; m < 4; ++m)
#pragma unroll
                for (int bj = 0; bj < 2; ++bj) { const int row = u.pm * 256 + ai * 128 + wr * 64 + m * 16 + fr, cl = bj * 128 + wc * 32 + 8 * fq; const int b = row >> 13, s = row & 8191;
                    const float rs = rsv[ai][m] * (QSCALE * SC_Q); const f32x4 v0 = acc[ai][bj][m][0] * esc, v1 = acc[ai][bj][m][1] * esc;
                    if (!is_rope) { const int cg = u.pn * 256 + cl, h = cg >> 7, d = cg & 127;
                        *(u32x2*)(Q + (unsigned)(((b * NH + h) * SEQ + s) * DQK + d)) = (u32x2){pk4_f8(v0.x * rs, v0.y * rs, v0.z * rs, v0.w * rs), pk4_f8(v1.x * rs, v1.y * rs, v1.z * rs, v1.w * rs)};
                    } else { const int cg = (u.pn - 8) * 256 + cl, h = cg >> 6, jj = cg & 63; const f32x4 c0 = cv[m * 2 + bj][0], c1 = cv[m * 2 + bj][1];
                        *(u32x2*)(Q + (unsigned)(((b * NH + h) * SEQ + s) * DQK + 128 + jj)) = (u32x2){
                            pk4_f8((v0.x * c0.x - v0.y * c0.y) * rs, (v0.y * c0.x + v0.x * c0.y) * rs, (v0.z * c0.z - v0.w * c0.w) * rs, (v0.w * c0.z + v0.z * c0.w) * rs),
                            pk4_f8((v1.x * c1.x - v1.y * c1.y) * rs, (v1.y * c1.x + v1.x * c1.y) * rs, (v1.z * c1.z - v1.w * c1.w) * rs, (v1.w * c1.z + v1.z * c1.w) * rs)}; } }
            __builtin_amdgcn_sched_barrier(0);
        }
    }
};
struct EpiK {
    static constexpr bool HAS_MID = false;
    static constexpr bool PERM = true; unsigned char* K; const float* SS; float esc;
    __device__ __forceinline__ void operator()(const AccT& acc, const pg8::Unit& u, int wr, int wc, int fr, int fq) const {
        float rsv[2][4];
#pragma unroll
        for (int ai = 0; ai < 2; ++ai)
#pragma unroll
            for (int m = 0; m < 4; ++m) rsv[ai][m] = SS[(size_t)(u.pm * 256 + ai * 128 + wr * 64 + m * 16 + fr) * 2 + 1];
        __builtin_amdgcn_sched_barrier(0);
        EPI_ROWS( const float rs = rsv[ai][m] * SC_K; const int b = row >> 13, s = row & 8191;
            const int cg = u.pn * 256 + cl, h = cg >> 7, d = cg & 127;
            *(u32x2*)(K + (unsigned)(((b * NH + h) * SEQ + s) * DQK + d)) = (u32x2){pk4_f8(v0.x * rs, v0.y * rs, v0.z * rs, v0.w * rs), pk4_f8(v1.x * rs, v1.y * rs, v1.z * rs, v1.w * rs)}; )
    }
};
struct EpiVT {
    static constexpr bool HAS_MID = false;
    static constexpr bool PERM = true; unsigned char* VT; const float* SS; float esc;
    __device__ __forceinline__ void operator()(const AccT& acc, const pg8::Unit& u, int wr, int wc, int fr, int fq) const {
#pragma unroll
        for (int bj = 0; bj < 2; ++bj) {
            const int cl = bj * 128 + wc * 32 + 8 * fq; const int t0 = u.pn * 256 + cl, b = t0 >> 13, s = t0 & 8191; const f32x4* sp = (const f32x4*)(SS + (size_t)t0 * 2);
            const f32x4 s0 = sp[0] * SC_V, s1 = sp[1] * SC_V, s2 = sp[2] * SC_V, s3 = sp[3] * SC_V;
            __builtin_amdgcn_sched_barrier(0);
#pragma unroll
            for (int ai = 0; ai < 2; ++ai)
#pragma unroll
                for (int m = 0; m < 4; ++m) { const int row = u.pm * 256 + ai * 128 + wr * 64 + m * 16 + fr, h = row >> 7, d = row & 127; const f32x4 v0 = acc[ai][bj][m][0] * esc, v1 = acc[ai][bj][m][1] * esc;
                    *(u32x2*)(VT + (unsigned)(((((b * NH + h) * 128 + (s >> 6)) * 128 + d) * 64 + (s & 63)))) = (u32x2){pk4_f8(v0.x * s0.y, v0.y * s0.w, v0.z * s1.y, v0.w * s1.w), pk4_f8(v1.x * s2.y, v1.y * s2.w, v1.z * s3.y, v1.w * s3.w)}; }
            __builtin_amdgcn_sched_barrier(0);
        }
    }
};

constexpr int RG_W = 288;
constexpr int RG_SUB = 64;
constexpr int RG_XC = 0, RG_GGT = 36864, RG_OUT = 69632;
__device__ __forceinline__ unsigned char* rg_ab(unsigned char* ws, int tile) { return tile < 1536 ? ws + WS_TMP + (size_t)tile * 131072 : ws + WS_AO8 + (size_t)(tile - 1536) * 131072; }
__device__ __forceinline__ float rg_h_lo(unsigned w) { return (float)__builtin_bit_cast(_Float16, (unsigned short)(w & 0xffffu)); }
__device__ __forceinline__ float rg_h_hi(unsigned w) { return (float)__builtin_bit_cast(_Float16, (unsigned short)(w >> 16)); }
struct RgMap { float A, H; };
__device__ __forceinline__ RgMap rg_then(const RgMap f, const RgMap g) { return RgMap{f.A * g.A, g.A * f.H + g.H}; }
__device__ __forceinline__ void rglru_passA(Frame& F) {
    const int tid = F.tid, lane = F.lane, wave = F.wave;
    {
        const float* ssp = WSP(float, WS_SSP); float* rs = WSP(float, WS_RS);
        for (int i = F.blk * NTHREADS + tid; i < NT * 2; i += F.G * NTHREADS) { const f32x4* p = (const f32x4*)(ssp + (size_t)i * 32); float s = 0.f;
#pragma unroll
            for (int k = 0; k < 8; ++k) { const f32x4 a = p[k]; s += (a.x + a.y) + (a.z + a.w); }
            rs[i] = __builtin_amdgcn_rsqf(s * (1.f / 512.f) + RMS_EPS); } }
    LAS unsigned char* L = F.lds;
    const bf16* XR = WSP(bf16, WS_XR); float* SUMM = WSP(float, WS_SUMM);
    const int q = lane >> 4;
    for (int tile = F.blk; tile < NB * 32 * NH; tile += F.G) {
        const int hh = tile & 15, c = (tile >> 4) & 31, b = tile >> 9;
        const int ech = 16 * wave + (lane & 15), egch = hh * 128 + ech;
        bf16x8 bA[4], bX[4];
        { const bf16* ga = WSP(bf16, WS_WGA) + hh * 16384 + ech * 128 + 8 * (lane >> 4); const bf16* gx = WSP(bf16, WS_WGX) + hh * 16384 + ech * 128 + 8 * (lane >> 4);
#pragma unroll
            for (int ks = 0; ks < 4; ++ks) { bA[ks] = *(const bf16x8*)(ga + 32 * ks); bX[ks] = *(const bf16x8*)(gx + 32 * ks); } }
        constexpr float L2E = 1.4426950408889634f; const float nba = -L2E * F.b_rg_a[egch], nbx = -L2E * F.b_rg_x[egch];
        const float lam = F.rg_lambda[egch]; const float e_sp8 = -8.0f * 1.4426950408889634f * ((lam > 15.f) ? expf(-lam) : (lam < -15.f ? -lam : log1pf(expf(-lam))));
        const int crow = tid >> 4, c8 = (tid & 15) * 8, cg = hh * 128 + c8;
        float cw[4][8], cb[8];
#pragma unroll
        for (int w = 0; w < 4; ++w) { const f32x4 p = *(const f32x4*)(F.conv_w + w * DM + cg), qq = *(const f32x4*)(F.conv_w + w * DM + cg + 4);
            cw[w][0] = p.x; cw[w][1] = p.y; cw[w][2] = p.z; cw[w][3] = p.w; cw[w][4] = qq.x; cw[w][5] = qq.y; cw[w][6] = qq.z; cw[w][7] = qq.w; }
        { const f32x4 p = *(const f32x4*)(F.conv_b + cg), qq = *(const f32x4*)(F.conv_b + cg + 4); cb[0] = p.x; cb[1] = p.y; cb[2] = p.z; cb[3] = p.w; cb[4] = qq.x; cb[5] = qq.y; cb[6] = qq.z; cb[7] = qq.w; }
        float S = 0.f, atot = 1.f;
        u32x4* abw = (u32x4*)rg_ab(F.ws, tile) + (wave * 64 + lane) * 4;
        const size_t tbase = (size_t)b * SEQ + c * 256;
        u32x4 xn[2][4];
#pragma unroll
        for (int hf = 0; hf < 2; ++hf)
#pragma unroll
            for (int w = 0; w < 4; ++w) { const int rr = crow + 32 * hf - 3 + w; xn[hf][w] = (u32x4){0u, 0u, 0u, 0u}; if (c * 256 + rr >= 0) xn[hf][w] = *(const u32x4*)(XR + (tbase + rr) * DM + cg); }
#pragma unroll 1
        for (int sub = 0; sub < 256 / RG_SUB; ++sub) {
            const size_t t0 = tbase + sub * RG_SUB;
            LAS unsigned char* XC = L + RG_XC + (sub & 1) * 18432;
#pragma unroll
            for (int hf = 0; hf < 2; ++hf) { float a[8];
#pragma unroll
                for (int e = 0; e < 8; ++e) a[e] = cb[e];
#pragma unroll
                for (int w = 0; w < 4; ++w) { const u32x4 xv = xn[hf][w];
                    a[0] += cw[w][0] * bflo(xv.x); a[1] += cw[w][1] * bfhi(xv.x); a[2] += cw[w][2] * bflo(xv.y); a[3] += cw[w][3] * bfhi(xv.y);
                    a[4] += cw[w][4] * bflo(xv.z); a[5] += cw[w][5] * bfhi(xv.z); a[6] += cw[w][6] * bflo(xv.w); a[7] += cw[w][7] * bfhi(xv.w); }
                *(LAS u32x4*)(XC + (crow + 32 * hf) * RG_W + c8 * 2) = (u32x4){pk2(a[0], a[1]), pk2(a[2], a[3]), pk2(a[4], a[5]), pk2(a[6], a[7])}; }
            __syncthreads();
            if (sub + 1 < 256 / RG_SUB) {
#pragma unroll
                for (int hf = 0; hf < 2; ++hf)
#pragma unroll
                    for (int w = 0; w < 4; ++w) xn[hf][w] = *(const u32x4*)(XR + (t0 + RG_SUB + crow + 32 * hf - 3 + w) * DM + cg); }
            f32x4 accA[4], accX[4];
#pragma unroll
            for (int rb = 0; rb < 4; ++rb) { accA[rb] = (f32x4){0, 0, 0, 0}; accX[rb] = (f32x4){0, 0, 0, 0}; }
#pragma unroll
            for (int ks = 0; ks < 4; ++ks) { const int ko = (ks * 32 + 8 * (lane >> 4)) * 2;
#pragma unroll
                for (int rb = 0; rb < 4; ++rb) { const bf16x8 af = *(const LAS bf16x8*)(XC + (rb * 16 + (lane & 15)) * RG_W + ko);
                    accA[rb] = __builtin_amdgcn_mfma_f32_16x16x32_bf16(af, bA[ks], accA[rb], 0, 0, 0);
                    accX[rb] = __builtin_amdgcn_mfma_f32_16x16x32_bf16(af, bX[ks], accX[rb], 0, 0, 0); } }
#pragma unroll
            for (int rb = 0; rb < 4; ++rb) {
                RgMap G{1.f, 0.f}; u32x4 pw = {0u, 0u, 0u, 0u};
#pragma unroll
                for (int hp = 0; hp < 2; ++hp) {
                    const int tr0 = rb * 16 + 4 * q + 2 * hp;
                    const f32x2 xc2 = {bf1(*(const LAS bf16*)(XC + tr0 * RG_W + ech * 2)), bf1(*(const LAS bf16*)(XC + (tr0 + 1) * RG_W + ech * 2))};
                    const f32x2 za = {accA[rb][2 * hp], accA[rb][2 * hp + 1]}, zx = {accX[rb][2 * hp], accX[rb][2 * hp + 1]};
                    const f32x2 ea = __builtin_elementwise_fma(za, (f32x2){-L2E, -L2E}, (f32x2){nba, nba}), ex = __builtin_elementwise_fma(zx, (f32x2){-L2E, -L2E}, (f32x2){nbx, nbx});
                    const f32x2 da = (f32x2){__builtin_amdgcn_exp2f(ea.x), __builtin_amdgcn_exp2f(ea.y)} + 1.0f, dx = (f32x2){__builtin_amdgcn_exp2f(ex.x), __builtin_amdgcn_exp2f(ex.y)} + 1.0f;
                    const f32x2 rr = {__builtin_amdgcn_rcpf(da.x), __builtin_amdgcn_rcpf(da.y)}, ii = {__builtin_amdgcn_rcpf(dx.x), __builtin_amdgcn_rcpf(dx.y)};
                    const f32x2 l2 = rr * e_sp8;
                    const f32x2 a2 = {__builtin_amdgcn_exp2f(l2.x), __builtin_amdgcn_exp2f(l2.y)};
                    const f32x2 x2 = l2 * (2.0f * 0.6931471805599453f);
                    f32x2 pl = __builtin_elementwise_fma(x2, (f32x2){0.008333334f, 0.008333334f}, (f32x2){0.041666668f, 0.041666668f});
                    pl = __builtin_elementwise_fma(x2, pl, (f32x2){0.16666667f, 0.16666667f}); pl = __builtin_elementwise_fma(x2, pl, (f32x2){0.5f, 0.5f}); pl = __builtin_elementwise_fma(x2, pl, (f32x2){1.0f, 1.0f});
                    const f32x2 ser = -x2 * pl;
                    const f32x2 dir = __builtin_elementwise_fma(-a2, a2, (f32x2){1.0f, 1.0f});
                    const f32x2 om = {x2.x > -0.25f ? ser.x : dir.x, x2.y > -0.25f ? ser.y : dir.y};
                    const f32x2 b2 = (f32x2){__builtin_amdgcn_sqrtf(om.x), __builtin_amdgcn_sqrtf(om.y)} * ii * xc2;
                    pw[2 * hp] = __builtin_bit_cast(unsigned, __builtin_amdgcn_cvt_pkrtz(l2.x, b2.x)); pw[2 * hp + 1] = __builtin_bit_cast(unsigned, __builtin_amdgcn_cvt_pkrtz(l2.y, b2.y));
                    G.H = a2.x * G.H + b2.x; G.A *= a2.x; G.H = a2.y * G.H + b2.y; G.A *= a2.y; }
                abw[sub * 2048 + rb] = pw;
                const RgMap P{__shfl_xor(G.A, 16), __shfl_xor(G.H, 16)};
                const RgMap pr = (q & 1) ? rg_then(P, G) : rg_then(G, P);
                const RgMap Q{__shfl_xor(pr.A, 32), __shfl_xor(pr.H, 32)};
                const RgMap T = (q & 2) ? rg_then(Q, pr) : rg_then(pr, Q);
                S = T.A * S + T.H; atot *= T.A;
            }
        }
        if (q == 0) *(f32x2*)(SUMM + ((size_t)(b * 32 + c) * DM + egch) * 2) = (f32x2){atot, S};
    }
    __syncthreads();
}
__device__ __forceinline__ void rglru_passB(Frame& F) {
    const int tid = F.tid, lane = F.lane, wave = F.wave;
    LAS unsigned char* L = F.lds;
    const bf16* GG = WSP(bf16, WS_GG); unsigned char* RA = WSP(unsigned char, WS_S0); const float* SUMM = WSP(float, WS_SUMM);
    const int q = lane >> 4;
    for (int tile = F.blk; tile < NB * 32 * NH; tile += F.G) {
        const int hh = tile & 15, c = (tile >> 4) & 31, b = tile >> 9;
        const int ech = 16 * wave + (lane & 15), egch = hh * 128 + ech;
        const int crow = tid >> 4, c8 = (tid & 15) * 8, cg = hh * 128 + c8;
        const size_t tbase = (size_t)b * SEQ + c * 256;
        const u32x4* abr = (const u32x4*)rg_ab(F.ws, tile) + (wave * 64 + lane) * 4;
        u32x4 gn[2], ab[4];
        gn[0] = *(const u32x4*)(GG + (tbase + crow) * DM + cg); gn[1] = *(const u32x4*)(GG + (tbase + crow + 32) * DM + cg);
#pragma unroll
        for (int rb = 0; rb < 4; ++rb) ab[rb] = abr[rb];
        float S;
        { f32x2 sv[8];
#pragma unroll
            for (int k = 0; k < 8; ++k) { const int cc = 8 * q + k; sv[k] = (f32x2){1.f, 0.f}; if (cc < c) sv[k] = *(const f32x2*)(SUMM + ((size_t)(b * 32 + cc) * DM + egch) * 2); }
            RgMap M{1.f, 0.f};
#pragma unroll
            for (int k = 0; k < 8; ++k) M = rg_then(M, RgMap{sv[k].x, sv[k].y});
            const RgMap P{__shfl_xor(M.A, 16), __shfl_xor(M.H, 16)}; const RgMap pr = (q & 1) ? rg_then(P, M) : rg_then(M, P);
            const RgMap Q{__shfl_xor(pr.A, 32), __shfl_xor(pr.H, 32)}; const RgMap T = (q & 2) ? rg_then(Q, pr) : rg_then(pr, Q);
            S = T.H; }
#pragma unroll 1
        for (int sub = 0; sub < 256 / RG_SUB; ++sub) {
            const size_t t0 = tbase + sub * RG_SUB;
            LAS unsigned char* GT = L + RG_GGT + (sub & 1) * 16384; LAS unsigned char* OT = L + RG_OUT + (sub & 1) * 8192;
            *(LAS u32x4*)(GT + crow * 256 + c8 * 2) = gn[0]; *(LAS u32x4*)(GT + (crow + 32) * 256 + c8 * 2) = gn[1];
            u32x4 abc[4];
#pragma unroll
            for (int rb = 0; rb < 4; ++rb) abc[rb] = ab[rb];
            __syncthreads();
            if (sub + 1 < 256 / RG_SUB) {
                gn[0] = *(const u32x4*)(GG + (t0 + RG_SUB + crow) * DM + cg); gn[1] = *(const u32x4*)(GG + (t0 + RG_SUB + crow + 32) * DM + cg);
#pragma unroll
                for (int rb = 0; rb < 4; ++rb) ab[rb] = abr[(sub + 1) * 2048 + rb]; }
#pragma unroll
            for (int rb = 0; rb < 4; ++rb) {
                float av[4], bv[4];
#pragma unroll
                for (int r = 0; r < 4; ++r) { const unsigned pk = abc[rb][r]; av[r] = __builtin_amdgcn_exp2f(rg_h_lo(pk)); bv[r] = rg_h_hi(pk); }
                RgMap G{1.f, 0.f};
#pragma unroll
                for (int r = 0; r < 4; ++r) { G.H = av[r] * G.H + bv[r]; G.A *= av[r]; }
                const RgMap P{__shfl_xor(G.A, 16), __shfl_xor(G.H, 16)};
                const RgMap pr = (q & 1) ? rg_then(P, G) : rg_then(G, P);
                const RgMap Q{__shfl_xor(pr.A, 32), __shfl_xor(pr.H, 32)};
                const RgMap T = (q & 2) ? rg_then(Q, pr) : rg_then(pr, Q);
                RgMap E{1.f, 0.f}; if (q & 2) E = Q; if (q & 1) E = rg_then(E, P);
                float h = E.A * S + E.H; float y[4];
#pragma unroll
                for (int r = 0; r < 4; ++r) { const int trow = rb * 16 + 4 * q + r; h = av[r] * h + bv[r]; y[r] = h * bf1(*(const LAS bf16*)(GT + trow * 256 + ech * 2)) * SC_RA; }
                const unsigned w = pk4_f8(y[0], y[1], y[2], y[3]); const int tr0 = rb * 16 + 4 * q;
                OT[tr0 * 128 + ech] = (unsigned char)w; OT[(tr0 + 1) * 128 + ech] = (unsigned char)(w >> 8); OT[(tr0 + 2) * 128 + ech] = (unsigned char)(w >> 16); OT[(tr0 + 3) * 128 + ech] = (unsigned char)(w >> 24);
                S = T.A * S + T.H;
            }
            __syncthreads();
            { const int r = tid >> 3, cq = (tid & 7) * 16; *(u32x4*)(RA + (t0 + r) * DM + hh * 128 + cq) = *(const LAS u32x4*)(OT + r * 128 + cq); }
        }
    }
    __syncthreads();
}

__device__ __forceinline__ void krope_fill(Frame& F) {
    const int fl = fresh_lane(); const int gw = F.blk * NWAVES + F.wave, NGW = F.G * NWAVES, j4 = (fl & 7) * 4, tsub = fl >> 3;
    const float* KR = WSP(float, WS_KR); const f32x2* rope = WSP(f32x2, WS_ROPE); unsigned char* K = (unsigned char*)F.out + OUT_K;
    for (int tp = gw; tp < NT / 8; tp += NGW) { const int t = 8 * tp + tsub, b = t >> 13, s = t & 8191;
        const f32x4 x1 = *(const f32x4*)(KR + (size_t)t * 64 + j4), x2 = *(const f32x4*)(KR + (size_t)t * 64 + 32 + j4);
        const f32x4 c01 = *(const f32x4*)(rope + (size_t)t * 32 + j4), c23 = *(const f32x4*)(rope + (size_t)t * 32 + j4 + 2);
        const u32x2 w = {pk4_f8((x1.x * c01.x - x2.x * c01.y) * SC_K, (x2.x * c01.x + x1.x * c01.y) * SC_K, (x1.y * c01.z - x2.y * c01.w) * SC_K, (x2.y * c01.z + x1.y * c01.w) * SC_K),
                         pk4_f8((x1.z * c23.x - x2.z * c23.y) * SC_K, (x2.z * c23.x + x1.z * c23.y) * SC_K, (x1.w * c23.z - x2.w * c23.w) * SC_K, (x2.w * c23.z + x1.w * c23.w) * SC_K)};
#pragma unroll
        for (int h = 0; h < NH; ++h) *(u32x2*)(K + ((size_t)(b * NH + h) * SEQ + s) * DQK + 128 + 2 * j4) = w; }
}

constexpr int AT_KB = 12288, AT_VB = 8192, AT_BUF = AT_KB + AT_VB;
#define AT_LD8(p0_, p1_) __builtin_shufflevector(*(const LAS i32x4*)(p0_), *(const LAS i32x4*)(p1_), 0, 1, 2, 3, 4, 5, 6, 7)
constexpr int AT_SLOT = AT_KB + AT_VB, AT_NSLOT = 5;
struct AttnState { f32x16 o[4], p0, p1; f32x4 osum; i32x8 pb; float m_run; };
#define AT_MFMA(A_, B_, C_) __builtin_amdgcn_mfma_scale_f32_32x32x64_f8f6f4(A_, B_, C_, 0, 0, 0, 0x7F7F7F7F, 0, 0x7F7F7F7F)
#define AT_PIN() __builtin_amdgcn_sched_barrier(0)
template <bool FAST>
__device__ __forceinline__ void attn_iter(AttnState& S, const i32x8 (&qf)[3], const LAS unsigned char* Vprev, const LAS unsigned char* Knext, int xo0, int xo1, int r32, int hi,
                                          bool act_prev, bool act_cur, bool act_next, bool need_mask, int dq) {
    constexpr float CS = 1.0f / (SC_Q * SC_K), LSP = 6.0f;
    const f32x16 z16 = {0.f, 0.f, 0.f, 0.f, 0.f, 0.f, 0.f, 0.f, 0.f, 0.f, 0.f, 0.f, 0.f, 0.f, 0.f, 0.f};
    const int sel = (((r32 & 15) >> 2) & 1) == ((hi * 2 + (r32 >> 4)) & 1) ? 0x38383838 : 0;
    const i32x8 ones8 = {sel, sel, sel, sel, sel, sel, sel, sel};
#define AT_ROWSUM(PB_, ACC_) __builtin_amdgcn_mfma_scale_f32_16x16x128_f8f6f4(ones8, PB_, ACC_, 0, 0, 0, 0x7F7F7F7F, 0, 0x7F7F7F7F)
    float pmax = -__builtin_inff();
    if (FAST) {
        const LAS unsigned char* vb = Vprev + r32 * 64;
        const i32x8 v0 = AT_LD8(vb + xo0, vb + xo1), v1 = AT_LD8(vb + 2048 + xo0, vb + 2048 + xo1);
        S.osum = AT_ROWSUM(S.pb, S.osum);
        AT_PIN(); pmax = fmaxf(fmaxf(S.p0[0], S.p0[1]), fmaxf(S.p0[2], S.p0[3])); pmax = fmaxf(pmax, fmaxf(fmaxf(S.p0[4], S.p0[5]), fmaxf(S.p0[6], S.p0[7]))); AT_PIN();
        S.o[0] = AT_MFMA(v0, S.pb, S.o[0]);
        const i32x8 v2 = AT_LD8(vb + 4096 + xo0, vb + 4096 + xo1);
        AT_PIN(); pmax = fmaxf(pmax, fmaxf(fmaxf(S.p0[8], S.p0[9]), fmaxf(S.p0[10], S.p0[11]))); pmax = fmaxf(pmax, fmaxf(fmaxf(S.p0[12], S.p0[13]), fmaxf(S.p0[14], S.p0[15]))); AT_PIN();
        S.o[1] = AT_MFMA(v1, S.pb, S.o[1]);
        const i32x8 v3 = AT_LD8(vb + 6144 + xo0, vb + 6144 + xo1);
        AT_PIN(); pmax = fmaxf(pmax, fmaxf(fmaxf(S.p1[0], S.p1[1]), fmaxf(S.p1[2], S.p1[3]))); pmax = fmaxf(pmax, fmaxf(fmaxf(S.p1[4], S.p1[5]), fmaxf(S.p1[6], S.p1[7]))); AT_PIN();
        S.o[2] = AT_MFMA(v2, S.pb, S.o[2]);
        AT_PIN(); pmax = fmaxf(pmax, fmaxf(fmaxf(S.p1[8], S.p1[9]), fmaxf(S.p1[10], S.p1[11]))); pmax = fmaxf(pmax, fmaxf(fmaxf(S.p1[12], S.p1[13]), fmaxf(S.p1[14], S.p1[15]))); AT_PIN();
        S.o[3] = AT_MFMA(v3, S.pb, S.o[3]);
    } else if (act_prev) {
        const LAS unsigned char* vb = Vprev + r32 * 64;
        S.osum = AT_ROWSUM(S.pb, S.osum);
#pragma unroll
        for (int d = 0; d < 4; ++d) { const i32x8 vf = AT_LD8(vb + d * 2048 + xo0, vb + d * 2048 + xo1); S.o[d] = AT_MFMA(vf, S.pb, S.o[d]); AT_PIN(); }
    }
    if (!FAST) {
        if (act_cur) {
            if (need_mask) { const float NEG = -__builtin_inff();
#pragma unroll
                for (int r = 0; r < 16; ++r) { const int cr = (r & 3) + 8 * (r >> 2); if (cr > dq) S.p0[r] = NEG; if (cr + 32 > dq) S.p1[r] = NEG; } }
#pragma unroll
            for (int r = 0; r < 16; ++r) pmax = fmaxf(pmax, fmaxf(S.p0[r], S.p1[r]));
        }
    }
    float alpha = 1.f; bool resc = false; f32x16 n0 = z16, n1 = z16;
    if (FAST || act_cur) {
        { auto rr = __builtin_amdgcn_permlane32_swap(__float_as_uint(pmax), __float_as_uint(pmax), false, false); pmax = fmaxf(__uint_as_float(rr[0]), __uint_as_float(rr[1])) * CS; }
        resc = !__all(pmax - S.m_run <= 2.0f);
        const float mn = resc ? fmaxf(S.m_run, pmax) : S.m_run; alpha = __builtin_amdgcn_exp2f(S.m_run - mn); S.m_run = mn;
    }
    const float moff = LSP - S.m_run;
    const LAS unsigned char* kb = Knext + r32 * 192;
    if (FAST) {
        i32x8 ka = AT_LD8(kb + xo0, kb + xo1), kc = AT_LD8(kb + 32 * 192 + xo0, kb + 32 * 192 + xo1);
#pragma unroll
        for (int ks = 0; ks < 3; ++ks) {
            n0 = AT_MFMA(ka, qf[ks], ks == 0 ? z16 : n0); n1 = AT_MFMA(kc, qf[ks], ks == 0 ? z16 : n1);
            if (ks < 2) { ka = AT_LD8(kb + (ks + 1) * 64 + xo0, kb + (ks + 1) * 64 + xo1); kc = AT_LD8(kb + 32 * 192 + (ks + 1) * 64 + xo0, kb + 32 * 192 + (ks + 1) * 64 + xo1); }
            AT_PIN();
#pragma unroll
            for (int r = (ks * 16) / 3; r < ((ks + 1) * 16) / 3; ++r) { S.p0[r] = __builtin_amdgcn_exp2f(__builtin_fmaf(S.p0[r], CS, moff)); S.p1[r] = __builtin_amdgcn_exp2f(__builtin_fmaf(S.p1[r], CS, moff)); }
            AT_PIN();
        }
    } else {
        if (act_next) {
#pragma unroll
            for (int ks = 0; ks < 3; ++ks) { const i32x8 ka = AT_LD8(kb + ks * 64 + xo0, kb + ks * 64 + xo1), kc = AT_LD8(kb + 32 * 192 + ks * 64 + xo0, kb + 32 * 192 + ks * 64 + xo1);
                n0 = AT_MFMA(ka, qf[ks], ks == 0 ? z16 : n0); n1 = AT_MFMA(kc, qf[ks], ks == 0 ? z16 : n1); } }
        if (act_cur) {
#pragma unroll
            for (int r = 0; r < 16; ++r) { S.p0[r] = __builtin_amdgcn_exp2f(__builtin_fmaf(S.p0[r], CS, moff)); S.p1[r] = __builtin_amdgcn_exp2f(__builtin_fmaf(S.p1[r], CS, moff)); } }
    }
    if (FAST || act_cur) {
#pragma unroll
        for (int jj = 0; jj < 4; ++jj) { int a = __builtin_amdgcn_cvt_pk_fp8_f32(S.p0[4 * jj], S.p0[4 * jj + 1], 0, false); a = __builtin_amdgcn_cvt_pk_fp8_f32(S.p0[4 * jj + 2], S.p0[4 * jj + 3], a, true);
            int bq = __builtin_amdgcn_cvt_pk_fp8_f32(S.p1[4 * jj], S.p1[4 * jj + 1], 0, false); bq = __builtin_amdgcn_cvt_pk_fp8_f32(S.p1[4 * jj + 2], S.p1[4 * jj + 3], bq, true);
            auto rr = __builtin_amdgcn_permlane32_swap((unsigned)a, (unsigned)bq, false, false); S.pb[2 * jj] = (int)rr[0]; S.pb[2 * jj + 1] = (int)rr[1]; }
        if (resc) {
#pragma unroll
            for (int d = 0; d < 4; ++d)
#pragma unroll
                for (int r = 0; r < 16; ++r) S.o[d][r] *= alpha;
            S.osum = S.osum * alpha;
        }
    }
    S.p0 = n0; S.p1 = n1;
#undef AT_ROWSUM
}
__device__ __forceinline__ void attn_block(Frame& F, int bh, int qb, const unsigned char* Q, const unsigned char* Kg, const unsigned char* VTg, unsigned char* AO) {
    const int lane = F.lane, wave = F.wave, r32 = lane & 31, hi = lane >> 5;
    LAS unsigned char* L = F.lds; const unsigned ldsbase = (unsigned)(size_t)L;
    const int q0 = qb * 256, qrow = q0 + 32 * wave + r32, ntiles = 4 * (qb + 1);
    unsigned kv0, kv1, vv;
    { const int q = wave * 64 + lane, row = q / 12, pos = q % 12, c = (pos & ~3) | ((pos ^ (row >> 2)) & 3); kv0 = (unsigned)((row * 12 + c) * 16); }
    { const int q = (wave + 8) * 64 + lane, row = q / 12, pos = q % 12, c = (pos & ~3) | ((pos ^ (row >> 2)) & 3); kv1 = (unsigned)((row * 12 + c) * 16); }
    { const int q = wave * 64 + lane, row = q >> 2, pos = q & 3, c = pos ^ ((row >> 2) & 3); vv = (unsigned)((row * 4 + c) * 16); }
    const bool k2 = wave < 4;
    const char* kgb = (const char*)Kg + (size_t)bh * SEQ * DQK; const char* vgb = (const char*)VTg + (size_t)bh * SEQ * DV;
#define AT_ISSUE(tile, slot) do { const int _t = (tile) < ntiles ? (tile) : ntiles - 1; const unsigned _s = ldsbase + (slot) * AT_SLOT; \
        glds16(kgb + (size_t)_t * AT_KB, kv0, _s + wave * 1024); if (k2) glds16(kgb + (size_t)_t * AT_KB, kv1, _s + (wave + 8) * 1024); \
        glds16(vgb + (size_t)_t * AT_VB, vv, _s + AT_KB + wave * 1024); } while (0)
    AT_ISSUE(0, 0); AT_ISSUE(1, 1); AT_ISSUE(2, 2);
    i32x8 qf[3];
    { const unsigned char* qp = Q + ((size_t)bh * SEQ + qrow) * DQK + 32 * hi;
#pragma unroll
        for (int ks = 0; ks < 3; ++ks) { const i32x4 lo = *(const i32x4*)(qp + 64 * ks), hh = *(const i32x4*)(qp + 64 * ks + 16); qf[ks] = __builtin_shufflevector(lo, hh, 0, 1, 2, 3, 4, 5, 6, 7); } }
    asm volatile("s_waitcnt vmcnt(0)" ::: "memory");
    const f32x16 z16 = {0.f, 0.f, 0.f, 0.f, 0.f, 0.f, 0.f, 0.f, 0.f, 0.f, 0.f, 0.f, 0.f, 0.f, 0.f, 0.f};
    AttnState S; S.o[0] = z16; S.o[1] = z16; S.o[2] = z16; S.o[3] = z16; S.osum = (f32x4){0.f, 0.f, 0.f, 0.f}; S.p0 = z16; S.p1 = z16; S.m_run = -1e30f;
    S.pb = (i32x8){0, 0, 0, 0, 0, 0, 0, 0};
    const int swz = (r32 >> 2) & 3; const int xo0 = (((2 * hi) ^ swz) << 4), xo1 = (((2 * hi + 1) ^ swz) << 4);
    const int wfirst = q0 + 32 * wave, wlast = wfirst + 31;
    __syncthreads();
    { const LAS unsigned char* kb = L + r32 * 192;
#pragma unroll
        for (int ks = 0; ks < 3; ++ks) { const i32x8 ka = AT_LD8(kb + ks * 64 + xo0, kb + ks * 64 + xo1), kc = AT_LD8(kb + 32 * 192 + ks * 64 + xo0, kb + 32 * 192 + ks * 64 + xo1);
            S.p0 = AT_MFMA(ka, qf[ks], ks == 0 ? z16 : S.p0); S.p1 = AT_MFMA(kc, qf[ks], ks == 0 ? z16 : S.p1); } }
    const int nfast = 4 * qb;
#define AT_HEAD(j) if (k2) asm volatile("s_waitcnt vmcnt(3)" ::: "memory"); else asm volatile("s_waitcnt vmcnt(2)" ::: "memory"); \
        __syncthreads(); AT_ISSUE((j) + 3, ((j) + 3) % 5); \
        const LAS unsigned char* Vprev = L + (((j) + 4) % 5) * AT_SLOT + AT_KB; const LAS unsigned char* Knext = L + (((j) + 1) % 5) * AT_SLOT;
#define AT_SLOW(j) { const bool ap = (j) >= 1 && 64 * ((j) - 1) <= wlast, ac = (j) < ntiles && 64 * (j) <= wlast, an = (j) + 1 < ntiles && 64 * ((j) + 1) <= wlast; \
        attn_iter<false>(S, qf, Vprev, Knext, xo0, xo1, r32, hi, ap, ac, an, 64 * (j) + 63 > wfirst, qrow - 64 * (j) - 4 * hi); }
    int j = 0;
    { AT_HEAD(0); AT_SLOW(0); j = 1; }
#pragma unroll 1
    for (; j + 1 < nfast; ++j) { AT_HEAD(j); attn_iter<true>(S, qf, Vprev, Knext, xo0, xo1, r32, hi, true, true, true, false, 0); }
#pragma unroll 1
    for (; j <= ntiles; ++j) { AT_HEAD(j); AT_SLOW(j); }
#undef AT_HEAD
#undef AT_SLOW
#undef AT_ISSUE
    { int l2; asm volatile("v_mbcnt_lo_u32_b32 %0, -1, 0\n\tv_mbcnt_hi_u32_b32 %0, -1, %0" : "=v"(l2));
      const float inv = SC_AO / (SC_V * S.osum[0]); unsigned char* op = AO + ((size_t)(bh >> 4) * SEQ + qb * 256 + 32 * wave + (l2 & 31)) * DM + (bh & 15) * 128 + 4 * (l2 >> 5);
#pragma unroll
        for (int d = 0; d < 4; ++d)
#pragma unroll
            for (int g = 0; g < 4; ++g) *(unsigned*)(op + 32 * d + 8 * g) = pk4_f8(S.o[d][4 * g] * inv, S.o[d][4 * g + 1] * inv, S.o[d][4 * g + 2] * inv, S.o[d][4 * g + 3] * inv); }
    asm volatile("s_waitcnt vmcnt(0)" ::: "memory");
    __syncthreads();
}
#undef AT_MFMA
#undef AT_PIN
__device__ __forceinline__ void attn_phase(Frame& F) {
    const unsigned char* Q = (const unsigned char*)F.out + OUT_Q; const unsigned char* Kg = (const unsigned char*)F.out + OUT_K; const unsigned char* VTg = (const unsigned char*)F.out + OUT_VT; unsigned char* AO = WSP(unsigned char, WS_AO8);
    for (int it = F.blk; it < 1024; it += F.G) {
        const int r = it / F.G;
        int bh, y;
        if (F.G == 256) { const int x = F.blk & 7, loc = F.blk >> 3; bh = x * 8 + r * 2 + (loc >> 4); y = loc & 15; }
        else { bh = it >> 4; y = it & 15; }
        attn_block(F, bh, 31 - y, Q, Kg, VTg, AO);
        attn_block(F, bh, y, Q, Kg, VTg, AO);
    }
}

__device__ __forceinline__ void ln1_phase(Frame& F) {
    const int gw = F.blk * NWAVES + F.wave, NGW = F.G * NWAVES, lane = fresh_lane();
    bf16* R1 = WSP(bf16, WS_R1); unsigned char* H2I = WSP(unsigned char, WS_H2I); float* HSC = WSP(float, WS_HSC); const float* mod = WSP(float, WS_MOD);
    { const int rpw = (NT + NGW - 1) / NGW, m0 = gw * rpw < NT ? gw * rpw : NT, m1 = m0 + rpw < NT ? m0 + rpw : NT, bq = (m0 < NT ? m0 : NT - 1) >> 13;
        const float* sh2 = mod + bq * 12288 + 6144; const float* sc2 = mod + bq * 12288 + 8192;
        f32x4 cg[8], cb2[8], cs[8], ch[8];
#pragma unroll
        for (int j = 0; j < 4; ++j)
#pragma unroll
            for (int q = 0; q < 2; ++q) { const int col = 512 * j + 8 * lane + 4 * q; cg[2 * j + q] = *(const f32x4*)(F.ln1_g + col); cb2[2 * j + q] = *(const f32x4*)(F.ln1_b + col);
                cs[2 * j + q] = 1.f + *(const f32x4*)(sc2 + col); ch[2 * j + q] = *(const f32x4*)(sh2 + col); }
#pragma unroll 1
        for (int m = m0; m < m1; ++m) {
            u32x4* rp = (u32x4*)(R1 + (size_t)m * DM) + lane; f32x4 v[8]; float s = 0.f;
#pragma unroll
            for (int j = 0; j < 4; ++j) { const u32x4 w = rp[64 * j]; v[2 * j] = (f32x4){bflo(w.x), bfhi(w.x), bflo(w.y), bfhi(w.y)}; v[2 * j + 1] = (f32x4){bflo(w.z), bfhi(w.z), bflo(w.w), bfhi(w.w)};
                s += ((v[2 * j].x + v[2 * j].y) + (v[2 * j].z + v[2 * j].w)) + ((v[2 * j + 1].x + v[2 * j + 1].y) + (v[2 * j + 1].z + v[2 * j + 1].w)); }
            const float mean = wave_sum(s) * (1.f / DM); float s2 = 0.f;
#pragma unroll
            for (int j = 0; j < 8; ++j) { v[j] = v[j] - mean; s2 += (v[j].x * v[j].x + v[j].y * v[j].y) + (v[j].z * v[j].z + v[j].w * v[j].w); }
            const float rstd = __builtin_amdgcn_rsqf(wave_sum(s2) * (1.f / DM) + LN_EPS);
            float amax = 0.f;
#pragma unroll
            for (int j = 0; j < 4; ++j) { f32x4 y[2];
#pragma unroll
                for (int q = 0; q < 2; ++q) { y[q] = v[2 * j + q] * rstd * cg[2 * j + q] + cb2[2 * j + q]; v[2 * j + q] = y[q] * cs[2 * j + q] + ch[2 * j + q];
                    const f32x4 hh = v[2 * j + q]; amax = fmaxf(amax, fmaxf(fmaxf(fabsf(hh.x), fabsf(hh.y)), fmaxf(fabsf(hh.z), fabsf(hh.w)))); }
                rp[64 * j] = pack8(y[0], y[1]); }
            amax = fmaxf(wave_max(amax), 1e-20f); const float qs = 127.0f / amax;
            if (lane == 0) HSC[m] = amax * (1.0f / 127.0f);
#pragma unroll
            for (int j = 0; j < 4; ++j) { const f32x4 a = v[2 * j] * qs, c = v[2 * j + 1] * qs;
                *(u32x2*)(H2I + (size_t)m * DM + 512 * j + 8 * lane) = (u32x2){pk4_i8(a.x, a.y, a.z, a.w), pk4_i8(c.x, c.y, c.z, c.w)}; }
        }
    }
    auto conv_table = [&](const float* src, unsigned char* dst, float* sc) {
        f32x4 rn[8];
#pragma unroll
        for (int j = 0; j < 4; ++j) { rn[2 * j] = *(const f32x4*)(src + (size_t)gw * DM + 512 * j + 8 * lane); rn[2 * j + 1] = *(const f32x4*)(src + (size_t)gw * DM + 512 * j + 8 * lane + 4); }
        for (int e = gw; e < 16384; e += NGW) { f32x4 r[8]; float amax = 0.f;
#pragma unroll
            for (int j = 0; j < 8; ++j) r[j] = rn[j];
            if (e + NGW < 16384) {
#pragma unroll
                for (int j = 0; j < 4; ++j) { rn[2 * j] = *(const f32x4*)(src + (size_t)(e + NGW) * DM + 512 * j + 8 * lane); rn[2 * j + 1] = *(const f32x4*)(src + (size_t)(e + NGW) * DM + 512 * j + 8 * lane + 4); } }
#pragma unroll
            for (int j = 0; j < 8; ++j) amax = fmaxf(amax, fmaxf(fmaxf(fabsf(r[j].x), fabsf(r[j].y)), fmaxf(fabsf(r[j].z), fabsf(r[j].w))));
            amax = fmaxf(wave_max(amax), 1e-30f); const float qs = 127.0f / amax;
            if (lane == 0) sc[e] = amax * (1.0f / 127.0f);
#pragma unroll
            for (int j = 0; j < 4; ++j) { const f32x4 a = r[2 * j] * qs, c = r[2 * j + 1] * qs;
                *(u32x2*)(dst + (size_t)(4 * j + (lane >> 4)) * 2097152 + (size_t)e * 128 + 8 * (lane & 15)) = (u32x2){pk4_i8(a.x, a.y, a.z, a.w), pk4_i8(c.x, c.y, c.z, c.w)}; } } };
    conv_table(F.peer_u, WSP(unsigned char, WS_PU), WSP(float, WS_USC));
    conv_table(F.peer_v, WSP(unsigned char, WS_PV), WSP(float, WS_VSC));
}

constexpr int PK_KW = 288, PK_KEYS = 0, PK_SF = 2 * 128 * PK_KW  , PK_SI = PK_SF + 64 * 2 * 16 * 4, PK_TAB = PK_SI + 64 * 2 * 16 * 4;
__device__ __forceinline__ unsigned ord_key(float s) { unsigned u = __float_as_uint(s); return u ^ ((u >> 31) ? 0xffffffffu : 0x80000000u); }
__device__ __forceinline__ float ord_inv(unsigned k) { return __uint_as_float((k >> 31) ? (k ^ 0x80000000u) : ~k); }
#define PK_CE(a_, b_) do { const unsigned _h = (a_) > (b_) ? (a_) : (b_), _l = (a_) > (b_) ? (b_) : (a_); (a_) = _h; (b_) = _l; } while (0)
__device__ __forceinline__ void sort16_desc(unsigned (&v)[16]) {
#pragma unroll
    for (int k = 2; k <= 16; k <<= 1)
#pragma unroll
        for (int j = k >> 1; j > 0; j >>= 1)
#pragma unroll
            for (int i = 0; i < 16; ++i) { const int l = i ^ j; if (l > i) { if ((i & k) == 0) PK_CE(v[i], v[l]); else PK_CE(v[l], v[i]); } }
}
__device__ __forceinline__ void merge16_desc(unsigned (&v)[16]) {
#pragma unroll
    for (int j = 8; j > 0; j >>= 1)
#pragma unroll
        for (int i = 0; i < 16; ++i) { const int l = i ^ j; if (l > i) PK_CE(v[i], v[l]); }
}
__device__ __forceinline__ void top16_with_partner(unsigned (&v)[16], int mask) {
    unsigned o[16];
#pragma unroll
    for (int i = 0; i < 16; ++i) o[i] = (unsigned)__shfl_xor((int)v[i], mask);
#pragma unroll
    for (int i = 0; i < 16; ++i) v[i] = v[i] > o[15 - i] ? v[i] : o[15 - i];
    merge16_desc(v);
}
__device__ __forceinline__ void peer_score_phase(Frame& F) {
    const int tid = F.tid, lane = F.lane, wave = F.wave;
    LAS unsigned char* L = F.lds;
    const bf16* PQ = WSP(bf16, WS_PQ); int* IDX = WSP(int, WS_IDX); float* GATE = WSP(float, WS_GATE);
    { const u32x4* kg = WSP(u32x4, WS_PKEYS);
#pragma unroll
        for (int i = 0; i < 8; ++i) { const int id = tid + NTHREADS * i, r = id >> 4, ch = id & 15; *(LAS u32x4*)(L + PK_KEYS + r * PK_KW + ch * 16) = kg[id]; } }
    if (tid == 0) { int n = 0; for (int i = 0; i < 16; ++i) for (int j = 0; j < 16; ++j) if ((i + 1) * (j + 1) <= 16) L[PK_TAB + n++] = (unsigned char)(i * 16 + j); for (; n < 64; ++n) L[PK_TAB + n] = 0xff; }
    __syncthreads();
    LAS float* SF = (LAS float*)(L + PK_SF); LAS int* SI = (LAS int*)(L + PK_SI);
    bf16x8 qnx[4];
    { const int p = wave >> 2, rb = (wave & 3) * 16, c = lane & 15, fq = lane >> 4; const bf16* qp = PQ + (size_t)(F.blk * 64 + rb + c) * 256 + p * 128 + 8 * fq;
#pragma unroll
        for (int ks = 0; ks < 4; ++ks) qnx[ks] = *(const bf16x8*)(qp + 32 * ks); }
    for (int tile = F.blk; tile < NT * PEER_H / 64; tile += F.G) {
        const int R0 = tile * 64;
        { const int p = wave >> 2, rb = (wave & 3) * 16, c = lane & 15, fq = lane >> 4;
            bf16x8 qfr[4];
#pragma unroll
            for (int ks = 0; ks < 4; ++ks) qfr[ks] = qnx[ks];
            if (tile + F.G < NT * PEER_H / 64) { const bf16* qp = PQ + (size_t)((tile + F.G) * 64 + rb + c) * 256 + p * 128 + 8 * fq;
#pragma unroll
                for (int ks = 0; ks < 4; ++ks) qnx[ks] = *(const bf16x8*)(qp + 32 * ks); }
            unsigned lo[16], hi[16];
#pragma unroll
            for (int nb = 0; nb < 8; ++nb) { f32x4 acc = {0, 0, 0, 0};
#pragma unroll
                for (int ks = 0; ks < 4; ++ks) { const bf16x8 kfr = *(const LAS bf16x8*)(L + PK_KEYS + (p * 128 + nb * 16 + c) * PK_KW + (ks * 32 + 8 * fq) * 2);
                    acc = __builtin_amdgcn_mfma_f32_16x16x32_bf16(kfr, qfr[ks], acc, 0, 0, 0); }
#pragma unroll
                for (int r = 0; r < 4; ++r) { const unsigned key = (ord_key(acc[r]) & ~127u) | (unsigned)(127 - (16 * nb + 4 * fq + r));
                    if (nb < 4) lo[nb * 4 + r] = key; else hi[(nb - 4) * 4 + r] = key; } }
            sort16_desc(lo); sort16_desc(hi);
#pragma unroll
            for (int i = 0; i < 16; ++i) lo[i] = lo[i] > hi[15 - i] ? lo[i] : hi[15 - i];
            merge16_desc(lo);
            top16_with_partner(lo, 16); top16_with_partner(lo, 32);
            if (fq == 0) { LAS float* sf = SF + ((rb + c) * 2 + p) * 16; LAS int* si = SI + ((rb + c) * 2 + p) * 16;
#pragma unroll
                for (int i = 0; i < 16; ++i) { sf[i] = ord_inv(lo[i] & ~127u); si[i] = 127 - (int)(lo[i] & 127u); } } }
        __syncthreads();
        if (tid < 256) { const int R = tid >> 2, c = tid & 3; const LAS float* a = SF + (R * 2) * 16; const LAS float* bq = a + 16;
            unsigned v[16];
#pragma unroll
            for (int m = 0; m < 16; ++m) { v[m] = 0u; if (m < 13) { const unsigned pr = L[PK_TAB + c + 4 * m]; if (pr != 0xffu) v[m] = (ord_key(a[pr >> 4] + bq[pr & 15]) & ~255u) | (255u - pr); } }
            sort16_desc(v); top16_with_partner(v, 1); top16_with_partner(v, 2);
            unsigned w0 = c == 0 ? v[0] : (c == 1 ? v[4] : (c == 2 ? v[8] : v[12])), w1 = c == 0 ? v[1] : (c == 1 ? v[5] : (c == 2 ? v[9] : v[13]));
            unsigned w2 = c == 0 ? v[2] : (c == 1 ? v[6] : (c == 2 ? v[10] : v[14])), w3 = c == 0 ? v[3] : (c == 1 ? v[7] : (c == 2 ? v[11] : v[15]));
            const unsigned pm = 255u - (v[0] & 255u); const float smax = a[pm >> 4] + bq[pm & 15];
            const LAS int* ia = SI + (R * 2) * 16; const LAS int* ib = ia + 16;
            const unsigned p0 = 255u - (w0 & 255u), p1 = 255u - (w1 & 255u), p2 = 255u - (w2 & 255u), p3 = 255u - (w3 & 255u);
            f32x4 e = {__expf(a[p0 >> 4] + bq[p0 & 15] - smax), __expf(a[p1 >> 4] + bq[p1 & 15] - smax), __expf(a[p2 >> 4] + bq[p2 & 15] - smax), __expf(a[p3 >> 4] + bq[p3 & 15] - smax)};
            float sum = (e.x + e.y) + (e.z + e.w); sum += __shfl_xor(sum, 1); sum += __shfl_xor(sum, 2);
            const float inv = 1.0f / sum; const size_t ob = (size_t)(R0 + R) * 16 + 4 * c;
            *(f32x4*)(GATE + ob) = e * inv;
            *(int4*)(IDX + ob) = make_int4(ia[p0 >> 4] * NKEYS + ib[p0 & 15], ia[p1 >> 4] * NKEYS + ib[p1 & 15], ia[p2 >> 4] * NKEYS + ib[p2 & 15], ia[p3 >> 4] * NKEYS + ib[p3 & 15]); }
        __syncthreads();
    }
}
#undef PK_CE

__device__ __forceinline__ void ln2_rows(Frame& F, int m0, int nrows) {
    int lane; asm volatile("v_mbcnt_lo_u32_b32 %0, -1, 0\n\tv_mbcnt_hi_u32_b32 %0, -1, %0" : "=v"(lane));
    const bf16* X1 = WSP(bf16, WS_R1); const float* mod = WSP(float, WS_MOD); const bf16* Y = WSP(bf16, WS_TMP);
    f32x4 g1[8], lg[8], lb[8];
    { const f32x4* gt2 = (const f32x4*)(mod + (m0 >> 13) * 12288 + 10240) + lane;
#pragma unroll
        for (int j = 0; j < 8; ++j) { g1[j] = 1.f + gt2[64 * j]; lg[j] = *((const f32x4*)F.ln2_g + 64 * j + lane); lb[j] = *((const f32x4*)F.ln2_b + 64 * j + lane); } }
    u32x2 yn[8], xn[8];
    { const u32x2* yb = (const u32x2*)(Y + (size_t)m0 * DM) + lane; const u32x2* xb = (const u32x2*)(X1 + (size_t)m0 * DM) + lane;
#pragma unroll
        for (int j = 0; j < 8; ++j) { yn[j] = yb[64 * j]; xn[j] = xb[64 * j]; } }
#pragma unroll 1
    for (int m = m0; m < m0 + nrows; ++m) {
        f32x4* yp = (f32x4*)(F.out + (size_t)m * DM) + lane;
        f32x4 v[8]; float s = 0.f;
#pragma unroll
        for (int j = 0; j < 8; ++j) { const u32x2 yw = yn[j], xw = xn[j]; const f32x4 y = {bflo(yw.x), bfhi(yw.x), bflo(yw.y), bfhi(yw.y)}, x = {bflo(xw.x), bfhi(xw.x), bflo(xw.y), bfhi(xw.y)};
            v[j] = DN_ALPHA * x + g1[j] * y; s += (v[j].x + v[j].y) + (v[j].z + v[j].w); }
        { const int mn = m + 1 < m0 + nrows ? m + 1 : m; const u32x2* yb = (const u32x2*)(Y + (size_t)mn * DM) + lane; const u32x2* xb = (const u32x2*)(X1 + (size_t)mn * DM) + lane;
#pragma unroll
            for (int j = 0; j < 8; ++j) { yn[j] = yb[64 * j]; xn[j] = xb[64 * j]; } }
        const float mean = wave_sum(s) * (1.f / DM); float s2 = 0.f;
#pragma unroll
        for (int j = 0; j < 8; ++j) { v[j] = v[j] - mean; s2 += (v[j].x * v[j].x + v[j].y * v[j].y) + (v[j].z * v[j].z + v[j].w * v[j].w); }
        const float rstd = __builtin_amdgcn_rsqf(wave_sum(s2) * (1.f / DM) + LN_EPS);
#pragma unroll
        for (int j = 0; j < 8; ++j) yp[64 * j] = v[j] * rstd * lg[j] + lb[j];
    }
}
constexpr int PE_WAVE_LDS = 16384;
template <int N, int M> __device__ __forceinline__ void xreduce_step(float (&v)[M], bool bit, int mask) {
#pragma unroll
    for (int i = 0; i < N / 2; ++i) { const float keep = bit ? v[i + N / 2] : v[i], send = bit ? v[i] : v[i + N / 2]; v[i] = keep + __shfl_xor(send, mask); }
}
template <int N, int M> __device__ __forceinline__ void xreduce_step_i(int (&v)[M], bool bit, int mask) {
#pragma unroll
    for (int i = 0; i < N / 2; ++i) { const int keep = bit ? v[i + N / 2] : v[i], send = bit ? v[i] : v[i + N / 2]; v[i] = keep + __shfl_xor(send, mask); }
}
__device__ __forceinline__ void peer_eval_phase(Frame& F) {
    const int lane = F.lane, g = lane >> 3, c16 = lane & 7;
    const unsigned char* H2I = WSP(unsigned char, WS_H2I); const float* HSC = WSP(float, WS_HSC); const float* USC = WSP(float, WS_USC); const float* VSC = WSP(float, WS_VSC); const int* IDX = WSP(int, WS_IDX); const float* GATE = WSP(float, WS_GATE);
    const unsigned char* PU = WSP(unsigned char, WS_PU); const unsigned char* PV = WSP(unsigned char, WS_PV); bf16* Y = WSP(bf16, WS_TMP);
    LAS int* idxL = (LAS int*)(F.lds + F.wave * PE_WAVE_LDS); LAS float* DL = (LAS float*)(F.lds + F.wave * PE_WAVE_LDS + 8192);
    for (int tb = F.blk; tb < NT / 128; tb += F.G) {
        const int tok0 = tb * 128 + F.wave * 16;
#pragma unroll 4
        for (int tk = 0; tk < 16; ++tk) { const int e0 = lane, e1 = lane + 64; const int i0 = IDX[(size_t)(tok0 + tk) * 128 + e0], i1 = IDX[(size_t)(tok0 + tk) * 128 + e1];
            idxL[(tk * 8 + (e0 & 7)) * 16 + (e0 >> 3)] = i0 << 7; idxL[(tk * 8 + (e1 & 7)) * 16 + (e1 >> 3)] = i1 << 7; DL[tk * 128 + e0] = 0.f; DL[tk * 128 + e1] = 0.f; }
        LDS_WAIT();
        {
            auto issueU = [&](int st, u32x4 (&w)[16], i32x4& hq) { const int sl = st >> 4, tk = st & 15; const unsigned char* pu = PU + (size_t)sl * 2097152; const unsigned lo16 = 16u * c16;
                int ids[16];
#pragma unroll
                for (int q = 0; q < 4; ++q) { const i32x4 v = *(const LAS i32x4*)(idxL + (tk * 8 + g) * 16 + 4 * q); ids[4 * q] = v.x; ids[4 * q + 1] = v.y; ids[4 * q + 2] = v.z; ids[4 * q + 3] = v.w; }
                hq = *(const i32x4*)(H2I + (size_t)(tok0 + tk) * DM + 128 * sl + 16 * c16);
#pragma unroll
                for (int k = 0; k < 16; ++k) w[k] = *(const u32x4*)(pu + ((unsigned)ids[k] + lo16)); };
            auto computeU = [&](int st, const u32x4 (&w)[16], const i32x4 hq) { const int tk = st & 15;
                int pd[16];
#pragma unroll
                for (int k = 0; k < 16; ++k) { int di = __builtin_amdgcn_sdot4((int)w[k][0], hq.x, 0, false); di = __builtin_amdgcn_sdot4((int)w[k][1], hq.y, di, false);
                    di = __builtin_amdgcn_sdot4((int)w[k][2], hq.z, di, false); di = __builtin_amdgcn_sdot4((int)w[k][3], hq.w, di, false); pd[k] = di; }
                xreduce_step_i<16>(pd, c16 & 1, 1); xreduce_step_i<8>(pd, c16 & 2, 2); xreduce_step_i<4>(pd, c16 & 4, 4);
                const int k0 = 8 * (c16 & 1) + 4 * ((c16 >> 1) & 1) + 2 * (c16 >> 2);
                LAS int* dp = (LAS int*)DL + tk * 128 + g; dp[8 * k0] += pd[0]; dp[8 * (k0 + 1)] += pd[1]; };
            u32x4 wa[16], wb[16]; i32x4 ha, hb;
            issueU(0, wa, ha);
#pragma unroll 1
            for (int st = 0; st < 256; st += 2) {
                issueU(st + 1, wb, hb); computeU(st, wa, ha);
                issueU(st + 2 < 256 ? st + 2 : 255, wa, ha); computeU(st + 1, wb, hb);
            }
        }
        LDS_WAIT();
        { float a0[16], a1[16]; const int e0 = lane, e1 = lane + 64;
#pragma unroll
            for (int tk = 0; tk < 16; ++tk) { const float g0 = GATE[(size_t)(tok0 + tk) * 128 + e0], g1 = GATE[(size_t)(tok0 + tk) * 128 + e1]; const float hs = HSC[tok0 + tk];
                const int x0 = idxL[(tk * 8 + (e0 & 7)) * 16 + (e0 >> 3)], x1 = idxL[(tk * 8 + (e1 & 7)) * 16 + (e1 >> 3)];
                a0[tk] = gelu_tanh((float)((LAS int*)DL)[tk * 128 + e0] * (hs * USC[x0 >> 7])) * g0 * VSC[x0 >> 7]; a1[tk] = gelu_tanh((float)((LAS int*)DL)[tk * 128 + e1] * (hs * USC[x1 >> 7])) * g1 * VSC[x1 >> 7]; }
            LDS_WAIT();
            LAS unsigned char* AB = (LAS unsigned char*)DL; LAS float* AS = DL + 512;
#pragma unroll
            for (int tk = 0; tk < 16; ++tk) { const float amax = fmaxf(wave_max(fmaxf(fabsf(a0[tk]), fabsf(a1[tk]))), 1e-30f); const float qs = 127.0f / amax;
                const int q0 = (int)__builtin_rintf(a0[tk] * qs), q1 = (int)__builtin_rintf(a1[tk] * qs);
                AB[(tk * 8 + (e0 & 7)) * 16 + (e0 >> 3)] = (unsigned char)q0; AB[(tk * 8 + (e1 & 7)) * 16 + (e1 >> 3)] = (unsigned char)q1;
                if (lane == 0) AS[tk] = amax * (1.0f / 127.0f); } }
        LDS_WAIT();
        {
            auto issueV = [&](int st, u32x4 (&w)[16]) { const int sl = st >> 4, tk = st & 15; const unsigned char* pv = PV + (size_t)sl * 2097152; const unsigned lo16 = 16u * c16;
                int ids[16];
#pragma unroll
                for (int q = 0; q < 4; ++q) { const i32x4 v = *(const LAS i32x4*)(idxL + (tk * 8 + g) * 16 + 4 * q); ids[4 * q] = v.x; ids[4 * q + 1] = v.y; ids[4 * q + 2] = v.z; ids[4 * q + 3] = v.w; }
#pragma unroll
                for (int k = 0; k < 16; ++k) w[k] = *(const u32x4*)(pv + ((unsigned)ids[k] + lo16)); };
            auto computeV = [&](int st, const u32x4 (&w)[16]) { const int sl = st >> 4, tk = st & 15;
                const i32x4 a4 = *(const LAS i32x4*)((const LAS unsigned char*)DL + (tk * 8 + g) * 16);
                const float ascale = (DL + 512)[tk];
                int yi[16];
#pragma unroll
                for (int c = 0; c < 16; ++c) yi[c] = 0;
#pragma unroll
                for (int m = 0; m < 4; ++m) { const int am = m == 0 ? a4.x : (m == 1 ? a4.y : (m == 2 ? a4.z : a4.w));
#pragma unroll
                    for (int q = 0; q < 4; ++q) {
                        const unsigned w0 = w[4 * m][q], w1 = w[4 * m + 1][q], w2 = w[4 * m + 2][q], w3 = w[4 * m + 3][q];
                        const unsigned t0 = __builtin_amdgcn_perm(w1, w0, 0x05010400u), t1 = __builtin_amdgcn_perm(w1, w0, 0x07030602u), t2 = __builtin_amdgcn_perm(w3, w2, 0x05010400u), t3 = __builtin_amdgcn_perm(w3, w2, 0x07030602u);
                        yi[4 * q + 0] = __builtin_amdgcn_sdot4((int)__builtin_amdgcn_perm(t2, t0, 0x05040100u), am, yi[4 * q + 0], false);
                        yi[4 * q + 1] = __builtin_amdgcn_sdot4((int)__builtin_amdgcn_perm(t2, t0, 0x07060302u), am, yi[4 * q + 1], false);
                        yi[4 * q + 2] = __builtin_amdgcn_sdot4((int)__builtin_amdgcn_perm(t3, t1, 0x05040100u), am, yi[4 * q + 2], false);
                        yi[4 * q + 3] = __builtin_amdgcn_sdot4((int)__builtin_amdgcn_perm(t3, t1, 0x07060302u), am, yi[4 * q + 3], false); } }
                float cv[16];
#pragma unroll
                for (int c = 0; c < 16; ++c) cv[c] = (float)yi[c] * ascale;
                xreduce_step<16>(cv, g & 1, 8); xreduce_step<8>(cv, g & 2, 16); xreduce_step<4>(cv, g & 4, 32);
                const int c0 = 8 * (g & 1) + 4 * ((g >> 1) & 1) + 2 * (g >> 2);
                *(unsigned*)(Y + (size_t)(tok0 + tk) * DM + 128 * sl + 16 * c16 + c0) = pk2(cv[0], cv[1]); };
            u32x4 wa[16], wb[16];
            issueV(0, wa);
#pragma unroll 1
            for (int st = 0; st < 256; st += 2) {
                issueV(st + 1, wb); computeV(st, wa);
                issueV(st + 2 < 256 ? st + 2 : 255, wa); computeV(st + 1, wb);
            }
        }
        LDS_WAIT();
        VM_WAIT();
        ln2_rows(F, tok0, 16);
    }
}

constexpr int NPHASE = 12;
__global__ void __launch_bounds__(NTHREADS, 2) fwd_kernel(Args args) {
    extern __shared__ __attribute__((aligned(16))) unsigned char lds_raw[];
    Frame F;
    F.lds = (LAS unsigned char*)lds_raw; F.tid = threadIdx.x; F.lane = F.tid & 63; F.wave = __builtin_amdgcn_readfirstlane(F.tid >> 6); F.G = gridDim.x; F.blk = blockIdx.x;
    F.x = args.in[0]; F.c = args.in[1]; F.positions = (const int*)args.in[2]; F.w_ada = args.in[3]; F.b_ada = args.in[4]; F.w_in = args.in[5]; F.conv_w = args.in[6]; F.conv_b = args.in[7];
    F.w_rg_a = args.in[8]; F.b_rg_a = args.in[9]; F.w_rg_x = args.in[10]; F.b_rg_x = args.in[11]; F.rg_lambda = args.in[12]; F.w_rnn_out = args.in[13]; F.q_norm_g = args.in[14]; F.w_uq = args.in[15];
    F.kv_norm_g = args.in[16]; F.w_ukv = args.in[17]; F.w_mla_out = args.in[18]; F.w_o = args.in[19]; F.ln1_g = args.in[20]; F.ln1_b = args.in[21]; F.peer_wq = args.in[22]; F.peer_keys = args.in[23];
    F.peer_u = args.in[24]; F.peer_v = args.in[25]; F.ln2_g = args.in[26]; F.ln2_b = args.in[27]; F.out = args.out; F.ws = args.ws;
    volatile LAS unsigned* ctlw = (volatile LAS unsigned*)(F.lds + LDSCTL_OFF);
    if (F.tid < 128) ctlw[F.tid] = 0u;
    __syncthreads();
    const int lo = args.ph_lo, hi = args.ph_hi;
    const bool multi = (hi - lo) > 1;
#ifdef PROBE_RELAUNCH
    const int bslot = args.bslot;
#else
    constexpr int bslot = 0;
#endif
    XcdBarrier bar; bar.bar = (unsigned*)(F.ws + WS_CTL) + 4096 + 16384 * (bslot & 1); bar.x = 0; bar.st = nullptr;
    if (multi) bar = xcd_barrier_post((unsigned*)(F.ws + WS_CTL) + 4096 + 16384 * (bslot & 1), ctlw + 8);
#ifndef PHASE_MASK
#define PHASE_MASK 0xfff
#endif
#define IN(k) (((PHASE_MASK >> (k)) & 1) && lo <= (k) && (k) < hi)
#define SEAM(k) do { if (IN(k) && IN((k) + 1)) xcd_barrier(bar); } while (0)
#ifndef DBL_MASK
#define DBL_MASK 0
#endif
#define DBL(k, ...) do { if ((DBL_MASK >> (k)) & 1) { __VA_ARGS__; xcd_barrier(bar); } } while (0)
    const pg8::StaticOrder S0{};
    if (IN(0)) { DBL(0, p0_prologue(F, 1)); p0_prologue(F, bslot); SEAM(0); }
    if (IN(1)) { DBL(1, p1_modulate(F)); p1_modulate(F); SEAM(1); }
    if (IN(2)) {
        const pg8::Gemm g = pg8::gemm_f8(WSP(unsigned char, WS_S0), WSP(unsigned char, WS_WIN), NT, NPROJ, DM, DM, DM); pg8::StaticOrder S; S.init(NT, NPROJ, F.G, F.blk);
        EpiProj E{WSP(bf16, WS_XR), WSP(bf16, WS_GG), WSP(unsigned char, WS_QKVC), WSP(unsigned char, WS_KVC8), WSP(bf16, WS_SGR), WSP(bf16, WS_SGM), WSP(float, WS_KR), WSP(float, WS_SSP), 1.0f / (SC_H * SC_WIN)};
        DBL(2, pg8::gemm_phase<EpiProj, pg8::StaticOrder, true, false>(F.lds, g, S, E, F.wave)); pg8::gemm_phase<EpiProj, pg8::StaticOrder, true, true>(F.lds, g, S, E, F.wave); SEAM(2); }
    if (IN(3)) { DBL(3, rglru_passA(F)); rglru_passA(F); SEAM(3); }
    if (IN(4)) {
        rglru_passB(F);
        constexpr float ESC6 = 1.0f / (SC_H * SC_WIN);
        { const pg8::Gemm g = pg8::gemm_f8(WSP(unsigned char, WS_QKVC), WSP(unsigned char, WS_WUQ), NT, 3072, 512, 512, 512); pg8::StaticOrder S; S.init(NT, 3072, F.G, F.blk);
          EpiQ E{(unsigned char*)F.out + OUT_Q, WSP(float, WS_RS), WSP(f32x2, WS_ROPE), ESC6}; pg8::gemm_phase<EpiQ, pg8::StaticOrder, true>(F.lds, g, S, E, F.wave); }
        { const pg8::Gemm g = pg8::gemm_f8(WSP(unsigned char, WS_KVC8), WSP(unsigned char, WS_WUK), NT, 2048, 512, 512, 512); pg8::StaticOrder S; S.init(NT, 2048, F.G, F.blk);
          EpiK E{(unsigned char*)F.out + OUT_K, WSP(float, WS_RS), ESC6}; pg8::gemm_phase<EpiK, pg8::StaticOrder, true>(F.lds, g, S, E, F.wave); }
        { const pg8::Gemm g = pg8::gemm_f8(WSP(unsigned char, WS_WUV), WSP(unsigned char, WS_KVC8), 2048, NT, 512, 512, 512); pg8::StaticOrder S; S.init(2048, NT, F.G, F.blk);
          EpiVT E{(unsigned char*)F.out + OUT_VT, WSP(float, WS_RS), ESC6}; pg8::gemm_phase<EpiVT, pg8::StaticOrder, true>(F.lds, g, S, E, F.wave); }
        krope_fill(F); SEAM(4); }
    if (IN(5)) {
#ifdef PROBE_ATTN
#pragma unroll 1
        for (int rep = 0; rep < PROBE_ATTN; ++rep) { attn_phase(F); xcd_barrier(bar); }
#else
        attn_phase(F);
#endif
        SEAM(5); }
    if (IN(6)) {
        pg8::Gemm g = pg8::gemm_f8(WSP(unsigned char, WS_S0), WSP(unsigned char, WS_WRNN), NT, DM, 2 * DM, DM, DM); g.A2 = WSP(unsigned char, WS_AO8); g.Bt2 = WSP(unsigned char, WS_WMLA); g.nt1 = DM / 128;
        pg8::StaticOrder S; S.init(NT, DM, F.G, F.blk);
        EpiMix E{WSP(bf16, WS_SGR), WSP(bf16, WS_SGM), WSP(unsigned char, WS_TMP8), SC_AO / SC_RA, 1.0f / (SC_AO * SC_WSQ)};
        pg8::gemm_phase<EpiMix, pg8::StaticOrder, true>(F.lds, g, S, E, F.wave); SEAM(6); }
    if (IN(7)) {
#ifdef PROBE_GEMM
#if PROBE_GEMM == 1
#define PROBE_ONE { pg8::Gemm gp = pg8::gemm_f8(WSP(unsigned char, WS_TMP8), WSP(unsigned char, WS_WO), NT, DM, DM, DM, DM); gp.nt = PROBE_NT; pg8::StaticOrder Sp; Sp.init(NT, DM, F.G, F.blk); \
            EpiRes1 Ep{F.x, WSP(float, WS_MOD), WSP(bf16, WS_PQ), 1.0f}; pg8::gemm_phase<EpiRes1, pg8::StaticOrder, true>(F.lds, gp, Sp, Ep, F.wave); xcd_barrier(bar); }
#elif PROBE_GEMM == 3
#define PROBE_ONE { pg8::Gemm gp = pg8::gemm_f8(WSP(unsigned char, WS_TMP8), WSP(unsigned char, WS_WO), NT, DM, DM, DM, DM); gp.nt = PROBE_NT; pg8::StaticOrder Sp; Sp.init(NT, DM, F.G, F.blk); \
            EpiPlain Ep{WSP(bf16, WS_PQ), 1.0f}; pg8::gemm_phase<EpiPlain, pg8::StaticOrder, true, true>(F.lds, gp, Sp, Ep, F.wave); xcd_barrier(bar); }
#elif PROBE_GEMM == 5
#define PROBE_ONE { pg8::Gemm gp = pg8::gemm_f8(WSP(unsigned char, WS_TMP8), WSP(unsigned char, WS_WO), NT, DM, DM, DM, DM); gp.nt = PROBE_NT; pg8::StaticOrder Sp; Sp.init(NT, DM, F.G, F.blk); \
            EpiNull Ep{WSP(float, WS_PQ)}; pg8::gemm_phase<EpiNull, pg8::StaticOrder, true, true>(F.lds, gp, Sp, Ep, F.wave); xcd_barrier(bar); }
#elif PROBE_GEMM == 4
#define PROBE_ONE { pg8::Gemm gp = pg8::gemm_bf16(WSP(bf16, WS_TMP), WSP(bf16, WS_WPQ), NT, DM, DM, DM, DM); gp.nt = PROBE_NT; pg8::StaticOrder Sp; Sp.init(NT, DM, F.G, F.blk); \
            EpiPlain Ep{WSP(bf16, WS_PQ), 1.0f}; pg8::gemm_phase<EpiPlain, pg8::StaticOrder>(F.lds, gp, Sp, Ep, F.wave); xcd_barrier(bar); }
#endif
#ifndef PROBE_PRB
#define PROBE_PRB 0
#endif
#ifndef PROBE_REP
#define PROBE_REP 1
#endif
        PROBE_ONE
#if PROBE_REP >= 2
        PROBE_ONE
#endif
#if PROBE_REP >= 3
        PROBE_ONE
#endif
#if PROBE_REP >= 4
        PROBE_ONE
#endif
#endif
        const pg8::Gemm g = pg8::gemm_f8(WSP(unsigned char, WS_TMP8), WSP(unsigned char, WS_WO), NT, DM, DM, DM, DM); pg8::StaticOrder S; S.init(NT, DM, F.G, F.blk);
        EpiRes1 E{F.x, WSP(float, WS_MOD), WSP(bf16, WS_R1), 1.0f / (SC_TMP * SC_WSQ)};
        pg8::gemm_phase<EpiRes1, pg8::StaticOrder, true>(F.lds, g, S, E, F.wave); SEAM(7); }
    if (IN(8)) { ln1_phase(F); SEAM(8); }
    if (IN(9)) {
        const pg8::Gemm g = pg8::gemm_f8(WSP(unsigned char, WS_H2I), WSP(unsigned char, WS_WPQ), NT, DM, DM, DM, DM); pg8::StaticOrder S; S.init(NT, DM, F.G, F.blk);
        EpiQuery E{WSP(bf16, WS_PQ), WSP(float, WS_HSC), WSP(float, WS_WQS)};
        pg8::gemm_phase<EpiQuery, pg8::StaticOrder, 2>(F.lds, g, S, E, F.wave); SEAM(9); }
#ifdef PROBE_BARS
#pragma unroll 1
    for (int r = 0; r < PROBE_BARS; ++r) xcd_barrier(bar);
#endif
    if (IN(10)) { DBL(10, peer_score_phase(F)); peer_score_phase(F); SEAM(10); }
    if (IN(11)) { DBL(11, peer_eval_phase(F)); peer_eval_phase(F); }
#undef IN
#undef SEAM
}

#ifdef PROBE_ATTN_PRB
__global__ void __launch_bounds__(NTHREADS, 2) attn_probe_kernel(Args args) {
    extern __shared__ __attribute__((aligned(16))) unsigned char lds_raw[];
    Frame F;
    F.lds = (LAS unsigned char*)lds_raw; F.tid = threadIdx.x; F.lane = F.tid & 63; F.wave = __builtin_amdgcn_readfirstlane(F.tid >> 6); F.G = gridDim.x; F.blk = blockIdx.x; F.out = args.out; F.ws = args.ws;
    attn_phase<32 | PROBE_ATTN_PRB>(F);
}
#endif
#ifdef DBG_STOP
__global__ void dbg_dump(const unsigned char* ws, size_t off, int is_f32, float* out) {
    const size_t n = (size_t)NT * DM; const size_t i0 = (size_t)blockIdx.x * blockDim.x + threadIdx.x, st = (size_t)gridDim.x * blockDim.x;
    if (is_f32) { const float* s = (const float*)(ws + off); for (size_t i = i0; i < n; i += st) out[i] = s[i]; }
    else { const bf16* s = (const bf16*)(ws + off); for (size_t i = i0; i < n; i += st) out[i] = i < (size_t)DBG_N ? bf1(s[i]) : 0.f; }
}
__global__ void dbg_count(const unsigned char* ws, size_t off, float lo, float hi, unsigned* cnt) {
    if (blockIdx.x != 0) return;
    const int pm = 3, ct = 2; const bf16* s = (const bf16*)(ws + off); __shared__ unsigned rowbad[256], colbad[256];
    rowbad[threadIdx.x] = 0; colbad[threadIdx.x] = 0; __syncthreads();
    for (int i = threadIdx.x; i < 65536; i += blockDim.x) { const int r = i >> 8, cc = i & 255; const float v = bf1(s[(size_t)(pm * 256 + r) * DM + ct * 256 + cc]); if (!(v >= lo && v <= hi)) { rowbad[r] = 1; colbad[cc] = 1; } }
    __syncthreads();
    if (threadIdx.x == 0) { unsigned nr = 0, nc = 0, fr = 999, fc = 999; for (int i = 0; i < 256; ++i) { if (rowbad[i]) { ++nr; if (fr == 999) fr = i; } if (colbad[i]) { ++nc; if (fc == 999) fc = i; } }
        cnt[0] = nr + 10; cnt[1] = nc + 10; cnt[2] = fr + 10; cnt[3] = fc + 10; }
}
__global__ void dbg_report(const unsigned* cnt, float* out) {
    const size_t n = (size_t)NT * DM; const size_t i0 = (size_t)blockIdx.x * blockDim.x + threadIdx.x, st = (size_t)gridDim.x * blockDim.x;
    const float v = (float)cnt[DBG_WHICH];
    for (size_t i = i0; i < n; i += st) out[i] = (i == 0) ? v : 0.f;
}
#endif
#ifdef PROBE_MB
template <int NM, int NV, int VT>
__global__ void __launch_bounds__(NTHREADS, 2) mb_kernel(float* sink, int iters) {
    const int lane = threadIdx.x & 63; unsigned h = (unsigned)(threadIdx.x + 512 * blockIdx.x) * 0x9E3779B9u + 0x7F4A7C15u;
    i32x8 a, b; for (int e = 0; e < 8; ++e) { h = h * 1664525u + 1013904223u; a[e] = (int)(h & 0x3F3F3F3Fu); h = h * 1664525u + 1013904223u; b[e] = (int)(h & 0x3F3F3F3Fu) ^ 0x00800080; }
    f32x16 acc[4]; for (int q = 0; q < 4; ++q) for (int e = 0; e < 16; ++e) acc[q][e] = 0.f;
    float v[12]; for (int e = 0; e < 12; ++e) v[e] = 0.001f * (float)(lane + e);
    const float c1 = 0.999f, c2 = 0.0007f;
#pragma unroll 1
    for (int it = 0; it < iters; ++it) {
#pragma unroll
        for (int q = 0; q < 4; ++q) {
            if (NM) acc[q] = __builtin_amdgcn_mfma_scale_f32_32x32x64_f8f6f4(a, b, acc[q], 0, 0, 0, 0x7F7F7F7F, 0, 0x7F7F7F7F);
            __builtin_amdgcn_sched_barrier(0);
#pragma unroll
            for (int e = 0; e < NV; ++e) v[e] = VT ? __builtin_amdgcn_exp2f(v[e]) : __builtin_fmaf(v[e], c1, c2);
            __builtin_amdgcn_sched_barrier(0);
        }
    }
    float sacc = 0.f; for (int q = 0; q < 4; ++q) for (int e = 0; e < 16; ++e) sacc += acc[q][e]; for (int e = 0; e < 12; ++e) sacc += v[e];
    sink[(size_t)blockIdx.x * 512 + threadIdx.x] = sacc;
}
#endif
extern "C" void kernel_launch(void* const* d_in, const int* in_sizes, int n_in, void* d_out, int out_size, void* d_ws, size_t ws_size, hipStream_t stream) {
    static int grid = 0;
    if (grid == 0) {
        if (n_in != 28 || out_size != NT * DM || ws_size < WS_END) { fprintf(stderr, "kernel_launch: unexpected shapes (n_in %d, out %d, ws %zu)\n", n_in, out_size, ws_size); grid = -1; return; }
        int dev = 0, cus = 0, per_cu = 0;
        if (hipGetDevice(&dev) != hipSuccess || hipDeviceGetAttribute(&cus, hipDeviceAttributeMultiprocessorCount, dev) != hipSuccess) { grid = -1; return; }
        if (hipFuncSetAttribute((const void*)fwd_kernel, hipFuncAttributeMaxDynamicSharedMemorySize, LDS_BYTES) != hipSuccess) { fprintf(stderr, "kernel_launch: hipFuncSetAttribute failed\n"); grid = -1; return; }
        if (hipOccupancyMaxActiveBlocksPerMultiprocessor(&per_cu, (const void*)fwd_kernel, NTHREADS, LDS_BYTES) != hipSuccess || per_cu < 1)
            fprintf(stderr, "kernel_launch: occupancy query reports %d workgroups per CU\n", per_cu);
        (void)hipGetLastError();
        grid = cus;
    }
    if (grid < 0) return;
    if (hipMemsetAsync((char*)d_ws + WS_CTL, 0, CTL_ZERO_BYTES, stream) != hipSuccess) return;
#ifdef PROBE_MB
    hipLaunchKernelGGL((mb_kernel<PROBE_MB_NM, PROBE_MB_NV, PROBE_MB_VT>), dim3(grid), dim3(NTHREADS), 0, stream, (float*)((char*)d_ws + WS_XR), 4000);
#endif
    Args a{};
    for (int i = 0; i < 28; ++i) a.in[i] = (const float*)d_in[i];
    a.out = (float*)d_out; a.ws = (unsigned char*)d_ws;
#ifdef PROBE_RELAUNCH
    a.ph_lo = 0; a.ph_hi = PROBE_RELAUNCH + 1; a.bslot = 0;
    hipLaunchKernelGGL(fwd_kernel, dim3(grid), dim3(NTHREADS), LDS_BYTES, stream, a);
#ifdef PROBE_ATTN_PRB
    { static bool once = false; if (!once) { once = true; (void)hipFuncSetAttribute((const void*)attn_probe_kernel, hipFuncAttributeMaxDynamicSharedMemorySize, LDS_BYTES); } }
    for (int r = 0; r < PROBE_RELAUNCH_N; ++r) hipLaunchKernelGGL(attn_probe_kernel, dim3(grid), dim3(NTHREADS), LDS_BYTES, stream, a);
#else
    for (int r = 0; r < PROBE_RELAUNCH_N; ++r) { a.ph_lo = PROBE_RELAUNCH; a.ph_hi = PROBE_RELAUNCH + 1; a.bslot = 2 + r; hipLaunchKernelGGL(fwd_kernel, dim3(grid), dim3(NTHREADS), LDS_BYTES, stream, a); }
#endif
    if (PROBE_RELAUNCH + 1 < NPHASE) { a.ph_lo = PROBE_RELAUNCH + 1; a.ph_hi = NPHASE; a.bslot = 1; hipLaunchKernelGGL(fwd_kernel, dim3(grid), dim3(NTHREADS), LDS_BYTES, stream, a); }
#elif MK_N_LAUNCHES == 1
    a.ph_lo = 0; a.ph_hi = NPHASE;
    hipLaunchKernelGGL(fwd_kernel, dim3(grid), dim3(NTHREADS), LDS_BYTES, stream, a);
#else
#ifdef DBG_STOP
    for (int p = 0; p <= DBG_STOP; ++p) { a.ph_lo = p; a.ph_hi = p + 1; hipLaunchKernelGGL(fwd_kernel, dim3(grid), dim3(NTHREADS), LDS_BYTES, stream, a); }
#ifdef DBG_COUNT
        hipLaunchKernelGGL(dbg_count, dim3(1024), dim3(256), 0, stream, (const unsigned char*)d_ws, (size_t)DBG_OFF, DBG_LO, DBG_HI, (unsigned*)d_ws + 1024);
    hipLaunchKernelGGL(dbg_report, dim3(2048), dim3(256), 0, stream, (const unsigned*)d_ws + 1024, (float*)d_out);
#else
    hipLaunchKernelGGL(dbg_dump, dim3(2048), dim3(256), 0, stream, (const unsigned char*)d_ws, (size_t)DBG_OFF, DBG_F32, (float*)d_out);
#endif
#else
    for (int p = 0; p < NPHASE; ++p) { a.ph_lo = p; a.ph_hi = p + 1; hipLaunchKernelGGL(fwd_kernel, dim3(grid), dim3(NTHREADS), LDS_BYTES, stream, a); }
#endif
#endif
    const hipError_t le = hipPeekAtLastError();
    if (le != hipSuccess) fprintf(stderr, "kernel_launch: launch failed: %s\n", hipGetErrorName(le));
}
```
